# Optimizing an MI355X kernel written in HIP

```python
import jax, jax.numpy as jnp
from jax import lax
import numpy as np

D_MODEL = 1024
BATCH = 4
SEQ = 4096
DEPTH = 1
DEC_BATCH = 128
DEC_SEQ = 8
PAST_LEN = 8192
PAGE_SIZE = 128

N_MEM = 256
MLA_HEADS = 8
QK_NOPE = 64
QK_ROPE = 32
V_HEAD = 64
Q_LORA = 256
KV_LORA = 128
MLA_W = MLA_HEADS * V_HEAD
MLA_SCALE = (QK_NOPE + QK_ROPE) ** -0.5
ROPE_BASE = 10000.0
RWKV_HEADS = 4
RWKV_N = 64
RWKV_W = RWKV_HEADS * RWKV_N
DECAY_LORA = 64
AAA_LORA = 64
SHIFT_COLS = 3 * RWKV_W + DECAY_LORA + AAA_LORA
GN_EPS = 64e-5
X_HEADS = 4
X_HEAD_DIM = 64
X_W = X_HEADS * X_HEAD_DIM
X_SCALE = X_HEAD_DIM ** -0.5
MIX_W = MLA_W + RWKV_W + X_W
IN_SPLITS = (Q_LORA, KV_LORA, QK_ROPE, MLA_W, SHIFT_COLS, RWKV_W, X_W, X_W)
IN_COLS = Q_LORA + KV_LORA + QK_ROPE + MLA_W + SHIFT_COLS + RWKV_W + X_W + X_W
Q_BLOCK = 128
RMS_EPS = 1e-6
NEG_INF = -1e30

kernel_name = 'hymba_mla_rwkv7_memory_decoder_step'


def rmsnorm(x, g):
    xf = x.astype(jnp.float32)
    y = xf * lax.rsqrt(jnp.mean(jnp.square(xf), axis=-1, keepdims=True) + RMS_EPS)
    return (y * g.astype(jnp.float32)).astype(x.dtype)


def rope(x, pos):
    r = x.shape[-1]
    half = r // 2
    inv = 1.0 / (ROPE_BASE ** (jnp.arange(half, dtype=jnp.float32) * (2.0 / r)))
    ang = pos.astype(jnp.float32)[:, None] * inv[None, :]
    ang = ang.reshape((1, ang.shape[0]) + (1,) * (x.ndim - 3) + (half,))
    c, s = jnp.cos(ang), jnp.sin(ang)
    xf = x.astype(jnp.float32)
    x1, x2 = xf[..., :half], xf[..., half:]
    return jnp.concatenate([x1 * c - x2 * s, x2 * c + x1 * s], axis=-1).astype(x.dtype)


def mixer_inputs(x, pos, ln_g, w_in, q_norm_g, kv_norm_g, w_uq):
    B, T, _ = x.shape
    h = rmsnorm(x, ln_g)
    proj = jnp.einsum('btd,dc->btc', h, w_in)
    c_q, c_kv, k_r, g_mla, z, g_rwkv, q_x, g_x = jnp.split(proj, np.cumsum(IN_SPLITS)[:-1], axis=-1)
    q = jnp.einsum('btc,chd->bthd', rmsnorm(c_q, q_norm_g), w_uq)
    q_nope = q[..., :QK_NOPE]
    q_pe = rope(q[..., QK_NOPE:], pos)
    c_kv = rmsnorm(c_kv, kv_norm_g)
    k_pe = rope(k_r, pos)
    q_x = q_x.reshape(B, T, X_HEADS, X_HEAD_DIM)
    return q_nope, q_pe, c_kv, k_pe, g_mla, z, g_rwkv, q_x, g_x


def mla_prompt_attention(q_nope, q_pe, k_nope, k_pe, v):
    B, S, H, _ = q_nope.shape
    nb = S // Q_BLOCK
    blk = lambda t: jnp.moveaxis(t.reshape((B, nb, Q_BLOCK) + t.shape[2:]), 1, 0)
    kpos = jnp.arange(S)

    def one_block(args):
        i, qn, qp = args
        s = jnp.einsum('bqhd,bkhd->bhqk', qn, k_nope) + jnp.einsum('bqhr,bkr->bhqk', qp, k_pe)
        qpos = i * Q_BLOCK + jnp.arange(Q_BLOCK)
        s = jnp.where(kpos[None, :] <= qpos[:, None], s.astype(jnp.float32) * MLA_SCALE, NEG_INF)
        p = jax.nn.softmax(s, axis=-1).astype(v.dtype)
        return jnp.einsum('bhqk,bkhd->bqhd', p, v)

    o = lax.map(one_block, (jnp.arange(nb), blk(q_nope), blk(q_pe)))
    return jnp.moveaxis(o, 0, 1).reshape(B, S, H * V_HEAD)


def mla_sample_attention(q_nope, q_pe, c_kv, k_pe, ckv_past, kpe_past, w_uk, w_uv):
    B, T, H, _ = q_nope.shape
    P = ckv_past.shape[1]
    q_lat = jnp.einsum('bthd,chd->bthc', q_nope, w_uk)
    s_past = jnp.einsum('bthc,bkc->bhtk', q_lat, ckv_past) + jnp.einsum('bthr,bkr->bhtk', q_pe, kpe_past)
    s_new = jnp.einsum('bthc,buc->bhtu', q_lat, c_kv) + jnp.einsum('bthr,bur->bhtu', q_pe, k_pe)
    causal = jnp.tril(jnp.ones((T, T), dtype=bool))
    s = jnp.concatenate([s_past.astype(jnp.float32) * MLA_SCALE,
                         jnp.where(causal, s_new.astype(jnp.float32) * MLA_SCALE, NEG_INF)], axis=-1)
    p = jax.nn.softmax(s, axis=-1).astype(c_kv.dtype)
    o_lat = jnp.einsum('bhtk,bkc->bthc', p[..., :P], ckv_past) + jnp.einsum('bhtu,buc->bthc', p[..., P:], c_kv)
    return jnp.einsum('bthc,chd->bthd', o_lat, w_uv).reshape(B, T, H * V_HEAD)


def wkv_step(S, inp):
    r_t, w_t, k_t, v_t, kk_t, a_t = inp
    sa = jnp.einsum('bhvk,bhk->bhv', S, -kk_t)
    S = S * w_t[:, :, None, :] + sa[..., None] * (kk_t * a_t)[:, :, None, :] + v_t[..., None] * k_t[:, :, None, :]
    y = jnp.einsum('bhvk,bhk->bhv', S, r_t)
    return S, y


def rwkv7_branch(z, prev_row, wkv0, mu, w0, w_up, a0, a_up, k_k, k_a, r_k, lnx_g, lnx_b):
    B, T, _ = z.shape
    f32 = jnp.float32
    prev = jnp.concatenate([prev_row[:, None, :].astype(z.dtype), z[:, :-1]], axis=1)
    zm = z + (prev - z) * mu
    r, k, v, wd, ad = jnp.split(zm, [RWKV_W, 2 * RWKV_W, 3 * RWKV_W, 3 * RWKV_W + DECAY_LORA], axis=-1)
    w = -jax.nn.softplus(-(w0 + jnp.tanh(wd) @ w_up).astype(f32)) - 0.5
    decay = jnp.exp(-jnp.exp(w))
    a = jax.nn.sigmoid((a0 + ad @ a_up).astype(f32))
    heads = lambda t: t.reshape(B, T, RWKV_HEADS, RWKV_N)
    kf = k.astype(f32)
    kk = heads(kf * k_k.astype(f32))
    kk = kk / jnp.maximum(jnp.sqrt(jnp.sum(jnp.square(kk), axis=-1, keepdims=True)), 1e-12)
    kf = heads(kf * (1.0 + (a - 1.0) * k_a.astype(f32)))
    rf, vf, decay, a = heads(r.astype(f32)), heads(v.astype(f32)), heads(decay), heads(a)
    tm = lambda t: jnp.swapaxes(t, 0, 1)
    S_fin, ys = lax.scan(wkv_step, wkv0.astype(f32), (tm(rf), tm(decay), tm(kf), tm(vf), tm(kk), tm(a)))
    y = tm(ys)
    mean = jnp.mean(y, axis=-1, keepdims=True)
    var = jnp.mean(jnp.square(y - mean), axis=-1, keepdims=True)
    y = ((y - mean) * lax.rsqrt(var + GN_EPS)).reshape(B, T, RWKV_W) * lnx_g.astype(f32) + lnx_b.astype(f32)
    bonus = jnp.sum(rf * kf * r_k.astype(f32), axis=-1, keepdims=True) * vf
    out = y + bonus.reshape(B, T, RWKV_W)
    return out.astype(z.dtype), S_fin.astype(z.dtype), z[:, -1]


def memory_kv(mem, g, w):
    kv = jnp.einsum('bmd,dchk->cbmhk', rmsnorm(mem, g), w)
    return kv[0], kv[1]


def memory_attention(q, mem_k, mem_v):
    B, T = q.shape[0], q.shape[1]
    s = jnp.einsum('bthd,bmhd->bhtm', q, mem_k).astype(jnp.float32) * X_SCALE
    p = jax.nn.softmax(s, axis=-1).astype(mem_v.dtype)
    return jnp.einsum('bhtm,bmhd->bthd', p, mem_v).reshape(B, T, X_W)


def mixer_output(x, mla_o, rwkv_o, x_o, g_mla, g_rwkv, g_x, w_out):
    mixed = jnp.concatenate([mla_o * jax.nn.silu(g_mla), rwkv_o * jax.nn.silu(g_rwkv), x_o * jax.nn.silu(g_x)], axis=-1)
    return x + jnp.einsum('btc,cd->btd', mixed, w_out)


def setup_inputs(seed: int = 0) -> dict:
    key = jax.random.key(seed)
    ks = iter(jax.random.split(key, 40))
    f32 = jnp.float32
    nrm = lambda shape, scale: jax.random.normal(next(ks), shape, f32) * scale
    n_pages = PAST_LEN // PAGE_SIZE
    n_used = DEC_BATCH * n_pages
    n_pool = n_used + n_used // 4
    d = {}
    d['x_prompt'] = nrm((BATCH, SEQ, D_MODEL), 1.0)
    d['x_sample'] = nrm((DEC_BATCH, DEC_SEQ, D_MODEL), 1.0)
    d['mem_prompt'] = nrm((BATCH, N_MEM, D_MODEL), 1.0)
    d['cache_ckv'] = nrm((DEPTH, n_pool, PAGE_SIZE, KV_LORA), 1.0)
    d['cache_kpe'] = nrm((DEPTH, n_pool, PAGE_SIZE, QK_ROPE), 1.0)
    d['page_table'] = jax.random.permutation(next(ks), n_pool)[:n_used].reshape(DEC_BATCH, n_pages).astype(jnp.int32)
    d['state_wkv'] = nrm((DEPTH, DEC_BATCH, RWKV_HEADS, RWKV_N, RWKV_N), 0.1)
    d['state_shift'] = nrm((DEPTH, DEC_BATCH, SHIFT_COLS), 1.0)
    d['cache_mem_k'] = nrm((DEPTH, DEC_BATCH, N_MEM, X_HEADS, X_HEAD_DIM), 1.0)
    d['cache_mem_v'] = nrm((DEPTH, DEC_BATCH, N_MEM, X_HEADS, X_HEAD_DIM), 1.0)
    d['ln_g'] = 1.0 + nrm((DEPTH, D_MODEL), 0.05)
    d['w_in'] = nrm((DEPTH, D_MODEL, IN_COLS), D_MODEL ** -0.5)
    d['q_norm_g'] = 1.0 + nrm((DEPTH, Q_LORA), 0.05)
    d['kv_norm_g'] = 1.0 + nrm((DEPTH, KV_LORA), 0.05)
    d['w_uq'] = nrm((DEPTH, Q_LORA, MLA_HEADS, QK_NOPE + QK_ROPE), Q_LORA ** -0.5)
    d['w_uk'] = nrm((DEPTH, KV_LORA, MLA_HEADS, QK_NOPE), KV_LORA ** -0.5)
    d['w_uv'] = nrm((DEPTH, KV_LORA, MLA_HEADS, V_HEAD), KV_LORA ** -0.5)
    d['shift_mu'] = jax.random.uniform(next(ks), (DEPTH, SHIFT_COLS), f32, 0.0, 1.0)
    d['w0'] = jax.random.uniform(next(ks), (DEPTH, RWKV_W), f32, -2.0, 1.0)
    d['w_up'] = nrm((DEPTH, DECAY_LORA, RWKV_W), 0.1 * DECAY_LORA ** -0.5)
    d['a0'] = nrm((DEPTH, RWKV_W), 0.1)
    d['a_up'] = nrm((DEPTH, AAA_LORA, RWKV_W), 0.5 * AAA_LORA ** -0.5)
    d['k_k'] = 0.85 + nrm((DEPTH, RWKV_W), 0.05)
    d['k_a'] = 1.0 + nrm((DEPTH, RWKV_W), 0.05)
    d['r_k'] = nrm((DEPTH, RWKV_HEADS, RWKV_N), 0.1)
    d['lnx_g'] = 1.0 + nrm((DEPTH, RWKV_W), 0.05)
    d['lnx_b'] = nrm((DEPTH, RWKV_W), 0.01)
    d['mem_norm_g'] = 1.0 + nrm((DEPTH, D_MODEL), 0.05)
    d['w_mem_kv'] = nrm((DEPTH, D_MODEL, 2, X_HEADS, X_HEAD_DIM), D_MODEL ** -0.5)
    d['w_out'] = nrm((DEPTH, MIX_W, D_MODEL), MIX_W ** -0.5)
    d['final_g'] = 1.0 + nrm((D_MODEL,), 0.05)
    return d


def reference(x_prompt, x_sample, mem_prompt, cache_ckv, cache_kpe, page_table, state_wkv, state_shift,
              cache_mem_k, cache_mem_v, ln_g, w_in, q_norm_g, kv_norm_g, w_uq, w_uk, w_uv, shift_mu, w0, w_up,
              a0, a_up, k_k, k_a, r_k, lnx_g, lnx_b, mem_norm_g, w_mem_kv, w_out, final_g):
    B, S, _ = x_prompt.shape
    DB, T, _ = x_sample.shape
    past_len = page_table.shape[1] * cache_ckv.shape[2]
    pos_p = jnp.arange(S, dtype=jnp.int32)
    pos_s = past_len + jnp.arange(T, dtype=jnp.int32)
    xp, xs = x_prompt, x_sample
    p_ckv, p_kpe, p_wkv, p_shift, p_mk, p_mv = [], [], [], [], [], []
    s_ckv, s_kpe, s_wkv, s_shift = [], [], [], []
    for l in range(DEPTH):
        rw = (shift_mu[l], w0[l], w_up[l], a0[l], a_up[l], k_k[l], k_a[l], r_k[l], lnx_g[l], lnx_b[l])
        qn, qp, ckv, kpe, g_mla, z, g_rwkv, qx, gx = mixer_inputs(xp, pos_p, ln_g[l], w_in[l], q_norm_g[l], kv_norm_g[l], w_uq[l])
        k_nope = jnp.einsum('btc,chd->bthd', ckv, w_uk[l])
        v = jnp.einsum('btc,chd->bthd', ckv, w_uv[l])
        mla_o = mla_prompt_attention(qn, qp, k_nope, kpe, v)
        zero_shift = jnp.zeros((B, SHIFT_COLS), xp.dtype)
        zero_wkv = jnp.zeros((B, RWKV_HEADS, RWKV_N, RWKV_N), xp.dtype)
        rw_o, wkv_p, shift_p = rwkv7_branch(z, zero_shift, zero_wkv, *rw)
        mk, mv = memory_kv(mem_prompt, mem_norm_g[l], w_mem_kv[l])
        x_o = memory_attention(qx, mk, mv)
        xp = mixer_output(xp, mla_o, rw_o, x_o, g_mla, g_rwkv, gx, w_out[l])
        p_ckv.append(ckv); p_kpe.append(kpe); p_wkv.append(wkv_p); p_shift.append(shift_p); p_mk.append(mk); p_mv.append(mv)
        qn, qp, ckv, kpe, g_mla, z, g_rwkv, qx, gx = mixer_inputs(xs, pos_s, ln_g[l], w_in[l], q_norm_g[l], kv_norm_g[l], w_uq[l])
        ckv_past = cache_ckv[l][page_table].reshape(DB, past_len, KV_LORA)
        kpe_past = cache_kpe[l][page_table].reshape(DB, past_len, QK_ROPE)
        mla_o = mla_sample_attention(qn, qp, ckv, kpe, ckv_past, kpe_past, w_uk[l], w_uv[l])
        rw_o, wkv_s, shift_s = rwkv7_branch(z, state_shift[l], state_wkv[l], *rw)
        x_o = memory_attention(qx, cache_mem_k[l], cache_mem_v[l])
        xs = mixer_output(xs, mla_o, rw_o, x_o, g_mla, g_rwkv, gx, w_out[l])
        s_ckv.append(ckv); s_kpe.append(kpe); s_wkv.append(wkv_s); s_shift.append(shift_s)
    y_prompt = rmsnorm(xp, final_g)
    y_sample = rmsnorm(xs, final_g)
    return (y_prompt, y_sample,
            jnp.stack(p_ckv), jnp.stack(p_kpe), jnp.stack(p_wkv), jnp.stack(p_shift), jnp.stack(p_mk), jnp.stack(p_mv),
            jnp.stack(s_ckv), jnp.stack(s_kpe), jnp.stack(s_wkv), jnp.stack(s_shift))
```

```cpp
#include <hip/hip_runtime.h>
#include <hip/hip_cooperative_groups.h>
#include <cstdio>
#include <cstdint>
namespace cg = cooperative_groups;

constexpr int DM = 1024, BATCH = 4, SEQ = 4096, DB = 128, DT = 8, PAST = 8192, PAGE = 128, NPG = 64, NMEM = 256;
constexpr int NP = BATCH * SEQ, NS = DB * DT, NT = NP + NS;
constexpr int INC = 2592;
constexpr int C_CQ = 0, C_CKV = 256, C_KR = 384, C_GMLA = 416, C_Z = 928, C_GRWKV = 1824, C_QX = 2080, C_GX = 2336;
constexpr float MLA_SCALE = 0.10206207261596575f;
constexpr float X_SCALE = 0.125f;
constexpr float RMS_EPS = 1e-6f, GN_EPS = 64e-5f;
constexpr size_t O_YP = 0, O_YS = 16777216, O_CKVP = 17825792, O_KPEP = 19922944, O_WKVP = 20447232, O_SHP = 20512768,
                 O_MKP = 20516352, O_MVP = 20778496, O_CKVS = 21040640, O_KPES = 21171712, O_WKVS = 21204480, O_SHS = 23301632;
constexpr size_t W_H = 0;
constexpr size_t W_HM = W_H + (size_t)NT * 1024;
constexpr size_t W_PROJ = W_HM + (size_t)1024 * 1024;
constexpr size_t W_CQN = W_PROJ + (size_t)NT * INC;
constexpr size_t W_Q = W_CQN + (size_t)NT * 256;
constexpr size_t W_KN = W_Q + (size_t)NT * 768;
constexpr size_t W_V = W_KN + (size_t)NP * 512;
constexpr size_t W_QLAT = W_V + (size_t)NP * 512;
constexpr size_t W_OLAT = W_QLAT + (size_t)NS * 1024;
constexpr size_t W_R = W_OLAT + (size_t)NS * 1024;
constexpr size_t W_W = W_R + (size_t)NT * 256;
constexpr size_t W_KF = W_W + (size_t)NT * 256;
constexpr size_t W_VV = W_KF + (size_t)NT * 256;
constexpr size_t W_KK = W_VV + (size_t)NT * 256;
constexpr size_t W_BB = W_KK + (size_t)NT * 256;
constexpr size_t W_MIX = W_BB + (size_t)NT * 256;
constexpr size_t W_END = W_MIX + (size_t)NT * 1024;

struct Params {
  const float* x_prompt; const float* x_sample; const float* mem_prompt; const float* cache_ckv; const float* cache_kpe;
  const int* page_table; const float* state_wkv; const float* state_shift; const float* cache_mem_k; const float* cache_mem_v;
  const float* ln_g; const float* w_in; const float* q_norm_g; const float* kv_norm_g; const float* w_uq; const float* w_uk;
  const float* w_uv; const float* shift_mu; const float* w0; const float* w_up; const float* a0; const float* a_up;
  const float* k_k; const float* k_a; const float* r_k; const float* lnx_g; const float* lnx_b; const float* mem_norm_g;
  const float* w_mem_kv; const float* w_out; const float* final_g;
  float* out; float* ws;
};

__device__ __forceinline__ float wave_sum(float v) {
#pragma unroll
  for (int o = 1; o < 64; o <<= 1) v += __shfl_xor(v, o);
  return v;
}
__device__ __forceinline__ float wave_max(float v) {
#pragma unroll
  for (int o = 1; o < 64; o <<= 1) v = fmaxf(v, __shfl_xor(v, o));
  return v;
}
__device__ __forceinline__ float silu(float x) { return x / (1.f + expf(-x)); }
__device__ __forceinline__ const float* xrow(const Params& p, int row) {
  return row < NP ? p.x_prompt + (size_t)row * DM : p.x_sample + (size_t)(row - NP) * DM;
}
__device__ __forceinline__ float* ckv_out_row(const Params& p, int row) {
  return row < NP ? p.out + O_CKVP + (size_t)row * 128 : p.out + O_CKVS + (size_t)(row - NP) * 128;
}
__device__ __forceinline__ float* kpe_out_row(const Params& p, int row) {
  return row < NP ? p.out + O_KPEP + (size_t)row * 32 : p.out + O_KPES + (size_t)(row - NP) * 32;
}

template <bool BT>
__device__ __forceinline__ void gemm_f32(const float* __restrict__ A, int lda, const float* __restrict__ B, int ldb, float* __restrict__ C, int ldc,
                         int M, int N, int K, float* sm) {
  const int tid = threadIdx.x, tx = tid & 15, ty = tid >> 4;
  float(*As)[68] = (float(*)[68])sm;
  float(*Bs)[68] = (float(*)[68])(sm + 16 * 68);
  const int tm = M / 64, tn = (N + 63) / 64;
  for (int tile = blockIdx.x; tile < tm * tn; tile += gridDim.x) {
    const int m0 = (tile / tn) * 64, n0 = (tile % tn) * 64;
    float acc[2][4];
#pragma unroll
    for (int i = 0; i < 2; ++i)
#pragma unroll
      for (int j = 0; j < 4; ++j) acc[i][j] = 0.f;
    for (int k0 = 0; k0 < K; k0 += 16) {
      for (int i = tid; i < 1024; i += 512) { const int r = i >> 4, kk = i & 15; As[kk][r] = A[(size_t)(m0 + r) * lda + k0 + kk]; }
      if (BT) {
        for (int i = tid; i < 1024; i += 512) { const int c = i >> 4, kk = i & 15; Bs[kk][c] = (n0 + c < N) ? B[(size_t)(n0 + c) * ldb + k0 + kk] : 0.f; }
      } else {
        for (int i = tid; i < 1024; i += 512) { const int kk = i >> 6, c = i & 63; Bs[kk][c] = (n0 + c < N) ? B[(size_t)(k0 + kk) * ldb + n0 + c] : 0.f; }
      }
      __syncthreads();
#pragma unroll
      for (int kk = 0; kk < 16; ++kk) {
        const float a0 = As[kk][ty * 2], a1 = As[kk][ty * 2 + 1];
        const float b0 = Bs[kk][tx * 4], b1 = Bs[kk][tx * 4 + 1], b2 = Bs[kk][tx * 4 + 2], b3 = Bs[kk][tx * 4 + 3];
        acc[0][0] += a0 * b0; acc[0][1] += a0 * b1; acc[0][2] += a0 * b2; acc[0][3] += a0 * b3;
        acc[1][0] += a1 * b0; acc[1][1] += a1 * b1; acc[1][2] += a1 * b2; acc[1][3] += a1 * b3;
      }
      __syncthreads();
    }
#pragma unroll
    for (int i = 0; i < 2; ++i)
#pragma unroll
      for (int j = 0; j < 4; ++j) { const int col = n0 + tx * 4 + j; if (col < N) C[(size_t)(m0 + ty * 2 + i) * ldc + col] = acc[i][j]; }
  }
}

template <int D1, int D2, int DV>
__device__ __forceinline__ void attn_row_tile(const float* wsm, const float* k1, const float* k2, const float* v, bool valid, int lane,
                                              float& m, float& l, float& o0, float& o1) {
  float sc = 0.f;
  for (int c = 0; c < D1; c += 4) { const float4 kv = *(const float4*)(k1 + c); sc += wsm[c] * kv.x + wsm[c + 1] * kv.y + wsm[c + 2] * kv.z + wsm[c + 3] * kv.w; }
  if (D2 > 0) for (int c = 0; c < D2; c += 4) { const float4 kv = *(const float4*)(k2 + c); sc += wsm[D1 + c] * kv.x + wsm[D1 + c + 1] * kv.y + wsm[D1 + c + 2] * kv.z + wsm[D1 + c + 3] * kv.w; }
  sc = valid ? sc : -1e30f;
  const float tmax = wave_max(sc), mn = fmaxf(m, tmax), alpha = expf(m - mn), pj = valid ? expf(sc - mn) : 0.f;
  l = l * alpha + wave_sum(pj); o0 *= alpha; o1 *= alpha;
  const unsigned long long pa = (unsigned long long)(uintptr_t)v;
  const int plo = (int)(unsigned)(pa & 0xffffffffull), phi = (int)(unsigned)(pa >> 32);
  for (int j = 0; j < 64; ++j) {
    const float pjj = __shfl(pj, j);
    const unsigned lo = (unsigned)__shfl(plo, j), hi = (unsigned)__shfl(phi, j);
    const float* vj = (const float*)(uintptr_t)(((unsigned long long)hi << 32) | lo);
    o0 += pjj * vj[lane];
    if (DV > 64) o1 += pjj * vj[64 + lane];
  }
  m = mn;
}

__device__ __forceinline__ void prompt_attn_wave(const Params& p, int bh, int qb, int lane, float* wsm) {
  const int b = bh >> 3, h = bh & 7;
  const float* Q = p.ws + W_Q; const float* KN = p.ws + W_KN; const float* V = p.ws + W_V; const float* KPE = p.out + O_KPEP;
  for (int qi = 0; qi < 64; ++qi) {
    const int s = qb * 64 + qi, row = b * SEQ + s;
    wsm[lane] = Q[(size_t)row * 768 + h * 96 + lane] * MLA_SCALE;
    if (lane < 32) wsm[64 + lane] = Q[(size_t)row * 768 + h * 96 + 64 + lane] * MLA_SCALE;
    float m = -1e30f, l = 0.f, o0 = 0.f, o1 = 0.f;
    for (int tile = 0; tile <= qb; ++tile) {
      const int j = tile * 64 + lane;
      const size_t krow = (size_t)b * SEQ + j;
      attn_row_tile<64, 32, 64>(wsm, KN + krow * 512 + h * 64, KPE + krow * 32, V + krow * 512 + h * 64, j <= s, lane, m, l, o0, o1);
    }
    const float g = p.ws[W_PROJ + (size_t)row * INC + C_GMLA + h * 64 + lane];
    p.ws[W_MIX + (size_t)row * 1024 + h * 64 + lane] = o0 / l * silu(g);
  }
}

__device__ __forceinline__ void sample_attn_wave(const Params& p, int rowid  , int lane, float* wsm) {
  const int h = rowid & 7, t = (rowid >> 3) & 7, db = rowid >> 6;
  const int srow = db * 8 + t, row = NP + srow;
  const float* QLAT = p.ws + W_QLAT; const float* Q = p.ws + W_Q;
  wsm[lane] = QLAT[(size_t)srow * 1024 + h * 128 + lane] * MLA_SCALE;
  wsm[64 + lane] = QLAT[(size_t)srow * 1024 + h * 128 + 64 + lane] * MLA_SCALE;
  if (lane < 32) wsm[128 + lane] = Q[(size_t)row * 768 + h * 96 + 64 + lane] * MLA_SCALE;
  float m = -1e30f, l = 0.f, o0 = 0.f, o1 = 0.f;
  for (int tile = 0; tile <= 128; ++tile) {
    const float* ckv; const float* kpe; bool valid;
    if (tile < 128) {
      const int k = tile * 64 + lane;
      const int page = p.page_table[db * NPG + (k >> 7)];
      const size_t base = (size_t)page * PAGE + (k & 127);
      ckv = p.cache_ckv + base * 128; kpe = p.cache_kpe + base * 32; valid = true;
    } else {
      const int u = lane < 8 ? lane : 0;
      valid = (lane < 8) && (lane <= t);
      ckv = p.out + O_CKVS + (size_t)(db * 8 + u) * 128; kpe = p.out + O_KPES + (size_t)(db * 8 + u) * 32;
    }
    attn_row_tile<128, 32, 128>(wsm, ckv, kpe, ckv, valid, lane, m, l, o0, o1);
  }
  float* OLAT = p.ws + W_OLAT;
  OLAT[(size_t)srow * 1024 + h * 128 + lane] = o0 / l;
  OLAT[(size_t)srow * 1024 + h * 128 + 64 + lane] = o1 / l;
}

__device__ __forceinline__ void mem_attn_wave(const Params& p, int item, int lane, float* wsm) {
  const int h = item / (NT / 16), r0 = (item - h * (NT / 16)) * 16;
  for (int ri = 0; ri < 16; ++ri) {
    const int row = r0 + ri;
    const float* kbase; const float* vbase;
    if (row < NP) { const int b = row / SEQ; kbase = p.out + O_MKP + (size_t)b * 256 * 256 + h * 64; vbase = p.out + O_MVP + (size_t)b * 256 * 256 + h * 64; }
    else { const int db = (row - NP) >> 3; kbase = p.cache_mem_k + (size_t)db * 256 * 256 + h * 64; vbase = p.cache_mem_v + (size_t)db * 256 * 256 + h * 64; }
    wsm[lane] = p.ws[W_PROJ + (size_t)row * INC + C_QX + h * 64 + lane] * X_SCALE;
    float m = -1e30f, l = 0.f, o0 = 0.f, o1 = 0.f;
    for (int tile = 0; tile < 4; ++tile) {
      const int j = tile * 64 + lane;
      attn_row_tile<64, 0, 64>(wsm, kbase + (size_t)j * 256, nullptr, vbase + (size_t)j * 256, true, lane, m, l, o0, o1);
    }
    const float g = p.ws[W_PROJ + (size_t)row * INC + C_GX + h * 64 + lane];
    p.ws[W_MIX + (size_t)row * 1024 + 768 + h * 64 + lane] = o0 / l * silu(g);
  }
}

#define CBAR() asm volatile("" ::: "memory")
__device__ __forceinline__ void rwkv_scan_wave(const Params& p, bool prompt, int bi, int h, int lane, float* wsm  ) {
  float S[64];
  const float* s0 = p.state_wkv + ((size_t)(bi * 4 + h) * 64 + lane) * 64;
#pragma unroll
  for (int k = 0; k < 64; ++k) S[k] = prompt ? 0.f : s0[k];
  const int T = prompt ? SEQ : DT, row0 = prompt ? bi * SEQ : NP + bi * DT;
  const float lg = p.lnx_g[h * 64 + lane], lb = p.lnx_b[h * 64 + lane], rk = p.r_k[h * 64 + lane];
#pragma unroll 1
  for (int t = 0; t < T; ++t) {
    const int row = row0 + t;
    const size_t off = (size_t)row * 256 + h * 64 + lane;
    const float r_l = p.ws[W_R + off], w_l = p.ws[W_W + off], kf_l = p.ws[W_KF + off], kk_l = p.ws[W_KK + off], bb_l = p.ws[W_BB + off];
    const float vv = p.ws[W_VV + off];
    wsm[lane] = kk_l; wsm[64 + lane] = w_l; wsm[128 + lane] = bb_l; wsm[192 + lane] = kf_l; wsm[256 + lane] = r_l;
    CBAR();
    float sa = 0.f;
#pragma unroll
    for (int c = 0; c < 4; ++c) {
#pragma unroll
      for (int k = 16 * c; k < 16 * c + 16; ++k) sa += S[k] * wsm[k];
      CBAR();
    }
    sa = -sa;
    float y = 0.f;
#pragma unroll
    for (int c = 0; c < 8; ++c) {
#pragma unroll
      for (int k = 8 * c; k < 8 * c + 8; ++k) { S[k] = S[k] * wsm[64 + k] + sa * wsm[128 + k] + vv * wsm[192 + k]; y += S[k] * wsm[256 + k]; }
      CBAR();
    }
    const float mean = wave_sum(y) * (1.f / 64.f), d = y - mean, var = wave_sum(d * d) * (1.f / 64.f);
    const float yn = d * rsqrtf(var + GN_EPS) * lg + lb;
    const float bsum = wave_sum(r_l * kf_l * rk);
    const float o = yn + bsum * vv;
    const float g = p.ws[W_PROJ + (size_t)row * INC + C_GRWKV + h * 64 + lane];
    p.ws[W_MIX + (size_t)row * 1024 + 512 + h * 64 + lane] = o * silu(g);
    CBAR();
  }
  float* so = prompt ? p.out + O_WKVP + ((size_t)(bi * 4 + h) * 64 + lane) * 64 : p.out + O_WKVS + ((size_t)(bi * 4 + h) * 64 + lane) * 64;
#pragma unroll
  for (int k = 0; k < 64; ++k) so[k] = S[k];
}

__global__ void __launch_bounds__(512) fwd_megakernel(Params p) {
  cg::grid_group grid = cg::this_grid();
  __shared__ float sm[4096];
  const int tid = threadIdx.x, lane = tid & 63, wv = tid >> 6;
  const int gw = blockIdx.x * 8 + wv, NGW = gridDim.x * 8;
  const int gtid = blockIdx.x * 512 + tid, NTH = gridDim.x * 512;
  float* ws = p.ws;

  for (int r = gw; r < NT + 1024; r += NGW) {
    const float* src; const float* g; float* dst;
    if (r < NT) { src = xrow(p, r); g = p.ln_g; dst = ws + W_H + (size_t)r * 1024; }
    else { src = p.mem_prompt + (size_t)(r - NT) * 1024; g = p.mem_norm_g; dst = ws + W_HM + (size_t)(r - NT) * 1024; }
    float v[16]; float ss = 0.f;
#pragma unroll
    for (int i = 0; i < 16; ++i) { v[i] = src[lane + 64 * i]; ss += v[i] * v[i]; }
    const float rs = rsqrtf(wave_sum(ss) * (1.f / 1024.f) + RMS_EPS);
#pragma unroll
    for (int i = 0; i < 16; ++i) dst[lane + 64 * i] = v[i] * rs * g[lane + 64 * i];
  }
  grid.sync();

  gemm_f32<false>(ws + W_H, 1024, p.w_in, INC, ws + W_PROJ, INC, NT, INC, 1024, sm);
  gemm_f32<false>(ws + W_HM, 1024, p.w_mem_kv, 512, p.out + O_MKP, 256, 1024, 256, 1024, sm);
  gemm_f32<false>(ws + W_HM, 1024, p.w_mem_kv + 256, 512, p.out + O_MVP, 256, 1024, 256, 1024, sm);
  grid.sync();

  {
    float* tds = sm + wv * 128;
    for (int row = gw; row < NT; row += NGW) {
      const float* pr = ws + W_PROJ + (size_t)row * INC;
      {
        float v[4]; float ss = 0.f;
#pragma unroll
        for (int i = 0; i < 4; ++i) { v[i] = pr[C_CQ + lane + 64 * i]; ss += v[i] * v[i]; }
        const float rs = rsqrtf(wave_sum(ss) * (1.f / 256.f) + RMS_EPS);
#pragma unroll
        for (int i = 0; i < 4; ++i) ws[W_CQN + (size_t)row * 256 + lane + 64 * i] = v[i] * rs * p.q_norm_g[lane + 64 * i];
      }
      {
        const float v0 = pr[C_CKV + lane], v1 = pr[C_CKV + 64 + lane];
        const float rs = rsqrtf(wave_sum(v0 * v0 + v1 * v1) * (1.f / 128.f) + RMS_EPS);
        float* o = ckv_out_row(p, row);
        o[lane] = v0 * rs * p.kv_norm_g[lane]; o[64 + lane] = v1 * rs * p.kv_norm_g[64 + lane];
      }
      const int pos = row < NP ? (row % SEQ) : PAST + ((row - NP) & 7);
      if (lane < 16) {
        const float inv = 1.0f / powf(10000.0f, (float)lane * (2.0f / 32.0f));
        const float ang = (float)pos * inv; const float c = cosf(ang), s = sinf(ang);
        const float x1 = pr[C_KR + lane], x2 = pr[C_KR + 16 + lane];
        float* o = kpe_out_row(p, row);
        o[lane] = x1 * c - x2 * s; o[16 + lane] = x2 * c + x1 * s;
      }
      if (row < NP) { if ((row % SEQ) == SEQ - 1) { const int b = row / SEQ; for (int i = lane; i < 896; i += 64) p.out[O_SHP + (size_t)b * 896 + i] = pr[C_Z + i]; } }
      else { if (((row - NP) & 7) == 7) { const int db = (row - NP) >> 3; for (int i = lane; i < 896; i += 64) p.out[O_SHS + (size_t)db * 896 + i] = pr[C_Z + i]; } }
      {
        const bool first = row < NP ? ((row % SEQ) == 0) : (((row - NP) & 7) == 0);
        const float* prev = first ? (row < NP ? nullptr : p.state_shift + (size_t)((row - NP) >> 3) * 896 - C_Z) : pr - INC;
        auto zmix = [&](int i) -> float { const float z = pr[C_Z + i]; const float pv = prev ? prev[C_Z + i] : 0.f; return z + (pv - z) * p.shift_mu[i]; };
        tds[lane] = tanhf(zmix(768 + lane)); tds[64 + lane] = zmix(832 + lane);
        __builtin_amdgcn_fence(__ATOMIC_RELEASE, "wavefront"); __builtin_amdgcn_wave_barrier();
#pragma unroll 1
        for (int hh = 0; hh < 4; ++hh) {
          const int c = hh * 64 + lane;
          float u = p.w0[c], au = p.a0[c];
#pragma unroll 4
          for (int j = 0; j < 64; ++j) { u += tds[j] * p.w_up[j * 256 + c]; au += tds[64 + j] * p.a_up[j * 256 + c]; }
          const float nu = -u;
          const float sp = fmaxf(nu, 0.f) + log1pf(expf(-fabsf(nu)));
          const float wl = -sp - 0.5f;
          const float decay = expf(-expf(wl));
          const float a = 1.f / (1.f + expf(-au));
          const float k = zmix(256 + c), r = zmix(c), v = zmix(512 + c);
          float kk = k * p.k_k[c];
          const float nrm = fmaxf(sqrtf(wave_sum(kk * kk)), 1e-12f);
          kk = kk / nrm;
          const float kf = k * (1.f + (a - 1.f) * p.k_a[c]);
          const size_t o = (size_t)row * 256 + c;
          ws[W_R + o] = r; ws[W_W + o] = decay; ws[W_KF + o] = kf; ws[W_VV + o] = v; ws[W_KK + o] = kk; ws[W_BB + o] = kk * a;
        }
        __builtin_amdgcn_fence(__ATOMIC_RELEASE, "wavefront"); __builtin_amdgcn_wave_barrier();
      }
    }
  }
  grid.sync();

  gemm_f32<false>(ws + W_CQN, 256, p.w_uq, 768, ws + W_Q, 768, NT, 768, 256, sm);
  gemm_f32<false>(p.out + O_CKVP, 128, p.w_uk, 512, ws + W_KN, 512, NP, 512, 128, sm);
  gemm_f32<false>(p.out + O_CKVP, 128, p.w_uv, 512, ws + W_V, 512, NP, 512, 128, sm);
  grid.sync();

  for (int i = gtid; i < NT * 8 * 16; i += NTH) {
    const int j = i & 15, h = (i >> 4) & 7, row = i >> 7;
    const int pos = row < NP ? (row % SEQ) : PAST + ((row - NP) & 7);
    const float inv = 1.0f / powf(10000.0f, (float)j * (2.0f / 32.0f));
    const float ang = (float)pos * inv; const float c = cosf(ang), s = sinf(ang);
    float* q = ws + W_Q + (size_t)row * 768 + h * 96 + 64;
    const float x1 = q[j], x2 = q[16 + j];
    q[j] = x1 * c - x2 * s; q[16 + j] = x2 * c + x1 * s;
  }
  for (int h = 0; h < 8; ++h)
    gemm_f32<true>(ws + W_Q + (size_t)NP * 768 + h * 96, 768, p.w_uk + h * 64, 512, ws + W_QLAT + h * 128, 1024, NS, 128, 64, sm);
  grid.sync();

  {
    constexpr int N_RP = 16, N_RS = 512, N_PA = 2048, N_SA = 8192, N_MA = NT * 4 / 16;
    constexpr int TOT = N_RP + N_PA + N_SA + N_RS + N_MA;
    float* wsm = sm + wv * 320;
    for (int it = gw; it < TOT; it += NGW) {
      int i = __builtin_amdgcn_readfirstlane(it);
      if (i < N_RP) { rwkv_scan_wave(p, true, i >> 2, i & 3, lane, wsm); continue; }
      i -= N_RP;
      if (i < N_PA) { const int qb = 63 - (i >> 5), bh = i & 31; prompt_attn_wave(p, bh, qb, lane, wsm); continue; }
      i -= N_PA;
      if (i < N_SA) { sample_attn_wave(p, i, lane, wsm); continue; }
      i -= N_SA;
      if (i < N_RS) { rwkv_scan_wave(p, false, i >> 2, i & 3, lane, wsm); continue; }
      i -= N_RS;
      mem_attn_wave(p, i, lane, wsm);
    }
  }
  grid.sync();

  for (int i = gtid; i < NS * 512; i += NTH) {
    const int c = i & 511, srow = i >> 9, h = c >> 6;
    const float* ol = ws + W_OLAT + (size_t)srow * 1024 + h * 128;
    float acc = 0.f;
    for (int k = 0; k < 128; ++k) acc += ol[k] * p.w_uv[k * 512 + c];
    const int row = NP + srow;
    const float g = ws[W_PROJ + (size_t)row * INC + C_GMLA + c];
    ws[W_MIX + (size_t)row * 1024 + c] = acc * silu(g);
  }
  grid.sync();

  gemm_f32<false>(ws + W_MIX, 1024, p.w_out, 1024, p.out, 1024, NT, 1024, 1024, sm);
  grid.sync();

  for (int r = gw; r < NT; r += NGW) {
    const float* xr = xrow(p, r); float* y = p.out + (size_t)r * 1024;
    float v[16]; float ss = 0.f;
#pragma unroll
    for (int i = 0; i < 16; ++i) { v[i] = xr[lane + 64 * i] + y[lane + 64 * i]; ss += v[i] * v[i]; }
    const float rs = rsqrtf(wave_sum(ss) * (1.f / 1024.f) + RMS_EPS);
#pragma unroll
    for (int i = 0; i < 16; ++i) y[lane + 64 * i] = v[i] * rs * p.final_g[lane + 64 * i];
  }
}

extern "C" void kernel_launch(void* const* d_in, const int* in_sizes, int n_in, void* d_out,
                              int out_size, void* d_ws, size_t ws_size, hipStream_t stream) {
  static int grid_blocks = 0;
  if (!grid_blocks) {
    int dev = 0, cus = 0, per_cu = 0;
    (void)hipGetDevice(&dev);
    (void)hipDeviceGetAttribute(&cus, hipDeviceAttributeMultiprocessorCount, dev);
    (void)hipOccupancyMaxActiveBlocksPerMultiprocessor(&per_cu, fwd_megakernel, 512, 0);
    if (per_cu < 1) per_cu = 1;
    grid_blocks = cus;
    if (ws_size < W_END * sizeof(float)) fprintf(stderr, "workspace too small: %zu < %zu\n", ws_size, (size_t)(W_END * sizeof(float)));
  }
  Params p{};
  const float** pf = (const float**)&p;
  (void)pf;
  p.x_prompt = (const float*)d_in[0]; p.x_sample = (const float*)d_in[1]; p.mem_prompt = (const float*)d_in[2];
  p.cache_ckv = (const float*)d_in[3]; p.cache_kpe = (const float*)d_in[4]; p.page_table = (const int*)d_in[5];
  p.state_wkv = (const float*)d_in[6]; p.state_shift = (const float*)d_in[7]; p.cache_mem_k = (const float*)d_in[8];
  p.cache_mem_v = (const float*)d_in[9]; p.ln_g = (const float*)d_in[10]; p.w_in = (const float*)d_in[11];
  p.q_norm_g = (const float*)d_in[12]; p.kv_norm_g = (const float*)d_in[13]; p.w_uq = (const float*)d_in[14];
  p.w_uk = (const float*)d_in[15]; p.w_uv = (const float*)d_in[16]; p.shift_mu = (const float*)d_in[17];
  p.w0 = (const float*)d_in[18]; p.w_up = (const float*)d_in[19]; p.a0 = (const float*)d_in[20]; p.a_up = (const float*)d_in[21];
  p.k_k = (const float*)d_in[22]; p.k_a = (const float*)d_in[23]; p.r_k = (const float*)d_in[24]; p.lnx_g = (const float*)d_in[25];
  p.lnx_b = (const float*)d_in[26]; p.mem_norm_g = (const float*)d_in[27]; p.w_mem_kv = (const float*)d_in[28];
  p.w_out = (const float*)d_in[29]; p.final_g = (const float*)d_in[30];
  p.out = (float*)d_out; p.ws = (float*)d_ws;
  void* args[] = {&p};
  hipError_t e = hipLaunchCooperativeKernel((void*)fwd_megakernel, dim3(grid_blocks), dim3(512), args, 0, stream);
  if (e != hipSuccess) fprintf(stderr, "cooperative launch failed: %s (grid %d)\n", hipGetErrorString(e), grid_blocks);
}
```

```cpp
#include <hip/hip_runtime.h>
#include <hip/hip_cooperative_groups.h>
#include <cstdio>
#include <cstdint>
namespace cg = cooperative_groups;
namespace pg8 {
#define PG8_LAS __attribute__((address_space(3)))
typedef unsigned short bf16_t;
typedef short bf16x8 __attribute__((ext_vector_type(8)));
typedef float f32x4 __attribute__((ext_vector_type(4)));
typedef unsigned u32x4 __attribute__((ext_vector_type(4)));
constexpr int BM = 256, BK = 64, HALF = 128, HTB = HALF * BK * 2  , STAGE_BYTES = 8 * HTB, NXCD = 8, WGM = 8;

__host__ __device__ __forceinline__ int lds_byte(int r, int c) { const int st = (r >> 4) * 2 + (c >> 5), rr = r & 15, cc = c & 31, ob = rr * 64 + cc * 2; return st * 1024 + (ob ^ (((ob >> 9) & 1) << 5)); }
__host__ __device__ __forceinline__ void stage_rc(int b, int& R, int& C) { const int st = b / 1024, sb = b % 1024, swz = sb ^ (((sb >> 9) & 1) << 5); R = (st >> 1) * 16 + swz / 64; C = (st & 1) * 32 + (swz % 64) / 2; }
__host__ __device__ __forceinline__ int perm32(int rho) { const int n = rho >> 4, i = rho & 15; return 8 * (i >> 2) + 4 * n + (i & 3); }

struct Unit { int pm, pn; };
struct Gemm { const bf16_t* A; const bf16_t* Bt; int M, N, K; };

struct StaticOrder {
    int nM, nN, nwg, G, c;
    __host__ __device__ void init(int M, int N, int G_, int c_) { nM = M / BM; nN = N / BM; nwg = nM * nN; G = G_; c = c_; }
    __host__ __device__ bool next(int i, Unit& u) const {
        const long L = (long)i * G + c; if (L >= nwg) return false;
        int wgid = (int)L; { const int q = nwg / NXCD, r = nwg % NXCD, xcd = wgid % NXCD, off = wgid / NXCD; wgid = (xcd < r ? xcd * (q + 1) : r * (q + 1) + (xcd - r) * q) + off; }
        const int nig = WGM * nN, gid = wgid / nig, fm = gid * WGM, gsz = (nM - fm) < WGM ? (nM - fm) : WGM;
        u.pm = fm + ((wgid % nig) % gsz); u.pn = (wgid % nig) / gsz; return true;
    }
    __device__ __forceinline__ void a_ready(const Unit&) const {}
    __device__ __forceinline__ void done(const Unit&) const {}
};
__device__ __forceinline__ unsigned cvt_pk_bf16(float lo, float hi) { unsigned r; asm volatile("v_cvt_pk_bf16_f32 %0, %1, %2" : "=v"(r) : "v"(lo), "v"(hi)); return r; }
typedef float f32x2 __attribute__((ext_vector_type(2)));
template <class Epi, class Sched, bool ALIGN_EPI = false, bool SP2 = false>
__device__ __forceinline__ void gemm_phase(PG8_LAS unsigned char* lds, const Gemm g, const Sched& S, const Epi& E) {
    const int tid = threadIdx.x, wid = __builtin_amdgcn_readfirstlane(tid >> 6), lane = tid & 63, wr = wid >> 2, wc = wid & 3, fr = lane & 15, fq = lane >> 4;
    const int K = g.K, nt = K / BK;
    unsigned voffA[2], voffB[2];
#pragma unroll
    for (int i = 0; i < 2; ++i) { int R, C; stage_rc(tid * 16 + i * 8192, R, C); const int Rb = Epi::PERM ? ((R & ~31) + perm32(R & 31)) : R;
        voffA[i] = (unsigned)(R * K + C) * 2u; voffB[i] = (unsigned)(Rb * K + C) * 2u; }
    const size_t kstep = (size_t)(BK * 2);
    const size_t hstep = (size_t)HALF * K * 2;
    const size_t tstep = 2 * hstep;
    const unsigned ldsw = (unsigned)wid * 1024u;
    const int aoff = lds_byte(wr * 64 + fr, fq * 8), boff = lds_byte(wc * 32 + fr, fq * 8);
#define PG8_SA(b, h) (((b) * 2 + (h)) * HTB)
#define PG8_SB(b, h) ((4 + (b) * 2 + (h)) * HTB)
#define PG8_STAGE(bufoff, gbase, voff) do { _Pragma("unroll") for (int _i = 0; _i < 2; ++_i) \
        __builtin_amdgcn_global_load_lds((const unsigned*)((const char*)(gbase) + (voff)[_i]), (PG8_LAS unsigned*)(lds + (bufoff) + ldsw + _i * 8192), 16, 0, 0); } while (0)
#define PG8_LDA(dst, b, h) do { _Pragma("unroll") for (int m = 0; m < 4; ++m) _Pragma("unroll") for (int k = 0; k < 2; ++k) dst[m][k] = *(const PG8_LAS bf16x8*)(lds + PG8_SA(b, h) + aoff + m * 2048 + k * 1024); } while (0)
#define PG8_LDB(dst, b, h) do { _Pragma("unroll") for (int n = 0; n < 2; ++n) _Pragma("unroll") for (int k = 0; k < 2; ++k) dst[n][k] = *(const PG8_LAS bf16x8*)(lds + PG8_SB(b, h) + boff + n * 2048 + k * 1024); } while (0)
#define PG8_MMA(ai, bj, At, Bt) do { __builtin_amdgcn_s_setprio(1); _Pragma("unroll") for (int m = 0; m < 4; ++m) _Pragma("unroll") for (int n = 0; n < 2; ++n) _Pragma("unroll") for (int k = 0; k < 2; ++k) \
        acc[ai][bj][m][n] = __builtin_amdgcn_mfma_f32_16x16x32_bf16(Bt[n][k], At[m][k], acc[ai][bj][m][n], 0, 0, 0); __builtin_amdgcn_s_setprio(0); } while (0)
#define PG8_WAIT_V(n) asm volatile("s_waitcnt vmcnt(" #n ")" ::: "memory")
#define PG8_WAIT_L(n) asm volatile("s_waitcnt lgkmcnt(" #n ")" ::: "memory")
#define PG8_BAR __builtin_amdgcn_s_barrier()
#define PG8_SCHED __builtin_amdgcn_sched_barrier(0)
    Unit cur, nxt; int ui = 0;
    if (!S.next(0, cur)) return;
    f32x4 acc[2][2][4][2];
#pragma unroll
    for (int a = 0; a < 2; ++a)
#pragma unroll
        for (int b = 0; b < 2; ++b)
#pragma unroll
            for (int m = 0; m < 4; ++m)
#pragma unroll
                for (int n = 0; n < 2; ++n) acc[a][b][m][n] = (f32x4){0.f, 0.f, 0.f, 0.f};
    bf16x8 At[4][2], B0[2][2], B1[2][2];
    const char* cA = (const char*)g.A + (size_t)cur.pm * tstep; const char* cB = (const char*)g.Bt + (size_t)cur.pn * tstep;
    S.a_ready(cur);
    if constexpr (SP2) {
        PG8_STAGE(PG8_SB(0, 0), cB, voffB); PG8_STAGE(PG8_SB(0, 1), cB + hstep, voffB); PG8_STAGE(PG8_SA(0, 0), cA, voffA); PG8_STAGE(PG8_SA(0, 1), cA + hstep, voffA);
        if (wr == 1) PG8_BAR;
        PG8_WAIT_V(2); PG8_BAR;
        PG8_STAGE(PG8_SB(1, 0), cB + kstep, voffB); PG8_STAGE(PG8_SA(1, 0), cA + kstep, voffA); PG8_STAGE(PG8_SB(1, 1), cB + hstep + kstep, voffB);
        PG8_WAIT_V(6); PG8_BAR;
    } else {
        PG8_STAGE(PG8_SB(0, 0), cB, voffB); PG8_STAGE(PG8_SA(0, 0), cA, voffA); PG8_STAGE(PG8_SB(0, 1), cB + hstep, voffB); PG8_STAGE(PG8_SA(0, 1), cA + hstep, voffA);
        if (wr == 1) PG8_BAR;
        PG8_WAIT_V(4); PG8_BAR;
        PG8_STAGE(PG8_SB(1, 0), cB + kstep, voffB); PG8_STAGE(PG8_SA(1, 0), cA + kstep, voffA); PG8_STAGE(PG8_SB(1, 1), cB + hstep + kstep, voffB);
        PG8_WAIT_V(6); PG8_BAR;
    }
    for (;;) {
        const bool has_next = S.next(ui + 1, nxt);
        const char* nA = has_next ? (const char*)g.A + (size_t)nxt.pm * tstep : cA; const char* nB = has_next ? (const char*)g.Bt + (size_t)nxt.pn * tstep : cB;
        for (int t = 0; t < nt; t += 2) {
            const bool last = (t == nt - 2);
            const char* a1 = cA + (size_t)(t + 1) * kstep;
            const char* a2 = last ? nA : cA + (size_t)(t + 2) * kstep; const char* b2 = last ? nB : cB + (size_t)(t + 2) * kstep;
            const char* a3 = a2 + kstep; const char* b3 = b2 + kstep;
            if (last && has_next) S.a_ready(nxt);
            if constexpr (SP2) {
            PG8_LDB(B0, 0, 0); PG8_LDB(B1, 0, 1); PG8_SCHED; PG8_LDA(At, 0, 0); PG8_STAGE(PG8_SA(1, 1), a1 + hstep, voffA);
            PG8_WAIT_V(8); PG8_WAIT_L(0); PG8_BAR; PG8_MMA(0, 0, At, B0); PG8_MMA(0, 1, At, B1); PG8_BAR; PG8_SCHED;
            PG8_LDA(At, 0, 1); PG8_STAGE(PG8_SB(0, 0), b2, voffB); PG8_STAGE(PG8_SB(0, 1), b2 + hstep, voffB); PG8_STAGE(PG8_SA(0, 0), a2, voffA);
            PG8_WAIT_V(8); PG8_WAIT_L(0); PG8_BAR; PG8_MMA(1, 0, At, B0); PG8_MMA(1, 1, At, B1); PG8_BAR; PG8_SCHED;
            PG8_LDB(B0, 1, 0); PG8_LDB(B1, 1, 1); PG8_SCHED; PG8_LDA(At, 1, 0); PG8_STAGE(PG8_SA(0, 1), a2 + hstep, voffA);
            PG8_WAIT_V(8); PG8_WAIT_L(0); PG8_BAR; PG8_MMA(0, 0, At, B0); PG8_MMA(0, 1, At, B1); PG8_BAR; PG8_SCHED;
            PG8_LDA(At, 1, 1); PG8_STAGE(PG8_SB(1, 0), b3, voffB); PG8_STAGE(PG8_SB(1, 1), b3 + hstep, voffB); PG8_STAGE(PG8_SA(1, 0), a3, voffA);
            PG8_WAIT_V(8); PG8_WAIT_L(0); PG8_BAR; PG8_MMA(1, 0, At, B0); PG8_MMA(1, 1, At, B1); PG8_BAR; PG8_SCHED;
            } else {
            PG8_LDB(B0, 0, 0); PG8_SCHED; PG8_LDA(At, 0, 0); PG8_STAGE(PG8_SA(1, 1), a1 + hstep, voffA);
            PG8_WAIT_L(8); PG8_BAR; PG8_WAIT_L(0); PG8_MMA(0, 0, At, B0); PG8_BAR; PG8_SCHED;
            PG8_LDB(B1, 0, 1); PG8_STAGE(PG8_SB(0, 0), b2, voffB);
            PG8_BAR; PG8_WAIT_L(0); PG8_MMA(0, 1, At, B1); PG8_BAR;
            PG8_LDA(At, 0, 1); PG8_STAGE(PG8_SA(0, 0), a2, voffA);
            PG8_BAR; PG8_WAIT_L(0); PG8_MMA(1, 0, At, B0); PG8_BAR; PG8_SCHED;
            PG8_STAGE(PG8_SB(0, 1), b2 + hstep, voffB);
            PG8_WAIT_V(6); PG8_BAR; PG8_MMA(1, 1, At, B1); PG8_BAR;
            PG8_LDB(B0, 1, 0); PG8_SCHED; PG8_LDA(At, 1, 0); PG8_STAGE(PG8_SA(0, 1), a2 + hstep, voffA);
            PG8_WAIT_L(8); PG8_BAR; PG8_WAIT_L(0); PG8_MMA(0, 0, At, B0); PG8_BAR; PG8_SCHED;
            PG8_LDB(B1, 1, 1); PG8_STAGE(PG8_SB(1, 0), b3, voffB);
            PG8_BAR; PG8_WAIT_L(0); PG8_MMA(0, 1, At, B1); PG8_BAR;
            PG8_LDA(At, 1, 1); PG8_STAGE(PG8_SA(1, 0), a3, voffA);
            PG8_BAR; PG8_WAIT_L(0); PG8_MMA(1, 0, At, B0); PG8_BAR; PG8_SCHED;
            PG8_STAGE(PG8_SB(1, 1), b3 + hstep, voffB);
            PG8_WAIT_V(6); PG8_BAR; PG8_MMA(1, 1, At, B1); PG8_BAR;
            }
        }
        if constexpr (ALIGN_EPI) { if (wr == 0) PG8_BAR; }
        if constexpr (!Epi::AFTER_DRAIN) { E(acc, cur, wr, wc, fr, fq); S.done(cur); }
        if (!has_next) break;
#pragma unroll
        for (int a = 0; a < 2; ++a)
#pragma unroll
            for (int b = 0; b < 2; ++b)
#pragma unroll
                for (int m = 0; m < 4; ++m)
#pragma unroll
                    for (int n = 0; n < 2; ++n) acc[a][b][m][n] = (f32x4){0.f, 0.f, 0.f, 0.f};
        cur = nxt; cA = nA; cB = nB; ++ui;
        if constexpr (ALIGN_EPI) { if (wr == 1) PG8_BAR; }
    }
    PG8_WAIT_V(0);
    if constexpr (!ALIGN_EPI) { if (wr == 0) PG8_BAR; }
    PG8_BAR;
    if constexpr (Epi::AFTER_DRAIN) { E.fused(acc, cur, wr, wc, fr, fq, lds, wid, lane); S.done(cur); }
#undef PG8_SA
#undef PG8_SB
#undef PG8_STAGE
#undef PG8_LDA
#undef PG8_LDB
#undef PG8_MMA
#undef PG8_WAIT_V
#undef PG8_WAIT_L
#undef PG8_BAR
#undef PG8_SCHED
}
}

namespace pg8 {
struct EpiF32 {
  static constexpr bool PERM = false, AFTER_DRAIN = false;
  float* C; int ldc; int ncols; int split_cols; size_t split_stride; const float* r0; const float* r1; int nr0;
  __device__ __forceinline__ void operator()(const f32x4 (&acc)[2][2][4][2], const Unit& u, int wr, int wc, int fr, int fq) const {
    const int row0 = u.pm * BM + wr * 64 + fr; int colt = u.pn * BM; float* base = C;
    if (split_cols) { const int t = colt / split_cols; base += (size_t)t * split_stride; colt -= t * split_cols; }
    const int col0 = colt + wc * 32 + 4 * fq;
#pragma unroll
    for (int ai = 0; ai < 2; ++ai)
#pragma unroll
      for (int m = 0; m < 4; ++m) {
        const int row = row0 + ai * HALF + m * 16;
        const float* rr = r0 ? (row < nr0 ? r0 + (size_t)row * ldc : r1 + (size_t)(row - nr0) * ldc) : nullptr;
#pragma unroll
        for (int bj = 0; bj < 2; ++bj)
#pragma unroll
          for (int n = 0; n < 2; ++n) {
            const int col = col0 + bj * HALF + n * 16;
            if (col < ncols) { f32x4 v = acc[ai][bj][m][n]; if (rr) v += *(const f32x4*)(rr + col); *(f32x4*)(base + (size_t)row * ldc + col) = v; }
          }
      }
  }
};
}

constexpr int DM = 1024, BATCH = 4, SEQ = 4096, DB = 128, DT = 8, PAST = 8192, PAGE = 128, NPG = 64, NMEM = 256;
constexpr int NP = BATCH * SEQ, NS = DB * DT, NT = NP + NS;
constexpr int INC = 2592;
constexpr int C_CQ = 0, C_CKV = 256, C_KR = 384, C_GMLA = 416, C_Z = 928, C_GRWKV = 1824, C_QX = 2080, C_GX = 2336;
constexpr float MLA_SCALE = 0.10206207261596575f;
constexpr float X_SCALE = 0.125f;
constexpr float RMS_EPS = 1e-6f, GN_EPS = 64e-5f;
constexpr size_t O_YP = 0, O_YS = 16777216, O_CKVP = 17825792, O_KPEP = 19922944, O_WKVP = 20447232, O_SHP = 20512768,
                 O_MKP = 20516352, O_MVP = 20778496, O_CKVS = 21040640, O_KPES = 21171712, O_WKVS = 21204480, O_SHS = 23301632;
constexpr size_t W_H = 0;
constexpr size_t W_HM = W_H + (size_t)NT * 1024;
constexpr size_t W_PROJ = W_HM + (size_t)1024 * 1024;
constexpr size_t W_CQN = W_PROJ + (size_t)NT * INC;
constexpr size_t W_Q = W_CQN + (size_t)NT * 256;
constexpr size_t W_KN = W_Q + (size_t)NT * 768;
constexpr size_t W_V = W_KN + (size_t)NP * 512;
constexpr size_t W_QLAT = W_V + (size_t)NP * 512;
constexpr size_t W_OLAT = W_QLAT + (size_t)NS * 1024;
constexpr size_t W_R = W_OLAT + (size_t)NS * 1024;
constexpr size_t W_W = W_R + (size_t)NT * 256;
constexpr size_t W_KF = W_W + (size_t)NT * 256;
constexpr size_t W_VV = W_KF + (size_t)NT * 256;
constexpr size_t W_KK = W_VV + (size_t)NT * 256;
constexpr size_t W_BB = W_KK + (size_t)NT * 256;
constexpr size_t W_MIX = W_BB + (size_t)NT * 256;
constexpr size_t W_END = W_MIX + (size_t)NT * 1024;
constexpr int INCP = 2816;
constexpr size_t B_H = 0;
constexpr size_t B_HM = B_H + (size_t)NT * 1024;
constexpr size_t B_WIN = B_HM + (size_t)1024 * 1024;
constexpr size_t B_WMEM = B_WIN + (size_t)INCP * 1024;
constexpr size_t B_WOUT = B_WMEM + (size_t)512 * 1024;
constexpr size_t B_MIX = B_WOUT + (size_t)1024 * 1024;
constexpr size_t B_END = B_MIX + (size_t)NT * 1024;
constexpr size_t WS_BYTES = W_END * 4 + B_END * 2;
constexpr int LDS_BYTES = 147456;

struct Params {
  const float* x_prompt; const float* x_sample; const float* mem_prompt; const float* cache_ckv; const float* cache_kpe;
  const int* page_table; const float* state_wkv; const float* state_shift; const float* cache_mem_k; const float* cache_mem_v;
  const float* ln_g; const float* w_in; const float* q_norm_g; const float* kv_norm_g; const float* w_uq; const float* w_uk;
  const float* w_uv; const float* shift_mu; const float* w0; const float* w_up; const float* a0; const float* a_up;
  const float* k_k; const float* k_a; const float* r_k; const float* lnx_g; const float* lnx_b; const float* mem_norm_g;
  const float* w_mem_kv; const float* w_out; const float* final_g;
  float* out; float* ws;
};

__device__ __forceinline__ float wave_sum(float v) {
#pragma unroll
  for (int o = 1; o < 64; o <<= 1) v += __shfl_xor(v, o);
  return v;
}
__device__ __forceinline__ float wave_max(float v) {
#pragma unroll
  for (int o = 1; o < 64; o <<= 1) v = fmaxf(v, __shfl_xor(v, o));
  return v;
}
__device__ __forceinline__ float silu(float x) { return x / (1.f + expf(-x)); }
__device__ __forceinline__ const float* xrow(const Params& p, int row) {
  return row < NP ? p.x_prompt + (size_t)row * DM : p.x_sample + (size_t)(row - NP) * DM;
}
__device__ __forceinline__ float* ckv_out_row(const Params& p, int row) {
  return row < NP ? p.out + O_CKVP + (size_t)row * 128 : p.out + O_CKVS + (size_t)(row - NP) * 128;
}
__device__ __forceinline__ float* kpe_out_row(const Params& p, int row) {
  return row < NP ? p.out + O_KPEP + (size_t)row * 32 : p.out + O_KPES + (size_t)(row - NP) * 32;
}

template <bool BT>
__device__ __forceinline__ void gemm_f32(const float* __restrict__ A, int lda, const float* __restrict__ B, int ldb, float* __restrict__ C, int ldc,
                         int M, int N, int K, float* sm) {
  const int tid = threadIdx.x, tx = tid & 15, ty = tid >> 4;
  float(*As)[68] = (float(*)[68])sm;
  float(*Bs)[68] = (float(*)[68])(sm + 16 * 68);
  const int tm = M / 64, tn = (N + 63) / 64;
  for (int tile = blockIdx.x; tile < tm * tn; tile += gridDim.x) {
    const int m0 = (tile / tn) * 64, n0 = (tile % tn) * 64;
    float acc[2][4];
#pragma unroll
    for (int i = 0; i < 2; ++i)
#pragma unroll
      for (int j = 0; j < 4; ++j) acc[i][j] = 0.f;
    for (int k0 = 0; k0 < K; k0 += 16) {
      for (int i = tid; i < 1024; i += 512) { const int r = i >> 4, kk = i & 15; As[kk][r] = A[(size_t)(m0 + r) * lda + k0 + kk]; }
      if (BT) {
        for (int i = tid; i < 1024; i += 512) { const int c = i >> 4, kk = i & 15; Bs[kk][c] = (n0 + c < N) ? B[(size_t)(n0 + c) * ldb + k0 + kk] : 0.f; }
      } else {
        for (int i = tid; i < 1024; i += 512) { const int kk = i >> 6, c = i & 63; Bs[kk][c] = (n0 + c < N) ? B[(size_t)(k0 + kk) * ldb + n0 + c] : 0.f; }
      }
      __syncthreads();
#pragma unroll
      for (int kk = 0; kk < 16; ++kk) {
        const float a0 = As[kk][ty * 2], a1 = As[kk][ty * 2 + 1];
        const float b0 = Bs[kk][tx * 4], b1 = Bs[kk][tx * 4 + 1], b2 = Bs[kk][tx * 4 + 2], b3 = Bs[kk][tx * 4 + 3];
        acc[0][0] += a0 * b0; acc[0][1] += a0 * b1; acc[0][2] += a0 * b2; acc[0][3] += a0 * b3;
        acc[1][0] += a1 * b0; acc[1][1] += a1 * b1; acc[1][2] += a1 * b2; acc[1][3] += a1 * b3;
      }
      __syncthreads();
    }
#pragma unroll
    for (int i = 0; i < 2; ++i)
#pragma unroll
      for (int j = 0; j < 4; ++j) { const int col = n0 + tx * 4 + j; if (col < N) C[(size_t)(m0 + ty * 2 + i) * ldc + col] = acc[i][j]; }
  }
}

template <int D1, int D2, int DV>
__device__ __forceinline__ void attn_row_tile(const float* wsm, const float* k1, const float* k2, const float* v, bool valid, int lane,
                                              float& m, float& l, float& o0, float& o1) {
  float sc = 0.f;
  for (int c = 0; c < D1; c += 4) { const float4 kv = *(const float4*)(k1 + c); sc += wsm[c] * kv.x + wsm[c + 1] * kv.y + wsm[c + 2] * kv.z + wsm[c + 3] * kv.w; }
  if (D2 > 0) for (int c = 0; c < D2; c += 4) { const float4 kv = *(const float4*)(k2 + c); sc += wsm[D1 + c] * kv.x + wsm[D1 + c + 1] * kv.y + wsm[D1 + c + 2] * kv.z + wsm[D1 + c + 3] * kv.w; }
  sc = valid ? sc : -1e30f;
  const float tmax = wave_max(sc), mn = fmaxf(m, tmax), alpha = expf(m - mn), pj = valid ? expf(sc - mn) : 0.f;
  l = l * alpha + wave_sum(pj); o0 *= alpha; o1 *= alpha;
  const unsigned long long pa = (unsigned long long)(uintptr_t)v;
  const int plo = (int)(unsigned)(pa & 0xffffffffull), phi = (int)(unsigned)(pa >> 32);
  for (int j = 0; j < 64; ++j) {
    const float pjj = __shfl(pj, j);
    const unsigned lo = (unsigned)__shfl(plo, j), hi = (unsigned)__shfl(phi, j);
    const float* vj = (const float*)(uintptr_t)(((unsigned long long)hi << 32) | lo);
    o0 += pjj * vj[lane];
    if (DV > 64) o1 += pjj * vj[64 + lane];
  }
  m = mn;
}

__device__ __forceinline__ void prompt_attn_wave(const Params& p, int bh, int qb, int lane, float* wsm) {
  const int b = bh >> 3, h = bh & 7;
  const float* Q = p.ws + W_Q; const float* KN = p.ws + W_KN; const float* V = p.ws + W_V; const float* KPE = p.out + O_KPEP;
  for (int qi = 0; qi < 64; ++qi) {
    const int s = qb * 64 + qi, row = b * SEQ + s;
    wsm[lane] = Q[(size_t)row * 768 + h * 96 + lane] * MLA_SCALE;
    if (lane < 32) wsm[64 + lane] = Q[(size_t)row * 768 + h * 96 + 64 + lane] * MLA_SCALE;
    float m = -1e30f, l = 0.f, o0 = 0.f, o1 = 0.f;
    for (int tile = 0; tile <= qb; ++tile) {
      const int j = tile * 64 + lane;
      const size_t krow = (size_t)b * SEQ + j;
      attn_row_tile<64, 32, 64>(wsm, KN + krow * 512 + h * 64, KPE + krow * 32, V + krow * 512 + h * 64, j <= s, lane, m, l, o0, o1);
    }
    const float g = p.ws[W_PROJ + (size_t)row * INC + C_GMLA + h * 64 + lane];
    p.ws[W_MIX + (size_t)row * 1024 + h * 64 + lane] = o0 / l * silu(g);
  }
}

__device__ __forceinline__ void sample_attn_wave(const Params& p, int rowid  , int lane, float* wsm) {
  const int h = rowid & 7, t = (rowid >> 3) & 7, db = rowid >> 6;
  const int srow = db * 8 + t, row = NP + srow;
  const float* QLAT = p.ws + W_QLAT; const float* Q = p.ws + W_Q;
  wsm[lane] = QLAT[(size_t)srow * 1024 + h * 128 + lane] * MLA_SCALE;
  wsm[64 + lane] = QLAT[(size_t)srow * 1024 + h * 128 + 64 + lane] * MLA_SCALE;
  if (lane < 32) wsm[128 + lane] = Q[(size_t)row * 768 + h * 96 + 64 + lane] * MLA_SCALE;
  float m = -1e30f, l = 0.f, o0 = 0.f, o1 = 0.f;
  for (int tile = 0; tile <= 128; ++tile) {
    const float* ckv; const float* kpe; bool valid;
    if (tile < 128) {
      const int k = tile * 64 + lane;
      const int page = p.page_table[db * NPG + (k >> 7)];
      const size_t base = (size_t)page * PAGE + (k & 127);
      ckv = p.cache_ckv + base * 128; kpe = p.cache_kpe + base * 32; valid = true;
    } else {
      const int u = lane < 8 ? lane : 0;
      valid = (lane < 8) && (lane <= t);
      ckv = p.out + O_CKVS + (size_t)(db * 8 + u) * 128; kpe = p.out + O_KPES + (size_t)(db * 8 + u) * 32;
    }
    attn_row_tile<128, 32, 128>(wsm, ckv, kpe, ckv, valid, lane, m, l, o0, o1);
  }
  float* OLAT = p.ws + W_OLAT;
  OLAT[(size_t)srow * 1024 + h * 128 + lane] = o0 / l;
  OLAT[(size_t)srow * 1024 + h * 128 + 64 + lane] = o1 / l;
}

__device__ __forceinline__ void mem_attn_wave(const Params& p, int item, int lane, float* wsm) {
  const int h = item / (NT / 16), r0 = (item - h * (NT / 16)) * 16;
  for (int ri = 0; ri < 16; ++ri) {
    const int row = r0 + ri;
    const float* kbase; const float* vbase;
    if (row < NP) { const int b = row / SEQ; kbase = p.out + O_MKP + (size_t)b * 256 * 256 + h * 64; vbase = p.out + O_MVP + (size_t)b * 256 * 256 + h * 64; }
    else { const int db = (row - NP) >> 3; kbase = p.cache_mem_k + (size_t)db * 256 * 256 + h * 64; vbase = p.cache_mem_v + (size_t)db * 256 * 256 + h * 64; }
    wsm[lane] = p.ws[W_PROJ + (size_t)row * INC + C_QX + h * 64 + lane] * X_SCALE;
    float m = -1e30f, l = 0.f, o0 = 0.f, o1 = 0.f;
    for (int tile = 0; tile < 4; ++tile) {
      const int j = tile * 64 + lane;
      attn_row_tile<64, 0, 64>(wsm, kbase + (size_t)j * 256, nullptr, vbase + (size_t)j * 256, true, lane, m, l, o0, o1);
    }
    const float g = p.ws[W_PROJ + (size_t)row * INC + C_GX + h * 64 + lane];
    p.ws[W_MIX + (size_t)row * 1024 + 768 + h * 64 + lane] = o0 / l * silu(g);
  }
}

#define CBAR() asm volatile("" ::: "memory")
__device__ __forceinline__ void rwkv_scan_wave(const Params& p, bool prompt, int bi, int h, int lane, float* wsm  ) {
  float S[64];
  const float* s0 = p.state_wkv + ((size_t)(bi * 4 + h) * 64 + lane) * 64;
#pragma unroll
  for (int k = 0; k < 64; ++k) S[k] = prompt ? 0.f : s0[k];
  const int T = prompt ? SEQ : DT, row0 = prompt ? bi * SEQ : NP + bi * DT;
  const float lg = p.lnx_g[h * 64 + lane], lb = p.lnx_b[h * 64 + lane], rk = p.r_k[h * 64 + lane];
#pragma unroll 1
  for (int t = 0; t < T; ++t) {
    const int row = row0 + t;
    const size_t off = (size_t)row * 256 + h * 64 + lane;
    const float r_l = p.ws[W_R + off], w_l = p.ws[W_W + off], kf_l = p.ws[W_KF + off], kk_l = p.ws[W_KK + off], bb_l = p.ws[W_BB + off];
    const float vv = p.ws[W_VV + off];
    wsm[lane] = kk_l; wsm[64 + lane] = w_l; wsm[128 + lane] = bb_l; wsm[192 + lane] = kf_l; wsm[256 + lane] = r_l;
    CBAR();
    float sa = 0.f;
#pragma unroll
    for (int c = 0; c < 4; ++c) {
#pragma unroll
      for (int k = 16 * c; k < 16 * c + 16; ++k) sa += S[k] * wsm[k];
      CBAR();
    }
    sa = -sa;
    float y = 0.f;
#pragma unroll
    for (int c = 0; c < 8; ++c) {
#pragma unroll
      for (int k = 8 * c; k < 8 * c + 8; ++k) { S[k] = S[k] * wsm[64 + k] + sa * wsm[128 + k] + vv * wsm[192 + k]; y += S[k] * wsm[256 + k]; }
      CBAR();
    }
    const float mean = wave_sum(y) * (1.f / 64.f), d = y - mean, var = wave_sum(d * d) * (1.f / 64.f);
    const float yn = d * rsqrtf(var + GN_EPS) * lg + lb;
    const float bsum = wave_sum(r_l * kf_l * rk);
    const float o = yn + bsum * vv;
    const float g = p.ws[W_PROJ + (size_t)row * INC + C_GRWKV + h * 64 + lane];
    p.ws[W_MIX + (size_t)row * 1024 + 512 + h * 64 + lane] = o * silu(g);
    CBAR();
  }
  float* so = prompt ? p.out + O_WKVP + ((size_t)(bi * 4 + h) * 64 + lane) * 64 : p.out + O_WKVS + ((size_t)(bi * 4 + h) * 64 + lane) * 64;
#pragma unroll
  for (int k = 0; k < 64; ++k) so[k] = S[k];
}


typedef unsigned short bf16;
#define LAS __attribute__((address_space(3)))
typedef unsigned v4u __attribute__((ext_vector_type(4)));
__device__ __forceinline__ unsigned f2bf(float f) { unsigned u = __builtin_bit_cast(unsigned, f); return (u + 0x7fffu + ((u >> 16) & 1u)) >> 16; }
__device__ __forceinline__ unsigned pk2(float lo, float hi) { return f2bf(lo) | (f2bf(hi) << 16); }
__device__ __forceinline__ void p0_transpose_item(const float* W, int K, int N, bf16* WT, int row_off, LAS float* scr, int item, int lane) {
  const int nblk = N / 32, kb = item / nblk, nb = item % nblk, k0 = 64 * kb, n0 = 32 * nb;
#pragma unroll 8
  for (int i = 0; i < 32; ++i) { const int kk = 2 * i + (lane >> 5); scr[kk * 33 + (lane & 31)] = W[(size_t)(k0 + kk) * N + n0 + (lane & 31)]; }
  asm volatile("s_waitcnt lgkmcnt(0)" ::: "memory");
  const int c = lane & 7;
#pragma unroll
  for (int j = 0; j < 4; ++j) { const int n = (lane >> 3) + 8 * j; const LAS float* s = scr + (8 * c) * 33 + n;
    v4u o; o.x = pk2(s[0 * 33], s[1 * 33]); o.y = pk2(s[2 * 33], s[3 * 33]); o.z = pk2(s[4 * 33], s[5 * 33]); o.w = pk2(s[6 * 33], s[7 * 33]);
    *(v4u*)(WT + (size_t)(row_off + n0 + n) * K + k0 + 8 * c) = o; }
  asm volatile("s_waitcnt lgkmcnt(0)" ::: "memory");
}

__global__ void __launch_bounds__(512) fwd_megakernel(Params p) {
  cg::grid_group grid = cg::this_grid();
  extern __shared__ __attribute__((aligned(16))) unsigned char lds[];
  float* sm = (float*)lds;
  bf16* wb = (bf16*)(p.ws + W_END);
  const int tid = threadIdx.x, lane = tid & 63, wv = tid >> 6;
  const int gw = blockIdx.x * 8 + wv, NGW = gridDim.x * 8;
  const int gtid = blockIdx.x * 512 + tid, NTH = gridDim.x * 512;
  float* ws = p.ws;

  {
    LAS float* scr = (LAS float*)((LAS unsigned char*)lds + wv * 16384);
    constexpr int I_IN = 16 * (INC / 32), I_MEM = 16 * (512 / 32), I_OUT = 16 * (1024 / 32);
    for (int it = gw; it < I_IN + I_MEM + I_OUT; it += NGW) {
      int r = it;
      if (r < I_IN) { p0_transpose_item(p.w_in, 1024, INC, wb + B_WIN, 0, scr, r, lane); continue; } r -= I_IN;
      if (r < I_MEM) { p0_transpose_item(p.w_mem_kv, 1024, 512, wb + B_WMEM, 0, scr, r, lane); continue; } r -= I_MEM;
      p0_transpose_item(p.w_out, 1024, 1024, wb + B_WOUT, 0, scr, r, lane);
    }
    for (int i = gtid; i < (INCP - INC) * 1024 / 8; i += NTH) ((v4u*)(wb + B_WIN + (size_t)INC * 1024))[i] = (v4u){0u, 0u, 0u, 0u};
  }
  for (int r = gw; r < NT + 1024; r += NGW) {
    const float* src; const float* g; bf16* dst;
    if (r < NT) { src = xrow(p, r); g = p.ln_g; dst = wb + B_H + (size_t)r * 1024; }
    else { src = p.mem_prompt + (size_t)(r - NT) * 1024; g = p.mem_norm_g; dst = wb + B_HM + (size_t)(r - NT) * 1024; }
    float4 v[4]; float ss = 0.f;
#pragma unroll
    for (int i = 0; i < 4; ++i) { v[i] = *(const float4*)(src + 4 * lane + 256 * i); ss += v[i].x * v[i].x + v[i].y * v[i].y + v[i].z * v[i].z + v[i].w * v[i].w; }
    const float rs = rsqrtf(wave_sum(ss) * (1.f / 1024.f) + RMS_EPS);
#pragma unroll
    for (int i = 0; i < 4; ++i) {
      const float4 gg = *(const float4*)(g + 4 * lane + 256 * i);
      uint2 o; o.x = pk2(v[i].x * rs * gg.x, v[i].y * rs * gg.y); o.y = pk2(v[i].z * rs * gg.z, v[i].w * rs * gg.w);
      *(uint2*)(dst + 4 * lane + 256 * i) = o;
    }
  }
  grid.sync();

  {
    pg8::Gemm g{wb + B_H, wb + B_WIN, NT, INCP, 1024}; pg8::StaticOrder S; S.init(NT, INCP, (int)gridDim.x, (int)blockIdx.x);
    pg8::EpiF32 E{ws + W_PROJ, INC, INC, 0, 0, nullptr, nullptr, 0};
    pg8::gemm_phase<pg8::EpiF32, pg8::StaticOrder, true, true>((PG8_LAS unsigned char*)lds, g, S, E);
  }
  {
    pg8::Gemm g{wb + B_HM, wb + B_WMEM, 1024, 512, 1024}; pg8::StaticOrder S; S.init(1024, 512, (int)gridDim.x, (int)((blockIdx.x + 20) % gridDim.x));
    pg8::EpiF32 E{p.out + O_MKP, 256, 256, 256, O_MVP - O_MKP, nullptr, nullptr, 0};
    pg8::gemm_phase<pg8::EpiF32, pg8::StaticOrder, true, true>((PG8_LAS unsigned char*)lds, g, S, E);
  }
  grid.sync();

  {
    float* tds = sm + wv * 128;
    for (int row = gw; row < NT; row += NGW) {
      const float* pr = ws + W_PROJ + (size_t)row * INC;
      {
        float v[4]; float ss = 0.f;
#pragma unroll
        for (int i = 0; i < 4; ++i) { v[i] = pr[C_CQ + lane + 64 * i]; ss += v[i] * v[i]; }
        const float rs = rsqrtf(wave_sum(ss) * (1.f / 256.f) + RMS_EPS);
#pragma unroll
        for (int i = 0; i < 4; ++i) ws[W_CQN + (size_t)row * 256 + lane + 64 * i] = v[i] * rs * p.q_norm_g[lane + 64 * i];
      }
      {
        const float v0 = pr[C_CKV + lane], v1 = pr[C_CKV + 64 + lane];
        const float rs = rsqrtf(wave_sum(v0 * v0 + v1 * v1) * (1.f / 128.f) + RMS_EPS);
        float* o = ckv_out_row(p, row);
        o[lane] = v0 * rs * p.kv_norm_g[lane]; o[64 + lane] = v1 * rs * p.kv_norm_g[64 + lane];
      }
      const int pos = row < NP ? (row % SEQ) : PAST + ((row - NP) & 7);
      if (lane < 16) {
        const float inv = 1.0f / powf(10000.0f, (float)lane * (2.0f / 32.0f));
        const float ang = (float)pos * inv; const float c = cosf(ang), s = sinf(ang);
        const float x1 = pr[C_KR + lane], x2 = pr[C_KR + 16 + lane];
        float* o = kpe_out_row(p, row);
        o[lane] = x1 * c - x2 * s; o[16 + lane] = x2 * c + x1 * s;
      }
      if (row < NP) { if ((row % SEQ) == SEQ - 1) { const int b = row / SEQ; for (int i = lane; i < 896; i += 64) p.out[O_SHP + (size_t)b * 896 + i] = pr[C_Z + i]; } }
      else { if (((row - NP) & 7) == 7) { const int db = (row - NP) >> 3; for (int i = lane; i < 896; i += 64) p.out[O_SHS + (size_t)db * 896 + i] = pr[C_Z + i]; } }
      {
        const bool first = row < NP ? ((row % SEQ) == 0) : (((row - NP) & 7) == 0);
        const float* prev = first ? (row < NP ? nullptr : p.state_shift + (size_t)((row - NP) >> 3) * 896 - C_Z) : pr - INC;
        auto zmix = [&](int i) -> float { const float z = pr[C_Z + i]; const float pv = prev ? prev[C_Z + i] : 0.f; return z + (pv - z) * p.shift_mu[i]; };
        tds[lane] = tanhf(zmix(768 + lane)); tds[64 + lane] = zmix(832 + lane);
        __builtin_amdgcn_fence(__ATOMIC_RELEASE, "wavefront"); __builtin_amdgcn_wave_barrier();
#pragma unroll 1
        for (int hh = 0; hh < 4; ++hh) {
          const int c = hh * 64 + lane;
          float u = p.w0[c], au = p.a0[c];
#pragma unroll 4
          for (int j = 0; j < 64; ++j) { u += tds[j] * p.w_up[j * 256 + c]; au += tds[64 + j] * p.a_up[j * 256 + c]; }
          const float nu = -u;
          const float sp = fmaxf(nu, 0.f) + log1pf(expf(-fabsf(nu)));
          const float wl = -sp - 0.5f;
          const float decay = expf(-expf(wl));
          const float a = 1.f / (1.f + expf(-au));
          const float k = zmix(256 + c), r = zmix(c), v = zmix(512 + c);
          float kk = k * p.k_k[c];
          const float nrm = fmaxf(sqrtf(wave_sum(kk * kk)), 1e-12f);
          kk = kk / nrm;
          const float kf = k * (1.f + (a - 1.f) * p.k_a[c]);
          const size_t o = (size_t)row * 256 + c;
          ws[W_R + o] = r; ws[W_W + o] = decay; ws[W_KF + o] = kf; ws[W_VV + o] = v; ws[W_KK + o] = kk; ws[W_BB + o] = kk * a;
        }
        __builtin_amdgcn_fence(__ATOMIC_RELEASE, "wavefront"); __builtin_amdgcn_wave_barrier();
      }
    }
  }
  grid.sync();

  gemm_f32<false>(ws + W_CQN, 256, p.w_uq, 768, ws + W_Q, 768, NT, 768, 256, sm);
  gemm_f32<false>(p.out + O_CKVP, 128, p.w_uk, 512, ws + W_KN, 512, NP, 512, 128, sm);
  gemm_f32<false>(p.out + O_CKVP, 128, p.w_uv, 512, ws + W_V, 512, NP, 512, 128, sm);
  grid.sync();

  for (int i = gtid; i < NT * 8 * 16; i += NTH) {
    const int j = i & 15, h = (i >> 4) & 7, row = i >> 7;
    const int pos = row < NP ? (row % SEQ) : PAST + ((row - NP) & 7);
    const float inv = 1.0f / powf(10000.0f, (float)j * (2.0f / 32.0f));
    const float ang = (float)pos * inv; const float c = cosf(ang), s = sinf(ang);
    float* q = ws + W_Q + (size_t)row * 768 + h * 96 + 64;
    const float x1 = q[j], x2 = q[16 + j];
    q[j] = x1 * c - x2 * s; q[16 + j] = x2 * c + x1 * s;
  }
  for (int h = 0; h < 8; ++h)
    gemm_f32<true>(ws + W_Q + (size_t)NP * 768 + h * 96, 768, p.w_uk + h * 64, 512, ws + W_QLAT + h * 128, 1024, NS, 128, 64, sm);
  grid.sync();

  {
    constexpr int N_RP = 16, N_RS = 512, N_PA = 2048, N_SA = 8192, N_MA = NT * 4 / 16;
    constexpr int TOT = N_RP + N_PA + N_SA + N_RS + N_MA;
    float* wsm = sm + wv * 320;
    for (int it = gw; it < TOT; it += NGW) {
      int i = __builtin_amdgcn_readfirstlane(it);
      if (i < N_RP) { rwkv_scan_wave(p, true, i >> 2, i & 3, lane, wsm); continue; }
      i -= N_RP;
      if (i < N_PA) { const int qb = 63 - (i >> 5), bh = i & 31; prompt_attn_wave(p, bh, qb, lane, wsm); continue; }
      i -= N_PA;
      if (i < N_SA) { sample_attn_wave(p, i, lane, wsm); continue; }
      i -= N_SA;
      if (i < N_RS) { rwkv_scan_wave(p, false, i >> 2, i & 3, lane, wsm); continue; }
      i -= N_RS;
      mem_attn_wave(p, i, lane, wsm);
    }
  }
  grid.sync();

  for (int i = gtid; i < NS * 512; i += NTH) {
    const int c = i & 511, srow = i >> 9, h = c >> 6;
    const float* ol = ws + W_OLAT + (size_t)srow * 1024 + h * 128;
    float acc = 0.f;
    for (int k = 0; k < 128; ++k) acc += ol[k] * p.w_uv[k * 512 + c];
    const int row = NP + srow;
    const float g = ws[W_PROJ + (size_t)row * INC + C_GMLA + c];
    ws[W_MIX + (size_t)row * 1024 + c] = acc * silu(g);
  }
  grid.sync();
  for (size_t i = gtid; i < (size_t)NT * 1024 / 4; i += NTH) {
    const float4 v = *(const float4*)(ws + W_MIX + i * 4);
    uint2 o; o.x = pk2(v.x, v.y); o.y = pk2(v.z, v.w);
    *(uint2*)(wb + B_MIX + i * 4) = o;
  }
  grid.sync();

  {
    pg8::Gemm g{wb + B_MIX, wb + B_WOUT, NT, 1024, 1024}; pg8::StaticOrder S; S.init(NT, 1024, (int)gridDim.x, (int)blockIdx.x);
    pg8::EpiF32 E{p.out, 1024, 1024, 0, 0, p.x_prompt, p.x_sample, NP};
    pg8::gemm_phase<pg8::EpiF32, pg8::StaticOrder, true, true>((PG8_LAS unsigned char*)lds, g, S, E);
  }
  grid.sync();

  for (int r = gw; r < NT; r += NGW) {
    float* y = p.out + (size_t)r * 1024;
    float v[16]; float ss = 0.f;
#pragma unroll
    for (int i = 0; i < 16; ++i) { v[i] = y[lane + 64 * i]; ss += v[i] * v[i]; }
    const float rs = rsqrtf(wave_sum(ss) * (1.f / 1024.f) + RMS_EPS);
#pragma unroll
    for (int i = 0; i < 16; ++i) y[lane + 64 * i] = v[i] * rs * p.final_g[lane + 64 * i];
  }
}

extern "C" void kernel_launch(void* const* d_in, const int* in_sizes, int n_in, void* d_out,
                              int out_size, void* d_ws, size_t ws_size, hipStream_t stream) {
  static int grid_blocks = 0;
  if (!grid_blocks) {
    int dev = 0, cus = 0, per_cu = 0;
    (void)hipGetDevice(&dev);
    (void)hipDeviceGetAttribute(&cus, hipDeviceAttributeMultiprocessorCount, dev);
    (void)hipFuncSetAttribute((const void*)fwd_megakernel, hipFuncAttributeMaxDynamicSharedMemorySize, LDS_BYTES);
    (void)hipOccupancyMaxActiveBlocksPerMultiprocessor(&per_cu, fwd_megakernel, 512, LDS_BYTES);
    if (per_cu < 1) per_cu = 1;
    grid_blocks = cus;
    if (ws_size < WS_BYTES) fprintf(stderr, "workspace too small: %zu < %zu\n", ws_size, (size_t)WS_BYTES);
  }
  Params p{};
  const float** pf = (const float**)&p;
  (void)pf;
  p.x_prompt = (const float*)d_in[0]; p.x_sample = (const float*)d_in[1]; p.mem_prompt = (const float*)d_in[2];
  p.cache_ckv = (const float*)d_in[3]; p.cache_kpe = (const float*)d_in[4]; p.page_table = (const int*)d_in[5];
  p.state_wkv = (const float*)d_in[6]; p.state_shift = (const float*)d_in[7]; p.cache_mem_k = (const float*)d_in[8];
  p.cache_mem_v = (const float*)d_in[9]; p.ln_g = (const float*)d_in[10]; p.w_in = (const float*)d_in[11];
  p.q_norm_g = (const float*)d_in[12]; p.kv_norm_g = (const float*)d_in[13]; p.w_uq = (const float*)d_in[14];
  p.w_uk = (const float*)d_in[15]; p.w_uv = (const float*)d_in[16]; p.shift_mu = (const float*)d_in[17];
  p.w0 = (const float*)d_in[18]; p.w_up = (const float*)d_in[19]; p.a0 = (const float*)d_in[20]; p.a_up = (const float*)d_in[21];
  p.k_k = (const float*)d_in[22]; p.k_a = (const float*)d_in[23]; p.r_k = (const float*)d_in[24]; p.lnx_g = (const float*)d_in[25];
  p.lnx_b = (const float*)d_in[26]; p.mem_norm_g = (const float*)d_in[27]; p.w_mem_kv = (const float*)d_in[28];
  p.w_out = (const float*)d_in[29]; p.final_g = (const float*)d_in[30];
  p.out = (float*)d_out; p.ws = (float*)d_ws;
  void* args[] = {&p};
  hipError_t e = hipLaunchCooperativeKernel((void*)fwd_megakernel, dim3(grid_blocks), dim3(512), args, LDS_BYTES, stream);
  if (e != hipSuccess) fprintf(stderr, "cooperative launch failed: %s (grid %d)\n", hipGetErrorString(e), grid_blocks);
}
```

```cpp
#include <hip/hip_runtime.h>
#include <hip/hip_cooperative_groups.h>
#include <cstdio>
#include <cstdint>
namespace cg = cooperative_groups;
namespace pg8 {
#define PG8_LAS __attribute__((address_space(3)))
typedef unsigned short bf16_t;
typedef short bf16x8 __attribute__((ext_vector_type(8)));
typedef float f32x4 __attribute__((ext_vector_type(4)));
typedef unsigned u32x4 __attribute__((ext_vector_type(4)));
constexpr int BM = 256, BK = 64, HALF = 128, HTB = HALF * BK * 2  , STAGE_BYTES = 8 * HTB, NXCD = 8, WGM = 8;

__host__ __device__ __forceinline__ int lds_byte(int r, int c) { const int st = (r >> 4) * 2 + (c >> 5), rr = r & 15, cc = c & 31, ob = rr * 64 + cc * 2; return st * 1024 + (ob ^ (((ob >> 9) & 1) << 5)); }
__host__ __device__ __forceinline__ void stage_rc(int b, int& R, int& C) { const int st = b / 1024, sb = b % 1024, swz = sb ^ (((sb >> 9) & 1) << 5); R = (st >> 1) * 16 + swz / 64; C = (st & 1) * 32 + (swz % 64) / 2; }
__host__ __device__ __forceinline__ int perm32(int rho) { const int n = rho >> 4, i = rho & 15; return 8 * (i >> 2) + 4 * n + (i & 3); }

struct Unit { int pm, pn; };
struct Gemm { const bf16_t* A; const bf16_t* Bt; int M, N, K; };

struct StaticOrder {
    int nM, nN, nwg, G, c;
    __host__ __device__ void init(int M, int N, int G_, int c_) { nM = M / BM; nN = N / BM; nwg = nM * nN; G = G_; c = c_; }
    __host__ __device__ bool next(int i, Unit& u) const {
        const long L = (long)i * G + c; if (L >= nwg) return false;
        int wgid = (int)L; { const int q = nwg / NXCD, r = nwg % NXCD, xcd = wgid % NXCD, off = wgid / NXCD; wgid = (xcd < r ? xcd * (q + 1) : r * (q + 1) + (xcd - r) * q) + off; }
        const int nig = WGM * nN, gid = wgid / nig, fm = gid * WGM, gsz = (nM - fm) < WGM ? (nM - fm) : WGM;
        u.pm = fm + ((wgid % nig) % gsz); u.pn = (wgid % nig) / gsz; return true;
    }
    __device__ __forceinline__ void a_ready(const Unit&) const {}
    __device__ __forceinline__ void done(const Unit&) const {}
};
__device__ __forceinline__ unsigned cvt_pk_bf16(float lo, float hi) { unsigned r; asm volatile("v_cvt_pk_bf16_f32 %0, %1, %2" : "=v"(r) : "v"(lo), "v"(hi)); return r; }
typedef float f32x2 __attribute__((ext_vector_type(2)));
template <class Epi, class Sched, bool ALIGN_EPI = false, bool SP2 = false>
__device__ __forceinline__ void gemm_phase(PG8_LAS unsigned char* lds, const Gemm g, const Sched& S, const Epi& E) {
    const int tid = threadIdx.x, wid = __builtin_amdgcn_readfirstlane(tid >> 6), lane = tid & 63, wr = wid >> 2, wc = wid & 3, fr = lane & 15, fq = lane >> 4;
    const int K = g.K, nt = K / BK;
    unsigned voffA[2], voffB[2];
#pragma unroll
    for (int i = 0; i < 2; ++i) { int R, C; stage_rc(tid * 16 + i * 8192, R, C); const int Rb = Epi::PERM ? ((R & ~31) + perm32(R & 31)) : R;
        voffA[i] = (unsigned)(R * K + C) * 2u; voffB[i] = (unsigned)(Rb * K + C) * 2u; }
    const size_t kstep = (size_t)(BK * 2);
    const size_t hstep = (size_t)HALF * K * 2;
    const size_t tstep = 2 * hstep;
    const unsigned ldsw = (unsigned)wid * 1024u;
    const int aoff = lds_byte(wr * 64 + fr, fq * 8), boff = lds_byte(wc * 32 + fr, fq * 8);
#define PG8_SA(b, h) (((b) * 2 + (h)) * HTB)
#define PG8_SB(b, h) ((4 + (b) * 2 + (h)) * HTB)
#define PG8_STAGE(bufoff, gbase, voff) do { _Pragma("unroll") for (int _i = 0; _i < 2; ++_i) \
        __builtin_amdgcn_global_load_lds((const unsigned*)((const char*)(gbase) + (voff)[_i]), (PG8_LAS unsigned*)(lds + (bufoff) + ldsw + _i * 8192), 16, 0, 0); } while (0)
#define PG8_LDA(dst, b, h) do { _Pragma("unroll") for (int m = 0; m < 4; ++m) _Pragma("unroll") for (int k = 0; k < 2; ++k) dst[m][k] = *(const PG8_LAS bf16x8*)(lds + PG8_SA(b, h) + aoff + m * 2048 + k * 1024); } while (0)
#define PG8_LDB(dst, b, h) do { _Pragma("unroll") for (int n = 0; n < 2; ++n) _Pragma("unroll") for (int k = 0; k < 2; ++k) dst[n][k] = *(const PG8_LAS bf16x8*)(lds + PG8_SB(b, h) + boff + n * 2048 + k * 1024); } while (0)
#define PG8_MMA(ai, bj, At, Bt) do { __builtin_amdgcn_s_setprio(1); _Pragma("unroll") for (int m = 0; m < 4; ++m) _Pragma("unroll") for (int n = 0; n < 2; ++n) _Pragma("unroll") for (int k = 0; k < 2; ++k) \
        acc[ai][bj][m][n] = __builtin_amdgcn_mfma_f32_16x16x32_bf16(Bt[n][k], At[m][k], acc[ai][bj][m][n], 0, 0, 0); __builtin_amdgcn_s_setprio(0); } while (0)
#define PG8_WAIT_V(n) asm volatile("s_waitcnt vmcnt(" #n ")" ::: "memory")
#define PG8_WAIT_L(n) asm volatile("s_waitcnt lgkmcnt(" #n ")" ::: "memory")
#define PG8_BAR __builtin_amdgcn_s_barrier()
#define PG8_SCHED __builtin_amdgcn_sched_barrier(0)
    Unit cur, nxt; int ui = 0;
    if (!S.next(0, cur)) return;
    f32x4 acc[2][2][4][2];
#pragma unroll
    for (int a = 0; a < 2; ++a)
#pragma unroll
        for (int b = 0; b < 2; ++b)
#pragma unroll
            for (int m = 0; m < 4; ++m)
#pragma unroll
                for (int n = 0; n < 2; ++n) acc[a][b][m][n] = (f32x4){0.f, 0.f, 0.f, 0.f};
    bf16x8 At[4][2], B0[2][2], B1[2][2];
    const char* cA = (const char*)g.A + (size_t)cur.pm * tstep; const char* cB = (const char*)g.Bt + (size_t)cur.pn * tstep;
    S.a_ready(cur);
    if constexpr (SP2) {
        PG8_STAGE(PG8_SB(0, 0), cB, voffB); PG8_STAGE(PG8_SB(0, 1), cB + hstep, voffB); PG8_STAGE(PG8_SA(0, 0), cA, voffA); PG8_STAGE(PG8_SA(0, 1), cA + hstep, voffA);
        if (wr == 1) PG8_BAR;
        PG8_WAIT_V(2); PG8_BAR;
        PG8_STAGE(PG8_SB(1, 0), cB + kstep, voffB); PG8_STAGE(PG8_SA(1, 0), cA + kstep, voffA); PG8_STAGE(PG8_SB(1, 1), cB + hstep + kstep, voffB);
        PG8_WAIT_V(6); PG8_BAR;
    } else {
        PG8_STAGE(PG8_SB(0, 0), cB, voffB); PG8_STAGE(PG8_SA(0, 0), cA, voffA); PG8_STAGE(PG8_SB(0, 1), cB + hstep, voffB); PG8_STAGE(PG8_SA(0, 1), cA + hstep, voffA);
        if (wr == 1) PG8_BAR;
        PG8_WAIT_V(4); PG8_BAR;
        PG8_STAGE(PG8_SB(1, 0), cB + kstep, voffB); PG8_STAGE(PG8_SA(1, 0), cA + kstep, voffA); PG8_STAGE(PG8_SB(1, 1), cB + hstep + kstep, voffB);
        PG8_WAIT_V(6); PG8_BAR;
    }
    for (;;) {
        const bool has_next = S.next(ui + 1, nxt);
        const char* nA = has_next ? (const char*)g.A + (size_t)nxt.pm * tstep : cA; const char* nB = has_next ? (const char*)g.Bt + (size_t)nxt.pn * tstep : cB;
        for (int t = 0; t < nt; t += 2) {
            const bool last = (t == nt - 2);
            const char* a1 = cA + (size_t)(t + 1) * kstep;
            const char* a2 = last ? nA : cA + (size_t)(t + 2) * kstep; const char* b2 = last ? nB : cB + (size_t)(t + 2) * kstep;
            const char* a3 = a2 + kstep; const char* b3 = b2 + kstep;
            if (last && has_next) S.a_ready(nxt);
            if constexpr (SP2) {
            PG8_LDB(B0, 0, 0); PG8_LDB(B1, 0, 1); PG8_SCHED; PG8_LDA(At, 0, 0); PG8_STAGE(PG8_SA(1, 1), a1 + hstep, voffA);
            PG8_WAIT_V(8); PG8_WAIT_L(0); PG8_BAR; PG8_MMA(0, 0, At, B0); PG8_MMA(0, 1, At, B1); PG8_BAR; PG8_SCHED;
            PG8_LDA(At, 0, 1); PG8_STAGE(PG8_SB(0, 0), b2, voffB); PG8_STAGE(PG8_SB(0, 1), b2 + hstep, voffB); PG8_STAGE(PG8_SA(0, 0), a2, voffA);
            PG8_WAIT_V(8); PG8_WAIT_L(0); PG8_BAR; PG8_MMA(1, 0, At, B0); PG8_MMA(1, 1, At, B1); PG8_BAR; PG8_SCHED;
            PG8_LDB(B0, 1, 0); PG8_LDB(B1, 1, 1); PG8_SCHED; PG8_LDA(At, 1, 0); PG8_STAGE(PG8_SA(0, 1), a2 + hstep, voffA);
            PG8_WAIT_V(8); PG8_WAIT_L(0); PG8_BAR; PG8_MMA(0, 0, At, B0); PG8_MMA(0, 1, At, B1); PG8_BAR; PG8_SCHED;
            PG8_LDA(At, 1, 1); PG8_STAGE(PG8_SB(1, 0), b3, voffB); PG8_STAGE(PG8_SB(1, 1), b3 + hstep, voffB); PG8_STAGE(PG8_SA(1, 0), a3, voffA);
            PG8_WAIT_V(8); PG8_WAIT_L(0); PG8_BAR; PG8_MMA(1, 0, At, B0); PG8_MMA(1, 1, At, B1); PG8_BAR; PG8_SCHED;
            } else {
            PG8_LDB(B0, 0, 0); PG8_SCHED; PG8_LDA(At, 0, 0); PG8_STAGE(PG8_SA(1, 1), a1 + hstep, voffA);
            PG8_WAIT_L(8); PG8_BAR; PG8_WAIT_L(0); PG8_MMA(0, 0, At, B0); PG8_BAR; PG8_SCHED;
            PG8_LDB(B1, 0, 1); PG8_STAGE(PG8_SB(0, 0), b2, voffB);
            PG8_BAR; PG8_WAIT_L(0); PG8_MMA(0, 1, At, B1); PG8_BAR;
            PG8_LDA(At, 0, 1); PG8_STAGE(PG8_SA(0, 0), a2, voffA);
            PG8_BAR; PG8_WAIT_L(0); PG8_MMA(1, 0, At, B0); PG8_BAR; PG8_SCHED;
            PG8_STAGE(PG8_SB(0, 1), b2 + hstep, voffB);
            PG8_WAIT_V(6); PG8_BAR; PG8_MMA(1, 1, At, B1); PG8_BAR;
            PG8_LDB(B0, 1, 0); PG8_SCHED; PG8_LDA(At, 1, 0); PG8_STAGE(PG8_SA(0, 1), a2 + hstep, voffA);
            PG8_WAIT_L(8); PG8_BAR; PG8_WAIT_L(0); PG8_MMA(0, 0, At, B0); PG8_BAR; PG8_SCHED;
            PG8_LDB(B1, 1, 1); PG8_STAGE(PG8_SB(1, 0), b3, voffB);
            PG8_BAR; PG8_WAIT_L(0); PG8_MMA(0, 1, At, B1); PG8_BAR;
            PG8_LDA(At, 1, 1); PG8_STAGE(PG8_SA(1, 0), a3, voffA);
            PG8_BAR; PG8_WAIT_L(0); PG8_MMA(1, 0, At, B0); PG8_BAR; PG8_SCHED;
            PG8_STAGE(PG8_SB(1, 1), b3 + hstep, voffB);
            PG8_WAIT_V(6); PG8_BAR; PG8_MMA(1, 1, At, B1); PG8_BAR;
            }
        }
        if constexpr (ALIGN_EPI) { if (wr == 0) PG8_BAR; }
        if constexpr (!Epi::AFTER_DRAIN) { E(acc, cur, wr, wc, fr, fq); S.done(cur); }
        if (!has_next) break;
#pragma unroll
        for (int a = 0; a < 2; ++a)
#pragma unroll
            for (int b = 0; b < 2; ++b)
#pragma unroll
                for (int m = 0; m < 4; ++m)
#pragma unroll
                    for (int n = 0; n < 2; ++n) acc[a][b][m][n] = (f32x4){0.f, 0.f, 0.f, 0.f};
        cur = nxt; cA = nA; cB = nB; ++ui;
        if constexpr (ALIGN_EPI) { if (wr == 1) PG8_BAR; }
    }
    PG8_WAIT_V(0);
    if constexpr (!ALIGN_EPI) { if (wr == 0) PG8_BAR; }
    PG8_BAR;
    if constexpr (Epi::AFTER_DRAIN) { E.fused(acc, cur, wr, wc, fr, fq, lds, wid, lane); S.done(cur); }
#undef PG8_SA
#undef PG8_SB
#undef PG8_STAGE
#undef PG8_LDA
#undef PG8_LDB
#undef PG8_MMA
#undef PG8_WAIT_V
#undef PG8_WAIT_L
#undef PG8_BAR
#undef PG8_SCHED
}
}

namespace pg8 {
struct EpiF32 {
  static constexpr bool PERM = false, AFTER_DRAIN = false;
  float* C; int ldc; int ncols; int split_cols; size_t split_stride; const float* r0; const float* r1; int nr0;
  __device__ __forceinline__ void operator()(const f32x4 (&acc)[2][2][4][2], const Unit& u, int wr, int wc, int fr, int fq) const {
    const int row0 = u.pm * BM + wr * 64 + fr; int colt = u.pn * BM; float* base = C;
    if (split_cols) { const int t = colt / split_cols; base += (size_t)t * split_stride; colt -= t * split_cols; }
    const int col0 = colt + wc * 32 + 4 * fq;
#pragma unroll
    for (int ai = 0; ai < 2; ++ai)
#pragma unroll
      for (int m = 0; m < 4; ++m) {
        const int row = row0 + ai * HALF + m * 16;
        const float* rr = r0 ? (row < nr0 ? r0 + (size_t)row * ldc : r1 + (size_t)(row - nr0) * ldc) : nullptr;
#pragma unroll
        for (int bj = 0; bj < 2; ++bj)
#pragma unroll
          for (int n = 0; n < 2; ++n) {
            const int col = col0 + bj * HALF + n * 16;
            if (col < ncols) { f32x4 v = acc[ai][bj][m][n]; if (rr) v += *(const f32x4*)(rr + col); *(f32x4*)(base + (size_t)row * ldc + col) = v; }
          }
      }
  }
};
}

constexpr int DM = 1024, BATCH = 4, SEQ = 4096, DB = 128, DT = 8, PAST = 8192, PAGE = 128, NPG = 64, NMEM = 256;
constexpr int NP = BATCH * SEQ, NS = DB * DT, NT = NP + NS;
constexpr int INC = 2592;
constexpr int C_CQ = 0, C_CKV = 256, C_KR = 384, C_GMLA = 416, C_Z = 928, C_GRWKV = 1824, C_QX = 2080, C_GX = 2336;
constexpr float MLA_SCALE = 0.10206207261596575f;
constexpr float X_SCALE = 0.125f;
constexpr float RMS_EPS = 1e-6f, GN_EPS = 64e-5f;
constexpr size_t O_YP = 0, O_YS = 16777216, O_CKVP = 17825792, O_KPEP = 19922944, O_WKVP = 20447232, O_SHP = 20512768,
                 O_MKP = 20516352, O_MVP = 20778496, O_CKVS = 21040640, O_KPES = 21171712, O_WKVS = 21204480, O_SHS = 23301632;
constexpr size_t W_H = 0;
constexpr size_t W_HM = W_H + (size_t)NT * 1024;
constexpr size_t W_PROJ = W_HM + (size_t)1024 * 1024;
constexpr size_t W_CQN = W_PROJ + (size_t)NT * INC;
constexpr size_t W_Q = W_CQN + (size_t)NT * 256;
constexpr size_t W_KN = W_Q + (size_t)NT * 768;
constexpr size_t W_V = W_KN + (size_t)NP * 512;
constexpr size_t W_QLAT = W_V + (size_t)NP * 512;
constexpr size_t W_OLAT = W_QLAT + (size_t)NS * 1024;
constexpr size_t W_R = W_OLAT + (size_t)NS * 1024;
constexpr size_t W_W = W_R + (size_t)NT * 256;
constexpr size_t W_KF = W_W + (size_t)NT * 256;
constexpr size_t W_VV = W_KF + (size_t)NT * 256;
constexpr size_t W_KK = W_VV + (size_t)NT * 256;
constexpr size_t W_BB = W_KK + (size_t)NT * 256;
constexpr size_t W_MIX = W_BB + (size_t)NT * 256;
constexpr size_t W_END = W_MIX + (size_t)NT * 1024;
constexpr int INCP = 2816;
constexpr size_t B_H = 0;
constexpr size_t B_HM = B_H + (size_t)NT * 1024;
constexpr size_t B_WIN = B_HM + (size_t)1024 * 1024;
constexpr size_t B_WMEM = B_WIN + (size_t)INCP * 1024;
constexpr size_t B_WOUT = B_WMEM + (size_t)512 * 1024;
constexpr size_t B_MIX = B_WOUT + (size_t)1024 * 1024;
constexpr size_t B_QP = B_MIX + (size_t)NT * 1024;
constexpr size_t B_KP = B_QP + (size_t)NP * 768;
constexpr size_t B_VT = B_KP + (size_t)NP * 768;
constexpr size_t B_END = B_VT + (size_t)512 * NP;
constexpr size_t WS_BYTES = W_END * 4 + B_END * 2;
constexpr int LDS_BYTES = 147456;

struct Params {
  const float* x_prompt; const float* x_sample; const float* mem_prompt; const float* cache_ckv; const float* cache_kpe;
  const int* page_table; const float* state_wkv; const float* state_shift; const float* cache_mem_k; const float* cache_mem_v;
  const float* ln_g; const float* w_in; const float* q_norm_g; const float* kv_norm_g; const float* w_uq; const float* w_uk;
  const float* w_uv; const float* shift_mu; const float* w0; const float* w_up; const float* a0; const float* a_up;
  const float* k_k; const float* k_a; const float* r_k; const float* lnx_g; const float* lnx_b; const float* mem_norm_g;
  const float* w_mem_kv; const float* w_out; const float* final_g;
  float* out; float* ws;
};

__device__ __forceinline__ float wave_sum(float v) {
#pragma unroll
  for (int o = 1; o < 64; o <<= 1) v += __shfl_xor(v, o);
  return v;
}
__device__ __forceinline__ float wave_max(float v) {
#pragma unroll
  for (int o = 1; o < 64; o <<= 1) v = fmaxf(v, __shfl_xor(v, o));
  return v;
}
__device__ __forceinline__ float silu(float x) { return x / (1.f + expf(-x)); }
__device__ __forceinline__ const float* xrow(const Params& p, int row) {
  return row < NP ? p.x_prompt + (size_t)row * DM : p.x_sample + (size_t)(row - NP) * DM;
}
__device__ __forceinline__ float* ckv_out_row(const Params& p, int row) {
  return row < NP ? p.out + O_CKVP + (size_t)row * 128 : p.out + O_CKVS + (size_t)(row - NP) * 128;
}
__device__ __forceinline__ float* kpe_out_row(const Params& p, int row) {
  return row < NP ? p.out + O_KPEP + (size_t)row * 32 : p.out + O_KPES + (size_t)(row - NP) * 32;
}

template <bool BT>
__device__ __forceinline__ void gemm_f32(const float* __restrict__ A, int lda, const float* __restrict__ B, int ldb, float* __restrict__ C, int ldc,
                         int M, int N, int K, float* sm) {
  const int tid = threadIdx.x, tx = tid & 15, ty = tid >> 4;
  float(*As)[68] = (float(*)[68])sm;
  float(*Bs)[68] = (float(*)[68])(sm + 16 * 68);
  const int tm = M / 64, tn = (N + 63) / 64;
  for (int tile = blockIdx.x; tile < tm * tn; tile += gridDim.x) {
    const int m0 = (tile / tn) * 64, n0 = (tile % tn) * 64;
    float acc[2][4];
#pragma unroll
    for (int i = 0; i < 2; ++i)
#pragma unroll
      for (int j = 0; j < 4; ++j) acc[i][j] = 0.f;
    for (int k0 = 0; k0 < K; k0 += 16) {
      for (int i = tid; i < 1024; i += 512) { const int r = i >> 4, kk = i & 15; As[kk][r] = A[(size_t)(m0 + r) * lda + k0 + kk]; }
      if (BT) {
        for (int i = tid; i < 1024; i += 512) { const int c = i >> 4, kk = i & 15; Bs[kk][c] = (n0 + c < N) ? B[(size_t)(n0 + c) * ldb + k0 + kk] : 0.f; }
      } else {
        for (int i = tid; i < 1024; i += 512) { const int kk = i >> 6, c = i & 63; Bs[kk][c] = (n0 + c < N) ? B[(size_t)(k0 + kk) * ldb + n0 + c] : 0.f; }
      }
      __syncthreads();
#pragma unroll
      for (int kk = 0; kk < 16; ++kk) {
        const float a0 = As[kk][ty * 2], a1 = As[kk][ty * 2 + 1];
        const float b0 = Bs[kk][tx * 4], b1 = Bs[kk][tx * 4 + 1], b2 = Bs[kk][tx * 4 + 2], b3 = Bs[kk][tx * 4 + 3];
        acc[0][0] += a0 * b0; acc[0][1] += a0 * b1; acc[0][2] += a0 * b2; acc[0][3] += a0 * b3;
        acc[1][0] += a1 * b0; acc[1][1] += a1 * b1; acc[1][2] += a1 * b2; acc[1][3] += a1 * b3;
      }
      __syncthreads();
    }
#pragma unroll
    for (int i = 0; i < 2; ++i)
#pragma unroll
      for (int j = 0; j < 4; ++j) { const int col = n0 + tx * 4 + j; if (col < N) C[(size_t)(m0 + ty * 2 + i) * ldc + col] = acc[i][j]; }
  }
}

template <int D1, int D2, int DV>
__device__ __forceinline__ void attn_row_tile(const float* wsm, const float* k1, const float* k2, const float* v, bool valid, int lane,
                                              float& m, float& l, float& o0, float& o1) {
  float sc = 0.f;
#pragma unroll 4
  for (int c = 0; c < D1; c += 4) { const float4 kv = *(const float4*)(k1 + c); sc += wsm[c] * kv.x + wsm[c + 1] * kv.y + wsm[c + 2] * kv.z + wsm[c + 3] * kv.w; }
  if (D2 > 0)
#pragma unroll 4
  for (int c = 0; c < D2; c += 4) { const float4 kv = *(const float4*)(k2 + c); sc += wsm[D1 + c] * kv.x + wsm[D1 + c + 1] * kv.y + wsm[D1 + c + 2] * kv.z + wsm[D1 + c + 3] * kv.w; }
  sc = valid ? sc : -1e30f;
  const float tmax = wave_max(sc), mn = fmaxf(m, tmax), alpha = expf(m - mn), pj = valid ? expf(sc - mn) : 0.f;
  l = l * alpha + wave_sum(pj); o0 *= alpha; o1 *= alpha;
  const unsigned long long pa = (unsigned long long)(uintptr_t)v;
  const int plo = (int)(unsigned)(pa & 0xffffffffull), phi = (int)(unsigned)(pa >> 32);
#pragma unroll 2
  for (int j = 0; j < 64; ++j) {
    const float pjj = __shfl(pj, j);
    const unsigned lo = (unsigned)__shfl(plo, j), hi = (unsigned)__shfl(phi, j);
    const float* vj = (const float*)(uintptr_t)(((unsigned long long)hi << 32) | lo);
    o0 += pjj * vj[lane];
    if (DV > 64) o1 += pjj * vj[64 + lane];
  }
  m = mn;
}

__device__ __forceinline__ void prompt_attn_wave(const Params& p, int bh, int qb, int lane, float* wsm) {
  const int b = bh >> 3, h = bh & 7;
  const float* Q = p.ws + W_Q; const float* KN = p.ws + W_KN; const float* V = p.ws + W_V; const float* KPE = p.out + O_KPEP;
  for (int qi = 0; qi < 64; ++qi) {
    const int s = qb * 64 + qi, row = b * SEQ + s;
    wsm[lane] = Q[(size_t)row * 768 + h * 96 + lane] * MLA_SCALE;
    if (lane < 32) wsm[64 + lane] = Q[(size_t)row * 768 + h * 96 + 64 + lane] * MLA_SCALE;
    float m = -1e30f, l = 0.f, o0 = 0.f, o1 = 0.f;
    for (int tile = 0; tile <= qb; ++tile) {
      const int j = tile * 64 + lane;
      const size_t krow = (size_t)b * SEQ + j;
      attn_row_tile<64, 32, 64>(wsm, KN + krow * 512 + h * 64, KPE + krow * 32, V + krow * 512 + h * 64, j <= s, lane, m, l, o0, o1);
    }
    const float g = p.ws[W_PROJ + (size_t)row * INC + C_GMLA + h * 64 + lane];
    p.ws[W_MIX + (size_t)row * 1024 + h * 64 + lane] = o0 / l * silu(g);
  }
}

__device__ __forceinline__ void sample_attn_wave(const Params& p, int rowid  , int lane, float* wsm) {
  const int h = rowid & 7, t = (rowid >> 3) & 7, db = rowid >> 6;
  const int srow = db * 8 + t, row = NP + srow;
  const float* QLAT = p.ws + W_QLAT; const float* Q = p.ws + W_Q;
  wsm[lane] = QLAT[(size_t)srow * 1024 + h * 128 + lane] * MLA_SCALE;
  wsm[64 + lane] = QLAT[(size_t)srow * 1024 + h * 128 + 64 + lane] * MLA_SCALE;
  if (lane < 32) wsm[128 + lane] = Q[(size_t)row * 768 + h * 96 + 64 + lane] * MLA_SCALE;
  float m = -1e30f, l = 0.f, o0 = 0.f, o1 = 0.f;
  for (int tile = 0; tile <= 128; ++tile) {
    const float* ckv; const float* kpe; bool valid;
    if (tile < 128) {
      const int k = tile * 64 + lane;
      const int page = p.page_table[db * NPG + (k >> 7)];
      const size_t base = (size_t)page * PAGE + (k & 127);
      ckv = p.cache_ckv + base * 128; kpe = p.cache_kpe + base * 32; valid = true;
    } else {
      const int u = lane < 8 ? lane : 0;
      valid = (lane < 8) && (lane <= t);
      ckv = p.out + O_CKVS + (size_t)(db * 8 + u) * 128; kpe = p.out + O_KPES + (size_t)(db * 8 + u) * 32;
    }
    attn_row_tile<128, 32, 128>(wsm, ckv, kpe, ckv, valid, lane, m, l, o0, o1);
  }
  float* OLAT = p.ws + W_OLAT;
  OLAT[(size_t)srow * 1024 + h * 128 + lane] = o0 / l;
  OLAT[(size_t)srow * 1024 + h * 128 + 64 + lane] = o1 / l;
}

__device__ __forceinline__ void mem_attn_wave(const Params& p, int item, int lane, float* wsm) {
  const int h = item / (NT / 16), r0 = (item - h * (NT / 16)) * 16;
  for (int ri = 0; ri < 16; ++ri) {
    const int row = r0 + ri;
    const float* kbase; const float* vbase;
    if (row < NP) { const int b = row / SEQ; kbase = p.out + O_MKP + (size_t)b * 256 * 256 + h * 64; vbase = p.out + O_MVP + (size_t)b * 256 * 256 + h * 64; }
    else { const int db = (row - NP) >> 3; kbase = p.cache_mem_k + (size_t)db * 256 * 256 + h * 64; vbase = p.cache_mem_v + (size_t)db * 256 * 256 + h * 64; }
    wsm[lane] = p.ws[W_PROJ + (size_t)row * INC + C_QX + h * 64 + lane] * X_SCALE;
    float m = -1e30f, l = 0.f, o0 = 0.f, o1 = 0.f;
    for (int tile = 0; tile < 4; ++tile) {
      const int j = tile * 64 + lane;
      attn_row_tile<64, 0, 64>(wsm, kbase + (size_t)j * 256, nullptr, vbase + (size_t)j * 256, true, lane, m, l, o0, o1);
    }
    const float g = p.ws[W_PROJ + (size_t)row * INC + C_GX + h * 64 + lane];
    p.ws[W_MIX + (size_t)row * 1024 + 768 + h * 64 + lane] = o0 / l * silu(g);
  }
}

#define CBAR() asm volatile("" ::: "memory")
__device__ __forceinline__ void rwkv_scan_wave(const Params& p, bool prompt, int bi, int h, int lane, float* wsm  ) {
  float S[64];
  const float* s0 = p.state_wkv + ((size_t)(bi * 4 + h) * 64 + lane) * 64;
#pragma unroll
  for (int k = 0; k < 64; ++k) S[k] = prompt ? 0.f : s0[k];
  const int T = prompt ? SEQ : DT, row0 = prompt ? bi * SEQ : NP + bi * DT;
  const float lg = p.lnx_g[h * 64 + lane], lb = p.lnx_b[h * 64 + lane], rk = p.r_k[h * 64 + lane];
#pragma unroll 1
  for (int t = 0; t < T; ++t) {
    const int row = row0 + t;
    const size_t off = (size_t)row * 256 + h * 64 + lane;
    const float r_l = p.ws[W_R + off], w_l = p.ws[W_W + off], kf_l = p.ws[W_KF + off], kk_l = p.ws[W_KK + off], bb_l = p.ws[W_BB + off];
    const float vv = p.ws[W_VV + off];
    wsm[lane] = kk_l; wsm[64 + lane] = w_l; wsm[128 + lane] = bb_l; wsm[192 + lane] = kf_l; wsm[256 + lane] = r_l;
    CBAR();
    float sa = 0.f;
#pragma unroll
    for (int c = 0; c < 4; ++c) {
#pragma unroll
      for (int k = 16 * c; k < 16 * c + 16; ++k) sa += S[k] * wsm[k];
      CBAR();
    }
    sa = -sa;
    float y = 0.f;
#pragma unroll
    for (int c = 0; c < 8; ++c) {
#pragma unroll
      for (int k = 8 * c; k < 8 * c + 8; ++k) { S[k] = S[k] * wsm[64 + k] + sa * wsm[128 + k] + vv * wsm[192 + k]; y += S[k] * wsm[256 + k]; }
      CBAR();
    }
    const float mean = wave_sum(y) * (1.f / 64.f), d = y - mean, var = wave_sum(d * d) * (1.f / 64.f);
    const float yn = d * rsqrtf(var + GN_EPS) * lg + lb;
    const float bsum = wave_sum(r_l * kf_l * rk);
    const float o = yn + bsum * vv;
    const float g = p.ws[W_PROJ + (size_t)row * INC + C_GRWKV + h * 64 + lane];
    p.ws[W_MIX + (size_t)row * 1024 + 512 + h * 64 + lane] = o * silu(g);
    CBAR();
  }
  float* so = prompt ? p.out + O_WKVP + ((size_t)(bi * 4 + h) * 64 + lane) * 64 : p.out + O_WKVS + ((size_t)(bi * 4 + h) * 64 + lane) * 64;
#pragma unroll
  for (int k = 0; k < 64; ++k) so[k] = S[k];
}


typedef unsigned short bf16;
namespace pa {
typedef short bf16x8 __attribute__((ext_vector_type(8)));
typedef short s16x4 __attribute__((ext_vector_type(4)));
typedef float f32x16 __attribute__((ext_vector_type(16)));
typedef unsigned u32x4 __attribute__((ext_vector_type(4)));
typedef unsigned u32x2 __attribute__((ext_vector_type(2)));
typedef float f32x2_t __attribute__((ext_vector_type(2)));
typedef __bf16 bf16x2_t __attribute__((ext_vector_type(2)));
constexpr int KSTR = 208, VSTR = 136, KBYTES = 64 * KSTR, VBYTES = 64 * VSTR, STG = KBYTES + VBYTES;
__device__ __forceinline__ unsigned cvtpk(float lo, float hi) { f32x2_t v = {lo, hi}; bf16x2_t b = __builtin_convertvector(v, bf16x2_t); return __builtin_bit_cast(unsigned, b); }
__device__ __forceinline__ int crow(int r, int hi) { return (r & 3) + 8 * (r >> 2) + 4 * hi; }
__device__ __forceinline__ float swap_max(float v) { auto rr = __builtin_amdgcn_permlane32_swap(__float_as_uint(v), __float_as_uint(v), false, false); return fmaxf(__uint_as_float(rr[0]), __uint_as_float(rr[1])); }
__device__ __forceinline__ float swap_sum(float v) { auto rr = __builtin_amdgcn_permlane32_swap(__float_as_uint(v), __float_as_uint(v), false, false); return __uint_as_float(rr[0]) + __uint_as_float(rr[1]); }

template <int DQK, bool CAUSAL, class Out>
__device__ __forceinline__ void attn_unit(unsigned char* lds, const bf16* Qb, int qs, const bf16* Kb, int ks, const bf16* Vb, int vs, int ntiles, int qpos0, const Out& out) {
  const int tid = threadIdx.x, lane = tid & 63, wid = __builtin_amdgcn_readfirstlane(tid >> 6), r32 = lane & 31, hi = lane >> 5;
  constexpr int CPR = DQK / 8, NKC = 64 * CPR, KS = DQK / 16;
  bf16x8 qf[KS];
#pragma unroll
  for (int s = 0; s < KS; ++s) qf[s] = *(const bf16x8*)(Qb + (size_t)(wid * 32 + r32) * qs + 16 * s + 8 * hi);
  u32x4 kreg0, kreg1, vreg;
  const int kc0 = tid, kc1 = tid + 512;
  const int krow0 = kc0 / CPR, kcc0 = kc0 % CPR, krow1 = kc1 / CPR, kcc1 = kc1 % CPR;
  const int vdv = tid >> 3, vcc = tid & 7;
#define PA_GLOAD(t) do { kreg0 = *(const u32x4*)(Kb + (size_t)(64 * (t) + krow0) * ks + kcc0 * 8); \
    if (kc1 < NKC) kreg1 = *(const u32x4*)(Kb + (size_t)(64 * (t) + krow1) * ks + kcc1 * 8); \
    vreg = *(const u32x4*)(Vb + (size_t)vdv * vs + 64 * (t) + vcc * 8); } while (0)
#define PA_LSTORE(buf) do { unsigned char* b_ = lds + (buf) * STG; *(u32x4*)(b_ + krow0 * KSTR + kcc0 * 16) = kreg0; \
    if (kc1 < NKC) *(u32x4*)(b_ + krow1 * KSTR + kcc1 * 16) = kreg1; \
    *(u32x2*)(b_ + KBYTES + vdv * VSTR + vcc * 16) = (u32x2){vreg.x, vreg.y}; *(u32x2*)(b_ + KBYTES + vdv * VSTR + vcc * 16 + 8) = (u32x2){vreg.z, vreg.w}; } while (0)
  PA_GLOAD(0); PA_LSTORE(0); __syncthreads();
  f32x16 o0, o1;
#pragma unroll
  for (int r = 0; r < 16; ++r) { o0[r] = 0.f; o1[r] = 0.f; }
  float m = -1e30f, l = 0.f;
  const int qlo = qpos0 + 32 * wid;
  for (int t = 0; t < ntiles; ++t) {
    if (t + 1 < ntiles) PA_GLOAD(t + 1);
    const unsigned char* kb = lds + (t & 1) * STG; const unsigned char* vb = kb + KBYTES;
    const bool active = !CAUSAL || (64 * t <= qlo + 31);
    if (active) {
      f32x16 p0, p1;
#pragma unroll
      for (int r = 0; r < 16; ++r) { p0[r] = 0.f; p1[r] = 0.f; }
#pragma unroll
      for (int s = 0; s < KS; ++s) {
        const bf16x8 a0 = *(const bf16x8*)(kb + r32 * KSTR + (16 * s + 8 * hi) * 2);
        const bf16x8 a1 = *(const bf16x8*)(kb + (32 + r32) * KSTR + (16 * s + 8 * hi) * 2);
        p0 = __builtin_amdgcn_mfma_f32_32x32x16_bf16(a0, qf[s], p0, 0, 0, 0);
        p1 = __builtin_amdgcn_mfma_f32_32x32x16_bf16(a1, qf[s], p1, 0, 0, 0);
      }
      if (CAUSAL && (64 * t + 63 > qlo)) {
        const int q = qlo + r32;
#pragma unroll
        for (int r = 0; r < 16; ++r) { const int key = 64 * t + crow(r, hi); if (key > q) p0[r] = -1e30f; if (key + 32 > q) p1[r] = -1e30f; }
      }
      float mx = fmaxf(p0[0], p1[0]);
#pragma unroll
      for (int r = 1; r < 16; ++r) mx = fmaxf(mx, fmaxf(p0[r], p1[r]));
      mx = swap_max(mx);
      const float mn = fmaxf(m, mx), alpha = __builtin_amdgcn_exp2f(m - mn);
      m = mn;
      float ps = 0.f;
#pragma unroll
      for (int r = 0; r < 16; ++r) { p0[r] = __builtin_amdgcn_exp2f(p0[r] - mn); p1[r] = __builtin_amdgcn_exp2f(p1[r] - mn); ps += p0[r] + p1[r]; }
      l = l * alpha + ps;
#pragma unroll
      for (int r = 0; r < 16; ++r) { o0[r] *= alpha; o1[r] *= alpha; }
      bf16x8 pb[4];
#pragma unroll
      for (int k = 0; k < 4; ++k) {
        u32x4 w;
        if (k < 2) { w.x = cvtpk(p0[8 * k], p0[8 * k + 1]); w.y = cvtpk(p0[8 * k + 2], p0[8 * k + 3]); w.z = cvtpk(p0[8 * k + 4], p0[8 * k + 5]); w.w = cvtpk(p0[8 * k + 6], p0[8 * k + 7]); }
        else { const int kk = k - 2; w.x = cvtpk(p1[8 * kk], p1[8 * kk + 1]); w.y = cvtpk(p1[8 * kk + 2], p1[8 * kk + 3]); w.z = cvtpk(p1[8 * kk + 4], p1[8 * kk + 5]); w.w = cvtpk(p1[8 * kk + 6], p1[8 * kk + 7]); }
        pb[k] = __builtin_bit_cast(bf16x8, w);
      }
#pragma unroll
      for (int k = 0; k < 4; ++k) {
#pragma unroll
        for (int d = 0; d < 2; ++d) {
          const unsigned char* vp = vb + (32 * d + r32) * VSTR + (16 * k + 4 * hi) * 2;
          const u32x2 lo = *(const u32x2*)vp, hi2 = *(const u32x2*)(vp + 16);
          const u32x4 w = {lo.x, lo.y, hi2.x, hi2.y};
          const bf16x8 va = __builtin_bit_cast(bf16x8, w);
          if (d == 0) o0 = __builtin_amdgcn_mfma_f32_32x32x16_bf16(va, pb[k], o0, 0, 0, 0);
          else o1 = __builtin_amdgcn_mfma_f32_32x32x16_bf16(va, pb[k], o1, 0, 0, 0);
        }
      }
    }
    if (t + 1 < ntiles) PA_LSTORE((t + 1) & 1);
    __syncthreads();
  }
#undef PA_GLOAD
#undef PA_LSTORE
  const float inv = 1.f / swap_sum(l);
#pragma unroll
  for (int g = 0; g < 4; ++g) {
    out(32 * wid + r32, 8 * g + 4 * hi, make_float4(o0[4 * g] * inv, o0[4 * g + 1] * inv, o0[4 * g + 2] * inv, o0[4 * g + 3] * inv));
    out(32 * wid + r32, 32 + 8 * g + 4 * hi, make_float4(o1[4 * g] * inv, o1[4 * g + 1] * inv, o1[4 * g + 2] * inv, o1[4 * g + 3] * inv));
  }
}
}

#define LAS __attribute__((address_space(3)))
typedef unsigned v4u __attribute__((ext_vector_type(4)));
__device__ __forceinline__ unsigned f2bf(float f) { unsigned u = __builtin_bit_cast(unsigned, f); return (u + 0x7fffu + ((u >> 16) & 1u)) >> 16; }
__device__ __forceinline__ unsigned pk2(float lo, float hi) { return f2bf(lo) | (f2bf(hi) << 16); }
__device__ __forceinline__ void p0_transpose_item(const float* W, int K, int N, bf16* WT, int row_off, LAS float* scr, int item, int lane) {
  const int nblk = N / 32, kb = item / nblk, nb = item % nblk, k0 = 64 * kb, n0 = 32 * nb;
#pragma unroll 8
  for (int i = 0; i < 32; ++i) { const int kk = 2 * i + (lane >> 5); scr[kk * 33 + (lane & 31)] = W[(size_t)(k0 + kk) * N + n0 + (lane & 31)]; }
  asm volatile("s_waitcnt lgkmcnt(0)" ::: "memory");
  const int c = lane & 7;
#pragma unroll
  for (int j = 0; j < 4; ++j) { const int n = (lane >> 3) + 8 * j; const LAS float* s = scr + (8 * c) * 33 + n;
    v4u o; o.x = pk2(s[0 * 33], s[1 * 33]); o.y = pk2(s[2 * 33], s[3 * 33]); o.z = pk2(s[4 * 33], s[5 * 33]); o.w = pk2(s[6 * 33], s[7 * 33]);
    *(v4u*)(WT + (size_t)(row_off + n0 + n) * K + k0 + 8 * c) = o; }
  asm volatile("s_waitcnt lgkmcnt(0)" ::: "memory");
}

__global__ void __launch_bounds__(512) fwd_megakernel(Params p) {
  cg::grid_group grid = cg::this_grid();
  extern __shared__ __attribute__((aligned(16))) unsigned char lds[];
  float* sm = (float*)lds;
  bf16* wb = (bf16*)(p.ws + W_END);
  const int tid = threadIdx.x, lane = tid & 63, wv = tid >> 6;
  const int gw = blockIdx.x * 8 + wv, NGW = gridDim.x * 8;
  const int gtid = blockIdx.x * 512 + tid, NTH = gridDim.x * 512;
  float* ws = p.ws;

  {
    LAS float* scr = (LAS float*)((LAS unsigned char*)lds + wv * 16384);
    constexpr int I_IN = 16 * (INC / 32), I_MEM = 16 * (512 / 32), I_OUT = 16 * (1024 / 32);
    for (int it = gw; it < I_IN + I_MEM + I_OUT; it += NGW) {
      int r = it;
      if (r < I_IN) { p0_transpose_item(p.w_in, 1024, INC, wb + B_WIN, 0, scr, r, lane); continue; } r -= I_IN;
      if (r < I_MEM) { p0_transpose_item(p.w_mem_kv, 1024, 512, wb + B_WMEM, 0, scr, r, lane); continue; } r -= I_MEM;
      p0_transpose_item(p.w_out, 1024, 1024, wb + B_WOUT, 0, scr, r, lane);
    }
    for (int i = gtid; i < (INCP - INC) * 1024 / 8; i += NTH) ((v4u*)(wb + B_WIN + (size_t)INC * 1024))[i] = (v4u){0u, 0u, 0u, 0u};
  }
  for (int r = gw; r < NT + 1024; r += NGW) {
    const float* src; const float* g; bf16* dst;
    if (r < NT) { src = xrow(p, r); g = p.ln_g; dst = wb + B_H + (size_t)r * 1024; }
    else { src = p.mem_prompt + (size_t)(r - NT) * 1024; g = p.mem_norm_g; dst = wb + B_HM + (size_t)(r - NT) * 1024; }
    float4 v[4]; float ss = 0.f;
#pragma unroll
    for (int i = 0; i < 4; ++i) { v[i] = *(const float4*)(src + 4 * lane + 256 * i); ss += v[i].x * v[i].x + v[i].y * v[i].y + v[i].z * v[i].z + v[i].w * v[i].w; }
    const float rs = rsqrtf(wave_sum(ss) * (1.f / 1024.f) + RMS_EPS);
#pragma unroll
    for (int i = 0; i < 4; ++i) {
      const float4 gg = *(const float4*)(g + 4 * lane + 256 * i);
      uint2 o; o.x = pk2(v[i].x * rs * gg.x, v[i].y * rs * gg.y); o.y = pk2(v[i].z * rs * gg.z, v[i].w * rs * gg.w);
      *(uint2*)(dst + 4 * lane + 256 * i) = o;
    }
  }
  grid.sync();

  {
    pg8::Gemm g{wb + B_H, wb + B_WIN, NT, INCP, 1024}; pg8::StaticOrder S; S.init(NT, INCP, (int)gridDim.x, (int)blockIdx.x);
    pg8::EpiF32 E{ws + W_PROJ, INC, INC, 0, 0, nullptr, nullptr, 0};
    pg8::gemm_phase<pg8::EpiF32, pg8::StaticOrder, true, true>((PG8_LAS unsigned char*)lds, g, S, E);
  }
  {
    pg8::Gemm g{wb + B_HM, wb + B_WMEM, 1024, 512, 1024}; pg8::StaticOrder S; S.init(1024, 512, (int)gridDim.x, (int)((blockIdx.x + 20) % gridDim.x));
    pg8::EpiF32 E{p.out + O_MKP, 256, 256, 256, O_MVP - O_MKP, nullptr, nullptr, 0};
    pg8::gemm_phase<pg8::EpiF32, pg8::StaticOrder, true, true>((PG8_LAS unsigned char*)lds, g, S, E);
  }
  grid.sync();

  {
    float* tds = sm + wv * 128;
    for (int row = gw; row < NT; row += NGW) {
      const float* pr = ws + W_PROJ + (size_t)row * INC;
      {
        float v[4]; float ss = 0.f;
#pragma unroll
        for (int i = 0; i < 4; ++i) { v[i] = pr[C_CQ + lane + 64 * i]; ss += v[i] * v[i]; }
        const float rs = rsqrtf(wave_sum(ss) * (1.f / 256.f) + RMS_EPS);
#pragma unroll
        for (int i = 0; i < 4; ++i) ws[W_CQN + (size_t)row * 256 + lane + 64 * i] = v[i] * rs * p.q_norm_g[lane + 64 * i];
      }
      {
        const float v0 = pr[C_CKV + lane], v1 = pr[C_CKV + 64 + lane];
        const float rs = rsqrtf(wave_sum(v0 * v0 + v1 * v1) * (1.f / 128.f) + RMS_EPS);
        float* o = ckv_out_row(p, row);
        o[lane] = v0 * rs * p.kv_norm_g[lane]; o[64 + lane] = v1 * rs * p.kv_norm_g[64 + lane];
      }
      const int pos = row < NP ? (row % SEQ) : PAST + ((row - NP) & 7);
      if (lane < 16) {
        const float inv = 1.0f / powf(10000.0f, (float)lane * (2.0f / 32.0f));
        const float ang = (float)pos * inv; const float c = cosf(ang), s = sinf(ang);
        const float x1 = pr[C_KR + lane], x2 = pr[C_KR + 16 + lane];
        float* o = kpe_out_row(p, row);
        o[lane] = x1 * c - x2 * s; o[16 + lane] = x2 * c + x1 * s;
      }
      if (row < NP) { if ((row % SEQ) == SEQ - 1) { const int b = row / SEQ; for (int i = lane; i < 896; i += 64) p.out[O_SHP + (size_t)b * 896 + i] = pr[C_Z + i]; } }
      else { if (((row - NP) & 7) == 7) { const int db = (row - NP) >> 3; for (int i = lane; i < 896; i += 64) p.out[O_SHS + (size_t)db * 896 + i] = pr[C_Z + i]; } }
      {
        const bool first = row < NP ? ((row % SEQ) == 0) : (((row - NP) & 7) == 0);
        const float* prev = first ? (row < NP ? nullptr : p.state_shift + (size_t)((row - NP) >> 3) * 896 - C_Z) : pr - INC;
        auto zmix = [&](int i) -> float { const float z = pr[C_Z + i]; const float pv = prev ? prev[C_Z + i] : 0.f; return z + (pv - z) * p.shift_mu[i]; };
        tds[lane] = tanhf(zmix(768 + lane)); tds[64 + lane] = zmix(832 + lane);
        __builtin_amdgcn_fence(__ATOMIC_RELEASE, "wavefront"); __builtin_amdgcn_wave_barrier();
#pragma unroll 1
        for (int hh = 0; hh < 4; ++hh) {
          const int c = hh * 64 + lane;
          float u = p.w0[c], au = p.a0[c];
#pragma unroll 4
          for (int j = 0; j < 64; ++j) { u += tds[j] * p.w_up[j * 256 + c]; au += tds[64 + j] * p.a_up[j * 256 + c]; }
          const float nu = -u;
          const float sp = fmaxf(nu, 0.f) + log1pf(expf(-fabsf(nu)));
          const float wl = -sp - 0.5f;
          const float decay = expf(-expf(wl));
          const float a = 1.f / (1.f + expf(-au));
          const float k = zmix(256 + c), r = zmix(c), v = zmix(512 + c);
          float kk = k * p.k_k[c];
          const float nrm = fmaxf(sqrtf(wave_sum(kk * kk)), 1e-12f);
          kk = kk / nrm;
          const float kf = k * (1.f + (a - 1.f) * p.k_a[c]);
          const size_t o = (size_t)row * 256 + c;
          ws[W_R + o] = r; ws[W_W + o] = decay; ws[W_KF + o] = kf; ws[W_VV + o] = v; ws[W_KK + o] = kk; ws[W_BB + o] = kk * a;
        }
        __builtin_amdgcn_fence(__ATOMIC_RELEASE, "wavefront"); __builtin_amdgcn_wave_barrier();
      }
    }
  }
  grid.sync();

  gemm_f32<false>(ws + W_CQN, 256, p.w_uq, 768, ws + W_Q, 768, NT, 768, 256, sm);
  gemm_f32<false>(p.out + O_CKVP, 128, p.w_uk, 512, ws + W_KN, 512, NP, 512, 128, sm);
  gemm_f32<false>(p.out + O_CKVP, 128, p.w_uv, 512, ws + W_V, 512, NP, 512, 128, sm);
  grid.sync();

  for (int i = gtid; i < NT * 8 * 16; i += NTH) {
    const int j = i & 15, h = (i >> 4) & 7, row = i >> 7;
    const int pos = row < NP ? (row % SEQ) : PAST + ((row - NP) & 7);
    const float inv = 1.0f / powf(10000.0f, (float)j * (2.0f / 32.0f));
    const float ang = (float)pos * inv; const float c = cosf(ang), s = sinf(ang);
    float* q = ws + W_Q + (size_t)row * 768 + h * 96 + 64;
    const float x1 = q[j], x2 = q[16 + j];
    q[j] = x1 * c - x2 * s; q[16 + j] = x2 * c + x1 * s;
  }
  for (int h = 0; h < 8; ++h)
    gemm_f32<true>(ws + W_Q + (size_t)NP * 768 + h * 96, 768, p.w_uk + h * 64, 512, ws + W_QLAT + h * 128, 1024, NS, 128, 64, sm);
  grid.sync();

  {
    const float QSC = MLA_SCALE * 1.4426950408889634f;
    for (size_t i = gtid; i < (size_t)NP * 768 / 4; i += NTH) {
      const float4 v = *(const float4*)(ws + W_Q + i * 4);
      *(uint2*)(wb + B_QP + i * 4) = make_uint2(pk2(v.x * QSC, v.y * QSC), pk2(v.z * QSC, v.w * QSC));
    }
    for (size_t i = gtid; i < (size_t)NP * 8 * 24; i += NTH) {
      const int g4 = (int)(i % 24), h = (int)((i / 24) & 7); const size_t row = i / 192;
      const float4 v = g4 < 16 ? *(const float4*)(ws + W_KN + row * 512 + h * 64 + g4 * 4) : *(const float4*)(p.out + O_KPEP + row * 32 + (g4 - 16) * 4);
      *(uint2*)(wb + B_KP + row * 768 + h * 96 + g4 * 4) = make_uint2(pk2(v.x, v.y), pk2(v.z, v.w));
    }
    for (size_t i = gtid; i < (size_t)512 * NP; i += NTH) {
      const size_t c = i / NP, row = i % NP;
      wb[B_VT + i] = (bf16)f2bf(ws[W_V + row * 512 + c]);
    }
  }
  grid.sync();

  {
    const int B = blockIdx.x;
    for (int u2 = 0; u2 < 2; ++u2) {
      for (int bb = B; bb < 256; bb += gridDim.x) {
        const int bh = bb & 31, qb = u2 == 0 ? 15 - (bb >> 5) : (bb >> 5);
        const int b = bh >> 3, h = bh & 7;
        const size_t row0 = (size_t)b * SEQ + 256 * qb;
        auto out = [&](int ql, int dv0, float4 v) {
          const size_t row = row0 + ql;
          const float4 g = *(const float4*)(ws + W_PROJ + row * INC + C_GMLA + h * 64 + dv0);
          *(float4*)(ws + W_MIX + row * 1024 + h * 64 + dv0) = make_float4(v.x * silu(g.x), v.y * silu(g.y), v.z * silu(g.z), v.w * silu(g.w));
        };
        pa::attn_unit<96, true>(lds, wb + B_QP + row0 * 768 + h * 96, 768, wb + B_KP + (size_t)b * SEQ * 768 + h * 96, 768,
                                wb + B_VT + (size_t)(h * 64) * NP + (size_t)b * SEQ, NP, 4 * qb + 4, 256 * qb, out);
      }
    }
    __syncthreads();
  }
  {
    constexpr int N_RP = 16, N_RS = 512, N_SA = 8192, N_MA = NT * 4 / 16;
    constexpr int TOT = N_RP + N_SA + N_RS + N_MA;
    float* wsm = sm + wv * 320;
    for (int it = gw; it < TOT; it += NGW) {
      int i = __builtin_amdgcn_readfirstlane(it);
      if (i < N_RP) { rwkv_scan_wave(p, true, i >> 2, i & 3, lane, wsm); continue; }
      i -= N_RP;
      if (i < N_SA) { sample_attn_wave(p, i, lane, wsm); continue; }
      i -= N_SA;
      if (i < N_RS) { rwkv_scan_wave(p, false, i >> 2, i & 3, lane, wsm); continue; }
      i -= N_RS;
      mem_attn_wave(p, i, lane, wsm);
    }
  }
  grid.sync();

  for (int i = gtid; i < NS * 512; i += NTH) {
    const int c = i & 511, srow = i >> 9, h = c >> 6;
    const float* ol = ws + W_OLAT + (size_t)srow * 1024 + h * 128;
    float acc = 0.f;
    for (int k = 0; k < 128; ++k) acc += ol[k] * p.w_uv[k * 512 + c];
    const int row = NP + srow;
    const float g = ws[W_PROJ + (size_t)row * INC + C_GMLA + c];
    ws[W_MIX + (size_t)row * 1024 + c] = acc * silu(g);
  }
  grid.sync();
  for (size_t i = gtid; i < (size_t)NT * 1024 / 4; i += NTH) {
    const float4 v = *(const float4*)(ws + W_MIX + i * 4);
    uint2 o; o.x = pk2(v.x, v.y); o.y = pk2(v.z, v.w);
    *(uint2*)(wb + B_MIX + i * 4) = o;
  }
  grid.sync();

  {
    pg8::Gemm g{wb + B_MIX, wb + B_WOUT, NT, 1024, 1024}; pg8::StaticOrder S; S.init(NT, 1024, (int)gridDim.x, (int)blockIdx.x);
    pg8::EpiF32 E{p.out, 1024, 1024, 0, 0, p.x_prompt, p.x_sample, NP};
    pg8::gemm_phase<pg8::EpiF32, pg8::StaticOrder, true, true>((PG8_LAS unsigned char*)lds, g, S, E);
  }
  grid.sync();

  for (int r = gw; r < NT; r += NGW) {
    float* y = p.out + (size_t)r * 1024;
    float v[16]; float ss = 0.f;
#pragma unroll
    for (int i = 0; i < 16; ++i) { v[i] = y[lane + 64 * i]; ss += v[i] * v[i]; }
    const float rs = rsqrtf(wave_sum(ss) * (1.f / 1024.f) + RMS_EPS);
#pragma unroll
    for (int i = 0; i < 16; ++i) y[lane + 64 * i] = v[i] * rs * p.final_g[lane + 64 * i];
  }
}

extern "C" void kernel_launch(void* const* d_in, const int* in_sizes, int n_in, void* d_out,
                              int out_size, void* d_ws, size_t ws_size, hipStream_t stream) {
  static int grid_blocks = 0;
  if (!grid_blocks) {
    int dev = 0, cus = 0, per_cu = 0;
    (void)hipGetDevice(&dev);
    (void)hipDeviceGetAttribute(&cus, hipDeviceAttributeMultiprocessorCount, dev);
    (void)hipFuncSetAttribute((const void*)fwd_megakernel, hipFuncAttributeMaxDynamicSharedMemorySize, LDS_BYTES);
    (void)hipOccupancyMaxActiveBlocksPerMultiprocessor(&per_cu, fwd_megakernel, 512, LDS_BYTES);
    if (per_cu < 1) per_cu = 1;
    grid_blocks = cus;
    if (ws_size < WS_BYTES) fprintf(stderr, "workspace too small: %zu < %zu\n", ws_size, (size_t)WS_BYTES);
  }
  Params p{};
  const float** pf = (const float**)&p;
  (void)pf;
  p.x_prompt = (const float*)d_in[0]; p.x_sample = (const float*)d_in[1]; p.mem_prompt = (const float*)d_in[2];
  p.cache_ckv = (const float*)d_in[3]; p.cache_kpe = (const float*)d_in[4]; p.page_table = (const int*)d_in[5];
  p.state_wkv = (const float*)d_in[6]; p.state_shift = (const float*)d_in[7]; p.cache_mem_k = (const float*)d_in[8];
  p.cache_mem_v = (const float*)d_in[9]; p.ln_g = (const float*)d_in[10]; p.w_in = (const float*)d_in[11];
  p.q_norm_g = (const float*)d_in[12]; p.kv_norm_g = (const float*)d_in[13]; p.w_uq = (const float*)d_in[14];
  p.w_uk = (const float*)d_in[15]; p.w_uv = (const float*)d_in[16]; p.shift_mu = (const float*)d_in[17];
  p.w0 = (const float*)d_in[18]; p.w_up = (const float*)d_in[19]; p.a0 = (const float*)d_in[20]; p.a_up = (const float*)d_in[21];
  p.k_k = (const float*)d_in[22]; p.k_a = (const float*)d_in[23]; p.r_k = (const float*)d_in[24]; p.lnx_g = (const float*)d_in[25];
  p.lnx_b = (const float*)d_in[26]; p.mem_norm_g = (const float*)d_in[27]; p.w_mem_kv = (const float*)d_in[28];
  p.w_out = (const float*)d_in[29]; p.final_g = (const float*)d_in[30];
  p.out = (float*)d_out; p.ws = (float*)d_ws;
  void* args[] = {&p};
  hipError_t e = hipLaunchCooperativeKernel((void*)fwd_megakernel, dim3(grid_blocks), dim3(512), args, LDS_BYTES, stream);
  if (e != hipSuccess) fprintf(stderr, "cooperative launch failed: %s (grid %d)\n", hipGetErrorString(e), grid_blocks);
}
```

```cpp
#include <hip/hip_runtime.h>
#include <hip/hip_cooperative_groups.h>
#include <cstdio>
#include <cstdint>
namespace cg = cooperative_groups;
namespace pg8 {
#define PG8_LAS __attribute__((address_space(3)))
typedef unsigned short bf16_t;
typedef short bf16x8 __attribute__((ext_vector_type(8)));
typedef float f32x4 __attribute__((ext_vector_type(4)));
typedef unsigned u32x4 __attribute__((ext_vector_type(4)));
constexpr int BM = 256, BK = 64, HALF = 128, HTB = HALF * BK * 2  , STAGE_BYTES = 8 * HTB, NXCD = 8, WGM = 8;

__host__ __device__ __forceinline__ int lds_byte(int r, int c) { const int st = (r >> 4) * 2 + (c >> 5), rr = r & 15, cc = c & 31, ob = rr * 64 + cc * 2; return st * 1024 + (ob ^ (((ob >> 9) & 1) << 5)); }
__host__ __device__ __forceinline__ void stage_rc(int b, int& R, int& C) { const int st = b / 1024, sb = b % 1024, swz = sb ^ (((sb >> 9) & 1) << 5); R = (st >> 1) * 16 + swz / 64; C = (st & 1) * 32 + (swz % 64) / 2; }
__host__ __device__ __forceinline__ int perm32(int rho) { const int n = rho >> 4, i = rho & 15; return 8 * (i >> 2) + 4 * n + (i & 3); }

struct Unit { int pm, pn; };
struct Gemm { const bf16_t* A; const bf16_t* Bt; int M, N, K; };

struct StaticOrder {
    int nM, nN, nwg, G, c;
    __host__ __device__ void init(int M, int N, int G_, int c_) { nM = M / BM; nN = N / BM; nwg = nM * nN; G = G_; c = c_; }
    __host__ __device__ bool next(int i, Unit& u) const {
        const long L = (long)i * G + c; if (L >= nwg) return false;
        int wgid = (int)L; { const int q = nwg / NXCD, r = nwg % NXCD, xcd = wgid % NXCD, off = wgid / NXCD; wgid = (xcd < r ? xcd * (q + 1) : r * (q + 1) + (xcd - r) * q) + off; }
        const int nig = WGM * nN, gid = wgid / nig, fm = gid * WGM, gsz = (nM - fm) < WGM ? (nM - fm) : WGM;
        u.pm = fm + ((wgid % nig) % gsz); u.pn = (wgid % nig) / gsz; return true;
    }
    __device__ __forceinline__ void a_ready(const Unit&) const {}
    __device__ __forceinline__ void done(const Unit&) const {}
};
__device__ __forceinline__ unsigned cvt_pk_bf16(float lo, float hi) { unsigned r; asm volatile("v_cvt_pk_bf16_f32 %0, %1, %2" : "=v"(r) : "v"(lo), "v"(hi)); return r; }
typedef float f32x2 __attribute__((ext_vector_type(2)));
template <class Epi, class Sched, bool ALIGN_EPI = false, bool SP2 = false>
__device__ __forceinline__ void gemm_phase(PG8_LAS unsigned char* lds, const Gemm g, const Sched& S, const Epi& E) {
    const int tid = threadIdx.x, wid = __builtin_amdgcn_readfirstlane(tid >> 6), lane = tid & 63, wr = wid >> 2, wc = wid & 3, fr = lane & 15, fq = lane >> 4;
    const int K = g.K, nt = K / BK;
    unsigned voffA[2], voffB[2];
#pragma unroll
    for (int i = 0; i < 2; ++i) { int R, C; stage_rc(tid * 16 + i * 8192, R, C); const int Rb = Epi::PERM ? ((R & ~31) + perm32(R & 31)) : R;
        voffA[i] = (unsigned)(R * K + C) * 2u; voffB[i] = (unsigned)(Rb * K + C) * 2u; }
    const size_t kstep = (size_t)(BK * 2);
    const size_t hstep = (size_t)HALF * K * 2;
    const size_t tstep = 2 * hstep;
    const unsigned ldsw = (unsigned)wid * 1024u;
    const int aoff = lds_byte(wr * 64 + fr, fq * 8), boff = lds_byte(wc * 32 + fr, fq * 8);
#define PG8_SA(b, h) (((b) * 2 + (h)) * HTB)
#define PG8_SB(b, h) ((4 + (b) * 2 + (h)) * HTB)
#define PG8_STAGE(bufoff, gbase, voff) do { _Pragma("unroll") for (int _i = 0; _i < 2; ++_i) \
        __builtin_amdgcn_global_load_lds((const unsigned*)((const char*)(gbase) + (voff)[_i]), (PG8_LAS unsigned*)(lds + (bufoff) + ldsw + _i * 8192), 16, 0, 0); } while (0)
#define PG8_LDA(dst, b, h) do { _Pragma("unroll") for (int m = 0; m < 4; ++m) _Pragma("unroll") for (int k = 0; k < 2; ++k) dst[m][k] = *(const PG8_LAS bf16x8*)(lds + PG8_SA(b, h) + aoff + m * 2048 + k * 1024); } while (0)
#define PG8_LDB(dst, b, h) do { _Pragma("unroll") for (int n = 0; n < 2; ++n) _Pragma("unroll") for (int k = 0; k < 2; ++k) dst[n][k] = *(const PG8_LAS bf16x8*)(lds + PG8_SB(b, h) + boff + n * 2048 + k * 1024); } while (0)
#define PG8_MMA(ai, bj, At, Bt) do { __builtin_amdgcn_s_setprio(1); _Pragma("unroll") for (int m = 0; m < 4; ++m) _Pragma("unroll") for (int n = 0; n < 2; ++n) _Pragma("unroll") for (int k = 0; k < 2; ++k) \
        acc[ai][bj][m][n] = __builtin_amdgcn_mfma_f32_16x16x32_bf16(Bt[n][k], At[m][k], acc[ai][bj][m][n], 0, 0, 0); __builtin_amdgcn_s_setprio(0); } while (0)
#define PG8_WAIT_V(n) asm volatile("s_waitcnt vmcnt(" #n ")" ::: "memory")
#define PG8_WAIT_L(n) asm volatile("s_waitcnt lgkmcnt(" #n ")" ::: "memory")
#define PG8_BAR __builtin_amdgcn_s_barrier()
#define PG8_SCHED __builtin_amdgcn_sched_barrier(0)
    Unit cur, nxt; int ui = 0;
    if (!S.next(0, cur)) return;
    f32x4 acc[2][2][4][2];
#pragma unroll
    for (int a = 0; a < 2; ++a)
#pragma unroll
        for (int b = 0; b < 2; ++b)
#pragma unroll
            for (int m = 0; m < 4; ++m)
#pragma unroll
                for (int n = 0; n < 2; ++n) acc[a][b][m][n] = (f32x4){0.f, 0.f, 0.f, 0.f};
    bf16x8 At[4][2], B0[2][2], B1[2][2];
    const char* cA = (const char*)g.A + (size_t)cur.pm * tstep; const char* cB = (const char*)g.Bt + (size_t)cur.pn * tstep;
    S.a_ready(cur);
    if constexpr (SP2) {
        PG8_STAGE(PG8_SB(0, 0), cB, voffB); PG8_STAGE(PG8_SB(0, 1), cB + hstep, voffB); PG8_STAGE(PG8_SA(0, 0), cA, voffA); PG8_STAGE(PG8_SA(0, 1), cA + hstep, voffA);
        if (wr == 1) PG8_BAR;
        PG8_WAIT_V(2); PG8_BAR;
        PG8_STAGE(PG8_SB(1, 0), cB + kstep, voffB); PG8_STAGE(PG8_SA(1, 0), cA + kstep, voffA); PG8_STAGE(PG8_SB(1, 1), cB + hstep + kstep, voffB);
        PG8_WAIT_V(6); PG8_BAR;
    } else {
        PG8_STAGE(PG8_SB(0, 0), cB, voffB); PG8_STAGE(PG8_SA(0, 0), cA, voffA); PG8_STAGE(PG8_SB(0, 1), cB + hstep, voffB); PG8_STAGE(PG8_SA(0, 1), cA + hstep, voffA);
        if (wr == 1) PG8_BAR;
        PG8_WAIT_V(4); PG8_BAR;
        PG8_STAGE(PG8_SB(1, 0), cB + kstep, voffB); PG8_STAGE(PG8_SA(1, 0), cA + kstep, voffA); PG8_STAGE(PG8_SB(1, 1), cB + hstep + kstep, voffB);
        PG8_WAIT_V(6); PG8_BAR;
    }
    for (;;) {
        const bool has_next = S.next(ui + 1, nxt);
        const char* nA = has_next ? (const char*)g.A + (size_t)nxt.pm * tstep : cA; const char* nB = has_next ? (const char*)g.Bt + (size_t)nxt.pn * tstep : cB;
        for (int t = 0; t < nt; t += 2) {
            const bool last = (t == nt - 2);
            const char* a1 = cA + (size_t)(t + 1) * kstep;
            const char* a2 = last ? nA : cA + (size_t)(t + 2) * kstep; const char* b2 = last ? nB : cB + (size_t)(t + 2) * kstep;
            const char* a3 = a2 + kstep; const char* b3 = b2 + kstep;
            if (last && has_next) S.a_ready(nxt);
            if constexpr (SP2) {
            PG8_LDB(B0, 0, 0); PG8_LDB(B1, 0, 1); PG8_SCHED; PG8_LDA(At, 0, 0); PG8_STAGE(PG8_SA(1, 1), a1 + hstep, voffA);
            PG8_WAIT_V(8); PG8_WAIT_L(0); PG8_BAR; PG8_MMA(0, 0, At, B0); PG8_MMA(0, 1, At, B1); PG8_BAR; PG8_SCHED;
            PG8_LDA(At, 0, 1); PG8_STAGE(PG8_SB(0, 0), b2, voffB); PG8_STAGE(PG8_SB(0, 1), b2 + hstep, voffB); PG8_STAGE(PG8_SA(0, 0), a2, voffA);
            PG8_WAIT_V(8); PG8_WAIT_L(0); PG8_BAR; PG8_MMA(1, 0, At, B0); PG8_MMA(1, 1, At, B1); PG8_BAR; PG8_SCHED;
            PG8_LDB(B0, 1, 0); PG8_LDB(B1, 1, 1); PG8_SCHED; PG8_LDA(At, 1, 0); PG8_STAGE(PG8_SA(0, 1), a2 + hstep, voffA);
            PG8_WAIT_V(8); PG8_WAIT_L(0); PG8_BAR; PG8_MMA(0, 0, At, B0); PG8_MMA(0, 1, At, B1); PG8_BAR; PG8_SCHED;
            PG8_LDA(At, 1, 1); PG8_STAGE(PG8_SB(1, 0), b3, voffB); PG8_STAGE(PG8_SB(1, 1), b3 + hstep, voffB); PG8_STAGE(PG8_SA(1, 0), a3, voffA);
            PG8_WAIT_V(8); PG8_WAIT_L(0); PG8_BAR; PG8_MMA(1, 0, At, B0); PG8_MMA(1, 1, At, B1); PG8_BAR; PG8_SCHED;
            } else {
            PG8_LDB(B0, 0, 0); PG8_SCHED; PG8_LDA(At, 0, 0); PG8_STAGE(PG8_SA(1, 1), a1 + hstep, voffA);
            PG8_WAIT_L(8); PG8_BAR; PG8_WAIT_L(0); PG8_MMA(0, 0, At, B0); PG8_BAR; PG8_SCHED;
            PG8_LDB(B1, 0, 1); PG8_STAGE(PG8_SB(0, 0), b2, voffB);
            PG8_BAR; PG8_WAIT_L(0); PG8_MMA(0, 1, At, B1); PG8_BAR;
            PG8_LDA(At, 0, 1); PG8_STAGE(PG8_SA(0, 0), a2, voffA);
            PG8_BAR; PG8_WAIT_L(0); PG8_MMA(1, 0, At, B0); PG8_BAR; PG8_SCHED;
            PG8_STAGE(PG8_SB(0, 1), b2 + hstep, voffB);
            PG8_WAIT_V(6); PG8_BAR; PG8_MMA(1, 1, At, B1); PG8_BAR;
            PG8_LDB(B0, 1, 0); PG8_SCHED; PG8_LDA(At, 1, 0); PG8_STAGE(PG8_SA(0, 1), a2 + hstep, voffA);
            PG8_WAIT_L(8); PG8_BAR; PG8_WAIT_L(0); PG8_MMA(0, 0, At, B0); PG8_BAR; PG8_SCHED;
            PG8_LDB(B1, 1, 1); PG8_STAGE(PG8_SB(1, 0), b3, voffB);
            PG8_BAR; PG8_WAIT_L(0); PG8_MMA(0, 1, At, B1); PG8_BAR;
            PG8_LDA(At, 1, 1); PG8_STAGE(PG8_SA(1, 0), a3, voffA);
            PG8_BAR; PG8_WAIT_L(0); PG8_MMA(1, 0, At, B0); PG8_BAR; PG8_SCHED;
            PG8_STAGE(PG8_SB(1, 1), b3 + hstep, voffB);
            PG8_WAIT_V(6); PG8_BAR; PG8_MMA(1, 1, At, B1); PG8_BAR;
            }
        }
        if constexpr (ALIGN_EPI) { if (wr == 0) PG8_BAR; }
        if constexpr (!Epi::AFTER_DRAIN) { E(acc, cur, wr, wc, fr, fq); S.done(cur); }
        if (!has_next) break;
#pragma unroll
        for (int a = 0; a < 2; ++a)
#pragma unroll
            for (int b = 0; b < 2; ++b)
#pragma unroll
                for (int m = 0; m < 4; ++m)
#pragma unroll
                    for (int n = 0; n < 2; ++n) acc[a][b][m][n] = (f32x4){0.f, 0.f, 0.f, 0.f};
        cur = nxt; cA = nA; cB = nB; ++ui;
        if constexpr (ALIGN_EPI) { if (wr == 1) PG8_BAR; }
    }
    PG8_WAIT_V(0);
    if constexpr (!ALIGN_EPI) { if (wr == 0) PG8_BAR; }
    PG8_BAR;
    if constexpr (Epi::AFTER_DRAIN) { E.fused(acc, cur, wr, wc, fr, fq, lds, wid, lane); S.done(cur); }
#undef PG8_SA
#undef PG8_SB
#undef PG8_STAGE
#undef PG8_LDA
#undef PG8_LDB
#undef PG8_MMA
#undef PG8_WAIT_V
#undef PG8_WAIT_L
#undef PG8_BAR
#undef PG8_SCHED
}
}

namespace pg8 {
struct EpiF32 {
  static constexpr bool PERM = false, AFTER_DRAIN = false;
  float* C; int ldc; int ncols; int split_cols; size_t split_stride; const float* r0; const float* r1; int nr0;
  __device__ __forceinline__ void operator()(const f32x4 (&acc)[2][2][4][2], const Unit& u, int wr, int wc, int fr, int fq) const {
    const int row0 = u.pm * BM + wr * 64 + fr; int colt = u.pn * BM; float* base = C;
    if (split_cols) { const int t = colt / split_cols; base += (size_t)t * split_stride; colt -= t * split_cols; }
    const int col0 = colt + wc * 32 + 4 * fq;
#pragma unroll
    for (int ai = 0; ai < 2; ++ai)
#pragma unroll
      for (int m = 0; m < 4; ++m) {
        const int row = row0 + ai * HALF + m * 16;
        const float* rr = r0 ? (row < nr0 ? r0 + (size_t)row * ldc : r1 + (size_t)(row - nr0) * ldc) : nullptr;
#pragma unroll
        for (int bj = 0; bj < 2; ++bj)
#pragma unroll
          for (int n = 0; n < 2; ++n) {
            const int col = col0 + bj * HALF + n * 16;
            if (col < ncols) { f32x4 v = acc[ai][bj][m][n]; if (rr) v += *(const f32x4*)(rr + col); *(f32x4*)(base + (size_t)row * ldc + col) = v; }
          }
      }
  }
};
}

constexpr int DM = 1024, BATCH = 4, SEQ = 4096, DB = 128, DT = 8, PAST = 8192, PAGE = 128, NPG = 64, NMEM = 256;
constexpr int NP = BATCH * SEQ, NS = DB * DT, NT = NP + NS;
constexpr int INC = 2592;
constexpr int C_CQ = 0, C_CKV = 256, C_KR = 384, C_GMLA = 416, C_Z = 928, C_GRWKV = 1824, C_QX = 2080, C_GX = 2336;
constexpr float MLA_SCALE = 0.10206207261596575f;
constexpr float X_SCALE = 0.125f;
constexpr float RMS_EPS = 1e-6f, GN_EPS = 64e-5f;
constexpr size_t O_YP = 0, O_YS = 16777216, O_CKVP = 17825792, O_KPEP = 19922944, O_WKVP = 20447232, O_SHP = 20512768,
                 O_MKP = 20516352, O_MVP = 20778496, O_CKVS = 21040640, O_KPES = 21171712, O_WKVS = 21204480, O_SHS = 23301632;
constexpr size_t W_H = 0;
constexpr size_t W_HM = W_H + (size_t)NT * 1024;
constexpr size_t W_PROJ = W_HM + (size_t)1024 * 1024;
constexpr size_t W_CQN = W_PROJ + (size_t)NT * INC;
constexpr size_t W_Q = W_CQN + (size_t)NT * 256;
constexpr size_t W_KN = W_Q + (size_t)NT * 768;
constexpr size_t W_V = W_KN + (size_t)NP * 512;
constexpr size_t W_QLAT = W_V + (size_t)NP * 512;
constexpr size_t W_OLAT = W_QLAT + (size_t)NS * 1024;
constexpr size_t W_R = W_OLAT + (size_t)NS * 1024;
constexpr size_t W_W = W_R + (size_t)NT * 256;
constexpr size_t W_KF = W_W + (size_t)NT * 256;
constexpr size_t W_VV = W_KF + (size_t)NT * 256;
constexpr size_t W_KK = W_VV + (size_t)NT * 256;
constexpr size_t W_BB = W_KK + (size_t)NT * 256;
constexpr size_t W_MIX = W_BB + (size_t)NT * 256;
constexpr size_t W_PO = W_MIX + (size_t)NT * 1024;
constexpr size_t W_PML = W_PO + (size_t)256 * 64 * 128;
constexpr size_t W_END = W_PML + (size_t)256 * 64 * 2;
constexpr int INCP = 2816;
constexpr size_t B_H = 0;
constexpr size_t B_HM = B_H + (size_t)NT * 1024;
constexpr size_t B_WIN = B_HM + (size_t)1024 * 1024;
constexpr size_t B_WMEM = B_WIN + (size_t)INCP * 1024;
constexpr size_t B_WOUT = B_WMEM + (size_t)512 * 1024;
constexpr size_t B_MIX = B_WOUT + (size_t)1024 * 1024;
constexpr size_t B_QP = B_MIX + (size_t)NT * 1024;
constexpr size_t B_KP = B_QP + (size_t)NP * 768;
constexpr size_t B_VT = B_KP + (size_t)NP * 768;
constexpr size_t B_QS = B_VT + (size_t)512 * NP;
constexpr size_t B_END = B_QS + (size_t)NS * 8 * 160;
constexpr size_t WS_BYTES = W_END * 4 + B_END * 2;
constexpr int LDS_BYTES = 147456;

struct Params {
  const float* x_prompt; const float* x_sample; const float* mem_prompt; const float* cache_ckv; const float* cache_kpe;
  const int* page_table; const float* state_wkv; const float* state_shift; const float* cache_mem_k; const float* cache_mem_v;
  const float* ln_g; const float* w_in; const float* q_norm_g; const float* kv_norm_g; const float* w_uq; const float* w_uk;
  const float* w_uv; const float* shift_mu; const float* w0; const float* w_up; const float* a0; const float* a_up;
  const float* k_k; const float* k_a; const float* r_k; const float* lnx_g; const float* lnx_b; const float* mem_norm_g;
  const float* w_mem_kv; const float* w_out; const float* final_g;
  float* out; float* ws;
};

__device__ __forceinline__ float wave_sum(float v) {
#pragma unroll
  for (int o = 1; o < 64; o <<= 1) v += __shfl_xor(v, o);
  return v;
}
__device__ __forceinline__ float wave_max(float v) {
#pragma unroll
  for (int o = 1; o < 64; o <<= 1) v = fmaxf(v, __shfl_xor(v, o));
  return v;
}
__device__ __forceinline__ float silu(float x) { return x / (1.f + expf(-x)); }
__device__ __forceinline__ const float* xrow(const Params& p, int row) {
  return row < NP ? p.x_prompt + (size_t)row * DM : p.x_sample + (size_t)(row - NP) * DM;
}
__device__ __forceinline__ float* ckv_out_row(const Params& p, int row) {
  return row < NP ? p.out + O_CKVP + (size_t)row * 128 : p.out + O_CKVS + (size_t)(row - NP) * 128;
}
__device__ __forceinline__ float* kpe_out_row(const Params& p, int row) {
  return row < NP ? p.out + O_KPEP + (size_t)row * 32 : p.out + O_KPES + (size_t)(row - NP) * 32;
}

template <bool BT>
__device__ __forceinline__ void gemm_f32(const float* __restrict__ A, int lda, const float* __restrict__ B, int ldb, float* __restrict__ C, int ldc,
                         int M, int N, int K, float* sm) {
  const int tid = threadIdx.x, tx = tid & 15, ty = tid >> 4;
  float(*As)[68] = (float(*)[68])sm;
  float(*Bs)[68] = (float(*)[68])(sm + 16 * 68);
  const int tm = M / 64, tn = (N + 63) / 64;
  for (int tile = blockIdx.x; tile < tm * tn; tile += gridDim.x) {
    const int m0 = (tile / tn) * 64, n0 = (tile % tn) * 64;
    float acc[2][4];
#pragma unroll
    for (int i = 0; i < 2; ++i)
#pragma unroll
      for (int j = 0; j < 4; ++j) acc[i][j] = 0.f;
    for (int k0 = 0; k0 < K; k0 += 16) {
      for (int i = tid; i < 1024; i += 512) { const int r = i >> 4, kk = i & 15; As[kk][r] = A[(size_t)(m0 + r) * lda + k0 + kk]; }
      if (BT) {
        for (int i = tid; i < 1024; i += 512) { const int c = i >> 4, kk = i & 15; Bs[kk][c] = (n0 + c < N) ? B[(size_t)(n0 + c) * ldb + k0 + kk] : 0.f; }
      } else {
        for (int i = tid; i < 1024; i += 512) { const int kk = i >> 6, c = i & 63; Bs[kk][c] = (n0 + c < N) ? B[(size_t)(k0 + kk) * ldb + n0 + c] : 0.f; }
      }
      __syncthreads();
#pragma unroll
      for (int kk = 0; kk < 16; ++kk) {
        const float a0 = As[kk][ty * 2], a1 = As[kk][ty * 2 + 1];
        const float b0 = Bs[kk][tx * 4], b1 = Bs[kk][tx * 4 + 1], b2 = Bs[kk][tx * 4 + 2], b3 = Bs[kk][tx * 4 + 3];
        acc[0][0] += a0 * b0; acc[0][1] += a0 * b1; acc[0][2] += a0 * b2; acc[0][3] += a0 * b3;
        acc[1][0] += a1 * b0; acc[1][1] += a1 * b1; acc[1][2] += a1 * b2; acc[1][3] += a1 * b3;
      }
      __syncthreads();
    }
#pragma unroll
    for (int i = 0; i < 2; ++i)
#pragma unroll
      for (int j = 0; j < 4; ++j) { const int col = n0 + tx * 4 + j; if (col < N) C[(size_t)(m0 + ty * 2 + i) * ldc + col] = acc[i][j]; }
  }
}

template <int D1, int D2, int DV>
__device__ __forceinline__ void attn_row_tile(const float* wsm, const float* k1, const float* k2, const float* v, bool valid, int lane,
                                              float& m, float& l, float& o0, float& o1) {
  float sc = 0.f;
#pragma unroll 4
  for (int c = 0; c < D1; c += 4) { const float4 kv = *(const float4*)(k1 + c); sc += wsm[c] * kv.x + wsm[c + 1] * kv.y + wsm[c + 2] * kv.z + wsm[c + 3] * kv.w; }
  if (D2 > 0)
#pragma unroll 4
  for (int c = 0; c < D2; c += 4) { const float4 kv = *(const float4*)(k2 + c); sc += wsm[D1 + c] * kv.x + wsm[D1 + c + 1] * kv.y + wsm[D1 + c + 2] * kv.z + wsm[D1 + c + 3] * kv.w; }
  sc = valid ? sc : -1e30f;
  const float tmax = wave_max(sc), mn = fmaxf(m, tmax), alpha = expf(m - mn), pj = valid ? expf(sc - mn) : 0.f;
  l = l * alpha + wave_sum(pj); o0 *= alpha; o1 *= alpha;
  const unsigned long long pa = (unsigned long long)(uintptr_t)v;
  const int plo = (int)(unsigned)(pa & 0xffffffffull), phi = (int)(unsigned)(pa >> 32);
#pragma unroll 2
  for (int j = 0; j < 64; ++j) {
    const float pjj = __shfl(pj, j);
    const unsigned lo = (unsigned)__shfl(plo, j), hi = (unsigned)__shfl(phi, j);
    const float* vj = (const float*)(uintptr_t)(((unsigned long long)hi << 32) | lo);
    o0 += pjj * vj[lane];
    if (DV > 64) o1 += pjj * vj[64 + lane];
  }
  m = mn;
}

__device__ __forceinline__ void prompt_attn_wave(const Params& p, int bh, int qb, int lane, float* wsm) {
  const int b = bh >> 3, h = bh & 7;
  const float* Q = p.ws + W_Q; const float* KN = p.ws + W_KN; const float* V = p.ws + W_V; const float* KPE = p.out + O_KPEP;
  for (int qi = 0; qi < 64; ++qi) {
    const int s = qb * 64 + qi, row = b * SEQ + s;
    wsm[lane] = Q[(size_t)row * 768 + h * 96 + lane] * MLA_SCALE;
    if (lane < 32) wsm[64 + lane] = Q[(size_t)row * 768 + h * 96 + 64 + lane] * MLA_SCALE;
    float m = -1e30f, l = 0.f, o0 = 0.f, o1 = 0.f;
    for (int tile = 0; tile <= qb; ++tile) {
      const int j = tile * 64 + lane;
      const size_t krow = (size_t)b * SEQ + j;
      attn_row_tile<64, 32, 64>(wsm, KN + krow * 512 + h * 64, KPE + krow * 32, V + krow * 512 + h * 64, j <= s, lane, m, l, o0, o1);
    }
    const float g = p.ws[W_PROJ + (size_t)row * INC + C_GMLA + h * 64 + lane];
    p.ws[W_MIX + (size_t)row * 1024 + h * 64 + lane] = o0 / l * silu(g);
  }
}

__device__ __forceinline__ void sample_attn_wave(const Params& p, int rowid  , int lane, float* wsm) {
  const int h = rowid & 7, t = (rowid >> 3) & 7, db = rowid >> 6;
  const int srow = db * 8 + t, row = NP + srow;
  const float* QLAT = p.ws + W_QLAT; const float* Q = p.ws + W_Q;
  wsm[lane] = QLAT[(size_t)srow * 1024 + h * 128 + lane] * MLA_SCALE;
  wsm[64 + lane] = QLAT[(size_t)srow * 1024 + h * 128 + 64 + lane] * MLA_SCALE;
  if (lane < 32) wsm[128 + lane] = Q[(size_t)row * 768 + h * 96 + 64 + lane] * MLA_SCALE;
  float m = -1e30f, l = 0.f, o0 = 0.f, o1 = 0.f;
  for (int tile = 0; tile <= 128; ++tile) {
    const float* ckv; const float* kpe; bool valid;
    if (tile < 128) {
      const int k = tile * 64 + lane;
      const int page = p.page_table[db * NPG + (k >> 7)];
      const size_t base = (size_t)page * PAGE + (k & 127);
      ckv = p.cache_ckv + base * 128; kpe = p.cache_kpe + base * 32; valid = true;
    } else {
      const int u = lane < 8 ? lane : 0;
      valid = (lane < 8) && (lane <= t);
      ckv = p.out + O_CKVS + (size_t)(db * 8 + u) * 128; kpe = p.out + O_KPES + (size_t)(db * 8 + u) * 32;
    }
    attn_row_tile<128, 32, 128>(wsm, ckv, kpe, ckv, valid, lane, m, l, o0, o1);
  }
  float* OLAT = p.ws + W_OLAT;
  OLAT[(size_t)srow * 1024 + h * 128 + lane] = o0 / l;
  OLAT[(size_t)srow * 1024 + h * 128 + 64 + lane] = o1 / l;
}

__device__ __forceinline__ void mem_attn_wave(const Params& p, int item, int lane, float* wsm) {
  const int h = item / (NT / 16), r0 = (item - h * (NT / 16)) * 16;
  for (int ri = 0; ri < 16; ++ri) {
    const int row = r0 + ri;
    const float* kbase; const float* vbase;
    if (row < NP) { const int b = row / SEQ; kbase = p.out + O_MKP + (size_t)b * 256 * 256 + h * 64; vbase = p.out + O_MVP + (size_t)b * 256 * 256 + h * 64; }
    else { const int db = (row - NP) >> 3; kbase = p.cache_mem_k + (size_t)db * 256 * 256 + h * 64; vbase = p.cache_mem_v + (size_t)db * 256 * 256 + h * 64; }
    wsm[lane] = p.ws[W_PROJ + (size_t)row * INC + C_QX + h * 64 + lane] * X_SCALE;
    float m = -1e30f, l = 0.f, o0 = 0.f, o1 = 0.f;
    for (int tile = 0; tile < 4; ++tile) {
      const int j = tile * 64 + lane;
      attn_row_tile<64, 0, 64>(wsm, kbase + (size_t)j * 256, nullptr, vbase + (size_t)j * 256, true, lane, m, l, o0, o1);
    }
    const float g = p.ws[W_PROJ + (size_t)row * INC + C_GX + h * 64 + lane];
    p.ws[W_MIX + (size_t)row * 1024 + 768 + h * 64 + lane] = o0 / l * silu(g);
  }
}

#define CBAR() asm volatile("" ::: "memory")
__device__ __forceinline__ void rwkv_scan_wave(const Params& p, bool prompt, int bi, int h, int lane, float* wsm  ) {
  float S[64];
  const float* s0 = p.state_wkv + ((size_t)(bi * 4 + h) * 64 + lane) * 64;
#pragma unroll
  for (int k = 0; k < 64; ++k) S[k] = prompt ? 0.f : s0[k];
  const int T = prompt ? SEQ : DT, row0 = prompt ? bi * SEQ : NP + bi * DT;
  const float lg = p.lnx_g[h * 64 + lane], lb = p.lnx_b[h * 64 + lane], rk = p.r_k[h * 64 + lane];
#pragma unroll 1
  for (int t = 0; t < T; ++t) {
    const int row = row0 + t;
    const size_t off = (size_t)row * 256 + h * 64 + lane;
    const float r_l = p.ws[W_R + off], w_l = p.ws[W_W + off], kf_l = p.ws[W_KF + off], kk_l = p.ws[W_KK + off], bb_l = p.ws[W_BB + off];
    const float vv = p.ws[W_VV + off];
    wsm[lane] = kk_l; wsm[64 + lane] = w_l; wsm[128 + lane] = bb_l; wsm[192 + lane] = kf_l; wsm[256 + lane] = r_l;
    CBAR();
    float sa = 0.f;
#pragma unroll
    for (int c = 0; c < 4; ++c) {
#pragma unroll
      for (int k = 16 * c; k < 16 * c + 16; ++k) sa += S[k] * wsm[k];
      CBAR();
    }
    sa = -sa;
    float y = 0.f;
#pragma unroll
    for (int c = 0; c < 8; ++c) {
#pragma unroll
      for (int k = 8 * c; k < 8 * c + 8; ++k) { S[k] = S[k] * wsm[64 + k] + sa * wsm[128 + k] + vv * wsm[192 + k]; y += S[k] * wsm[256 + k]; }
      CBAR();
    }
    const float mean = wave_sum(y) * (1.f / 64.f), d = y - mean, var = wave_sum(d * d) * (1.f / 64.f);
    const float yn = d * rsqrtf(var + GN_EPS) * lg + lb;
    const float bsum = wave_sum(r_l * kf_l * rk);
    const float o = yn + bsum * vv;
    const float g = p.ws[W_PROJ + (size_t)row * INC + C_GRWKV + h * 64 + lane];
    p.ws[W_MIX + (size_t)row * 1024 + 512 + h * 64 + lane] = o * silu(g);
    CBAR();
  }
  float* so = prompt ? p.out + O_WKVP + ((size_t)(bi * 4 + h) * 64 + lane) * 64 : p.out + O_WKVS + ((size_t)(bi * 4 + h) * 64 + lane) * 64;
#pragma unroll
  for (int k = 0; k < 64; ++k) so[k] = S[k];
}


typedef unsigned short bf16;
#define LAS __attribute__((address_space(3)))
namespace pa {
typedef short bf16x8 __attribute__((ext_vector_type(8)));
typedef short s16x4 __attribute__((ext_vector_type(4)));
typedef float f32x16 __attribute__((ext_vector_type(16)));
typedef unsigned u32x4 __attribute__((ext_vector_type(4)));
typedef unsigned u32x2 __attribute__((ext_vector_type(2)));
typedef float f32x2_t __attribute__((ext_vector_type(2)));
typedef __bf16 bf16x2_t __attribute__((ext_vector_type(2)));
constexpr int KSTR = 208, VSTR = 136, KBYTES = 64 * KSTR, VBYTES = 64 * VSTR, STG = KBYTES + VBYTES;
__device__ __forceinline__ unsigned cvtpk(float lo, float hi) { f32x2_t v = {lo, hi}; bf16x2_t b = __builtin_convertvector(v, bf16x2_t); return __builtin_bit_cast(unsigned, b); }
__device__ __forceinline__ int crow(int r, int hi) { return (r & 3) + 8 * (r >> 2) + 4 * hi; }
__device__ __forceinline__ float swap_max(float v) { auto rr = __builtin_amdgcn_permlane32_swap(__float_as_uint(v), __float_as_uint(v), false, false); return fmaxf(__uint_as_float(rr[0]), __uint_as_float(rr[1])); }
__device__ __forceinline__ float swap_sum(float v) { auto rr = __builtin_amdgcn_permlane32_swap(__float_as_uint(v), __float_as_uint(v), false, false); return __uint_as_float(rr[0]) + __uint_as_float(rr[1]); }

template <int DQK, bool CAUSAL, class Out>
__device__ __forceinline__ void attn_unit(unsigned char* lds, const bf16* Qb, int qs, const bf16* Kb, int ks, const bf16* Vb, int vs, int ntiles, int qpos0, const Out& out) {
  const int tid = threadIdx.x, lane = tid & 63, wid = __builtin_amdgcn_readfirstlane(tid >> 6), r32 = lane & 31, hi = lane >> 5;
  constexpr int CPR = DQK / 8, NKC = 64 * CPR, KS = DQK / 16;
  bf16x8 qf[KS];
#pragma unroll
  for (int s = 0; s < KS; ++s) qf[s] = *(const bf16x8*)(Qb + (size_t)(wid * 32 + r32) * qs + 16 * s + 8 * hi);
  u32x4 kreg0, kreg1, vreg;
  const int kc0 = tid, kc1 = tid + 512;
  const int krow0 = kc0 / CPR, kcc0 = kc0 % CPR, krow1 = kc1 / CPR, kcc1 = kc1 % CPR;
  const int vdv = tid >> 3, vcc = tid & 7;
#define PA_GLOAD(t) do { kreg0 = *(const u32x4*)(Kb + (size_t)(64 * (t) + krow0) * ks + kcc0 * 8); \
    if (kc1 < NKC) kreg1 = *(const u32x4*)(Kb + (size_t)(64 * (t) + krow1) * ks + kcc1 * 8); \
    vreg = *(const u32x4*)(Vb + (size_t)vdv * vs + 64 * (t) + vcc * 8); } while (0)
#define PA_LSTORE(buf) do { unsigned char* b_ = lds + (buf) * STG; *(u32x4*)(b_ + krow0 * KSTR + kcc0 * 16) = kreg0; \
    if (kc1 < NKC) *(u32x4*)(b_ + krow1 * KSTR + kcc1 * 16) = kreg1; \
    *(u32x2*)(b_ + KBYTES + vdv * VSTR + vcc * 16) = (u32x2){vreg.x, vreg.y}; *(u32x2*)(b_ + KBYTES + vdv * VSTR + vcc * 16 + 8) = (u32x2){vreg.z, vreg.w}; } while (0)
  PA_GLOAD(0); PA_LSTORE(0); __syncthreads();
  f32x16 o0, o1;
#pragma unroll
  for (int r = 0; r < 16; ++r) { o0[r] = 0.f; o1[r] = 0.f; }
  float m = -1e30f, l = 0.f;
  const int qlo = qpos0 + 32 * wid;
  for (int t = 0; t < ntiles; ++t) {
    if (t + 1 < ntiles) PA_GLOAD(t + 1);
    const unsigned char* kb = lds + (t & 1) * STG; const unsigned char* vb = kb + KBYTES;
    const bool active = !CAUSAL || (64 * t <= qlo + 31);
    if (active) {
      f32x16 p0, p1;
#pragma unroll
      for (int r = 0; r < 16; ++r) { p0[r] = 0.f; p1[r] = 0.f; }
#pragma unroll
      for (int s = 0; s < KS; ++s) {
        const bf16x8 a0 = *(const bf16x8*)(kb + r32 * KSTR + (16 * s + 8 * hi) * 2);
        const bf16x8 a1 = *(const bf16x8*)(kb + (32 + r32) * KSTR + (16 * s + 8 * hi) * 2);
        p0 = __builtin_amdgcn_mfma_f32_32x32x16_bf16(a0, qf[s], p0, 0, 0, 0);
        p1 = __builtin_amdgcn_mfma_f32_32x32x16_bf16(a1, qf[s], p1, 0, 0, 0);
      }
      if (CAUSAL && (64 * t + 63 > qlo)) {
        const int q = qlo + r32;
#pragma unroll
        for (int r = 0; r < 16; ++r) { const int key = 64 * t + crow(r, hi); if (key > q) p0[r] = -1e30f; if (key + 32 > q) p1[r] = -1e30f; }
      }
      float mx = fmaxf(p0[0], p1[0]);
#pragma unroll
      for (int r = 1; r < 16; ++r) mx = fmaxf(mx, fmaxf(p0[r], p1[r]));
      mx = swap_max(mx);
      const float mn = fmaxf(m, mx), alpha = __builtin_amdgcn_exp2f(m - mn);
      m = mn;
      float ps = 0.f;
#pragma unroll
      for (int r = 0; r < 16; ++r) { p0[r] = __builtin_amdgcn_exp2f(p0[r] - mn); p1[r] = __builtin_amdgcn_exp2f(p1[r] - mn); ps += p0[r] + p1[r]; }
      l = l * alpha + ps;
#pragma unroll
      for (int r = 0; r < 16; ++r) { o0[r] *= alpha; o1[r] *= alpha; }
      bf16x8 pb[4];
#pragma unroll
      for (int k = 0; k < 4; ++k) {
        u32x4 w;
        if (k < 2) { w.x = cvtpk(p0[8 * k], p0[8 * k + 1]); w.y = cvtpk(p0[8 * k + 2], p0[8 * k + 3]); w.z = cvtpk(p0[8 * k + 4], p0[8 * k + 5]); w.w = cvtpk(p0[8 * k + 6], p0[8 * k + 7]); }
        else { const int kk = k - 2; w.x = cvtpk(p1[8 * kk], p1[8 * kk + 1]); w.y = cvtpk(p1[8 * kk + 2], p1[8 * kk + 3]); w.z = cvtpk(p1[8 * kk + 4], p1[8 * kk + 5]); w.w = cvtpk(p1[8 * kk + 6], p1[8 * kk + 7]); }
        pb[k] = __builtin_bit_cast(bf16x8, w);
      }
#pragma unroll
      for (int k = 0; k < 4; ++k) {
#pragma unroll
        for (int d = 0; d < 2; ++d) {
          const unsigned char* vp = vb + (32 * d + r32) * VSTR + (16 * k + 4 * hi) * 2;
          const u32x2 lo = *(const u32x2*)vp, hi2 = *(const u32x2*)(vp + 16);
          const u32x4 w = {lo.x, lo.y, hi2.x, hi2.y};
          const bf16x8 va = __builtin_bit_cast(bf16x8, w);
          if (d == 0) o0 = __builtin_amdgcn_mfma_f32_32x32x16_bf16(va, pb[k], o0, 0, 0, 0);
          else o1 = __builtin_amdgcn_mfma_f32_32x32x16_bf16(va, pb[k], o1, 0, 0, 0);
        }
      }
    }
    if (t + 1 < ntiles) PA_LSTORE((t + 1) & 1);
    __syncthreads();
  }
#undef PA_GLOAD
#undef PA_LSTORE
  const float inv = 1.f / swap_sum(l);
#pragma unroll
  for (int g = 0; g < 4; ++g) {
    out(32 * wid + r32, 8 * g + 4 * hi, make_float4(o0[4 * g] * inv, o0[4 * g + 1] * inv, o0[4 * g + 2] * inv, o0[4 * g + 3] * inv));
    out(32 * wid + r32, 32 + 8 * g + 4 * hi, make_float4(o1[4 * g] * inv, o1[4 * g + 1] * inv, o1[4 * g + 2] * inv, o1[4 * g + 3] * inv));
  }
}
}

namespace sa {
using pa::bf16x8; using pa::f32x16; using pa::u32x4; using pa::u32x2; using pa::cvtpk; using pa::crow; using pa::swap_max; using pa::swap_sum;
typedef float f32x4 __attribute__((ext_vector_type(4)));
typedef short v4i16_t __attribute__((ext_vector_type(4)));
constexpr int KVSTR = 336, TILE = 64 * KVSTR;
__device__ __forceinline__ void sample_attn_item(unsigned char* lds, const Params& p, const bf16* Qs, float* PO, float* PML, int item) {
  const int db = item >> 1, half = item & 1;
  const int tid = threadIdx.x, lane = tid & 63, wid = __builtin_amdgcn_readfirstlane(tid >> 6), r32 = lane & 31, hi = lane >> 5;
  const int qt = wid >> 2, ct = wid & 3;
  bf16x8 qf[10];
#pragma unroll
  for (int s = 0; s < 10; ++s) qf[s] = *(const bf16x8*)(Qs + (size_t)(db * 64 + 32 * qt + r32) * 160 + 16 * s + 8 * hi);
  const int ntiles = 64 + half;
  f32x4 st0, st1, st2, st3, sp;
  const f32x4 zero4 = {0.f, 0.f, 0.f, 0.f};
#define SA_GLOAD(t) do { if ((t) < 64) { const int key0_ = 4096 * half + 64 * (t); const int page_ = p.page_table[db * NPG + (key0_ >> 7)]; \
      const size_t base_ = (size_t)page_ * PAGE + (key0_ & 127); const float* ck_ = p.cache_ckv + base_ * 128; const float* kp_ = p.cache_kpe + base_ * 32; \
      st0 = *(const f32x4*)(ck_ + (size_t)(tid) * 4); st1 = *(const f32x4*)(ck_ + (size_t)(tid + 512) * 4); st2 = *(const f32x4*)(ck_ + (size_t)(tid + 1024) * 4); st3 = *(const f32x4*)(ck_ + (size_t)(tid + 1536) * 4); \
      sp = *(const f32x4*)(kp_ + (size_t)tid * 4); \
    } else { const float* ck_ = p.out + O_CKVS + (size_t)db * 8 * 128; const float* kp_ = p.out + O_KPES + (size_t)db * 8 * 32; \
      st0 = (tid < 256) ? *(const f32x4*)(ck_ + (size_t)tid * 4) : zero4; st1 = zero4; st2 = zero4; st3 = zero4; \
      sp = (tid < 64) ? *(const f32x4*)(kp_ + (size_t)tid * 4) : zero4; } } while (0)
#define SA_ST1(buf, f_, v_) do { const int key_ = (f_) >> 5, c4_ = (f_) & 31; *(u32x2*)(lds + (buf) * TILE + key_ * KVSTR + c4_ * 8) = (u32x2){cvtpk((v_).x, (v_).y), cvtpk((v_).z, (v_).w)}; } while (0)
#define SA_LSTORE(buf) do { SA_ST1(buf, tid, st0); SA_ST1(buf, tid + 512, st1); SA_ST1(buf, tid + 1024, st2); SA_ST1(buf, tid + 1536, st3); \
    { const int key_ = tid >> 3, c4_ = tid & 7; *(u32x2*)(lds + (buf) * TILE + key_ * KVSTR + 256 + c4_ * 8) = (u32x2){cvtpk(sp.x, sp.y), cvtpk(sp.z, sp.w)}; } } while (0)
  SA_GLOAD(0); SA_LSTORE(0); __syncthreads();
  f32x16 o;
#pragma unroll
  for (int r = 0; r < 16; ++r) o[r] = 0.f;
  float m = -1e30f, l = 0.f;
  const int tq = (32 * qt + r32) >> 3;
  for (int t = 0; t < ntiles; ++t) {
    if (t + 1 < ntiles) SA_GLOAD(t + 1);
    const unsigned char* kb = lds + (t & 1) * TILE;
    f32x16 p0, p1;
#pragma unroll
    for (int r = 0; r < 16; ++r) { p0[r] = 0.f; p1[r] = 0.f; }
#pragma unroll
    for (int s = 0; s < 10; ++s) {
      const bf16x8 a0 = *(const bf16x8*)(kb + r32 * KVSTR + (16 * s + 8 * hi) * 2);
      const bf16x8 a1 = *(const bf16x8*)(kb + (32 + r32) * KVSTR + (16 * s + 8 * hi) * 2);
      p0 = __builtin_amdgcn_mfma_f32_32x32x16_bf16(a0, qf[s], p0, 0, 0, 0);
      p1 = __builtin_amdgcn_mfma_f32_32x32x16_bf16(a1, qf[s], p1, 0, 0, 0);
    }
    if (t == 64) {
#pragma unroll
      for (int r = 0; r < 16; ++r) { const int u = crow(r, hi); if (!(u < 8 && u <= tq)) p0[r] = -1e30f; p1[r] = -1e30f; }
    }
    float mx = fmaxf(p0[0], p1[0]);
#pragma unroll
    for (int r = 1; r < 16; ++r) mx = fmaxf(mx, fmaxf(p0[r], p1[r]));
    mx = swap_max(mx);
    const float mn = fmaxf(m, mx), alpha = __builtin_amdgcn_exp2f(m - mn);
    m = mn;
    float ps = 0.f;
#pragma unroll
    for (int r = 0; r < 16; ++r) { p0[r] = __builtin_amdgcn_exp2f(p0[r] - mn); p1[r] = __builtin_amdgcn_exp2f(p1[r] - mn); ps += p0[r] + p1[r]; }
    l = l * alpha + ps;
#pragma unroll
    for (int r = 0; r < 16; ++r) o[r] *= alpha;
    bf16x8 pb[4];
#pragma unroll
    for (int k = 0; k < 4; ++k) {
      u32x4 w;
      if (k < 2) { w.x = cvtpk(p0[8 * k], p0[8 * k + 1]); w.y = cvtpk(p0[8 * k + 2], p0[8 * k + 3]); w.z = cvtpk(p0[8 * k + 4], p0[8 * k + 5]); w.w = cvtpk(p0[8 * k + 6], p0[8 * k + 7]); }
      else { const int kk = k - 2; w.x = cvtpk(p1[8 * kk], p1[8 * kk + 1]); w.y = cvtpk(p1[8 * kk + 2], p1[8 * kk + 3]); w.z = cvtpk(p1[8 * kk + 4], p1[8 * kk + 5]); w.w = cvtpk(p1[8 * kk + 6], p1[8 * kk + 7]); }
      pb[k] = __builtin_bit_cast(bf16x8, w);
    }
    {
      const int g = lane >> 4, i = lane & 15;
      const LAS unsigned char* vbase = (const LAS unsigned char*)kb + (4 * (g >> 1) + (i >> 2)) * KVSTR + (32 * ct + 16 * (g & 1) + 4 * (i & 3)) * 2;
#pragma unroll
      for (int k = 0; k < 4; ++k) {
        const v4i16_t lo = __builtin_amdgcn_ds_read_tr16_b64_v4i16((LAS v4i16_t*)(vbase + (16 * k) * KVSTR));
        const v4i16_t hi4 = __builtin_amdgcn_ds_read_tr16_b64_v4i16((LAS v4i16_t*)(vbase + (16 * k + 8) * KVSTR));
        const bf16x8 va = {lo[0], lo[1], lo[2], lo[3], hi4[0], hi4[1], hi4[2], hi4[3]};
        o = __builtin_amdgcn_mfma_f32_32x32x16_bf16(va, pb[k], o, 0, 0, 0);
      }
    }
    if (t + 1 < ntiles) SA_LSTORE((t + 1) & 1);
    __syncthreads();
  }
#undef SA_GLOAD
#undef SA_ST1
#undef SA_LSTORE
  const float lt = swap_sum(l);
  const int q = 32 * qt + r32;
  if (ct == 0 && hi == 0) { PML[((size_t)item * 64 + q) * 2] = m; PML[((size_t)item * 64 + q) * 2 + 1] = lt; }
#pragma unroll
  for (int g4 = 0; g4 < 4; ++g4) {
    const int c0 = 32 * ct + 8 * g4 + 4 * hi;
    *(f32x4*)(PO + ((size_t)item * 64 + q) * 128 + c0) = (f32x4){o[4 * g4], o[4 * g4 + 1], o[4 * g4 + 2], o[4 * g4 + 3]};
  }
}
}

typedef unsigned v4u __attribute__((ext_vector_type(4)));
__device__ __forceinline__ unsigned f2bf(float f) { unsigned u = __builtin_bit_cast(unsigned, f); return (u + 0x7fffu + ((u >> 16) & 1u)) >> 16; }
__device__ __forceinline__ unsigned pk2(float lo, float hi) { return f2bf(lo) | (f2bf(hi) << 16); }
__device__ __forceinline__ void p0_transpose_item(const float* W, int K, int N, bf16* WT, int row_off, LAS float* scr, int item, int lane) {
  const int nblk = N / 32, kb = item / nblk, nb = item % nblk, k0 = 64 * kb, n0 = 32 * nb;
#pragma unroll 8
  for (int i = 0; i < 32; ++i) { const int kk = 2 * i + (lane >> 5); scr[kk * 33 + (lane & 31)] = W[(size_t)(k0 + kk) * N + n0 + (lane & 31)]; }
  asm volatile("s_waitcnt lgkmcnt(0)" ::: "memory");
  const int c = lane & 7;
#pragma unroll
  for (int j = 0; j < 4; ++j) { const int n = (lane >> 3) + 8 * j; const LAS float* s = scr + (8 * c) * 33 + n;
    v4u o; o.x = pk2(s[0 * 33], s[1 * 33]); o.y = pk2(s[2 * 33], s[3 * 33]); o.z = pk2(s[4 * 33], s[5 * 33]); o.w = pk2(s[6 * 33], s[7 * 33]);
    *(v4u*)(WT + (size_t)(row_off + n0 + n) * K + k0 + 8 * c) = o; }
  asm volatile("s_waitcnt lgkmcnt(0)" ::: "memory");
}

__global__ void __launch_bounds__(512) fwd_megakernel(Params p) {
  cg::grid_group grid = cg::this_grid();
  extern __shared__ __attribute__((aligned(16))) unsigned char lds[];
  float* sm = (float*)lds;
  bf16* wb = (bf16*)(p.ws + W_END);
  const int tid = threadIdx.x, lane = tid & 63, wv = tid >> 6;
  const int gw = blockIdx.x * 8 + wv, NGW = gridDim.x * 8;
  const int gtid = blockIdx.x * 512 + tid, NTH = gridDim.x * 512;
  float* ws = p.ws;

  {
    LAS float* scr = (LAS float*)((LAS unsigned char*)lds + wv * 16384);
    constexpr int I_IN = 16 * (INC / 32), I_MEM = 16 * (512 / 32), I_OUT = 16 * (1024 / 32);
    for (int it = gw; it < I_IN + I_MEM + I_OUT; it += NGW) {
      int r = it;
      if (r < I_IN) { p0_transpose_item(p.w_in, 1024, INC, wb + B_WIN, 0, scr, r, lane); continue; } r -= I_IN;
      if (r < I_MEM) { p0_transpose_item(p.w_mem_kv, 1024, 512, wb + B_WMEM, 0, scr, r, lane); continue; } r -= I_MEM;
      p0_transpose_item(p.w_out, 1024, 1024, wb + B_WOUT, 0, scr, r, lane);
    }
    for (int i = gtid; i < (INCP - INC) * 1024 / 8; i += NTH) ((v4u*)(wb + B_WIN + (size_t)INC * 1024))[i] = (v4u){0u, 0u, 0u, 0u};
  }
  for (int r = gw; r < NT + 1024; r += NGW) {
    const float* src; const float* g; bf16* dst;
    if (r < NT) { src = xrow(p, r); g = p.ln_g; dst = wb + B_H + (size_t)r * 1024; }
    else { src = p.mem_prompt + (size_t)(r - NT) * 1024; g = p.mem_norm_g; dst = wb + B_HM + (size_t)(r - NT) * 1024; }
    float4 v[4]; float ss = 0.f;
#pragma unroll
    for (int i = 0; i < 4; ++i) { v[i] = *(const float4*)(src + 4 * lane + 256 * i); ss += v[i].x * v[i].x + v[i].y * v[i].y + v[i].z * v[i].z + v[i].w * v[i].w; }
    const float rs = rsqrtf(wave_sum(ss) * (1.f / 1024.f) + RMS_EPS);
#pragma unroll
    for (int i = 0; i < 4; ++i) {
      const float4 gg = *(const float4*)(g + 4 * lane + 256 * i);
      uint2 o; o.x = pk2(v[i].x * rs * gg.x, v[i].y * rs * gg.y); o.y = pk2(v[i].z * rs * gg.z, v[i].w * rs * gg.w);
      *(uint2*)(dst + 4 * lane + 256 * i) = o;
    }
  }
  grid.sync();

  {
    pg8::Gemm g{wb + B_H, wb + B_WIN, NT, INCP, 1024}; pg8::StaticOrder S; S.init(NT, INCP, (int)gridDim.x, (int)blockIdx.x);
    pg8::EpiF32 E{ws + W_PROJ, INC, INC, 0, 0, nullptr, nullptr, 0};
    pg8::gemm_phase<pg8::EpiF32, pg8::StaticOrder, true, true>((PG8_LAS unsigned char*)lds, g, S, E);
  }
  {
    pg8::Gemm g{wb + B_HM, wb + B_WMEM, 1024, 512, 1024}; pg8::StaticOrder S; S.init(1024, 512, (int)gridDim.x, (int)((blockIdx.x + 20) % gridDim.x));
    pg8::EpiF32 E{p.out + O_MKP, 256, 256, 256, O_MVP - O_MKP, nullptr, nullptr, 0};
    pg8::gemm_phase<pg8::EpiF32, pg8::StaticOrder, true, true>((PG8_LAS unsigned char*)lds, g, S, E);
  }
  grid.sync();

  {
    float* tds = sm + wv * 128;
    for (int row = gw; row < NT; row += NGW) {
      const float* pr = ws + W_PROJ + (size_t)row * INC;
      {
        float v[4]; float ss = 0.f;
#pragma unroll
        for (int i = 0; i < 4; ++i) { v[i] = pr[C_CQ + lane + 64 * i]; ss += v[i] * v[i]; }
        const float rs = rsqrtf(wave_sum(ss) * (1.f / 256.f) + RMS_EPS);
#pragma unroll
        for (int i = 0; i < 4; ++i) ws[W_CQN + (size_t)row * 256 + lane + 64 * i] = v[i] * rs * p.q_norm_g[lane + 64 * i];
      }
      {
        const float v0 = pr[C_CKV + lane], v1 = pr[C_CKV + 64 + lane];
        const float rs = rsqrtf(wave_sum(v0 * v0 + v1 * v1) * (1.f / 128.f) + RMS_EPS);
        float* o = ckv_out_row(p, row);
        o[lane] = v0 * rs * p.kv_norm_g[lane]; o[64 + lane] = v1 * rs * p.kv_norm_g[64 + lane];
      }
      const int pos = row < NP ? (row % SEQ) : PAST + ((row - NP) & 7);
      if (lane < 16) {
        const float inv = 1.0f / powf(10000.0f, (float)lane * (2.0f / 32.0f));
        const float ang = (float)pos * inv; const float c = cosf(ang), s = sinf(ang);
        const float x1 = pr[C_KR + lane], x2 = pr[C_KR + 16 + lane];
        float* o = kpe_out_row(p, row);
        o[lane] = x1 * c - x2 * s; o[16 + lane] = x2 * c + x1 * s;
      }
      if (row < NP) { if ((row % SEQ) == SEQ - 1) { const int b = row / SEQ; for (int i = lane; i < 896; i += 64) p.out[O_SHP + (size_t)b * 896 + i] = pr[C_Z + i]; } }
      else { if (((row - NP) & 7) == 7) { const int db = (row - NP) >> 3; for (int i = lane; i < 896; i += 64) p.out[O_SHS + (size_t)db * 896 + i] = pr[C_Z + i]; } }
      {
        const bool first = row < NP ? ((row % SEQ) == 0) : (((row - NP) & 7) == 0);
        const float* prev = first ? (row < NP ? nullptr : p.state_shift + (size_t)((row - NP) >> 3) * 896 - C_Z) : pr - INC;
        auto zmix = [&](int i) -> float { const float z = pr[C_Z + i]; const float pv = prev ? prev[C_Z + i] : 0.f; return z + (pv - z) * p.shift_mu[i]; };
        tds[lane] = tanhf(zmix(768 + lane)); tds[64 + lane] = zmix(832 + lane);
        __builtin_amdgcn_fence(__ATOMIC_RELEASE, "wavefront"); __builtin_amdgcn_wave_barrier();
#pragma unroll 1
        for (int hh = 0; hh < 4; ++hh) {
          const int c = hh * 64 + lane;
          float u = p.w0[c], au = p.a0[c];
#pragma unroll 4
          for (int j = 0; j < 64; ++j) { u += tds[j] * p.w_up[j * 256 + c]; au += tds[64 + j] * p.a_up[j * 256 + c]; }
          const float nu = -u;
          const float sp = fmaxf(nu, 0.f) + log1pf(expf(-fabsf(nu)));
          const float wl = -sp - 0.5f;
          const float decay = expf(-expf(wl));
          const float a = 1.f / (1.f + expf(-au));
          const float k = zmix(256 + c), r = zmix(c), v = zmix(512 + c);
          float kk = k * p.k_k[c];
          const float nrm = fmaxf(sqrtf(wave_sum(kk * kk)), 1e-12f);
          kk = kk / nrm;
          const float kf = k * (1.f + (a - 1.f) * p.k_a[c]);
          const size_t o = (size_t)row * 256 + c;
          ws[W_R + o] = r; ws[W_W + o] = decay; ws[W_KF + o] = kf; ws[W_VV + o] = v; ws[W_KK + o] = kk; ws[W_BB + o] = kk * a;
        }
        __builtin_amdgcn_fence(__ATOMIC_RELEASE, "wavefront"); __builtin_amdgcn_wave_barrier();
      }
    }
  }
  grid.sync();

  gemm_f32<false>(ws + W_CQN, 256, p.w_uq, 768, ws + W_Q, 768, NT, 768, 256, sm);
  gemm_f32<false>(p.out + O_CKVP, 128, p.w_uk, 512, ws + W_KN, 512, NP, 512, 128, sm);
  gemm_f32<false>(p.out + O_CKVP, 128, p.w_uv, 512, ws + W_V, 512, NP, 512, 128, sm);
  grid.sync();

  for (int i = gtid; i < NT * 8 * 16; i += NTH) {
    const int j = i & 15, h = (i >> 4) & 7, row = i >> 7;
    const int pos = row < NP ? (row % SEQ) : PAST + ((row - NP) & 7);
    const float inv = 1.0f / powf(10000.0f, (float)j * (2.0f / 32.0f));
    const float ang = (float)pos * inv; const float c = cosf(ang), s = sinf(ang);
    float* q = ws + W_Q + (size_t)row * 768 + h * 96 + 64;
    const float x1 = q[j], x2 = q[16 + j];
    q[j] = x1 * c - x2 * s; q[16 + j] = x2 * c + x1 * s;
  }
  for (int h = 0; h < 8; ++h)
    gemm_f32<true>(ws + W_Q + (size_t)NP * 768 + h * 96, 768, p.w_uk + h * 64, 512, ws + W_QLAT + h * 128, 1024, NS, 128, 64, sm);
  grid.sync();

  {
    const float QSC = MLA_SCALE * 1.4426950408889634f;
    for (size_t i = gtid; i < (size_t)NP * 768 / 4; i += NTH) {
      const float4 v = *(const float4*)(ws + W_Q + i * 4);
      *(uint2*)(wb + B_QP + i * 4) = make_uint2(pk2(v.x * QSC, v.y * QSC), pk2(v.z * QSC, v.w * QSC));
    }
    for (size_t i = gtid; i < (size_t)NP * 8 * 24; i += NTH) {
      const int g4 = (int)(i % 24), h = (int)((i / 24) & 7); const size_t row = i / 192;
      const float4 v = g4 < 16 ? *(const float4*)(ws + W_KN + row * 512 + h * 64 + g4 * 4) : *(const float4*)(p.out + O_KPEP + row * 32 + (g4 - 16) * 4);
      *(uint2*)(wb + B_KP + row * 768 + h * 96 + g4 * 4) = make_uint2(pk2(v.x, v.y), pk2(v.z, v.w));
    }
    for (size_t i = gtid; i < (size_t)NS * 8 * 40; i += NTH) {
      const int g4 = (int)(i % 40); const size_t rh = i / 40, srow = rh >> 3; const int h = (int)(rh & 7);
      const float4 v = g4 < 32 ? *(const float4*)(ws + W_QLAT + srow * 1024 + h * 128 + g4 * 4) : *(const float4*)(ws + W_Q + (NP + srow) * 768 + h * 96 + 64 + (g4 - 32) * 4);
      *(uint2*)(wb + B_QS + rh * 160 + g4 * 4) = make_uint2(pk2(v.x * QSC, v.y * QSC), pk2(v.z * QSC, v.w * QSC));
    }
    for (size_t i = gtid; i < (size_t)512 * NP; i += NTH) {
      const size_t c = i / NP, row = i % NP;
      wb[B_VT + i] = (bf16)f2bf(ws[W_V + row * 512 + c]);
    }
  }
  grid.sync();

  {
    const int B = blockIdx.x;
    for (int u2 = 0; u2 < 2; ++u2) {
      for (int bb = B; bb < 256; bb += gridDim.x) {
        const int bh = bb & 31, qb = u2 == 0 ? 15 - (bb >> 5) : (bb >> 5);
        const int b = bh >> 3, h = bh & 7;
        const size_t row0 = (size_t)b * SEQ + 256 * qb;
        auto out = [&](int ql, int dv0, float4 v) {
          const size_t row = row0 + ql;
          const float4 g = *(const float4*)(ws + W_PROJ + row * INC + C_GMLA + h * 64 + dv0);
          *(float4*)(ws + W_MIX + row * 1024 + h * 64 + dv0) = make_float4(v.x * silu(g.x), v.y * silu(g.y), v.z * silu(g.z), v.w * silu(g.w));
        };
        pa::attn_unit<96, true>(lds, wb + B_QP + row0 * 768 + h * 96, 768, wb + B_KP + (size_t)b * SEQ * 768 + h * 96, 768,
                                wb + B_VT + (size_t)(h * 64) * NP + (size_t)b * SEQ, NP, 4 * qb + 4, 256 * qb, out);
      }
    }
    for (int item = B; item < 256; item += gridDim.x) sa::sample_attn_item(lds, p, wb + B_QS, ws + W_PO, ws + W_PML, item);
    __syncthreads();
  }
  {
    constexpr int N_RP = 16, N_RS = 512, N_MA = NT * 4 / 16;
    constexpr int TOT = N_RP + N_RS + N_MA;
    float* wsm = sm + wv * 320;
    for (int it = gw; it < TOT; it += NGW) {
      int i = __builtin_amdgcn_readfirstlane(it);
      if (i < N_RP + N_RS) { const bool pr = i < N_RP; const int j = pr ? i : i - N_RP; rwkv_scan_wave(p, pr, j >> 2, j & 3, lane, wsm); continue; }
      i -= N_RP + N_RS;
      mem_attn_wave(p, i, lane, wsm);
    }
  }
  grid.sync();

  for (int i = gtid; i < NS * 512; i += NTH) {
    const int c = i & 511, srow = i >> 9, h = c >> 6;
    const int db_ = srow >> 3, qi = (srow & 7) * 8 + h;
    const float* ml0 = ws + W_PML + ((size_t)(2 * db_) * 64 + qi) * 2; const float* ml1 = ml0 + 128;
    const float M_ = fmaxf(ml0[0], ml1[0]), w0_ = exp2f(ml0[0] - M_), w1_ = exp2f(ml1[0] - M_);
    const float invL = 1.f / (ml0[1] * w0_ + ml1[1] * w1_);
    const float* po0 = ws + W_PO + ((size_t)(2 * db_) * 64 + qi) * 128; const float* po1 = po0 + 64 * 128;
    float acc = 0.f;
#pragma unroll 4
    for (int k = 0; k < 128; ++k) acc += (po0[k] * w0_ + po1[k] * w1_) * p.w_uv[k * 512 + c];
    acc *= invL;
    const int row = NP + srow;
    const float g = ws[W_PROJ + (size_t)row * INC + C_GMLA + c];
    ws[W_MIX + (size_t)row * 1024 + c] = acc * silu(g);
  }
  grid.sync();
  for (size_t i = gtid; i < (size_t)NT * 1024 / 4; i += NTH) {
    const float4 v = *(const float4*)(ws + W_MIX + i * 4);
    uint2 o; o.x = pk2(v.x, v.y); o.y = pk2(v.z, v.w);
    *(uint2*)(wb + B_MIX + i * 4) = o;
  }
  grid.sync();

  {
    pg8::Gemm g{wb + B_MIX, wb + B_WOUT, NT, 1024, 1024}; pg8::StaticOrder S; S.init(NT, 1024, (int)gridDim.x, (int)blockIdx.x);
    pg8::EpiF32 E{p.out, 1024, 1024, 0, 0, p.x_prompt, p.x_sample, NP};
    pg8::gemm_phase<pg8::EpiF32, pg8::StaticOrder, true, true>((PG8_LAS unsigned char*)lds, g, S, E);
  }
  grid.sync();

  for (int r = gw; r < NT; r += NGW) {
    float* y = p.out + (size_t)r * 1024;
    float v[16]; float ss = 0.f;
#pragma unroll
    for (int i = 0; i < 16; ++i) { v[i] = y[lane + 64 * i]; ss += v[i] * v[i]; }
    const float rs = rsqrtf(wave_sum(ss) * (1.f / 1024.f) + RMS_EPS);
#pragma unroll
    for (int i = 0; i < 16; ++i) y[lane + 64 * i] = v[i] * rs * p.final_g[lane + 64 * i];
  }
}

extern "C" void kernel_launch(void* const* d_in, const int* in_sizes, int n_in, void* d_out,
                              int out_size, void* d_ws, size_t ws_size, hipStream_t stream) {
  static int grid_blocks = 0;
  if (!grid_blocks) {
    int dev = 0, cus = 0, per_cu = 0;
    (void)hipGetDevice(&dev);
    (void)hipDeviceGetAttribute(&cus, hipDeviceAttributeMultiprocessorCount, dev);
    (void)hipFuncSetAttribute((const void*)fwd_megakernel, hipFuncAttributeMaxDynamicSharedMemorySize, LDS_BYTES);
    (void)hipOccupancyMaxActiveBlocksPerMultiprocessor(&per_cu, fwd_megakernel, 512, LDS_BYTES);
    if (per_cu < 1) per_cu = 1;
    grid_blocks = cus;
    if (ws_size < WS_BYTES) fprintf(stderr, "workspace too small: %zu < %zu\n", ws_size, (size_t)WS_BYTES);
  }
  Params p{};
  const float** pf = (const float**)&p;
  (void)pf;
  p.x_prompt = (const float*)d_in[0]; p.x_sample = (const float*)d_in[1]; p.mem_prompt = (const float*)d_in[2];
  p.cache_ckv = (const float*)d_in[3]; p.cache_kpe = (const float*)d_in[4]; p.page_table = (const int*)d_in[5];
  p.state_wkv = (const float*)d_in[6]; p.state_shift = (const float*)d_in[7]; p.cache_mem_k = (const float*)d_in[8];
  p.cache_mem_v = (const float*)d_in[9]; p.ln_g = (const float*)d_in[10]; p.w_in = (const float*)d_in[11];
  p.q_norm_g = (const float*)d_in[12]; p.kv_norm_g = (const float*)d_in[13]; p.w_uq = (const float*)d_in[14];
  p.w_uk = (const float*)d_in[15]; p.w_uv = (const float*)d_in[16]; p.shift_mu = (const float*)d_in[17];
  p.w0 = (const float*)d_in[18]; p.w_up = (const float*)d_in[19]; p.a0 = (const float*)d_in[20]; p.a_up = (const float*)d_in[21];
  p.k_k = (const float*)d_in[22]; p.k_a = (const float*)d_in[23]; p.r_k = (const float*)d_in[24]; p.lnx_g = (const float*)d_in[25];
  p.lnx_b = (const float*)d_in[26]; p.mem_norm_g = (const float*)d_in[27]; p.w_mem_kv = (const float*)d_in[28];
  p.w_out = (const float*)d_in[29]; p.final_g = (const float*)d_in[30];
  p.out = (float*)d_out; p.ws = (float*)d_ws;
  void* args[] = {&p};
  hipError_t e = hipLaunchCooperativeKernel((void*)fwd_megakernel, dim3(grid_blocks), dim3(512), args, LDS_BYTES, stream);
  if (e != hipSuccess) fprintf(stderr, "cooperative launch failed: %s (grid %d)\n", hipGetErrorString(e), grid_blocks);
}
```

```cpp
#include <hip/hip_runtime.h>
#include <hip/hip_cooperative_groups.h>
#include <cstdio>
#include <cstdint>
namespace cg = cooperative_groups;
namespace pg8 {
#define PG8_LAS __attribute__((address_space(3)))
typedef unsigned short bf16_t;
typedef short bf16x8 __attribute__((ext_vector_type(8)));
typedef float f32x4 __attribute__((ext_vector_type(4)));
typedef unsigned u32x4 __attribute__((ext_vector_type(4)));
constexpr int BM = 256, BK = 64, HALF = 128, HTB = HALF * BK * 2  , STAGE_BYTES = 8 * HTB, NXCD = 8, WGM = 8;

__host__ __device__ __forceinline__ int lds_byte(int r, int c) { const int st = (r >> 4) * 2 + (c >> 5), rr = r & 15, cc = c & 31, ob = rr * 64 + cc * 2; return st * 1024 + (ob ^ (((ob >> 9) & 1) << 5)); }
__host__ __device__ __forceinline__ void stage_rc(int b, int& R, int& C) { const int st = b / 1024, sb = b % 1024, swz = sb ^ (((sb >> 9) & 1) << 5); R = (st >> 1) * 16 + swz / 64; C = (st & 1) * 32 + (swz % 64) / 2; }
__host__ __device__ __forceinline__ int perm32(int rho) { const int n = rho >> 4, i = rho & 15; return 8 * (i >> 2) + 4 * n + (i & 3); }

struct Unit { int pm, pn; };
struct Gemm { const bf16_t* A; const bf16_t* Bt; int M, N, K; };

struct StaticOrder {
    int nM, nN, nwg, G, c;
    __host__ __device__ void init(int M, int N, int G_, int c_) { nM = M / BM; nN = N / BM; nwg = nM * nN; G = G_; c = c_; }
    __host__ __device__ bool next(int i, Unit& u) const {
        const long L = (long)i * G + c; if (L >= nwg) return false;
        int wgid = (int)L; { const int q = nwg / NXCD, r = nwg % NXCD, xcd = wgid % NXCD, off = wgid / NXCD; wgid = (xcd < r ? xcd * (q + 1) : r * (q + 1) + (xcd - r) * q) + off; }
        const int nig = WGM * nN, gid = wgid / nig, fm = gid * WGM, gsz = (nM - fm) < WGM ? (nM - fm) : WGM;
        u.pm = fm + ((wgid % nig) % gsz); u.pn = (wgid % nig) / gsz; return true;
    }
    __device__ __forceinline__ void a_ready(const Unit&) const {}
    __device__ __forceinline__ void done(const Unit&) const {}
};
__device__ __forceinline__ unsigned cvt_pk_bf16(float lo, float hi) { unsigned r; asm volatile("v_cvt_pk_bf16_f32 %0, %1, %2" : "=v"(r) : "v"(lo), "v"(hi)); return r; }
typedef float f32x2 __attribute__((ext_vector_type(2)));
template <class Epi, class Sched, bool ALIGN_EPI = false, bool SP2 = false>
__device__ __forceinline__ void gemm_phase(PG8_LAS unsigned char* lds, const Gemm g, const Sched& S, const Epi& E) {
    const int tid = threadIdx.x, wid = __builtin_amdgcn_readfirstlane(tid >> 6), lane = tid & 63, wr = wid >> 2, wc = wid & 3, fr = lane & 15, fq = lane >> 4;
    const int K = g.K, nt = K / BK;
    unsigned voffA[2], voffB[2];
#pragma unroll
    for (int i = 0; i < 2; ++i) { int R, C; stage_rc(tid * 16 + i * 8192, R, C); const int Rb = Epi::PERM ? ((R & ~31) + perm32(R & 31)) : R;
        voffA[i] = (unsigned)(R * K + C) * 2u; voffB[i] = (unsigned)(Rb * K + C) * 2u; }
    const size_t kstep = (size_t)(BK * 2);
    const size_t hstep = (size_t)HALF * K * 2;
    const size_t tstep = 2 * hstep;
    const unsigned ldsw = (unsigned)wid * 1024u;
    const int aoff = lds_byte(wr * 64 + fr, fq * 8), boff = lds_byte(wc * 32 + fr, fq * 8);
#define PG8_SA(b, h) (((b) * 2 + (h)) * HTB)
#define PG8_SB(b, h) ((4 + (b) * 2 + (h)) * HTB)
#define PG8_STAGE(bufoff, gbase, voff) do { _Pragma("unroll") for (int _i = 0; _i < 2; ++_i) \
        __builtin_amdgcn_global_load_lds((const unsigned*)((const char*)(gbase) + (voff)[_i]), (PG8_LAS unsigned*)(lds + (bufoff) + ldsw + _i * 8192), 16, 0, 0); } while (0)
#define PG8_LDA(dst, b, h) do { _Pragma("unroll") for (int m = 0; m < 4; ++m) _Pragma("unroll") for (int k = 0; k < 2; ++k) dst[m][k] = *(const PG8_LAS bf16x8*)(lds + PG8_SA(b, h) + aoff + m * 2048 + k * 1024); } while (0)
#define PG8_LDB(dst, b, h) do { _Pragma("unroll") for (int n = 0; n < 2; ++n) _Pragma("unroll") for (int k = 0; k < 2; ++k) dst[n][k] = *(const PG8_LAS bf16x8*)(lds + PG8_SB(b, h) + boff + n * 2048 + k * 1024); } while (0)
#define PG8_MMA(ai, bj, At, Bt) do { __builtin_amdgcn_s_setprio(1); _Pragma("unroll") for (int m = 0; m < 4; ++m) _Pragma("unroll") for (int n = 0; n < 2; ++n) _Pragma("unroll") for (int k = 0; k < 2; ++k) \
        acc[ai][bj][m][n] = __builtin_amdgcn_mfma_f32_16x16x32_bf16(Bt[n][k], At[m][k], acc[ai][bj][m][n], 0, 0, 0); __builtin_amdgcn_s_setprio(0); } while (0)
#define PG8_WAIT_V(n) asm volatile("s_waitcnt vmcnt(" #n ")" ::: "memory")
#define PG8_WAIT_L(n) asm volatile("s_waitcnt lgkmcnt(" #n ")" ::: "memory")
#define PG8_BAR __builtin_amdgcn_s_barrier()
#define PG8_SCHED __builtin_amdgcn_sched_barrier(0)
    Unit cur, nxt; int ui = 0;
    if (!S.next(0, cur)) return;
    f32x4 acc[2][2][4][2];
#pragma unroll
    for (int a = 0; a < 2; ++a)
#pragma unroll
        for (int b = 0; b < 2; ++b)
#pragma unroll
            for (int m = 0; m < 4; ++m)
#pragma unroll
                for (int n = 0; n < 2; ++n) acc[a][b][m][n] = (f32x4){0.f, 0.f, 0.f, 0.f};
    bf16x8 At[4][2], B0[2][2], B1[2][2];
    const char* cA = (const char*)g.A + (size_t)cur.pm * tstep; const char* cB = (const char*)g.Bt + (size_t)cur.pn * tstep;
    S.a_ready(cur);
    if constexpr (SP2) {
        PG8_STAGE(PG8_SB(0, 0), cB, voffB); PG8_STAGE(PG8_SB(0, 1), cB + hstep, voffB); PG8_STAGE(PG8_SA(0, 0), cA, voffA); PG8_STAGE(PG8_SA(0, 1), cA + hstep, voffA);
        if (wr == 1) PG8_BAR;
        PG8_WAIT_V(2); PG8_BAR;
        PG8_STAGE(PG8_SB(1, 0), cB + kstep, voffB); PG8_STAGE(PG8_SA(1, 0), cA + kstep, voffA); PG8_STAGE(PG8_SB(1, 1), cB + hstep + kstep, voffB);
        PG8_WAIT_V(6); PG8_BAR;
    } else {
        PG8_STAGE(PG8_SB(0, 0), cB, voffB); PG8_STAGE(PG8_SA(0, 0), cA, voffA); PG8_STAGE(PG8_SB(0, 1), cB + hstep, voffB); PG8_STAGE(PG8_SA(0, 1), cA + hstep, voffA);
        if (wr == 1) PG8_BAR;
        PG8_WAIT_V(4); PG8_BAR;
        PG8_STAGE(PG8_SB(1, 0), cB + kstep, voffB); PG8_STAGE(PG8_SA(1, 0), cA + kstep, voffA); PG8_STAGE(PG8_SB(1, 1), cB + hstep + kstep, voffB);
        PG8_WAIT_V(6); PG8_BAR;
    }
    for (;;) {
        const bool has_next = S.next(ui + 1, nxt);
        const char* nA = has_next ? (const char*)g.A + (size_t)nxt.pm * tstep : cA; const char* nB = has_next ? (const char*)g.Bt + (size_t)nxt.pn * tstep : cB;
        for (int t = 0; t < nt; t += 2) {
            const bool last = (t == nt - 2);
            const char* a1 = cA + (size_t)(t + 1) * kstep;
            const char* a2 = last ? nA : cA + (size_t)(t + 2) * kstep; const char* b2 = last ? nB : cB + (size_t)(t + 2) * kstep;
            const char* a3 = a2 + kstep; const char* b3 = b2 + kstep;
            if (last && has_next) S.a_ready(nxt);
            if constexpr (SP2) {
            PG8_LDB(B0, 0, 0); PG8_LDB(B1, 0, 1); PG8_SCHED; PG8_LDA(At, 0, 0); PG8_STAGE(PG8_SA(1, 1), a1 + hstep, voffA);
            PG8_WAIT_V(8); PG8_WAIT_L(0); PG8_BAR; PG8_MMA(0, 0, At, B0); PG8_MMA(0, 1, At, B1); PG8_BAR; PG8_SCHED;
            PG8_LDA(At, 0, 1); PG8_STAGE(PG8_SB(0, 0), b2, voffB); PG8_STAGE(PG8_SB(0, 1), b2 + hstep, voffB); PG8_STAGE(PG8_SA(0, 0), a2, voffA);
            PG8_WAIT_V(8); PG8_WAIT_L(0); PG8_BAR; PG8_MMA(1, 0, At, B0); PG8_MMA(1, 1, At, B1); PG8_BAR; PG8_SCHED;
            PG8_LDB(B0, 1, 0); PG8_LDB(B1, 1, 1); PG8_SCHED; PG8_LDA(At, 1, 0); PG8_STAGE(PG8_SA(0, 1), a2 + hstep, voffA);
            PG8_WAIT_V(8); PG8_WAIT_L(0); PG8_BAR; PG8_MMA(0, 0, At, B0); PG8_MMA(0, 1, At, B1); PG8_BAR; PG8_SCHED;
            PG8_LDA(At, 1, 1); PG8_STAGE(PG8_SB(1, 0), b3, voffB); PG8_STAGE(PG8_SB(1, 1), b3 + hstep, voffB); PG8_STAGE(PG8_SA(1, 0), a3, voffA);
            PG8_WAIT_V(8); PG8_WAIT_L(0); PG8_BAR; PG8_MMA(1, 0, At, B0); PG8_MMA(1, 1, At, B1); PG8_BAR; PG8_SCHED;
            } else {
            PG8_LDB(B0, 0, 0); PG8_SCHED; PG8_LDA(At, 0, 0); PG8_STAGE(PG8_SA(1, 1), a1 + hstep, voffA);
            PG8_WAIT_L(8); PG8_BAR; PG8_WAIT_L(0); PG8_MMA(0, 0, At, B0); PG8_BAR; PG8_SCHED;
            PG8_LDB(B1, 0, 1); PG8_STAGE(PG8_SB(0, 0), b2, voffB);
            PG8_BAR; PG8_WAIT_L(0); PG8_MMA(0, 1, At, B1); PG8_BAR;
            PG8_LDA(At, 0, 1); PG8_STAGE(PG8_SA(0, 0), a2, voffA);
            PG8_BAR; PG8_WAIT_L(0); PG8_MMA(1, 0, At, B0); PG8_BAR; PG8_SCHED;
            PG8_STAGE(PG8_SB(0, 1), b2 + hstep, voffB);
            PG8_WAIT_V(6); PG8_BAR; PG8_MMA(1, 1, At, B1); PG8_BAR;
            PG8_LDB(B0, 1, 0); PG8_SCHED; PG8_LDA(At, 1, 0); PG8_STAGE(PG8_SA(0, 1), a2 + hstep, voffA);
            PG8_WAIT_L(8); PG8_BAR; PG8_WAIT_L(0); PG8_MMA(0, 0, At, B0); PG8_BAR; PG8_SCHED;
            PG8_LDB(B1, 1, 1); PG8_STAGE(PG8_SB(1, 0), b3, voffB);
            PG8_BAR; PG8_WAIT_L(0); PG8_MMA(0, 1, At, B1); PG8_BAR;
            PG8_LDA(At, 1, 1); PG8_STAGE(PG8_SA(1, 0), a3, voffA);
            PG8_BAR; PG8_WAIT_L(0); PG8_MMA(1, 0, At, B0); PG8_BAR; PG8_SCHED;
            PG8_STAGE(PG8_SB(1, 1), b3 + hstep, voffB);
            PG8_WAIT_V(6); PG8_BAR; PG8_MMA(1, 1, At, B1); PG8_BAR;
            }
        }
        if constexpr (ALIGN_EPI) { if (wr == 0) PG8_BAR; }
        if constexpr (!Epi::AFTER_DRAIN) { E(acc, cur, wr, wc, fr, fq); S.done(cur); }
        if (!has_next) break;
#pragma unroll
        for (int a = 0; a < 2; ++a)
#pragma unroll
            for (int b = 0; b < 2; ++b)
#pragma unroll
                for (int m = 0; m < 4; ++m)
#pragma unroll
                    for (int n = 0; n < 2; ++n) acc[a][b][m][n] = (f32x4){0.f, 0.f, 0.f, 0.f};
        cur = nxt; cA = nA; cB = nB; ++ui;
        if constexpr (ALIGN_EPI) { if (wr == 1) PG8_BAR; }
    }
    PG8_WAIT_V(0);
    if constexpr (!ALIGN_EPI) { if (wr == 0) PG8_BAR; }
    PG8_BAR;
    if constexpr (Epi::AFTER_DRAIN) { E.fused(acc, cur, wr, wc, fr, fq, lds, wid, lane); S.done(cur); }
#undef PG8_SA
#undef PG8_SB
#undef PG8_STAGE
#undef PG8_LDA
#undef PG8_LDB
#undef PG8_MMA
#undef PG8_WAIT_V
#undef PG8_WAIT_L
#undef PG8_BAR
#undef PG8_SCHED
}
}

namespace pg8 {
struct EpiF32 {
  static constexpr bool PERM = false, AFTER_DRAIN = false;
  float* C; int ldc; int ncols; int split_cols; size_t split_stride; const float* r0; const float* r1; int nr0;
  __device__ __forceinline__ void operator()(const f32x4 (&acc)[2][2][4][2], const Unit& u, int wr, int wc, int fr, int fq) const {
    const int row0 = u.pm * BM + wr * 64 + fr; int colt = u.pn * BM; float* base = C;
    if (split_cols) { const int t = colt / split_cols; base += (size_t)t * split_stride; colt -= t * split_cols; }
    const int col0 = colt + wc * 32 + 4 * fq;
#pragma unroll
    for (int ai = 0; ai < 2; ++ai)
#pragma unroll
      for (int m = 0; m < 4; ++m) {
        const int row = row0 + ai * HALF + m * 16;
        const float* rr = r0 ? (row < nr0 ? r0 + (size_t)row * ldc : r1 + (size_t)(row - nr0) * ldc) : nullptr;
#pragma unroll
        for (int bj = 0; bj < 2; ++bj)
#pragma unroll
          for (int n = 0; n < 2; ++n) {
            const int col = col0 + bj * HALF + n * 16;
            if (col < ncols) { f32x4 v = acc[ai][bj][m][n]; if (rr) v += *(const f32x4*)(rr + col); *(f32x4*)(base + (size_t)row * ldc + col) = v; }
          }
      }
  }
};
}

constexpr int DM = 1024, BATCH = 4, SEQ = 4096, DB = 128, DT = 8, PAST = 8192, PAGE = 128, NPG = 64, NMEM = 256;
constexpr int NP = BATCH * SEQ, NS = DB * DT, NT = NP + NS;
constexpr int INC = 2592;
constexpr int C_CQ = 0, C_CKV = 256, C_KR = 384, C_GMLA = 416, C_Z = 928, C_GRWKV = 1824, C_QX = 2080, C_GX = 2336;
constexpr float MLA_SCALE = 0.10206207261596575f;
constexpr float X_SCALE = 0.125f;
constexpr float RMS_EPS = 1e-6f, GN_EPS = 64e-5f;
constexpr size_t O_YP = 0, O_YS = 16777216, O_CKVP = 17825792, O_KPEP = 19922944, O_WKVP = 20447232, O_SHP = 20512768,
                 O_MKP = 20516352, O_MVP = 20778496, O_CKVS = 21040640, O_KPES = 21171712, O_WKVS = 21204480, O_SHS = 23301632;
constexpr size_t W_H = 0;
constexpr size_t W_HM = W_H + (size_t)NT * 1024;
constexpr size_t W_PROJ = W_HM + (size_t)1024 * 1024;
constexpr size_t W_CQN = W_PROJ + (size_t)NT * INC;
constexpr size_t W_Q = W_CQN + (size_t)NT * 256;
constexpr size_t W_KN = W_Q + (size_t)NT * 768;
constexpr size_t W_V = W_KN + (size_t)NP * 512;
constexpr size_t W_QLAT = W_V + (size_t)NP * 512;
constexpr size_t W_OLAT = W_QLAT + (size_t)NS * 1024;
constexpr size_t W_R = W_OLAT + (size_t)NS * 1024;
constexpr size_t W_W = W_R + (size_t)NT * 256;
constexpr size_t W_KF = W_W + (size_t)NT * 256;
constexpr size_t W_VV = W_KF + (size_t)NT * 256;
constexpr size_t W_KK = W_VV + (size_t)NT * 256;
constexpr size_t W_BB = W_KK + (size_t)NT * 256;
constexpr size_t W_MIX = W_BB + (size_t)NT * 256;
constexpr size_t W_PO = W_MIX + (size_t)NT * 1024;
constexpr size_t W_PML = W_PO + (size_t)256 * 64 * 128;
constexpr size_t W_Y = W_PML + (size_t)256 * 64 * 2;
constexpr size_t W_CTL = W_Y + (size_t)NP * 256;
constexpr size_t W_END = W_CTL + 64;
constexpr int INCP = 2816;
constexpr size_t B_H = 0;
constexpr size_t B_HM = B_H + (size_t)NT * 1024;
constexpr size_t B_WIN = B_HM + (size_t)1024 * 1024;
constexpr size_t B_WMEM = B_WIN + (size_t)INCP * 1024;
constexpr size_t B_WOUT = B_WMEM + (size_t)512 * 1024;
constexpr size_t B_MIX = B_WOUT + (size_t)1024 * 1024;
constexpr size_t B_QP = B_MIX + (size_t)NT * 1024;
constexpr size_t B_KP = B_QP + (size_t)NP * 768;
constexpr size_t B_VT = B_KP + (size_t)NP * 768;
constexpr size_t B_QS = B_VT + (size_t)512 * NP;
constexpr size_t B_END = B_QS + (size_t)NS * 8 * 160;
constexpr size_t WS_BYTES = W_END * 4 + B_END * 2;
constexpr int LDS_BYTES = 147456;

struct Params {
  const float* x_prompt; const float* x_sample; const float* mem_prompt; const float* cache_ckv; const float* cache_kpe;
  const int* page_table; const float* state_wkv; const float* state_shift; const float* cache_mem_k; const float* cache_mem_v;
  const float* ln_g; const float* w_in; const float* q_norm_g; const float* kv_norm_g; const float* w_uq; const float* w_uk;
  const float* w_uv; const float* shift_mu; const float* w0; const float* w_up; const float* a0; const float* a_up;
  const float* k_k; const float* k_a; const float* r_k; const float* lnx_g; const float* lnx_b; const float* mem_norm_g;
  const float* w_mem_kv; const float* w_out; const float* final_g;
  float* out; float* ws;
};

__device__ __forceinline__ float wave_sum(float v) {
#pragma unroll
  for (int o = 1; o < 64; o <<= 1) v += __shfl_xor(v, o);
  return v;
}
__device__ __forceinline__ float wave_max(float v) {
#pragma unroll
  for (int o = 1; o < 64; o <<= 1) v = fmaxf(v, __shfl_xor(v, o));
  return v;
}
__device__ __forceinline__ float silu(float x) { return x / (1.f + expf(-x)); }
__device__ __forceinline__ const float* xrow(const Params& p, int row) {
  return row < NP ? p.x_prompt + (size_t)row * DM : p.x_sample + (size_t)(row - NP) * DM;
}
__device__ __forceinline__ float* ckv_out_row(const Params& p, int row) {
  return row < NP ? p.out + O_CKVP + (size_t)row * 128 : p.out + O_CKVS + (size_t)(row - NP) * 128;
}
__device__ __forceinline__ float* kpe_out_row(const Params& p, int row) {
  return row < NP ? p.out + O_KPEP + (size_t)row * 32 : p.out + O_KPES + (size_t)(row - NP) * 32;
}

template <bool BT>
__device__ __forceinline__ void gemm_f32(const float* __restrict__ A, int lda, const float* __restrict__ B, int ldb, float* __restrict__ C, int ldc,
                         int M, int N, int K, float* sm) {
  const int tid = threadIdx.x, tx = tid & 15, ty = tid >> 4;
  float(*As)[68] = (float(*)[68])sm;
  float(*Bs)[68] = (float(*)[68])(sm + 16 * 68);
  const int tm = M / 64, tn = (N + 63) / 64;
  for (int tile = blockIdx.x; tile < tm * tn; tile += gridDim.x) {
    const int m0 = (tile / tn) * 64, n0 = (tile % tn) * 64;
    float acc[2][4];
#pragma unroll
    for (int i = 0; i < 2; ++i)
#pragma unroll
      for (int j = 0; j < 4; ++j) acc[i][j] = 0.f;
    for (int k0 = 0; k0 < K; k0 += 16) {
      for (int i = tid; i < 1024; i += 512) { const int r = i >> 4, kk = i & 15; As[kk][r] = A[(size_t)(m0 + r) * lda + k0 + kk]; }
      if (BT) {
        for (int i = tid; i < 1024; i += 512) { const int c = i >> 4, kk = i & 15; Bs[kk][c] = (n0 + c < N) ? B[(size_t)(n0 + c) * ldb + k0 + kk] : 0.f; }
      } else {
        for (int i = tid; i < 1024; i += 512) { const int kk = i >> 6, c = i & 63; Bs[kk][c] = (n0 + c < N) ? B[(size_t)(k0 + kk) * ldb + n0 + c] : 0.f; }
      }
      __syncthreads();
#pragma unroll
      for (int kk = 0; kk < 16; ++kk) {
        const float a0 = As[kk][ty * 2], a1 = As[kk][ty * 2 + 1];
        const float b0 = Bs[kk][tx * 4], b1 = Bs[kk][tx * 4 + 1], b2 = Bs[kk][tx * 4 + 2], b3 = Bs[kk][tx * 4 + 3];
        acc[0][0] += a0 * b0; acc[0][1] += a0 * b1; acc[0][2] += a0 * b2; acc[0][3] += a0 * b3;
        acc[1][0] += a1 * b0; acc[1][1] += a1 * b1; acc[1][2] += a1 * b2; acc[1][3] += a1 * b3;
      }
      __syncthreads();
    }
#pragma unroll
    for (int i = 0; i < 2; ++i)
#pragma unroll
      for (int j = 0; j < 4; ++j) { const int col = n0 + tx * 4 + j; if (col < N) C[(size_t)(m0 + ty * 2 + i) * ldc + col] = acc[i][j]; }
  }
}

template <int D1, int D2, int DV>
__device__ __forceinline__ void attn_row_tile(const float* wsm, const float* k1, const float* k2, const float* v, bool valid, int lane,
                                              float& m, float& l, float& o0, float& o1) {
  float sc = 0.f;
#pragma unroll 4
  for (int c = 0; c < D1; c += 4) { const float4 kv = *(const float4*)(k1 + c); sc += wsm[c] * kv.x + wsm[c + 1] * kv.y + wsm[c + 2] * kv.z + wsm[c + 3] * kv.w; }
  if (D2 > 0)
#pragma unroll 4
  for (int c = 0; c < D2; c += 4) { const float4 kv = *(const float4*)(k2 + c); sc += wsm[D1 + c] * kv.x + wsm[D1 + c + 1] * kv.y + wsm[D1 + c + 2] * kv.z + wsm[D1 + c + 3] * kv.w; }
  sc = valid ? sc : -1e30f;
  const float tmax = wave_max(sc), mn = fmaxf(m, tmax), alpha = expf(m - mn), pj = valid ? expf(sc - mn) : 0.f;
  l = l * alpha + wave_sum(pj); o0 *= alpha; o1 *= alpha;
  const unsigned long long pa = (unsigned long long)(uintptr_t)v;
  const int plo = (int)(unsigned)(pa & 0xffffffffull), phi = (int)(unsigned)(pa >> 32);
#pragma unroll 2
  for (int j = 0; j < 64; ++j) {
    const float pjj = __shfl(pj, j);
    const unsigned lo = (unsigned)__shfl(plo, j), hi = (unsigned)__shfl(phi, j);
    const float* vj = (const float*)(uintptr_t)(((unsigned long long)hi << 32) | lo);
    o0 += pjj * vj[lane];
    if (DV > 64) o1 += pjj * vj[64 + lane];
  }
  m = mn;
}

__device__ __forceinline__ void prompt_attn_wave(const Params& p, int bh, int qb, int lane, float* wsm) {
  const int b = bh >> 3, h = bh & 7;
  const float* Q = p.ws + W_Q; const float* KN = p.ws + W_KN; const float* V = p.ws + W_V; const float* KPE = p.out + O_KPEP;
  for (int qi = 0; qi < 64; ++qi) {
    const int s = qb * 64 + qi, row = b * SEQ + s;
    wsm[lane] = Q[(size_t)row * 768 + h * 96 + lane] * MLA_SCALE;
    if (lane < 32) wsm[64 + lane] = Q[(size_t)row * 768 + h * 96 + 64 + lane] * MLA_SCALE;
    float m = -1e30f, l = 0.f, o0 = 0.f, o1 = 0.f;
    for (int tile = 0; tile <= qb; ++tile) {
      const int j = tile * 64 + lane;
      const size_t krow = (size_t)b * SEQ + j;
      attn_row_tile<64, 32, 64>(wsm, KN + krow * 512 + h * 64, KPE + krow * 32, V + krow * 512 + h * 64, j <= s, lane, m, l, o0, o1);
    }
    const float g = p.ws[W_PROJ + (size_t)row * INC + C_GMLA + h * 64 + lane];
    p.ws[W_MIX + (size_t)row * 1024 + h * 64 + lane] = o0 / l * silu(g);
  }
}

__device__ __forceinline__ void sample_attn_wave(const Params& p, int rowid  , int lane, float* wsm) {
  const int h = rowid & 7, t = (rowid >> 3) & 7, db = rowid >> 6;
  const int srow = db * 8 + t, row = NP + srow;
  const float* QLAT = p.ws + W_QLAT; const float* Q = p.ws + W_Q;
  wsm[lane] = QLAT[(size_t)srow * 1024 + h * 128 + lane] * MLA_SCALE;
  wsm[64 + lane] = QLAT[(size_t)srow * 1024 + h * 128 + 64 + lane] * MLA_SCALE;
  if (lane < 32) wsm[128 + lane] = Q[(size_t)row * 768 + h * 96 + 64 + lane] * MLA_SCALE;
  float m = -1e30f, l = 0.f, o0 = 0.f, o1 = 0.f;
  for (int tile = 0; tile <= 128; ++tile) {
    const float* ckv; const float* kpe; bool valid;
    if (tile < 128) {
      const int k = tile * 64 + lane;
      const int page = p.page_table[db * NPG + (k >> 7)];
      const size_t base = (size_t)page * PAGE + (k & 127);
      ckv = p.cache_ckv + base * 128; kpe = p.cache_kpe + base * 32; valid = true;
    } else {
      const int u = lane < 8 ? lane : 0;
      valid = (lane < 8) && (lane <= t);
      ckv = p.out + O_CKVS + (size_t)(db * 8 + u) * 128; kpe = p.out + O_KPES + (size_t)(db * 8 + u) * 32;
    }
    attn_row_tile<128, 32, 128>(wsm, ckv, kpe, ckv, valid, lane, m, l, o0, o1);
  }
  float* OLAT = p.ws + W_OLAT;
  OLAT[(size_t)srow * 1024 + h * 128 + lane] = o0 / l;
  OLAT[(size_t)srow * 1024 + h * 128 + 64 + lane] = o1 / l;
}

__device__ __forceinline__ void mem_attn_wave(const Params& p, int item, int lane, float* wsm) {
  const int h = item / (NT / 16), r0 = (item - h * (NT / 16)) * 16;
  for (int ri = 0; ri < 16; ++ri) {
    const int row = r0 + ri;
    const float* kbase; const float* vbase;
    if (row < NP) { const int b = row / SEQ; kbase = p.out + O_MKP + (size_t)b * 256 * 256 + h * 64; vbase = p.out + O_MVP + (size_t)b * 256 * 256 + h * 64; }
    else { const int db = (row - NP) >> 3; kbase = p.cache_mem_k + (size_t)db * 256 * 256 + h * 64; vbase = p.cache_mem_v + (size_t)db * 256 * 256 + h * 64; }
    wsm[lane] = p.ws[W_PROJ + (size_t)row * INC + C_QX + h * 64 + lane] * X_SCALE;
    float m = -1e30f, l = 0.f, o0 = 0.f, o1 = 0.f;
    for (int tile = 0; tile < 4; ++tile) {
      const int j = tile * 64 + lane;
      attn_row_tile<64, 0, 64>(wsm, kbase + (size_t)j * 256, nullptr, vbase + (size_t)j * 256, true, lane, m, l, o0, o1);
    }
    const float g = p.ws[W_PROJ + (size_t)row * INC + C_GX + h * 64 + lane];
    p.ws[W_MIX + (size_t)row * 1024 + 768 + h * 64 + lane] = o0 / l * silu(g);
  }
}

#define CBAR() asm volatile("" ::: "memory")
__device__ __forceinline__ void rwkv_scan_wave(const Params& p, bool prompt, int bi, int h, int lane, float* wsm  ) {
  float S[64];
  const float* s0 = p.state_wkv + ((size_t)(bi * 4 + h) * 64 + lane) * 64;
#pragma unroll
  for (int k = 0; k < 64; ++k) S[k] = prompt ? 0.f : s0[k];
  const int T = prompt ? SEQ : DT, row0 = prompt ? bi * SEQ : NP + bi * DT;
  const float lg = p.lnx_g[h * 64 + lane], lb = p.lnx_b[h * 64 + lane], rk = p.r_k[h * 64 + lane];
#pragma unroll 1
  for (int t = 0; t < T; ++t) {
    const int row = row0 + t;
    const size_t off = (size_t)row * 256 + h * 64 + lane;
    const float r_l = p.ws[W_R + off], w_l = p.ws[W_W + off], kf_l = p.ws[W_KF + off], kk_l = p.ws[W_KK + off], bb_l = p.ws[W_BB + off];
    const float vv = p.ws[W_VV + off];
    wsm[lane] = kk_l; wsm[64 + lane] = w_l; wsm[128 + lane] = bb_l; wsm[192 + lane] = kf_l; wsm[256 + lane] = r_l;
    CBAR();
    float sa = 0.f;
#pragma unroll
    for (int c = 0; c < 4; ++c) {
#pragma unroll
      for (int k = 16 * c; k < 16 * c + 16; ++k) sa += S[k] * wsm[k];
      CBAR();
    }
    sa = -sa;
    float y = 0.f;
#pragma unroll
    for (int c = 0; c < 8; ++c) {
#pragma unroll
      for (int k = 8 * c; k < 8 * c + 8; ++k) { S[k] = S[k] * wsm[64 + k] + sa * wsm[128 + k] + vv * wsm[192 + k]; y += S[k] * wsm[256 + k]; }
      CBAR();
    }
    const float mean = wave_sum(y) * (1.f / 64.f), d = y - mean, var = wave_sum(d * d) * (1.f / 64.f);
    const float yn = d * rsqrtf(var + GN_EPS) * lg + lb;
    const float bsum = wave_sum(r_l * kf_l * rk);
    const float o = yn + bsum * vv;
    const float g = p.ws[W_PROJ + (size_t)row * INC + C_GRWKV + h * 64 + lane];
    p.ws[W_MIX + (size_t)row * 1024 + 512 + h * 64 + lane] = o * silu(g);
    CBAR();
  }
  float* so = prompt ? p.out + O_WKVP + ((size_t)(bi * 4 + h) * 64 + lane) * 64 : p.out + O_WKVS + ((size_t)(bi * 4 + h) * 64 + lane) * 64;
#pragma unroll
  for (int k = 0; k < 64; ++k) so[k] = S[k];
}


typedef unsigned short bf16;
#define LAS __attribute__((address_space(3)))
namespace pa {
typedef short bf16x8 __attribute__((ext_vector_type(8)));
typedef short s16x4 __attribute__((ext_vector_type(4)));
typedef float f32x16 __attribute__((ext_vector_type(16)));
typedef unsigned u32x4 __attribute__((ext_vector_type(4)));
typedef unsigned u32x2 __attribute__((ext_vector_type(2)));
typedef float f32x2_t __attribute__((ext_vector_type(2)));
typedef __bf16 bf16x2_t __attribute__((ext_vector_type(2)));
constexpr int KSTR = 208, VSTR = 136, KBYTES = 64 * KSTR, VBYTES = 64 * VSTR, STG = KBYTES + VBYTES;
__device__ __forceinline__ unsigned cvtpk(float lo, float hi) { f32x2_t v = {lo, hi}; bf16x2_t b = __builtin_convertvector(v, bf16x2_t); return __builtin_bit_cast(unsigned, b); }
__device__ __forceinline__ int crow(int r, int hi) { return (r & 3) + 8 * (r >> 2) + 4 * hi; }
__device__ __forceinline__ float swap_max(float v) { auto rr = __builtin_amdgcn_permlane32_swap(__float_as_uint(v), __float_as_uint(v), false, false); return fmaxf(__uint_as_float(rr[0]), __uint_as_float(rr[1])); }
__device__ __forceinline__ float swap_sum(float v) { auto rr = __builtin_amdgcn_permlane32_swap(__float_as_uint(v), __float_as_uint(v), false, false); return __uint_as_float(rr[0]) + __uint_as_float(rr[1]); }

template <int DQK, bool CAUSAL, class Out>
__device__ __forceinline__ void attn_unit(unsigned char* lds, const bf16* Qb, int qs, const bf16* Kb, int ks, const bf16* Vb, int vs, int ntiles, int qpos0, const Out& out) {
  const int tid = threadIdx.x, lane = tid & 63, wid = __builtin_amdgcn_readfirstlane(tid >> 6), r32 = lane & 31, hi = lane >> 5;
  constexpr int CPR = DQK / 8, NKC = 64 * CPR, KS = DQK / 16;
  bf16x8 qf[KS];
#pragma unroll
  for (int s = 0; s < KS; ++s) qf[s] = *(const bf16x8*)(Qb + (size_t)(wid * 32 + r32) * qs + 16 * s + 8 * hi);
  u32x4 kreg0, kreg1, vreg;
  const int kc0 = tid, kc1 = tid + 512;
  const int krow0 = kc0 / CPR, kcc0 = kc0 % CPR, krow1 = kc1 / CPR, kcc1 = kc1 % CPR;
  const int vdv = tid >> 3, vcc = tid & 7;
#define PA_GLOAD(t) do { kreg0 = *(const u32x4*)(Kb + (size_t)(64 * (t) + krow0) * ks + kcc0 * 8); \
    if (kc1 < NKC) kreg1 = *(const u32x4*)(Kb + (size_t)(64 * (t) + krow1) * ks + kcc1 * 8); \
    vreg = *(const u32x4*)(Vb + (size_t)vdv * vs + 64 * (t) + vcc * 8); } while (0)
#define PA_LSTORE(buf) do { unsigned char* b_ = lds + (buf) * STG; *(u32x4*)(b_ + krow0 * KSTR + kcc0 * 16) = kreg0; \
    if (kc1 < NKC) *(u32x4*)(b_ + krow1 * KSTR + kcc1 * 16) = kreg1; \
    *(u32x2*)(b_ + KBYTES + vdv * VSTR + vcc * 16) = (u32x2){vreg.x, vreg.y}; *(u32x2*)(b_ + KBYTES + vdv * VSTR + vcc * 16 + 8) = (u32x2){vreg.z, vreg.w}; } while (0)
  PA_GLOAD(0); PA_LSTORE(0); __syncthreads();
  f32x16 o0, o1;
#pragma unroll
  for (int r = 0; r < 16; ++r) { o0[r] = 0.f; o1[r] = 0.f; }
  float m = -1e30f, l = 0.f;
  const int qlo = qpos0 + 32 * wid;
  for (int t = 0; t < ntiles; ++t) {
    if (t + 1 < ntiles) PA_GLOAD(t + 1);
    const unsigned char* kb = lds + (t & 1) * STG; const unsigned char* vb = kb + KBYTES;
    const bool active = !CAUSAL || (64 * t <= qlo + 31);
    if (active) {
      f32x16 p0, p1;
#pragma unroll
      for (int r = 0; r < 16; ++r) { p0[r] = 0.f; p1[r] = 0.f; }
#pragma unroll
      for (int s = 0; s < KS; ++s) {
        const bf16x8 a0 = *(const bf16x8*)(kb + r32 * KSTR + (16 * s + 8 * hi) * 2);
        const bf16x8 a1 = *(const bf16x8*)(kb + (32 + r32) * KSTR + (16 * s + 8 * hi) * 2);
        p0 = __builtin_amdgcn_mfma_f32_32x32x16_bf16(a0, qf[s], p0, 0, 0, 0);
        p1 = __builtin_amdgcn_mfma_f32_32x32x16_bf16(a1, qf[s], p1, 0, 0, 0);
      }
      if (CAUSAL && (64 * t + 63 > qlo)) {
        const int q = qlo + r32;
#pragma unroll
        for (int r = 0; r < 16; ++r) { const int key = 64 * t + crow(r, hi); if (key > q) p0[r] = -1e30f; if (key + 32 > q) p1[r] = -1e30f; }
      }
      float mx = fmaxf(p0[0], p1[0]);
#pragma unroll
      for (int r = 1; r < 16; ++r) mx = fmaxf(mx, fmaxf(p0[r], p1[r]));
      mx = swap_max(mx);
      const float mn = fmaxf(m, mx), alpha = __builtin_amdgcn_exp2f(m - mn);
      m = mn;
      float ps = 0.f;
#pragma unroll
      for (int r = 0; r < 16; ++r) { p0[r] = __builtin_amdgcn_exp2f(p0[r] - mn); p1[r] = __builtin_amdgcn_exp2f(p1[r] - mn); ps += p0[r] + p1[r]; }
      l = l * alpha + ps;
#pragma unroll
      for (int r = 0; r < 16; ++r) { o0[r] *= alpha; o1[r] *= alpha; }
      bf16x8 pb[4];
#pragma unroll
      for (int k = 0; k < 4; ++k) {
        u32x4 w;
        if (k < 2) { w.x = cvtpk(p0[8 * k], p0[8 * k + 1]); w.y = cvtpk(p0[8 * k + 2], p0[8 * k + 3]); w.z = cvtpk(p0[8 * k + 4], p0[8 * k + 5]); w.w = cvtpk(p0[8 * k + 6], p0[8 * k + 7]); }
        else { const int kk = k - 2; w.x = cvtpk(p1[8 * kk], p1[8 * kk + 1]); w.y = cvtpk(p1[8 * kk + 2], p1[8 * kk + 3]); w.z = cvtpk(p1[8 * kk + 4], p1[8 * kk + 5]); w.w = cvtpk(p1[8 * kk + 6], p1[8 * kk + 7]); }
        pb[k] = __builtin_bit_cast(bf16x8, w);
      }
#pragma unroll
      for (int k = 0; k < 4; ++k) {
#pragma unroll
        for (int d = 0; d < 2; ++d) {
          const unsigned char* vp = vb + (32 * d + r32) * VSTR + (16 * k + 4 * hi) * 2;
          const u32x2 lo = *(const u32x2*)vp, hi2 = *(const u32x2*)(vp + 16);
          const u32x4 w = {lo.x, lo.y, hi2.x, hi2.y};
          const bf16x8 va = __builtin_bit_cast(bf16x8, w);
          if (d == 0) o0 = __builtin_amdgcn_mfma_f32_32x32x16_bf16(va, pb[k], o0, 0, 0, 0);
          else o1 = __builtin_amdgcn_mfma_f32_32x32x16_bf16(va, pb[k], o1, 0, 0, 0);
        }
      }
    }
    if (t + 1 < ntiles) PA_LSTORE((t + 1) & 1);
    __syncthreads();
  }
#undef PA_GLOAD
#undef PA_LSTORE
  const float inv = 1.f / swap_sum(l);
#pragma unroll
  for (int g = 0; g < 4; ++g) {
    out(32 * wid + r32, 8 * g + 4 * hi, make_float4(o0[4 * g] * inv, o0[4 * g + 1] * inv, o0[4 * g + 2] * inv, o0[4 * g + 3] * inv));
    out(32 * wid + r32, 32 + 8 * g + 4 * hi, make_float4(o1[4 * g] * inv, o1[4 * g + 1] * inv, o1[4 * g + 2] * inv, o1[4 * g + 3] * inv));
  }
}
}

namespace sa {
using pa::bf16x8; using pa::f32x16; using pa::u32x4; using pa::u32x2; using pa::cvtpk; using pa::crow; using pa::swap_max; using pa::swap_sum;
typedef float f32x4 __attribute__((ext_vector_type(4)));
typedef short v4i16_t __attribute__((ext_vector_type(4)));
constexpr int KVSTR = 336, TILE = 64 * KVSTR;
__device__ __forceinline__ void sample_attn_item(unsigned char* lds, const Params& p, const bf16* Qs, float* PO, float* PML, int item) {
  const int db = item >> 1, half = item & 1;
  const int tid = threadIdx.x, lane = tid & 63, wid = __builtin_amdgcn_readfirstlane(tid >> 6), r32 = lane & 31, hi = lane >> 5;
  const int qt = wid >> 2, ct = wid & 3;
  bf16x8 qf[10];
#pragma unroll
  for (int s = 0; s < 10; ++s) qf[s] = *(const bf16x8*)(Qs + (size_t)(db * 64 + 32 * qt + r32) * 160 + 16 * s + 8 * hi);
  const int ntiles = 64 + half;
  f32x4 st0, st1, st2, st3, sp;
  const f32x4 zero4 = {0.f, 0.f, 0.f, 0.f};
#define SA_GLOAD(t) do { if ((t) < 64) { const int key0_ = 4096 * half + 64 * (t); const int page_ = p.page_table[db * NPG + (key0_ >> 7)]; \
      const size_t base_ = (size_t)page_ * PAGE + (key0_ & 127); const float* ck_ = p.cache_ckv + base_ * 128; const float* kp_ = p.cache_kpe + base_ * 32; \
      st0 = *(const f32x4*)(ck_ + (size_t)(tid) * 4); st1 = *(const f32x4*)(ck_ + (size_t)(tid + 512) * 4); st2 = *(const f32x4*)(ck_ + (size_t)(tid + 1024) * 4); st3 = *(const f32x4*)(ck_ + (size_t)(tid + 1536) * 4); \
      sp = *(const f32x4*)(kp_ + (size_t)tid * 4); \
    } else { const float* ck_ = p.out + O_CKVS + (size_t)db * 8 * 128; const float* kp_ = p.out + O_KPES + (size_t)db * 8 * 32; \
      st0 = (tid < 256) ? *(const f32x4*)(ck_ + (size_t)tid * 4) : zero4; st1 = zero4; st2 = zero4; st3 = zero4; \
      sp = (tid < 64) ? *(const f32x4*)(kp_ + (size_t)tid * 4) : zero4; } } while (0)
#define SA_ST1(buf, f_, v_) do { const int key_ = (f_) >> 5, c4_ = (f_) & 31; *(u32x2*)(lds + (buf) * TILE + key_ * KVSTR + c4_ * 8) = (u32x2){cvtpk((v_).x, (v_).y), cvtpk((v_).z, (v_).w)}; } while (0)
#define SA_LSTORE(buf) do { SA_ST1(buf, tid, st0); SA_ST1(buf, tid + 512, st1); SA_ST1(buf, tid + 1024, st2); SA_ST1(buf, tid + 1536, st3); \
    { const int key_ = tid >> 3, c4_ = tid & 7; *(u32x2*)(lds + (buf) * TILE + key_ * KVSTR + 256 + c4_ * 8) = (u32x2){cvtpk(sp.x, sp.y), cvtpk(sp.z, sp.w)}; } } while (0)
  SA_GLOAD(0); SA_LSTORE(0); __syncthreads();
  f32x16 o;
#pragma unroll
  for (int r = 0; r < 16; ++r) o[r] = 0.f;
  float m = -1e30f, l = 0.f;
  const int tq = (32 * qt + r32) >> 3;
  for (int t = 0; t < ntiles; ++t) {
    if (t + 1 < ntiles) SA_GLOAD(t + 1);
    const unsigned char* kb = lds + (t & 1) * TILE;
    f32x16 p0, p1;
#pragma unroll
    for (int r = 0; r < 16; ++r) { p0[r] = 0.f; p1[r] = 0.f; }
#pragma unroll
    for (int s = 0; s < 10; ++s) {
      const bf16x8 a0 = *(const bf16x8*)(kb + r32 * KVSTR + (16 * s + 8 * hi) * 2);
      const bf16x8 a1 = *(const bf16x8*)(kb + (32 + r32) * KVSTR + (16 * s + 8 * hi) * 2);
      p0 = __builtin_amdgcn_mfma_f32_32x32x16_bf16(a0, qf[s], p0, 0, 0, 0);
      p1 = __builtin_amdgcn_mfma_f32_32x32x16_bf16(a1, qf[s], p1, 0, 0, 0);
    }
    if (t == 64) {
#pragma unroll
      for (int r = 0; r < 16; ++r) { const int u = crow(r, hi); if (!(u < 8 && u <= tq)) p0[r] = -1e30f; p1[r] = -1e30f; }
    }
    float mx = fmaxf(p0[0], p1[0]);
#pragma unroll
    for (int r = 1; r < 16; ++r) mx = fmaxf(mx, fmaxf(p0[r], p1[r]));
    mx = swap_max(mx);
    const float mn = fmaxf(m, mx), alpha = __builtin_amdgcn_exp2f(m - mn);
    m = mn;
    float ps = 0.f;
#pragma unroll
    for (int r = 0; r < 16; ++r) { p0[r] = __builtin_amdgcn_exp2f(p0[r] - mn); p1[r] = __builtin_amdgcn_exp2f(p1[r] - mn); ps += p0[r] + p1[r]; }
    l = l * alpha + ps;
#pragma unroll
    for (int r = 0; r < 16; ++r) o[r] *= alpha;
    bf16x8 pb[4];
#pragma unroll
    for (int k = 0; k < 4; ++k) {
      u32x4 w;
      if (k < 2) { w.x = cvtpk(p0[8 * k], p0[8 * k + 1]); w.y = cvtpk(p0[8 * k + 2], p0[8 * k + 3]); w.z = cvtpk(p0[8 * k + 4], p0[8 * k + 5]); w.w = cvtpk(p0[8 * k + 6], p0[8 * k + 7]); }
      else { const int kk = k - 2; w.x = cvtpk(p1[8 * kk], p1[8 * kk + 1]); w.y = cvtpk(p1[8 * kk + 2], p1[8 * kk + 3]); w.z = cvtpk(p1[8 * kk + 4], p1[8 * kk + 5]); w.w = cvtpk(p1[8 * kk + 6], p1[8 * kk + 7]); }
      pb[k] = __builtin_bit_cast(bf16x8, w);
    }
    {
      const int g = lane >> 4, i = lane & 15;
      const LAS unsigned char* vbase = (const LAS unsigned char*)kb + (4 * (g >> 1) + (i >> 2)) * KVSTR + (32 * ct + 16 * (g & 1) + 4 * (i & 3)) * 2;
#pragma unroll
      for (int k = 0; k < 4; ++k) {
        const v4i16_t lo = __builtin_amdgcn_ds_read_tr16_b64_v4i16((LAS v4i16_t*)(vbase + (16 * k) * KVSTR));
        const v4i16_t hi4 = __builtin_amdgcn_ds_read_tr16_b64_v4i16((LAS v4i16_t*)(vbase + (16 * k + 8) * KVSTR));
        const bf16x8 va = {lo[0], lo[1], lo[2], lo[3], hi4[0], hi4[1], hi4[2], hi4[3]};
        o = __builtin_amdgcn_mfma_f32_32x32x16_bf16(va, pb[k], o, 0, 0, 0);
      }
    }
    if (t + 1 < ntiles) SA_LSTORE((t + 1) & 1);
    __syncthreads();
  }
#undef SA_GLOAD
#undef SA_ST1
#undef SA_LSTORE
  const float lt = swap_sum(l);
  const int q = 32 * qt + r32;
  if (ct == 0 && hi == 0) { PML[((size_t)item * 64 + q) * 2] = m; PML[((size_t)item * 64 + q) * 2 + 1] = lt; }
#pragma unroll
  for (int g4 = 0; g4 < 4; ++g4) {
    const int c0 = 32 * ct + 8 * g4 + 4 * hi;
    *(f32x4*)(PO + ((size_t)item * 64 + q) * 128 + c0) = (f32x4){o[4 * g4], o[4 * g4 + 1], o[4 * g4 + 2], o[4 * g4 + 3]};
  }
}
}

namespace rw {
typedef float f32x4 __attribute__((ext_vector_type(4)));
constexpr int CH = 32, STEPF = 384, CHF = CH * STEPF;
__device__ __forceinline__ float dpp_sum16(float v) {
  v += __int_as_float(__builtin_amdgcn_update_dpp(0, __float_as_int(v), 0xB1, 0xF, 0xF, true));
  v += __int_as_float(__builtin_amdgcn_update_dpp(0, __float_as_int(v), 0x4E, 0xF, 0xF, true));
  v += __int_as_float(__builtin_amdgcn_update_dpp(0, __float_as_int(v), 0x141, 0xF, 0xF, true));
  v += __int_as_float(__builtin_amdgcn_update_dpp(0, __float_as_int(v), 0x140, 0xF, 0xF, true));
  return v;
}
__device__ __forceinline__ void rwkv_prompt_item(unsigned char* lds, const Params& p, int item) {
  const int bh = item >> 1, half = item & 1, b = bh >> 2, h = bh & 3;
  const int tid = threadIdx.x, sub = tid & 15, vl = tid >> 4, v = 32 * half + vl;
  float* L = (float*)lds; float* yb = L + 2 * CHF;
  const float* ws = p.ws;
  const size_t rowbase = (size_t)b * SEQ;
  const int ls = tid >> 4, lk4 = tid & 15;
  f32x4 g0, g1, g2, g3, g4, g5;
#define RW_GLOAD(c) do { const size_t off_ = (rowbase + (size_t)(c) * CH + ls) * 256 + h * 64 + lk4 * 4; \
    g0 = *(const f32x4*)(ws + W_KK + off_); g1 = *(const f32x4*)(ws + W_W + off_); g2 = *(const f32x4*)(ws + W_BB + off_); \
    g3 = *(const f32x4*)(ws + W_KF + off_); g4 = *(const f32x4*)(ws + W_R + off_); g5 = *(const f32x4*)(ws + W_VV + off_); } while (0)
#define RW_LSTORE(buf) do { float* b_ = L + (buf) * CHF + ls * STEPF + lk4 * 4; *(f32x4*)(b_) = g0; *(f32x4*)(b_ + 64) = g1; *(f32x4*)(b_ + 128) = g2; \
    *(f32x4*)(b_ + 192) = g3; *(f32x4*)(b_ + 256) = g4; *(f32x4*)(b_ + 320) = g5; } while (0)
  float S0 = 0.f, S1 = 0.f, S2 = 0.f, S3 = 0.f;
  RW_GLOAD(0); RW_LSTORE(0); __syncthreads();
  constexpr int NCH = SEQ / CH;
  for (int c = 0; c < NCH; ++c) {
    if (c + 1 < NCH) RW_GLOAD(c + 1);
    const float* cb = L + (c & 1) * CHF;
    float* ybc = yb + (c & 1) * (CH * 32);
#pragma unroll 4
    for (int s = 0; s < CH; ++s) {
      const float* sb = cb + s * STEPF;
      const f32x4 kk = *(const f32x4*)(sb + 4 * sub), w = *(const f32x4*)(sb + 64 + 4 * sub), bb = *(const f32x4*)(sb + 128 + 4 * sub);
      const f32x4 kf = *(const f32x4*)(sb + 192 + 4 * sub), r = *(const f32x4*)(sb + 256 + 4 * sub);
      const float vv = sb[320 + v];
      float dot = (S0 * kk.x + S1 * kk.y) + (S2 * kk.z + S3 * kk.w);
      dot = dpp_sum16(dot);
      const float sa = -dot;
      S0 = S0 * w.x + (sa * bb.x + vv * kf.x); S1 = S1 * w.y + (sa * bb.y + vv * kf.y);
      S2 = S2 * w.z + (sa * bb.z + vv * kf.z); S3 = S3 * w.w + (sa * bb.w + vv * kf.w);
      float y = (S0 * r.x + S1 * r.y) + (S2 * r.z + S3 * r.w);
      y = dpp_sum16(y);
      if (sub == 0) ybc[s * 32 + vl] = y;
    }
    if (c + 1 < NCH) RW_LSTORE((c + 1) & 1);
    __syncthreads();
#pragma unroll
    for (int i = 0; i < 2; ++i) { const int f = tid + 512 * i, s = f >> 5, vv_ = f & 31;
      p.ws[W_Y + (rowbase + (size_t)c * CH + s) * 256 + h * 64 + 32 * half + vv_] = ybc[s * 32 + vv_]; }
  }
#undef RW_GLOAD
#undef RW_LSTORE
  *(f32x4*)(p.out + O_WKVP + ((size_t)(b * 4 + h) * 64 + v) * 64 + 4 * sub) = (f32x4){S0, S1, S2, S3};
  __syncthreads();
}
}

typedef unsigned v4u __attribute__((ext_vector_type(4)));
__device__ __forceinline__ unsigned f2bf(float f) { unsigned u = __builtin_bit_cast(unsigned, f); return (u + 0x7fffu + ((u >> 16) & 1u)) >> 16; }
__device__ __forceinline__ unsigned pk2(float lo, float hi) { return f2bf(lo) | (f2bf(hi) << 16); }
__device__ __forceinline__ void p0_transpose_item(const float* W, int K, int N, bf16* WT, int row_off, LAS float* scr, int item, int lane) {
  const int nblk = N / 32, kb = item / nblk, nb = item % nblk, k0 = 64 * kb, n0 = 32 * nb;
#pragma unroll 8
  for (int i = 0; i < 32; ++i) { const int kk = 2 * i + (lane >> 5); scr[kk * 33 + (lane & 31)] = W[(size_t)(k0 + kk) * N + n0 + (lane & 31)]; }
  asm volatile("s_waitcnt lgkmcnt(0)" ::: "memory");
  const int c = lane & 7;
#pragma unroll
  for (int j = 0; j < 4; ++j) { const int n = (lane >> 3) + 8 * j; const LAS float* s = scr + (8 * c) * 33 + n;
    v4u o; o.x = pk2(s[0 * 33], s[1 * 33]); o.y = pk2(s[2 * 33], s[3 * 33]); o.z = pk2(s[4 * 33], s[5 * 33]); o.w = pk2(s[6 * 33], s[7 * 33]);
    *(v4u*)(WT + (size_t)(row_off + n0 + n) * K + k0 + 8 * c) = o; }
  asm volatile("s_waitcnt lgkmcnt(0)" ::: "memory");
}

__global__ void __launch_bounds__(512) fwd_megakernel(Params p) {
  cg::grid_group grid = cg::this_grid();
  extern __shared__ __attribute__((aligned(16))) unsigned char lds[];
  float* sm = (float*)lds;
  bf16* wb = (bf16*)(p.ws + W_END);
  const int tid = threadIdx.x, lane = tid & 63, wv = tid >> 6;
  const int gw = blockIdx.x * 8 + wv, NGW = gridDim.x * 8;
  const int gtid = blockIdx.x * 512 + tid, NTH = gridDim.x * 512;
  float* ws = p.ws;

  {
    LAS float* scr = (LAS float*)((LAS unsigned char*)lds + wv * 16384);
    constexpr int I_IN = 16 * (INC / 32), I_MEM = 16 * (512 / 32), I_OUT = 16 * (1024 / 32);
    for (int it = gw; it < I_IN + I_MEM + I_OUT; it += NGW) {
      int r = it;
      if (r < I_IN) { p0_transpose_item(p.w_in, 1024, INC, wb + B_WIN, 0, scr, r, lane); continue; } r -= I_IN;
      if (r < I_MEM) { p0_transpose_item(p.w_mem_kv, 1024, 512, wb + B_WMEM, 0, scr, r, lane); continue; } r -= I_MEM;
      p0_transpose_item(p.w_out, 1024, 1024, wb + B_WOUT, 0, scr, r, lane);
    }
    if (gtid < 64) ((unsigned*)(p.ws + W_CTL))[gtid] = 0u;
    for (int i = gtid; i < (INCP - INC) * 1024 / 8; i += NTH) ((v4u*)(wb + B_WIN + (size_t)INC * 1024))[i] = (v4u){0u, 0u, 0u, 0u};
  }
  for (int r = gw; r < NT + 1024; r += NGW) {
    const float* src; const float* g; bf16* dst;
    if (r < NT) { src = xrow(p, r); g = p.ln_g; dst = wb + B_H + (size_t)r * 1024; }
    else { src = p.mem_prompt + (size_t)(r - NT) * 1024; g = p.mem_norm_g; dst = wb + B_HM + (size_t)(r - NT) * 1024; }
    float4 v[4]; float ss = 0.f;
#pragma unroll
    for (int i = 0; i < 4; ++i) { v[i] = *(const float4*)(src + 4 * lane + 256 * i); ss += v[i].x * v[i].x + v[i].y * v[i].y + v[i].z * v[i].z + v[i].w * v[i].w; }
    const float rs = rsqrtf(wave_sum(ss) * (1.f / 1024.f) + RMS_EPS);
#pragma unroll
    for (int i = 0; i < 4; ++i) {
      const float4 gg = *(const float4*)(g + 4 * lane + 256 * i);
      uint2 o; o.x = pk2(v[i].x * rs * gg.x, v[i].y * rs * gg.y); o.y = pk2(v[i].z * rs * gg.z, v[i].w * rs * gg.w);
      *(uint2*)(dst + 4 * lane + 256 * i) = o;
    }
  }
  grid.sync();

  {
    pg8::Gemm g{wb + B_H, wb + B_WIN, NT, INCP, 1024}; pg8::StaticOrder S; S.init(NT, INCP, (int)gridDim.x, (int)blockIdx.x);
    pg8::EpiF32 E{ws + W_PROJ, INC, INC, 0, 0, nullptr, nullptr, 0};
    pg8::gemm_phase<pg8::EpiF32, pg8::StaticOrder, true, true>((PG8_LAS unsigned char*)lds, g, S, E);
  }
  {
    pg8::Gemm g{wb + B_HM, wb + B_WMEM, 1024, 512, 1024}; pg8::StaticOrder S; S.init(1024, 512, (int)gridDim.x, (int)((blockIdx.x + 20) % gridDim.x));
    pg8::EpiF32 E{p.out + O_MKP, 256, 256, 256, O_MVP - O_MKP, nullptr, nullptr, 0};
    pg8::gemm_phase<pg8::EpiF32, pg8::StaticOrder, true, true>((PG8_LAS unsigned char*)lds, g, S, E);
  }
  grid.sync();

  {
    float* tds = sm + wv * 128;
    for (int row = gw; row < NT; row += NGW) {
      const float* pr = ws + W_PROJ + (size_t)row * INC;
      {
        float v[4]; float ss = 0.f;
#pragma unroll
        for (int i = 0; i < 4; ++i) { v[i] = pr[C_CQ + lane + 64 * i]; ss += v[i] * v[i]; }
        const float rs = rsqrtf(wave_sum(ss) * (1.f / 256.f) + RMS_EPS);
#pragma unroll
        for (int i = 0; i < 4; ++i) ws[W_CQN + (size_t)row * 256 + lane + 64 * i] = v[i] * rs * p.q_norm_g[lane + 64 * i];
      }
      {
        const float v0 = pr[C_CKV + lane], v1 = pr[C_CKV + 64 + lane];
        const float rs = rsqrtf(wave_sum(v0 * v0 + v1 * v1) * (1.f / 128.f) + RMS_EPS);
        float* o = ckv_out_row(p, row);
        o[lane] = v0 * rs * p.kv_norm_g[lane]; o[64 + lane] = v1 * rs * p.kv_norm_g[64 + lane];
      }
      const int pos = row < NP ? (row % SEQ) : PAST + ((row - NP) & 7);
      if (lane < 16) {
        const float inv = 1.0f / powf(10000.0f, (float)lane * (2.0f / 32.0f));
        const float ang = (float)pos * inv; const float c = cosf(ang), s = sinf(ang);
        const float x1 = pr[C_KR + lane], x2 = pr[C_KR + 16 + lane];
        float* o = kpe_out_row(p, row);
        o[lane] = x1 * c - x2 * s; o[16 + lane] = x2 * c + x1 * s;
      }
      if (row < NP) { if ((row % SEQ) == SEQ - 1) { const int b = row / SEQ; for (int i = lane; i < 896; i += 64) p.out[O_SHP + (size_t)b * 896 + i] = pr[C_Z + i]; } }
      else { if (((row - NP) & 7) == 7) { const int db = (row - NP) >> 3; for (int i = lane; i < 896; i += 64) p.out[O_SHS + (size_t)db * 896 + i] = pr[C_Z + i]; } }
      {
        const bool first = row < NP ? ((row % SEQ) == 0) : (((row - NP) & 7) == 0);
        const float* prev = first ? (row < NP ? nullptr : p.state_shift + (size_t)((row - NP) >> 3) * 896 - C_Z) : pr - INC;
        auto zmix = [&](int i) -> float { const float z = pr[C_Z + i]; const float pv = prev ? prev[C_Z + i] : 0.f; return z + (pv - z) * p.shift_mu[i]; };
        tds[lane] = tanhf(zmix(768 + lane)); tds[64 + lane] = zmix(832 + lane);
        __builtin_amdgcn_fence(__ATOMIC_RELEASE, "wavefront"); __builtin_amdgcn_wave_barrier();
#pragma unroll 1
        for (int hh = 0; hh < 4; ++hh) {
          const int c = hh * 64 + lane;
          float u = p.w0[c], au = p.a0[c];
#pragma unroll 4
          for (int j = 0; j < 64; ++j) { u += tds[j] * p.w_up[j * 256 + c]; au += tds[64 + j] * p.a_up[j * 256 + c]; }
          const float nu = -u;
          const float sp = fmaxf(nu, 0.f) + log1pf(expf(-fabsf(nu)));
          const float wl = -sp - 0.5f;
          const float decay = expf(-expf(wl));
          const float a = 1.f / (1.f + expf(-au));
          const float k = zmix(256 + c), r = zmix(c), v = zmix(512 + c);
          float kk = k * p.k_k[c];
          const float nrm = fmaxf(sqrtf(wave_sum(kk * kk)), 1e-12f);
          kk = kk / nrm;
          const float kf = k * (1.f + (a - 1.f) * p.k_a[c]);
          const size_t o = (size_t)row * 256 + c;
          ws[W_R + o] = r; ws[W_W + o] = decay; ws[W_KF + o] = kf; ws[W_VV + o] = v; ws[W_KK + o] = kk; ws[W_BB + o] = kk * a;
        }
        __builtin_amdgcn_fence(__ATOMIC_RELEASE, "wavefront"); __builtin_amdgcn_wave_barrier();
      }
    }
  }
  grid.sync();

  gemm_f32<false>(ws + W_CQN, 256, p.w_uq, 768, ws + W_Q, 768, NT, 768, 256, sm);
  gemm_f32<false>(p.out + O_CKVP, 128, p.w_uk, 512, ws + W_KN, 512, NP, 512, 128, sm);
  gemm_f32<false>(p.out + O_CKVP, 128, p.w_uv, 512, ws + W_V, 512, NP, 512, 128, sm);
  grid.sync();

  for (int i = gtid; i < NT * 8 * 16; i += NTH) {
    const int j = i & 15, h = (i >> 4) & 7, row = i >> 7;
    const int pos = row < NP ? (row % SEQ) : PAST + ((row - NP) & 7);
    const float inv = 1.0f / powf(10000.0f, (float)j * (2.0f / 32.0f));
    const float ang = (float)pos * inv; const float c = cosf(ang), s = sinf(ang);
    float* q = ws + W_Q + (size_t)row * 768 + h * 96 + 64;
    const float x1 = q[j], x2 = q[16 + j];
    q[j] = x1 * c - x2 * s; q[16 + j] = x2 * c + x1 * s;
  }
  for (int h = 0; h < 8; ++h)
    gemm_f32<true>(ws + W_Q + (size_t)NP * 768 + h * 96, 768, p.w_uk + h * 64, 512, ws + W_QLAT + h * 128, 1024, NS, 128, 64, sm);
  grid.sync();

  {
    const float QSC = MLA_SCALE * 1.4426950408889634f;
    for (size_t i = gtid; i < (size_t)NP * 768 / 4; i += NTH) {
      const float4 v = *(const float4*)(ws + W_Q + i * 4);
      *(uint2*)(wb + B_QP + i * 4) = make_uint2(pk2(v.x * QSC, v.y * QSC), pk2(v.z * QSC, v.w * QSC));
    }
    for (size_t i = gtid; i < (size_t)NP * 8 * 24; i += NTH) {
      const int g4 = (int)(i % 24), h = (int)((i / 24) & 7); const size_t row = i / 192;
      const float4 v = g4 < 16 ? *(const float4*)(ws + W_KN + row * 512 + h * 64 + g4 * 4) : *(const float4*)(p.out + O_KPEP + row * 32 + (g4 - 16) * 4);
      *(uint2*)(wb + B_KP + row * 768 + h * 96 + g4 * 4) = make_uint2(pk2(v.x, v.y), pk2(v.z, v.w));
    }
    for (size_t i = gtid; i < (size_t)NS * 8 * 40; i += NTH) {
      const int g4 = (int)(i % 40); const size_t rh = i / 40, srow = rh >> 3; const int h = (int)(rh & 7);
      const float4 v = g4 < 32 ? *(const float4*)(ws + W_QLAT + srow * 1024 + h * 128 + g4 * 4) : *(const float4*)(ws + W_Q + (NP + srow) * 768 + h * 96 + 64 + (g4 - 32) * 4);
      *(uint2*)(wb + B_QS + rh * 160 + g4 * 4) = make_uint2(pk2(v.x * QSC, v.y * QSC), pk2(v.z * QSC, v.w * QSC));
    }
    for (size_t i = gtid; i < (size_t)512 * NP; i += NTH) {
      const size_t c = i / NP, row = i % NP;
      wb[B_VT + i] = (bf16)f2bf(ws[W_V + row * 512 + c]);
    }
  }
  grid.sync();

  {
    unsigned* qctr = (unsigned*)(p.ws + W_CTL);
    volatile unsigned* qslot = (volatile unsigned*)(lds + LDS_BYTES - 16);
    constexpr int Q_RW = 32, Q_PA = 512, Q_SA = 256, Q_TOT = Q_RW + Q_PA + Q_SA;
    for (;;) {
      if (tid == 0) *qslot = atomicAdd(qctr, 1u);
      __syncthreads();
      int item = (int)*qslot;
      __syncthreads();
      item = __builtin_amdgcn_readfirstlane(item);
      if (item >= Q_TOT) break;
      if (item < Q_RW) { rw::rwkv_prompt_item(lds, p, item); continue; }
      item -= Q_RW;
      if (item < Q_PA) {
        const int bh = item & 31, qb = 15 - (item >> 5);
        const int b = bh >> 3, h = bh & 7;
        const size_t row0 = (size_t)b * SEQ + 256 * qb;
        auto out = [&](int ql, int dv0, float4 v) {
          const size_t row = row0 + ql;
          const float4 g = *(const float4*)(ws + W_PROJ + row * INC + C_GMLA + h * 64 + dv0);
          *(float4*)(ws + W_MIX + row * 1024 + h * 64 + dv0) = make_float4(v.x * silu(g.x), v.y * silu(g.y), v.z * silu(g.z), v.w * silu(g.w));
        };
        pa::attn_unit<96, true>(lds, wb + B_QP + row0 * 768 + h * 96, 768, wb + B_KP + (size_t)b * SEQ * 768 + h * 96, 768,
                                wb + B_VT + (size_t)(h * 64) * NP + (size_t)b * SEQ, NP, 4 * qb + 4, 256 * qb, out);
        continue;
      }
      item -= Q_PA;
      sa::sample_attn_item(lds, p, wb + B_QS, ws + W_PO, ws + W_PML, item);
    }
    __syncthreads();
  }
  {
    constexpr int N_RS = 512, N_MA = NT * 4 / 16;
    constexpr int TOT = N_RS + N_MA;
    float* wsm = sm + wv * 320;
    for (int it = gw; it < TOT; it += NGW) {
      int i = __builtin_amdgcn_readfirstlane(it);
      if (i < N_RS) { rwkv_scan_wave(p, false, i >> 2, i & 3, lane, wsm); continue; }
      i -= N_RS;
      mem_attn_wave(p, i, lane, wsm);
    }
  }
  grid.sync();

  for (int i = gtid; i < NS * 512; i += NTH) {
    const int c = i & 511, srow = i >> 9, h = c >> 6;
    const int db_ = srow >> 3, qi = (srow & 7) * 8 + h;
    const float* ml0 = ws + W_PML + ((size_t)(2 * db_) * 64 + qi) * 2; const float* ml1 = ml0 + 128;
    const float M_ = fmaxf(ml0[0], ml1[0]), w0_ = exp2f(ml0[0] - M_), w1_ = exp2f(ml1[0] - M_);
    const float invL = 1.f / (ml0[1] * w0_ + ml1[1] * w1_);
    const float* po0 = ws + W_PO + ((size_t)(2 * db_) * 64 + qi) * 128; const float* po1 = po0 + 64 * 128;
    float acc = 0.f;
#pragma unroll 4
    for (int k = 0; k < 128; ++k) acc += (po0[k] * w0_ + po1[k] * w1_) * p.w_uv[k * 512 + c];
    acc *= invL;
    const int row = NP + srow;
    const float g = ws[W_PROJ + (size_t)row * INC + C_GMLA + c];
    ws[W_MIX + (size_t)row * 1024 + c] = acc * silu(g);
  }
  for (int it = gw; it < NP * 4; it += NGW) {
    const int row = it >> 2, h = it & 3;
    const size_t off = (size_t)row * 256 + h * 64 + lane;
    const float y = ws[W_Y + off];
    const float mean = wave_sum(y) * (1.f / 64.f), d = y - mean, var = wave_sum(d * d) * (1.f / 64.f);
    const float yn = d * rsqrtf(var + GN_EPS) * p.lnx_g[h * 64 + lane] + p.lnx_b[h * 64 + lane];
    const float bsum = wave_sum(ws[W_R + off] * ws[W_KF + off] * p.r_k[h * 64 + lane]);
    const float o = yn + bsum * ws[W_VV + off];
    const float g = ws[W_PROJ + (size_t)row * INC + C_GRWKV + h * 64 + lane];
    ws[W_MIX + (size_t)row * 1024 + 512 + h * 64 + lane] = o * silu(g);
  }
  grid.sync();
  for (size_t i = gtid; i < (size_t)NT * 1024 / 4; i += NTH) {
    const float4 v = *(const float4*)(ws + W_MIX + i * 4);
    uint2 o; o.x = pk2(v.x, v.y); o.y = pk2(v.z, v.w);
    *(uint2*)(wb + B_MIX + i * 4) = o;
  }
  grid.sync();

  {
    pg8::Gemm g{wb + B_MIX, wb + B_WOUT, NT, 1024, 1024}; pg8::StaticOrder S; S.init(NT, 1024, (int)gridDim.x, (int)blockIdx.x);
    pg8::EpiF32 E{p.out, 1024, 1024, 0, 0, p.x_prompt, p.x_sample, NP};
    pg8::gemm_phase<pg8::EpiF32, pg8::StaticOrder, true, true>((PG8_LAS unsigned char*)lds, g, S, E);
  }
  grid.sync();

  for (int r = gw; r < NT; r += NGW) {
    float* y = p.out + (size_t)r * 1024;
    float v[16]; float ss = 0.f;
#pragma unroll
    for (int i = 0; i < 16; ++i) { v[i] = y[lane + 64 * i]; ss += v[i] * v[i]; }
    const float rs = rsqrtf(wave_sum(ss) * (1.f / 1024.f) + RMS_EPS);
#pragma unroll
    for (int i = 0; i < 16; ++i) y[lane + 64 * i] = v[i] * rs * p.final_g[lane + 64 * i];
  }
}

extern "C" void kernel_launch(void* const* d_in, const int* in_sizes, int n_in, void* d_out,
                              int out_size, void* d_ws, size_t ws_size, hipStream_t stream) {
  static int grid_blocks = 0;
  if (!grid_blocks) {
    int dev = 0, cus = 0, per_cu = 0;
    (void)hipGetDevice(&dev);
    (void)hipDeviceGetAttribute(&cus, hipDeviceAttributeMultiprocessorCount, dev);
    (void)hipFuncSetAttribute((const void*)fwd_megakernel, hipFuncAttributeMaxDynamicSharedMemorySize, LDS_BYTES);
    (void)hipOccupancyMaxActiveBlocksPerMultiprocessor(&per_cu, fwd_megakernel, 512, LDS_BYTES);
    if (per_cu < 1) per_cu = 1;
    grid_blocks = cus;
    if (ws_size < WS_BYTES) fprintf(stderr, "workspace too small: %zu < %zu\n", ws_size, (size_t)WS_BYTES);
  }
  Params p{};
  const float** pf = (const float**)&p;
  (void)pf;
  p.x_prompt = (const float*)d_in[0]; p.x_sample = (const float*)d_in[1]; p.mem_prompt = (const float*)d_in[2];
  p.cache_ckv = (const float*)d_in[3]; p.cache_kpe = (const float*)d_in[4]; p.page_table = (const int*)d_in[5];
  p.state_wkv = (const float*)d_in[6]; p.state_shift = (const float*)d_in[7]; p.cache_mem_k = (const float*)d_in[8];
  p.cache_mem_v = (const float*)d_in[9]; p.ln_g = (const float*)d_in[10]; p.w_in = (const float*)d_in[11];
  p.q_norm_g = (const float*)d_in[12]; p.kv_norm_g = (const float*)d_in[13]; p.w_uq = (const float*)d_in[14];
  p.w_uk = (const float*)d_in[15]; p.w_uv = (const float*)d_in[16]; p.shift_mu = (const float*)d_in[17];
  p.w0 = (const float*)d_in[18]; p.w_up = (const float*)d_in[19]; p.a0 = (const float*)d_in[20]; p.a_up = (const float*)d_in[21];
  p.k_k = (const float*)d_in[22]; p.k_a = (const float*)d_in[23]; p.r_k = (const float*)d_in[24]; p.lnx_g = (const float*)d_in[25];
  p.lnx_b = (const float*)d_in[26]; p.mem_norm_g = (const float*)d_in[27]; p.w_mem_kv = (const float*)d_in[28];
  p.w_out = (const float*)d_in[29]; p.final_g = (const float*)d_in[30];
  p.out = (float*)d_out; p.ws = (float*)d_ws;
  void* args[] = {&p};
  hipError_t e = hipLaunchCooperativeKernel((void*)fwd_megakernel, dim3(grid_blocks), dim3(512), args, LDS_BYTES, stream);
  if (e != hipSuccess) fprintf(stderr, "cooperative launch failed: %s (grid %d)\n", hipGetErrorString(e), grid_blocks);
}
```

```cpp
#include <hip/hip_runtime.h>
#include <hip/hip_cooperative_groups.h>
#include <cstdio>
#include <cstdint>
namespace cg = cooperative_groups;
namespace pg8 {
#define PG8_LAS __attribute__((address_space(3)))
typedef unsigned short bf16_t;
typedef short bf16x8 __attribute__((ext_vector_type(8)));
typedef float f32x4 __attribute__((ext_vector_type(4)));
typedef unsigned u32x4 __attribute__((ext_vector_type(4)));
constexpr int BM = 256, BK = 64, HALF = 128, HTB = HALF * BK * 2  , STAGE_BYTES = 8 * HTB, NXCD = 8, WGM = 8;

__host__ __device__ __forceinline__ int lds_byte(int r, int c) { const int st = (r >> 4) * 2 + (c >> 5), rr = r & 15, cc = c & 31, ob = rr * 64 + cc * 2; return st * 1024 + (ob ^ (((ob >> 9) & 1) << 5)); }
__host__ __device__ __forceinline__ void stage_rc(int b, int& R, int& C) { const int st = b / 1024, sb = b % 1024, swz = sb ^ (((sb >> 9) & 1) << 5); R = (st >> 1) * 16 + swz / 64; C = (st & 1) * 32 + (swz % 64) / 2; }
__host__ __device__ __forceinline__ int perm32(int rho) { const int n = rho >> 4, i = rho & 15; return 8 * (i >> 2) + 4 * n + (i & 3); }

struct Unit { int pm, pn; };
struct Gemm { const bf16_t* A; const bf16_t* Bt; int M, N, K; };

struct StaticOrder {
    int nM, nN, nwg, G, c;
    __host__ __device__ void init(int M, int N, int G_, int c_) { nM = M / BM; nN = N / BM; nwg = nM * nN; G = G_; c = c_; }
    __host__ __device__ bool next(int i, Unit& u) const {
        const long L = (long)i * G + c; if (L >= nwg) return false;
        int wgid = (int)L; { const int q = nwg / NXCD, r = nwg % NXCD, xcd = wgid % NXCD, off = wgid / NXCD; wgid = (xcd < r ? xcd * (q + 1) : r * (q + 1) + (xcd - r) * q) + off; }
        const int nig = WGM * nN, gid = wgid / nig, fm = gid * WGM, gsz = (nM - fm) < WGM ? (nM - fm) : WGM;
        u.pm = fm + ((wgid % nig) % gsz); u.pn = (wgid % nig) / gsz; return true;
    }
    __device__ __forceinline__ void a_ready(const Unit&) const {}
    __device__ __forceinline__ void done(const Unit&) const {}
};
__device__ __forceinline__ unsigned cvt_pk_bf16(float lo, float hi) { unsigned r; asm volatile("v_cvt_pk_bf16_f32 %0, %1, %2" : "=v"(r) : "v"(lo), "v"(hi)); return r; }
typedef float f32x2 __attribute__((ext_vector_type(2)));
template <class Epi, class Sched, bool ALIGN_EPI = false, bool SP2 = false>
__device__ __forceinline__ void gemm_phase(PG8_LAS unsigned char* lds, const Gemm g, const Sched& S, const Epi& E) {
    const int tid = threadIdx.x, wid = __builtin_amdgcn_readfirstlane(tid >> 6), lane = tid & 63, wr = wid >> 2, wc = wid & 3, fr = lane & 15, fq = lane >> 4;
    const int K = g.K, nt = K / BK;
    unsigned voffA[2], voffB[2];
#pragma unroll
    for (int i = 0; i < 2; ++i) { int R, C; stage_rc(tid * 16 + i * 8192, R, C); const int Rb = Epi::PERM ? ((R & ~31) + perm32(R & 31)) : R;
        voffA[i] = (unsigned)(R * K + C) * 2u; voffB[i] = (unsigned)(Rb * K + C) * 2u; }
    const size_t kstep = (size_t)(BK * 2);
    const size_t hstep = (size_t)HALF * K * 2;
    const size_t tstep = 2 * hstep;
    const unsigned ldsw = (unsigned)wid * 1024u;
    const int aoff = lds_byte(wr * 64 + fr, fq * 8), boff = lds_byte(wc * 32 + fr, fq * 8);
#define PG8_SA(b, h) (((b) * 2 + (h)) * HTB)
#define PG8_SB(b, h) ((4 + (b) * 2 + (h)) * HTB)
#define PG8_STAGE(bufoff, gbase, voff) do { _Pragma("unroll") for (int _i = 0; _i < 2; ++_i) \
        __builtin_amdgcn_global_load_lds((const unsigned*)((const char*)(gbase) + (voff)[_i]), (PG8_LAS unsigned*)(lds + (bufoff) + ldsw + _i * 8192), 16, 0, 0); } while (0)
#define PG8_LDA(dst, b, h) do { _Pragma("unroll") for (int m = 0; m < 4; ++m) _Pragma("unroll") for (int k = 0; k < 2; ++k) dst[m][k] = *(const PG8_LAS bf16x8*)(lds + PG8_SA(b, h) + aoff + m * 2048 + k * 1024); } while (0)
#define PG8_LDB(dst, b, h) do { _Pragma("unroll") for (int n = 0; n < 2; ++n) _Pragma("unroll") for (int k = 0; k < 2; ++k) dst[n][k] = *(const PG8_LAS bf16x8*)(lds + PG8_SB(b, h) + boff + n * 2048 + k * 1024); } while (0)
#define PG8_MMA(ai, bj, At, Bt) do { __builtin_amdgcn_s_setprio(1); _Pragma("unroll") for (int m = 0; m < 4; ++m) _Pragma("unroll") for (int n = 0; n < 2; ++n) _Pragma("unroll") for (int k = 0; k < 2; ++k) \
        acc[ai][bj][m][n] = __builtin_amdgcn_mfma_f32_16x16x32_bf16(Bt[n][k], At[m][k], acc[ai][bj][m][n], 0, 0, 0); __builtin_amdgcn_s_setprio(0); } while (0)
#define PG8_WAIT_V(n) asm volatile("s_waitcnt vmcnt(" #n ")" ::: "memory")
#define PG8_WAIT_L(n) asm volatile("s_waitcnt lgkmcnt(" #n ")" ::: "memory")
#define PG8_BAR __builtin_amdgcn_s_barrier()
#define PG8_SCHED __builtin_amdgcn_sched_barrier(0)
    Unit cur, nxt; int ui = 0;
    if (!S.next(0, cur)) return;
    f32x4 acc[2][2][4][2];
#pragma unroll
    for (int a = 0; a < 2; ++a)
#pragma unroll
        for (int b = 0; b < 2; ++b)
#pragma unroll
            for (int m = 0; m < 4; ++m)
#pragma unroll
                for (int n = 0; n < 2; ++n) acc[a][b][m][n] = (f32x4){0.f, 0.f, 0.f, 0.f};
    bf16x8 At[4][2], B0[2][2], B1[2][2];
    const char* cA = (const char*)g.A + (size_t)cur.pm * tstep; const char* cB = (const char*)g.Bt + (size_t)cur.pn * tstep;
    S.a_ready(cur);
    if constexpr (SP2) {
        PG8_STAGE(PG8_SB(0, 0), cB, voffB); PG8_STAGE(PG8_SB(0, 1), cB + hstep, voffB); PG8_STAGE(PG8_SA(0, 0), cA, voffA); PG8_STAGE(PG8_SA(0, 1), cA + hstep, voffA);
        if (wr == 1) PG8_BAR;
        PG8_WAIT_V(2); PG8_BAR;
        PG8_STAGE(PG8_SB(1, 0), cB + kstep, voffB); PG8_STAGE(PG8_SA(1, 0), cA + kstep, voffA); PG8_STAGE(PG8_SB(1, 1), cB + hstep + kstep, voffB);
        PG8_WAIT_V(6); PG8_BAR;
    } else {
        PG8_STAGE(PG8_SB(0, 0), cB, voffB); PG8_STAGE(PG8_SA(0, 0), cA, voffA); PG8_STAGE(PG8_SB(0, 1), cB + hstep, voffB); PG8_STAGE(PG8_SA(0, 1), cA + hstep, voffA);
        if (wr == 1) PG8_BAR;
        PG8_WAIT_V(4); PG8_BAR;
        PG8_STAGE(PG8_SB(1, 0), cB + kstep, voffB); PG8_STAGE(PG8_SA(1, 0), cA + kstep, voffA); PG8_STAGE(PG8_SB(1, 1), cB + hstep + kstep, voffB);
        PG8_WAIT_V(6); PG8_BAR;
    }
    for (;;) {
        const bool has_next = S.next(ui + 1, nxt);
        const char* nA = has_next ? (const char*)g.A + (size_t)nxt.pm * tstep : cA; const char* nB = has_next ? (const char*)g.Bt + (size_t)nxt.pn * tstep : cB;
        for (int t = 0; t < nt; t += 2) {
            const bool last = (t == nt - 2);
            const char* a1 = cA + (size_t)(t + 1) * kstep;
            const char* a2 = last ? nA : cA + (size_t)(t + 2) * kstep; const char* b2 = last ? nB : cB + (size_t)(t + 2) * kstep;
            const char* a3 = a2 + kstep; const char* b3 = b2 + kstep;
            if (last && has_next) S.a_ready(nxt);
            if constexpr (SP2) {
            PG8_LDB(B0, 0, 0); PG8_LDB(B1, 0, 1); PG8_SCHED; PG8_LDA(At, 0, 0); PG8_STAGE(PG8_SA(1, 1), a1 + hstep, voffA);
            PG8_WAIT_V(8); PG8_WAIT_L(0); PG8_BAR; PG8_MMA(0, 0, At, B0); PG8_MMA(0, 1, At, B1); PG8_BAR; PG8_SCHED;
            PG8_LDA(At, 0, 1); PG8_STAGE(PG8_SB(0, 0), b2, voffB); PG8_STAGE(PG8_SB(0, 1), b2 + hstep, voffB); PG8_STAGE(PG8_SA(0, 0), a2, voffA);
            PG8_WAIT_V(8); PG8_WAIT_L(0); PG8_BAR; PG8_MMA(1, 0, At, B0); PG8_MMA(1, 1, At, B1); PG8_BAR; PG8_SCHED;
            PG8_LDB(B0, 1, 0); PG8_LDB(B1, 1, 1); PG8_SCHED; PG8_LDA(At, 1, 0); PG8_STAGE(PG8_SA(0, 1), a2 + hstep, voffA);
            PG8_WAIT_V(8); PG8_WAIT_L(0); PG8_BAR; PG8_MMA(0, 0, At, B0); PG8_MMA(0, 1, At, B1); PG8_BAR; PG8_SCHED;
            PG8_LDA(At, 1, 1); PG8_STAGE(PG8_SB(1, 0), b3, voffB); PG8_STAGE(PG8_SB(1, 1), b3 + hstep, voffB); PG8_STAGE(PG8_SA(1, 0), a3, voffA);
            PG8_WAIT_V(8); PG8_WAIT_L(0); PG8_BAR; PG8_MMA(1, 0, At, B0); PG8_MMA(1, 1, At, B1); PG8_BAR; PG8_SCHED;
            } else {
            PG8_LDB(B0, 0, 0); PG8_SCHED; PG8_LDA(At, 0, 0); PG8_STAGE(PG8_SA(1, 1), a1 + hstep, voffA);
            PG8_WAIT_L(8); PG8_BAR; PG8_WAIT_L(0); PG8_MMA(0, 0, At, B0); PG8_BAR; PG8_SCHED;
            PG8_LDB(B1, 0, 1); PG8_STAGE(PG8_SB(0, 0), b2, voffB);
            PG8_BAR; PG8_WAIT_L(0); PG8_MMA(0, 1, At, B1); PG8_BAR;
            PG8_LDA(At, 0, 1); PG8_STAGE(PG8_SA(0, 0), a2, voffA);
            PG8_BAR; PG8_WAIT_L(0); PG8_MMA(1, 0, At, B0); PG8_BAR; PG8_SCHED;
            PG8_STAGE(PG8_SB(0, 1), b2 + hstep, voffB);
            PG8_WAIT_V(6); PG8_BAR; PG8_MMA(1, 1, At, B1); PG8_BAR;
            PG8_LDB(B0, 1, 0); PG8_SCHED; PG8_LDA(At, 1, 0); PG8_STAGE(PG8_SA(0, 1), a2 + hstep, voffA);
            PG8_WAIT_L(8); PG8_BAR; PG8_WAIT_L(0); PG8_MMA(0, 0, At, B0); PG8_BAR; PG8_SCHED;
            PG8_LDB(B1, 1, 1); PG8_STAGE(PG8_SB(1, 0), b3, voffB);
            PG8_BAR; PG8_WAIT_L(0); PG8_MMA(0, 1, At, B1); PG8_BAR;
            PG8_LDA(At, 1, 1); PG8_STAGE(PG8_SA(1, 0), a3, voffA);
            PG8_BAR; PG8_WAIT_L(0); PG8_MMA(1, 0, At, B0); PG8_BAR; PG8_SCHED;
            PG8_STAGE(PG8_SB(1, 1), b3 + hstep, voffB);
            PG8_WAIT_V(6); PG8_BAR; PG8_MMA(1, 1, At, B1); PG8_BAR;
            }
        }
        if constexpr (ALIGN_EPI) { if (wr == 0) PG8_BAR; }
        if constexpr (!Epi::AFTER_DRAIN) { E(acc, cur, wr, wc, fr, fq); S.done(cur); }
        if (!has_next) break;
#pragma unroll
        for (int a = 0; a < 2; ++a)
#pragma unroll
            for (int b = 0; b < 2; ++b)
#pragma unroll
                for (int m = 0; m < 4; ++m)
#pragma unroll
                    for (int n = 0; n < 2; ++n) acc[a][b][m][n] = (f32x4){0.f, 0.f, 0.f, 0.f};
        cur = nxt; cA = nA; cB = nB; ++ui;
        if constexpr (ALIGN_EPI) { if (wr == 1) PG8_BAR; }
    }
    PG8_WAIT_V(0);
    if constexpr (!ALIGN_EPI) { if (wr == 0) PG8_BAR; }
    PG8_BAR;
    if constexpr (Epi::AFTER_DRAIN) { E.fused(acc, cur, wr, wc, fr, fq, lds, wid, lane); S.done(cur); }
#undef PG8_SA
#undef PG8_SB
#undef PG8_STAGE
#undef PG8_LDA
#undef PG8_LDB
#undef PG8_MMA
#undef PG8_WAIT_V
#undef PG8_WAIT_L
#undef PG8_BAR
#undef PG8_SCHED
}
}

namespace pg8 {
struct EpiF32 {
  static constexpr bool PERM = false, AFTER_DRAIN = false;
  float* C; int ldc; int ncols; int split_cols; size_t split_stride; const float* r0; const float* r1; int nr0;
  __device__ __forceinline__ void operator()(const f32x4 (&acc)[2][2][4][2], const Unit& u, int wr, int wc, int fr, int fq) const {
    const int row0 = u.pm * BM + wr * 64 + fr; int colt = u.pn * BM; float* base = C;
    if (split_cols) { const int t = colt / split_cols; base += (size_t)t * split_stride; colt -= t * split_cols; }
    const int col0 = colt + wc * 32 + 4 * fq;
#pragma unroll
    for (int ai = 0; ai < 2; ++ai)
#pragma unroll
      for (int m = 0; m < 4; ++m) {
        const int row = row0 + ai * HALF + m * 16;
        const float* rr = r0 ? (row < nr0 ? r0 + (size_t)row * ldc : r1 + (size_t)(row - nr0) * ldc) : nullptr;
#pragma unroll
        for (int bj = 0; bj < 2; ++bj)
#pragma unroll
          for (int n = 0; n < 2; ++n) {
            const int col = col0 + bj * HALF + n * 16;
            if (col < ncols) { f32x4 v = acc[ai][bj][m][n]; if (rr) v += *(const f32x4*)(rr + col); *(f32x4*)(base + (size_t)row * ldc + col) = v; }
          }
      }
  }
};
}

constexpr int DM = 1024, BATCH = 4, SEQ = 4096, DB = 128, DT = 8, PAST = 8192, PAGE = 128, NPG = 64, NMEM = 256;
constexpr int NP = BATCH * SEQ, NS = DB * DT, NT = NP + NS;
constexpr int INC = 2592;
constexpr int C_CQ = 0, C_CKV = 256, C_KR = 384, C_GMLA = 416, C_Z = 928, C_GRWKV = 1824, C_QX = 2080, C_GX = 2336;
constexpr float MLA_SCALE = 0.10206207261596575f;
constexpr float X_SCALE = 0.125f;
constexpr float RMS_EPS = 1e-6f, GN_EPS = 64e-5f;
constexpr size_t O_YP = 0, O_YS = 16777216, O_CKVP = 17825792, O_KPEP = 19922944, O_WKVP = 20447232, O_SHP = 20512768,
                 O_MKP = 20516352, O_MVP = 20778496, O_CKVS = 21040640, O_KPES = 21171712, O_WKVS = 21204480, O_SHS = 23301632;
constexpr size_t W_H = 0;
constexpr size_t W_HM = W_H + (size_t)NT * 1024;
constexpr size_t W_PROJ = W_HM + (size_t)1024 * 1024;
constexpr size_t W_CQN = W_PROJ + (size_t)NT * INC;
constexpr size_t W_Q = W_CQN + (size_t)NT * 256;
constexpr size_t W_KN = W_Q + (size_t)NT * 768;
constexpr size_t W_V = W_KN + (size_t)NP * 512;
constexpr size_t W_QLAT = W_V + (size_t)NP * 512;
constexpr size_t W_OLAT = W_QLAT + (size_t)NS * 1024;
constexpr size_t W_R = W_OLAT + (size_t)NS * 1024;
constexpr size_t W_W = W_R + (size_t)NT * 256;
constexpr size_t W_KF = W_W + (size_t)NT * 256;
constexpr size_t W_VV = W_KF + (size_t)NT * 256;
constexpr size_t W_KK = W_VV + (size_t)NT * 256;
constexpr size_t W_BB = W_KK + (size_t)NT * 256;
constexpr size_t W_MIX = W_BB + (size_t)NT * 256;
constexpr size_t W_PO = W_MIX + (size_t)NT * 1024;
constexpr size_t W_PML = W_PO + (size_t)256 * 64 * 128;
constexpr size_t W_Y = W_PML + (size_t)256 * 64 * 2;
constexpr size_t W_CTL = W_Y + (size_t)NP * 256;
constexpr size_t W_END = W_CTL + 64;
constexpr int INCP = 2816;
constexpr size_t B_H = 0;
constexpr size_t B_HM = B_H + (size_t)NT * 1024;
constexpr size_t B_WIN = B_HM + (size_t)1024 * 1024;
constexpr size_t B_WMEM = B_WIN + (size_t)INCP * 1024;
constexpr size_t B_WOUT = B_WMEM + (size_t)512 * 1024;
constexpr size_t B_MIX = B_WOUT + (size_t)1024 * 1024;
constexpr size_t B_QP = B_MIX + (size_t)NT * 1024;
constexpr size_t B_KP = B_QP + (size_t)NP * 768;
constexpr size_t B_VT = B_KP + (size_t)NP * 768;
constexpr size_t B_QS = B_VT + (size_t)512 * NP;
constexpr size_t B_QX = B_QS + (size_t)NS * 8 * 160;
constexpr size_t B_KM = B_QX + (size_t)NP * 256;
constexpr size_t B_VMT = B_KM + (size_t)4 * 256 * 256;
constexpr size_t B_END = B_VMT + (size_t)4 * 256 * 256;
constexpr size_t WS_BYTES = W_END * 4 + B_END * 2;
constexpr int LDS_BYTES = 147456;

struct Params {
  const float* x_prompt; const float* x_sample; const float* mem_prompt; const float* cache_ckv; const float* cache_kpe;
  const int* page_table; const float* state_wkv; const float* state_shift; const float* cache_mem_k; const float* cache_mem_v;
  const float* ln_g; const float* w_in; const float* q_norm_g; const float* kv_norm_g; const float* w_uq; const float* w_uk;
  const float* w_uv; const float* shift_mu; const float* w0; const float* w_up; const float* a0; const float* a_up;
  const float* k_k; const float* k_a; const float* r_k; const float* lnx_g; const float* lnx_b; const float* mem_norm_g;
  const float* w_mem_kv; const float* w_out; const float* final_g;
  float* out; float* ws;
};

__device__ __forceinline__ float wave_sum(float v) {
#pragma unroll
  for (int o = 1; o < 64; o <<= 1) v += __shfl_xor(v, o);
  return v;
}
__device__ __forceinline__ float wave_max(float v) {
#pragma unroll
  for (int o = 1; o < 64; o <<= 1) v = fmaxf(v, __shfl_xor(v, o));
  return v;
}
__device__ __forceinline__ float silu(float x) { return x / (1.f + expf(-x)); }
__device__ __forceinline__ const float* xrow(const Params& p, int row) {
  return row < NP ? p.x_prompt + (size_t)row * DM : p.x_sample + (size_t)(row - NP) * DM;
}
__device__ __forceinline__ float* ckv_out_row(const Params& p, int row) {
  return row < NP ? p.out + O_CKVP + (size_t)row * 128 : p.out + O_CKVS + (size_t)(row - NP) * 128;
}
__device__ __forceinline__ float* kpe_out_row(const Params& p, int row) {
  return row < NP ? p.out + O_KPEP + (size_t)row * 32 : p.out + O_KPES + (size_t)(row - NP) * 32;
}

template <bool BT>
__device__ __forceinline__ void gemm_f32(const float* __restrict__ A, int lda, const float* __restrict__ B, int ldb, float* __restrict__ C, int ldc,
                         int M, int N, int K, float* sm) {
  const int tid = threadIdx.x, tx = tid & 15, ty = tid >> 4;
  float(*As)[68] = (float(*)[68])sm;
  float(*Bs)[68] = (float(*)[68])(sm + 16 * 68);
  const int tm = M / 64, tn = (N + 63) / 64;
  for (int tile = blockIdx.x; tile < tm * tn; tile += gridDim.x) {
    const int m0 = (tile / tn) * 64, n0 = (tile % tn) * 64;
    float acc[2][4];
#pragma unroll
    for (int i = 0; i < 2; ++i)
#pragma unroll
      for (int j = 0; j < 4; ++j) acc[i][j] = 0.f;
    for (int k0 = 0; k0 < K; k0 += 16) {
      for (int i = tid; i < 1024; i += 512) { const int r = i >> 4, kk = i & 15; As[kk][r] = A[(size_t)(m0 + r) * lda + k0 + kk]; }
      if (BT) {
        for (int i = tid; i < 1024; i += 512) { const int c = i >> 4, kk = i & 15; Bs[kk][c] = (n0 + c < N) ? B[(size_t)(n0 + c) * ldb + k0 + kk] : 0.f; }
      } else {
        for (int i = tid; i < 1024; i += 512) { const int kk = i >> 6, c = i & 63; Bs[kk][c] = (n0 + c < N) ? B[(size_t)(k0 + kk) * ldb + n0 + c] : 0.f; }
      }
      __syncthreads();
#pragma unroll
      for (int kk = 0; kk < 16; ++kk) {
        const float a0 = As[kk][ty * 2], a1 = As[kk][ty * 2 + 1];
        const float b0 = Bs[kk][tx * 4], b1 = Bs[kk][tx * 4 + 1], b2 = Bs[kk][tx * 4 + 2], b3 = Bs[kk][tx * 4 + 3];
        acc[0][0] += a0 * b0; acc[0][1] += a0 * b1; acc[0][2] += a0 * b2; acc[0][3] += a0 * b3;
        acc[1][0] += a1 * b0; acc[1][1] += a1 * b1; acc[1][2] += a1 * b2; acc[1][3] += a1 * b3;
      }
      __syncthreads();
    }
#pragma unroll
    for (int i = 0; i < 2; ++i)
#pragma unroll
      for (int j = 0; j < 4; ++j) { const int col = n0 + tx * 4 + j; if (col < N) C[(size_t)(m0 + ty * 2 + i) * ldc + col] = acc[i][j]; }
  }
}

template <int D1, int D2, int DV>
__device__ __forceinline__ void attn_row_tile(const float* wsm, const float* k1, const float* k2, const float* v, bool valid, int lane,
                                              float& m, float& l, float& o0, float& o1) {
  float sc = 0.f;
#pragma unroll 4
  for (int c = 0; c < D1; c += 4) { const float4 kv = *(const float4*)(k1 + c); sc += wsm[c] * kv.x + wsm[c + 1] * kv.y + wsm[c + 2] * kv.z + wsm[c + 3] * kv.w; }
  if (D2 > 0)
#pragma unroll 4
  for (int c = 0; c < D2; c += 4) { const float4 kv = *(const float4*)(k2 + c); sc += wsm[D1 + c] * kv.x + wsm[D1 + c + 1] * kv.y + wsm[D1 + c + 2] * kv.z + wsm[D1 + c + 3] * kv.w; }
  sc = valid ? sc : -1e30f;
  const float tmax = wave_max(sc), mn = fmaxf(m, tmax), alpha = expf(m - mn), pj = valid ? expf(sc - mn) : 0.f;
  l = l * alpha + wave_sum(pj); o0 *= alpha; o1 *= alpha;
  const unsigned long long pa = (unsigned long long)(uintptr_t)v;
  const int plo = (int)(unsigned)(pa & 0xffffffffull), phi = (int)(unsigned)(pa >> 32);
#pragma unroll 2
  for (int j = 0; j < 64; ++j) {
    const float pjj = __shfl(pj, j);
    const unsigned lo = (unsigned)__shfl(plo, j), hi = (unsigned)__shfl(phi, j);
    const float* vj = (const float*)(uintptr_t)(((unsigned long long)hi << 32) | lo);
    o0 += pjj * vj[lane];
    if (DV > 64) o1 += pjj * vj[64 + lane];
  }
  m = mn;
}

__device__ __forceinline__ void prompt_attn_wave(const Params& p, int bh, int qb, int lane, float* wsm) {
  const int b = bh >> 3, h = bh & 7;
  const float* Q = p.ws + W_Q; const float* KN = p.ws + W_KN; const float* V = p.ws + W_V; const float* KPE = p.out + O_KPEP;
  for (int qi = 0; qi < 64; ++qi) {
    const int s = qb * 64 + qi, row = b * SEQ + s;
    wsm[lane] = Q[(size_t)row * 768 + h * 96 + lane] * MLA_SCALE;
    if (lane < 32) wsm[64 + lane] = Q[(size_t)row * 768 + h * 96 + 64 + lane] * MLA_SCALE;
    float m = -1e30f, l = 0.f, o0 = 0.f, o1 = 0.f;
    for (int tile = 0; tile <= qb; ++tile) {
      const int j = tile * 64 + lane;
      const size_t krow = (size_t)b * SEQ + j;
      attn_row_tile<64, 32, 64>(wsm, KN + krow * 512 + h * 64, KPE + krow * 32, V + krow * 512 + h * 64, j <= s, lane, m, l, o0, o1);
    }
    const float g = p.ws[W_PROJ + (size_t)row * INC + C_GMLA + h * 64 + lane];
    p.ws[W_MIX + (size_t)row * 1024 + h * 64 + lane] = o0 / l * silu(g);
  }
}

__device__ __forceinline__ void sample_attn_wave(const Params& p, int rowid  , int lane, float* wsm) {
  const int h = rowid & 7, t = (rowid >> 3) & 7, db = rowid >> 6;
  const int srow = db * 8 + t, row = NP + srow;
  const float* QLAT = p.ws + W_QLAT; const float* Q = p.ws + W_Q;
  wsm[lane] = QLAT[(size_t)srow * 1024 + h * 128 + lane] * MLA_SCALE;
  wsm[64 + lane] = QLAT[(size_t)srow * 1024 + h * 128 + 64 + lane] * MLA_SCALE;
  if (lane < 32) wsm[128 + lane] = Q[(size_t)row * 768 + h * 96 + 64 + lane] * MLA_SCALE;
  float m = -1e30f, l = 0.f, o0 = 0.f, o1 = 0.f;
  for (int tile = 0; tile <= 128; ++tile) {
    const float* ckv; const float* kpe; bool valid;
    if (tile < 128) {
      const int k = tile * 64 + lane;
      const int page = p.page_table[db * NPG + (k >> 7)];
      const size_t base = (size_t)page * PAGE + (k & 127);
      ckv = p.cache_ckv + base * 128; kpe = p.cache_kpe + base * 32; valid = true;
    } else {
      const int u = lane < 8 ? lane : 0;
      valid = (lane < 8) && (lane <= t);
      ckv = p.out + O_CKVS + (size_t)(db * 8 + u) * 128; kpe = p.out + O_KPES + (size_t)(db * 8 + u) * 32;
    }
    attn_row_tile<128, 32, 128>(wsm, ckv, kpe, ckv, valid, lane, m, l, o0, o1);
  }
  float* OLAT = p.ws + W_OLAT;
  OLAT[(size_t)srow * 1024 + h * 128 + lane] = o0 / l;
  OLAT[(size_t)srow * 1024 + h * 128 + 64 + lane] = o1 / l;
}

__device__ __forceinline__ void mem_attn_wave(const Params& p, int item, int lane, float* wsm) {
  const int h = item / (NS / 2), r0 = NP + (item - h * (NS / 2)) * 2;
  for (int ri = 0; ri < 2; ++ri) {
    const int row = r0 + ri;
    const int db = (row - NP) >> 3;
    const float* kbase = p.cache_mem_k + (size_t)db * 256 * 256 + h * 64; const float* vbase = p.cache_mem_v + (size_t)db * 256 * 256 + h * 64;
    wsm[lane] = p.ws[W_PROJ + (size_t)row * INC + C_QX + h * 64 + lane] * X_SCALE;
    float m = -1e30f, l = 0.f, o0 = 0.f, o1 = 0.f;
    for (int tile = 0; tile < 4; ++tile) {
      const int j = tile * 64 + lane;
      attn_row_tile<64, 0, 64>(wsm, kbase + (size_t)j * 256, nullptr, vbase + (size_t)j * 256, true, lane, m, l, o0, o1);
    }
    const float g = p.ws[W_PROJ + (size_t)row * INC + C_GX + h * 64 + lane];
    p.ws[W_MIX + (size_t)row * 1024 + 768 + h * 64 + lane] = o0 / l * silu(g);
  }
}

#define CBAR() asm volatile("" ::: "memory")
__device__ __forceinline__ void rwkv_scan_wave(const Params& p, bool prompt, int bi, int h, int lane, float* wsm  ) {
  float S[64];
  const float* s0 = p.state_wkv + ((size_t)(bi * 4 + h) * 64 + lane) * 64;
#pragma unroll
  for (int k = 0; k < 64; ++k) S[k] = prompt ? 0.f : s0[k];
  const int T = prompt ? SEQ : DT, row0 = prompt ? bi * SEQ : NP + bi * DT;
  const float lg = p.lnx_g[h * 64 + lane], lb = p.lnx_b[h * 64 + lane], rk = p.r_k[h * 64 + lane];
#pragma unroll 1
  for (int t = 0; t < T; ++t) {
    const int row = row0 + t;
    const size_t off = (size_t)row * 256 + h * 64 + lane;
    const float r_l = p.ws[W_R + off], w_l = p.ws[W_W + off], kf_l = p.ws[W_KF + off], kk_l = p.ws[W_KK + off], bb_l = p.ws[W_BB + off];
    const float vv = p.ws[W_VV + off];
    wsm[lane] = kk_l; wsm[64 + lane] = w_l; wsm[128 + lane] = bb_l; wsm[192 + lane] = kf_l; wsm[256 + lane] = r_l;
    CBAR();
    float sa = 0.f;
#pragma unroll
    for (int c = 0; c < 4; ++c) {
#pragma unroll
      for (int k = 16 * c; k < 16 * c + 16; ++k) sa += S[k] * wsm[k];
      CBAR();
    }
    sa = -sa;
    float y = 0.f;
#pragma unroll
    for (int c = 0; c < 8; ++c) {
#pragma unroll
      for (int k = 8 * c; k < 8 * c + 8; ++k) { S[k] = S[k] * wsm[64 + k] + sa * wsm[128 + k] + vv * wsm[192 + k]; y += S[k] * wsm[256 + k]; }
      CBAR();
    }
    const float mean = wave_sum(y) * (1.f / 64.f), d = y - mean, var = wave_sum(d * d) * (1.f / 64.f);
    const float yn = d * rsqrtf(var + GN_EPS) * lg + lb;
    const float bsum = wave_sum(r_l * kf_l * rk);
    const float o = yn + bsum * vv;
    const float g = p.ws[W_PROJ + (size_t)row * INC + C_GRWKV + h * 64 + lane];
    p.ws[W_MIX + (size_t)row * 1024 + 512 + h * 64 + lane] = o * silu(g);
    CBAR();
  }
  float* so = prompt ? p.out + O_WKVP + ((size_t)(bi * 4 + h) * 64 + lane) * 64 : p.out + O_WKVS + ((size_t)(bi * 4 + h) * 64 + lane) * 64;
#pragma unroll
  for (int k = 0; k < 64; ++k) so[k] = S[k];
}


typedef unsigned short bf16;
#define LAS __attribute__((address_space(3)))
namespace pa {
typedef short bf16x8 __attribute__((ext_vector_type(8)));
typedef short s16x4 __attribute__((ext_vector_type(4)));
typedef float f32x16 __attribute__((ext_vector_type(16)));
typedef unsigned u32x4 __attribute__((ext_vector_type(4)));
typedef unsigned u32x2 __attribute__((ext_vector_type(2)));
typedef float f32x2_t __attribute__((ext_vector_type(2)));
typedef __bf16 bf16x2_t __attribute__((ext_vector_type(2)));
constexpr int KSTR = 208, VSTR = 136, KBYTES = 64 * KSTR, VBYTES = 64 * VSTR, STG = KBYTES + VBYTES;
__device__ __forceinline__ unsigned cvtpk(float lo, float hi) { f32x2_t v = {lo, hi}; bf16x2_t b = __builtin_convertvector(v, bf16x2_t); return __builtin_bit_cast(unsigned, b); }
__device__ __forceinline__ int crow(int r, int hi) { return (r & 3) + 8 * (r >> 2) + 4 * hi; }
__device__ __forceinline__ float swap_max(float v) { auto rr = __builtin_amdgcn_permlane32_swap(__float_as_uint(v), __float_as_uint(v), false, false); return fmaxf(__uint_as_float(rr[0]), __uint_as_float(rr[1])); }
__device__ __forceinline__ float swap_sum(float v) { auto rr = __builtin_amdgcn_permlane32_swap(__float_as_uint(v), __float_as_uint(v), false, false); return __uint_as_float(rr[0]) + __uint_as_float(rr[1]); }

template <int DQK, bool CAUSAL, class Out>
__device__ __forceinline__ void attn_unit(unsigned char* lds, const bf16* Qb, int qs, const bf16* Kb, int ks, const bf16* Vb, int vs, int ntiles, int qpos0, const Out& out) {
  const int tid = threadIdx.x, lane = tid & 63, wid = __builtin_amdgcn_readfirstlane(tid >> 6), r32 = lane & 31, hi = lane >> 5;
  constexpr int CPR = DQK / 8, NKC = 64 * CPR, KS = DQK / 16;
  bf16x8 qf[KS];
#pragma unroll
  for (int s = 0; s < KS; ++s) qf[s] = *(const bf16x8*)(Qb + (size_t)(wid * 32 + r32) * qs + 16 * s + 8 * hi);
  u32x4 kreg0, kreg1, vreg;
  const int kc0 = tid, kc1 = tid + 512;
  const int krow0 = kc0 / CPR, kcc0 = kc0 % CPR, krow1 = kc1 / CPR, kcc1 = kc1 % CPR;
  const int vdv = tid >> 3, vcc = tid & 7;
#define PA_GLOAD(t) do { kreg0 = *(const u32x4*)(Kb + (size_t)(64 * (t) + krow0) * ks + kcc0 * 8); \
    if (kc1 < NKC) kreg1 = *(const u32x4*)(Kb + (size_t)(64 * (t) + krow1) * ks + kcc1 * 8); \
    vreg = *(const u32x4*)(Vb + (size_t)vdv * vs + 64 * (t) + vcc * 8); } while (0)
#define PA_LSTORE(buf) do { unsigned char* b_ = lds + (buf) * STG; *(u32x4*)(b_ + krow0 * KSTR + kcc0 * 16) = kreg0; \
    if (kc1 < NKC) *(u32x4*)(b_ + krow1 * KSTR + kcc1 * 16) = kreg1; \
    *(u32x2*)(b_ + KBYTES + vdv * VSTR + vcc * 16) = (u32x2){vreg.x, vreg.y}; *(u32x2*)(b_ + KBYTES + vdv * VSTR + vcc * 16 + 8) = (u32x2){vreg.z, vreg.w}; } while (0)
  PA_GLOAD(0); PA_LSTORE(0); __syncthreads();
  f32x16 o0, o1;
#pragma unroll
  for (int r = 0; r < 16; ++r) { o0[r] = 0.f; o1[r] = 0.f; }
  float m = -1e30f, l = 0.f;
  const int qlo = qpos0 + 32 * wid;
  for (int t = 0; t < ntiles; ++t) {
    if (t + 1 < ntiles) PA_GLOAD(t + 1);
    const unsigned char* kb = lds + (t & 1) * STG; const unsigned char* vb = kb + KBYTES;
    const bool active = !CAUSAL || (64 * t <= qlo + 31);
    if (active) {
      f32x16 p0, p1;
#pragma unroll
      for (int r = 0; r < 16; ++r) { p0[r] = 0.f; p1[r] = 0.f; }
#pragma unroll
      for (int s = 0; s < KS; ++s) {
        const bf16x8 a0 = *(const bf16x8*)(kb + r32 * KSTR + (16 * s + 8 * hi) * 2);
        const bf16x8 a1 = *(const bf16x8*)(kb + (32 + r32) * KSTR + (16 * s + 8 * hi) * 2);
        p0 = __builtin_amdgcn_mfma_f32_32x32x16_bf16(a0, qf[s], p0, 0, 0, 0);
        p1 = __builtin_amdgcn_mfma_f32_32x32x16_bf16(a1, qf[s], p1, 0, 0, 0);
      }
      if (CAUSAL && (64 * t + 63 > qlo)) {
        const int q = qlo + r32;
#pragma unroll
        for (int r = 0; r < 16; ++r) { const int key = 64 * t + crow(r, hi); if (key > q) p0[r] = -1e30f; if (key + 32 > q) p1[r] = -1e30f; }
      }
      float mx = fmaxf(p0[0], p1[0]);
#pragma unroll
      for (int r = 1; r < 16; ++r) mx = fmaxf(mx, fmaxf(p0[r], p1[r]));
      mx = swap_max(mx);
      const float mn = fmaxf(m, mx), alpha = __builtin_amdgcn_exp2f(m - mn);
      m = mn;
      float ps = 0.f;
#pragma unroll
      for (int r = 0; r < 16; ++r) { p0[r] = __builtin_amdgcn_exp2f(p0[r] - mn); p1[r] = __builtin_amdgcn_exp2f(p1[r] - mn); ps += p0[r] + p1[r]; }
      l = l * alpha + ps;
#pragma unroll
      for (int r = 0; r < 16; ++r) { o0[r] *= alpha; o1[r] *= alpha; }
      bf16x8 pb[4];
#pragma unroll
      for (int k = 0; k < 4; ++k) {
        u32x4 w;
        if (k < 2) { w.x = cvtpk(p0[8 * k], p0[8 * k + 1]); w.y = cvtpk(p0[8 * k + 2], p0[8 * k + 3]); w.z = cvtpk(p0[8 * k + 4], p0[8 * k + 5]); w.w = cvtpk(p0[8 * k + 6], p0[8 * k + 7]); }
        else { const int kk = k - 2; w.x = cvtpk(p1[8 * kk], p1[8 * kk + 1]); w.y = cvtpk(p1[8 * kk + 2], p1[8 * kk + 3]); w.z = cvtpk(p1[8 * kk + 4], p1[8 * kk + 5]); w.w = cvtpk(p1[8 * kk + 6], p1[8 * kk + 7]); }
        pb[k] = __builtin_bit_cast(bf16x8, w);
      }
#pragma unroll
      for (int k = 0; k < 4; ++k) {
#pragma unroll
        for (int d = 0; d < 2; ++d) {
          const unsigned char* vp = vb + (32 * d + r32) * VSTR + (16 * k + 4 * hi) * 2;
          const u32x2 lo = *(const u32x2*)vp, hi2 = *(const u32x2*)(vp + 16);
          const u32x4 w = {lo.x, lo.y, hi2.x, hi2.y};
          const bf16x8 va = __builtin_bit_cast(bf16x8, w);
          if (d == 0) o0 = __builtin_amdgcn_mfma_f32_32x32x16_bf16(va, pb[k], o0, 0, 0, 0);
          else o1 = __builtin_amdgcn_mfma_f32_32x32x16_bf16(va, pb[k], o1, 0, 0, 0);
        }
      }
    }
    if (t + 1 < ntiles) PA_LSTORE((t + 1) & 1);
    __syncthreads();
  }
#undef PA_GLOAD
#undef PA_LSTORE
  const float inv = 1.f / swap_sum(l);
#pragma unroll
  for (int g = 0; g < 4; ++g) {
    out(32 * wid + r32, 8 * g + 4 * hi, make_float4(o0[4 * g] * inv, o0[4 * g + 1] * inv, o0[4 * g + 2] * inv, o0[4 * g + 3] * inv));
    out(32 * wid + r32, 32 + 8 * g + 4 * hi, make_float4(o1[4 * g] * inv, o1[4 * g + 1] * inv, o1[4 * g + 2] * inv, o1[4 * g + 3] * inv));
  }
}
}

namespace sa {
using pa::bf16x8; using pa::f32x16; using pa::u32x4; using pa::u32x2; using pa::cvtpk; using pa::crow; using pa::swap_max; using pa::swap_sum;
typedef float f32x4 __attribute__((ext_vector_type(4)));
typedef short v4i16_t __attribute__((ext_vector_type(4)));
constexpr int KVSTR = 336, TILE = 64 * KVSTR;
__device__ __forceinline__ void sample_attn_item(unsigned char* lds, const Params& p, const bf16* Qs, float* PO, float* PML, int item) {
  const int db = item >> 1, half = item & 1;
  const int tid = threadIdx.x, lane = tid & 63, wid = __builtin_amdgcn_readfirstlane(tid >> 6), r32 = lane & 31, hi = lane >> 5;
  const int qt = wid >> 2, ct = wid & 3;
  bf16x8 qf[10];
#pragma unroll
  for (int s = 0; s < 10; ++s) qf[s] = *(const bf16x8*)(Qs + (size_t)(db * 64 + 32 * qt + r32) * 160 + 16 * s + 8 * hi);
  const int ntiles = 64 + half;
  f32x4 st0, st1, st2, st3, sp;
  const f32x4 zero4 = {0.f, 0.f, 0.f, 0.f};
#define SA_GLOAD(t) do { if ((t) < 64) { const int key0_ = 4096 * half + 64 * (t); const int page_ = p.page_table[db * NPG + (key0_ >> 7)]; \
      const size_t base_ = (size_t)page_ * PAGE + (key0_ & 127); const float* ck_ = p.cache_ckv + base_ * 128; const float* kp_ = p.cache_kpe + base_ * 32; \
      st0 = *(const f32x4*)(ck_ + (size_t)(tid) * 4); st1 = *(const f32x4*)(ck_ + (size_t)(tid + 512) * 4); st2 = *(const f32x4*)(ck_ + (size_t)(tid + 1024) * 4); st3 = *(const f32x4*)(ck_ + (size_t)(tid + 1536) * 4); \
      sp = *(const f32x4*)(kp_ + (size_t)tid * 4); \
    } else { const float* ck_ = p.out + O_CKVS + (size_t)db * 8 * 128; const float* kp_ = p.out + O_KPES + (size_t)db * 8 * 32; \
      st0 = (tid < 256) ? *(const f32x4*)(ck_ + (size_t)tid * 4) : zero4; st1 = zero4; st2 = zero4; st3 = zero4; \
      sp = (tid < 64) ? *(const f32x4*)(kp_ + (size_t)tid * 4) : zero4; } } while (0)
#define SA_ST1(buf, f_, v_) do { const int key_ = (f_) >> 5, c4_ = (f_) & 31; *(u32x2*)(lds + (buf) * TILE + key_ * KVSTR + c4_ * 8) = (u32x2){cvtpk((v_).x, (v_).y), cvtpk((v_).z, (v_).w)}; } while (0)
#define SA_LSTORE(buf) do { SA_ST1(buf, tid, st0); SA_ST1(buf, tid + 512, st1); SA_ST1(buf, tid + 1024, st2); SA_ST1(buf, tid + 1536, st3); \
    { const int key_ = tid >> 3, c4_ = tid & 7; *(u32x2*)(lds + (buf) * TILE + key_ * KVSTR + 256 + c4_ * 8) = (u32x2){cvtpk(sp.x, sp.y), cvtpk(sp.z, sp.w)}; } } while (0)
  SA_GLOAD(0); SA_LSTORE(0); __syncthreads();
  f32x16 o;
#pragma unroll
  for (int r = 0; r < 16; ++r) o[r] = 0.f;
  float m = -1e30f, l = 0.f;
  const int tq = (32 * qt + r32) >> 3;
  for (int t = 0; t < ntiles; ++t) {
    if (t + 1 < ntiles) SA_GLOAD(t + 1);
    const unsigned char* kb = lds + (t & 1) * TILE;
    f32x16 p0, p1;
#pragma unroll
    for (int r = 0; r < 16; ++r) { p0[r] = 0.f; p1[r] = 0.f; }
#pragma unroll
    for (int s = 0; s < 10; ++s) {
      const bf16x8 a0 = *(const bf16x8*)(kb + r32 * KVSTR + (16 * s + 8 * hi) * 2);
      const bf16x8 a1 = *(const bf16x8*)(kb + (32 + r32) * KVSTR + (16 * s + 8 * hi) * 2);
      p0 = __builtin_amdgcn_mfma_f32_32x32x16_bf16(a0, qf[s], p0, 0, 0, 0);
      p1 = __builtin_amdgcn_mfma_f32_32x32x16_bf16(a1, qf[s], p1, 0, 0, 0);
    }
    if (t == 64) {
#pragma unroll
      for (int r = 0; r < 16; ++r) { const int u = crow(r, hi); if (!(u < 8 && u <= tq)) p0[r] = -1e30f; p1[r] = -1e30f; }
    }
    float mx = fmaxf(p0[0], p1[0]);
#pragma unroll
    for (int r = 1; r < 16; ++r) mx = fmaxf(mx, fmaxf(p0[r], p1[r]));
    mx = swap_max(mx);
    const float mn = fmaxf(m, mx), alpha = __builtin_amdgcn_exp2f(m - mn);
    m = mn;
    float ps = 0.f;
#pragma unroll
    for (int r = 0; r < 16; ++r) { p0[r] = __builtin_amdgcn_exp2f(p0[r] - mn); p1[r] = __builtin_amdgcn_exp2f(p1[r] - mn); ps += p0[r] + p1[r]; }
    l = l * alpha + ps;
#pragma unroll
    for (int r = 0; r < 16; ++r) o[r] *= alpha;
    bf16x8 pb[4];
#pragma unroll
    for (int k = 0; k < 4; ++k) {
      u32x4 w;
      if (k < 2) { w.x = cvtpk(p0[8 * k], p0[8 * k + 1]); w.y = cvtpk(p0[8 * k + 2], p0[8 * k + 3]); w.z = cvtpk(p0[8 * k + 4], p0[8 * k + 5]); w.w = cvtpk(p0[8 * k + 6], p0[8 * k + 7]); }
      else { const int kk = k - 2; w.x = cvtpk(p1[8 * kk], p1[8 * kk + 1]); w.y = cvtpk(p1[8 * kk + 2], p1[8 * kk + 3]); w.z = cvtpk(p1[8 * kk + 4], p1[8 * kk + 5]); w.w = cvtpk(p1[8 * kk + 6], p1[8 * kk + 7]); }
      pb[k] = __builtin_bit_cast(bf16x8, w);
    }
    {
      const int g = lane >> 4, i = lane & 15;
      const LAS unsigned char* vbase = (const LAS unsigned char*)kb + (4 * (g >> 1) + (i >> 2)) * KVSTR + (32 * ct + 16 * (g & 1) + 4 * (i & 3)) * 2;
#pragma unroll
      for (int k = 0; k < 4; ++k) {
        const v4i16_t lo = __builtin_amdgcn_ds_read_tr16_b64_v4i16((LAS v4i16_t*)(vbase + (16 * k) * KVSTR));
        const v4i16_t hi4 = __builtin_amdgcn_ds_read_tr16_b64_v4i16((LAS v4i16_t*)(vbase + (16 * k + 8) * KVSTR));
        const bf16x8 va = {lo[0], lo[1], lo[2], lo[3], hi4[0], hi4[1], hi4[2], hi4[3]};
        o = __builtin_amdgcn_mfma_f32_32x32x16_bf16(va, pb[k], o, 0, 0, 0);
      }
    }
    if (t + 1 < ntiles) SA_LSTORE((t + 1) & 1);
    __syncthreads();
  }
#undef SA_GLOAD
#undef SA_ST1
#undef SA_LSTORE
  const float lt = swap_sum(l);
  const int q = 32 * qt + r32;
  if (ct == 0 && hi == 0) { PML[((size_t)item * 64 + q) * 2] = m; PML[((size_t)item * 64 + q) * 2 + 1] = lt; }
#pragma unroll
  for (int g4 = 0; g4 < 4; ++g4) {
    const int c0 = 32 * ct + 8 * g4 + 4 * hi;
    *(f32x4*)(PO + ((size_t)item * 64 + q) * 128 + c0) = (f32x4){o[4 * g4], o[4 * g4 + 1], o[4 * g4 + 2], o[4 * g4 + 3]};
  }
}
}

namespace rw {
typedef float f32x4 __attribute__((ext_vector_type(4)));
constexpr int CH = 32, STEPF = 384, CHF = CH * STEPF;
__device__ __forceinline__ float dpp_sum16(float v) {
  v += __int_as_float(__builtin_amdgcn_update_dpp(0, __float_as_int(v), 0xB1, 0xF, 0xF, true));
  v += __int_as_float(__builtin_amdgcn_update_dpp(0, __float_as_int(v), 0x4E, 0xF, 0xF, true));
  v += __int_as_float(__builtin_amdgcn_update_dpp(0, __float_as_int(v), 0x141, 0xF, 0xF, true));
  v += __int_as_float(__builtin_amdgcn_update_dpp(0, __float_as_int(v), 0x140, 0xF, 0xF, true));
  return v;
}
__device__ __forceinline__ void rwkv_prompt_item(unsigned char* lds, const Params& p, int item) {
  const int bh = item >> 1, half = item & 1, b = bh >> 2, h = bh & 3;
  const int tid = threadIdx.x, sub = tid & 15, vl = tid >> 4, v = 32 * half + vl;
  float* L = (float*)lds; float* yb = L + 2 * CHF;
  const float* ws = p.ws;
  const size_t rowbase = (size_t)b * SEQ;
  const int ls = tid >> 4, lk4 = tid & 15;
  f32x4 g0, g1, g2, g3, g4, g5;
#define RW_GLOAD(c) do { const size_t off_ = (rowbase + (size_t)(c) * CH + ls) * 256 + h * 64 + lk4 * 4; \
    g0 = *(const f32x4*)(ws + W_KK + off_); g1 = *(const f32x4*)(ws + W_W + off_); g2 = *(const f32x4*)(ws + W_BB + off_); \
    g3 = *(const f32x4*)(ws + W_KF + off_); g4 = *(const f32x4*)(ws + W_R + off_); g5 = *(const f32x4*)(ws + W_VV + off_); } while (0)
#define RW_LSTORE(buf) do { float* b_ = L + (buf) * CHF + ls * STEPF + lk4 * 4; *(f32x4*)(b_) = g0; *(f32x4*)(b_ + 64) = g1; *(f32x4*)(b_ + 128) = g2; \
    *(f32x4*)(b_ + 192) = g3; *(f32x4*)(b_ + 256) = g4; *(f32x4*)(b_ + 320) = g5; } while (0)
  float S0 = 0.f, S1 = 0.f, S2 = 0.f, S3 = 0.f;
  RW_GLOAD(0); RW_LSTORE(0); __syncthreads();
  constexpr int NCH = SEQ / CH;
  for (int c = 0; c < NCH; ++c) {
    if (c + 1 < NCH) RW_GLOAD(c + 1);
    const float* cb = L + (c & 1) * CHF;
    float* ybc = yb + (c & 1) * (CH * 32);
#pragma unroll 4
    for (int s = 0; s < CH; ++s) {
      const float* sb = cb + s * STEPF;
      const f32x4 kk = *(const f32x4*)(sb + 4 * sub), w = *(const f32x4*)(sb + 64 + 4 * sub), bb = *(const f32x4*)(sb + 128 + 4 * sub);
      const f32x4 kf = *(const f32x4*)(sb + 192 + 4 * sub), r = *(const f32x4*)(sb + 256 + 4 * sub);
      const float vv = sb[320 + v];
      float dot = (S0 * kk.x + S1 * kk.y) + (S2 * kk.z + S3 * kk.w);
      dot = dpp_sum16(dot);
      const float sa = -dot;
      S0 = S0 * w.x + (sa * bb.x + vv * kf.x); S1 = S1 * w.y + (sa * bb.y + vv * kf.y);
      S2 = S2 * w.z + (sa * bb.z + vv * kf.z); S3 = S3 * w.w + (sa * bb.w + vv * kf.w);
      float y = (S0 * r.x + S1 * r.y) + (S2 * r.z + S3 * r.w);
      y = dpp_sum16(y);
      if (sub == 0) ybc[s * 32 + vl] = y;
    }
    if (c + 1 < NCH) RW_LSTORE((c + 1) & 1);
    __syncthreads();
#pragma unroll
    for (int i = 0; i < 2; ++i) { const int f = tid + 512 * i, s = f >> 5, vv_ = f & 31;
      p.ws[W_Y + (rowbase + (size_t)c * CH + s) * 256 + h * 64 + 32 * half + vv_] = ybc[s * 32 + vv_]; }
  }
#undef RW_GLOAD
#undef RW_LSTORE
  *(f32x4*)(p.out + O_WKVP + ((size_t)(b * 4 + h) * 64 + v) * 64 + 4 * sub) = (f32x4){S0, S1, S2, S3};
  __syncthreads();
}
}

typedef unsigned v4u __attribute__((ext_vector_type(4)));
__device__ __forceinline__ unsigned f2bf(float f) { unsigned u = __builtin_bit_cast(unsigned, f); return (u + 0x7fffu + ((u >> 16) & 1u)) >> 16; }
__device__ __forceinline__ unsigned pk2(float lo, float hi) { return f2bf(lo) | (f2bf(hi) << 16); }
__device__ __forceinline__ void p0_transpose_item(const float* W, int K, int N, bf16* WT, int row_off, LAS float* scr, int item, int lane) {
  const int nblk = N / 32, kb = item / nblk, nb = item % nblk, k0 = 64 * kb, n0 = 32 * nb;
#pragma unroll 8
  for (int i = 0; i < 32; ++i) { const int kk = 2 * i + (lane >> 5); scr[kk * 33 + (lane & 31)] = W[(size_t)(k0 + kk) * N + n0 + (lane & 31)]; }
  asm volatile("s_waitcnt lgkmcnt(0)" ::: "memory");
  const int c = lane & 7;
#pragma unroll
  for (int j = 0; j < 4; ++j) { const int n = (lane >> 3) + 8 * j; const LAS float* s = scr + (8 * c) * 33 + n;
    v4u o; o.x = pk2(s[0 * 33], s[1 * 33]); o.y = pk2(s[2 * 33], s[3 * 33]); o.z = pk2(s[4 * 33], s[5 * 33]); o.w = pk2(s[6 * 33], s[7 * 33]);
    *(v4u*)(WT + (size_t)(row_off + n0 + n) * K + k0 + 8 * c) = o; }
  asm volatile("s_waitcnt lgkmcnt(0)" ::: "memory");
}

__global__ void __launch_bounds__(512) fwd_megakernel(Params p) {
  cg::grid_group grid = cg::this_grid();
  extern __shared__ __attribute__((aligned(16))) unsigned char lds[];
  float* sm = (float*)lds;
  bf16* wb = (bf16*)(p.ws + W_END);
  const int tid = threadIdx.x, lane = tid & 63, wv = tid >> 6;
  const int gw = blockIdx.x * 8 + wv, NGW = gridDim.x * 8;
  const int gtid = blockIdx.x * 512 + tid, NTH = gridDim.x * 512;
  float* ws = p.ws;

  {
    LAS float* scr = (LAS float*)((LAS unsigned char*)lds + wv * 16384);
    constexpr int I_IN = 16 * (INC / 32), I_MEM = 16 * (512 / 32), I_OUT = 16 * (1024 / 32);
    for (int it = gw; it < I_IN + I_MEM + I_OUT; it += NGW) {
      int r = it;
      if (r < I_IN) { p0_transpose_item(p.w_in, 1024, INC, wb + B_WIN, 0, scr, r, lane); continue; } r -= I_IN;
      if (r < I_MEM) { p0_transpose_item(p.w_mem_kv, 1024, 512, wb + B_WMEM, 0, scr, r, lane); continue; } r -= I_MEM;
      p0_transpose_item(p.w_out, 1024, 1024, wb + B_WOUT, 0, scr, r, lane);
    }
    if (gtid < 64) ((unsigned*)(p.ws + W_CTL))[gtid] = 0u;
    for (int i = gtid; i < (INCP - INC) * 1024 / 8; i += NTH) ((v4u*)(wb + B_WIN + (size_t)INC * 1024))[i] = (v4u){0u, 0u, 0u, 0u};
  }
  for (int r = gw; r < NT + 1024; r += NGW) {
    const float* src; const float* g; bf16* dst;
    if (r < NT) { src = xrow(p, r); g = p.ln_g; dst = wb + B_H + (size_t)r * 1024; }
    else { src = p.mem_prompt + (size_t)(r - NT) * 1024; g = p.mem_norm_g; dst = wb + B_HM + (size_t)(r - NT) * 1024; }
    float4 v[4]; float ss = 0.f;
#pragma unroll
    for (int i = 0; i < 4; ++i) { v[i] = *(const float4*)(src + 4 * lane + 256 * i); ss += v[i].x * v[i].x + v[i].y * v[i].y + v[i].z * v[i].z + v[i].w * v[i].w; }
    const float rs = rsqrtf(wave_sum(ss) * (1.f / 1024.f) + RMS_EPS);
#pragma unroll
    for (int i = 0; i < 4; ++i) {
      const float4 gg = *(const float4*)(g + 4 * lane + 256 * i);
      uint2 o; o.x = pk2(v[i].x * rs * gg.x, v[i].y * rs * gg.y); o.y = pk2(v[i].z * rs * gg.z, v[i].w * rs * gg.w);
      *(uint2*)(dst + 4 * lane + 256 * i) = o;
    }
  }
  grid.sync();

  {
    pg8::Gemm g{wb + B_H, wb + B_WIN, NT, INCP, 1024}; pg8::StaticOrder S; S.init(NT, INCP, (int)gridDim.x, (int)blockIdx.x);
    pg8::EpiF32 E{ws + W_PROJ, INC, INC, 0, 0, nullptr, nullptr, 0};
    pg8::gemm_phase<pg8::EpiF32, pg8::StaticOrder, true, true>((PG8_LAS unsigned char*)lds, g, S, E);
  }
  {
    pg8::Gemm g{wb + B_HM, wb + B_WMEM, 1024, 512, 1024}; pg8::StaticOrder S; S.init(1024, 512, (int)gridDim.x, (int)((blockIdx.x + 20) % gridDim.x));
    pg8::EpiF32 E{p.out + O_MKP, 256, 256, 256, O_MVP - O_MKP, nullptr, nullptr, 0};
    pg8::gemm_phase<pg8::EpiF32, pg8::StaticOrder, true, true>((PG8_LAS unsigned char*)lds, g, S, E);
  }
  grid.sync();

  {
    float* tds = sm + wv * 128;
    for (int row = gw; row < NT; row += NGW) {
      const float* pr = ws + W_PROJ + (size_t)row * INC;
      {
        float v[4]; float ss = 0.f;
#pragma unroll
        for (int i = 0; i < 4; ++i) { v[i] = pr[C_CQ + lane + 64 * i]; ss += v[i] * v[i]; }
        const float rs = rsqrtf(wave_sum(ss) * (1.f / 256.f) + RMS_EPS);
#pragma unroll
        for (int i = 0; i < 4; ++i) ws[W_CQN + (size_t)row * 256 + lane + 64 * i] = v[i] * rs * p.q_norm_g[lane + 64 * i];
      }
      {
        const float v0 = pr[C_CKV + lane], v1 = pr[C_CKV + 64 + lane];
        const float rs = rsqrtf(wave_sum(v0 * v0 + v1 * v1) * (1.f / 128.f) + RMS_EPS);
        float* o = ckv_out_row(p, row);
        o[lane] = v0 * rs * p.kv_norm_g[lane]; o[64 + lane] = v1 * rs * p.kv_norm_g[64 + lane];
      }
      const int pos = row < NP ? (row % SEQ) : PAST + ((row - NP) & 7);
      if (lane < 16) {
        const float inv = 1.0f / powf(10000.0f, (float)lane * (2.0f / 32.0f));
        const float ang = (float)pos * inv; const float c = cosf(ang), s = sinf(ang);
        const float x1 = pr[C_KR + lane], x2 = pr[C_KR + 16 + lane];
        float* o = kpe_out_row(p, row);
        o[lane] = x1 * c - x2 * s; o[16 + lane] = x2 * c + x1 * s;
      }
      if (row < NP) { if ((row % SEQ) == SEQ - 1) { const int b = row / SEQ; for (int i = lane; i < 896; i += 64) p.out[O_SHP + (size_t)b * 896 + i] = pr[C_Z + i]; } }
      else { if (((row - NP) & 7) == 7) { const int db = (row - NP) >> 3; for (int i = lane; i < 896; i += 64) p.out[O_SHS + (size_t)db * 896 + i] = pr[C_Z + i]; } }
      {
        const bool first = row < NP ? ((row % SEQ) == 0) : (((row - NP) & 7) == 0);
        const float* prev = first ? (row < NP ? nullptr : p.state_shift + (size_t)((row - NP) >> 3) * 896 - C_Z) : pr - INC;
        auto zmix = [&](int i) -> float { const float z = pr[C_Z + i]; const float pv = prev ? prev[C_Z + i] : 0.f; return z + (pv - z) * p.shift_mu[i]; };
        tds[lane] = tanhf(zmix(768 + lane)); tds[64 + lane] = zmix(832 + lane);
        __builtin_amdgcn_fence(__ATOMIC_RELEASE, "wavefront"); __builtin_amdgcn_wave_barrier();
#pragma unroll 1
        for (int hh = 0; hh < 4; ++hh) {
          const int c = hh * 64 + lane;
          float u = p.w0[c], au = p.a0[c];
#pragma unroll 4
          for (int j = 0; j < 64; ++j) { u += tds[j] * p.w_up[j * 256 + c]; au += tds[64 + j] * p.a_up[j * 256 + c]; }
          const float nu = -u;
          const float sp = fmaxf(nu, 0.f) + log1pf(expf(-fabsf(nu)));
          const float wl = -sp - 0.5f;
          const float decay = expf(-expf(wl));
          const float a = 1.f / (1.f + expf(-au));
          const float k = zmix(256 + c), r = zmix(c), v = zmix(512 + c);
          float kk = k * p.k_k[c];
          const float nrm = fmaxf(sqrtf(wave_sum(kk * kk)), 1e-12f);
          kk = kk / nrm;
          const float kf = k * (1.f + (a - 1.f) * p.k_a[c]);
          const size_t o = (size_t)row * 256 + c;
          ws[W_R + o] = r; ws[W_W + o] = decay; ws[W_KF + o] = kf; ws[W_VV + o] = v; ws[W_KK + o] = kk; ws[W_BB + o] = kk * a;
        }
        __builtin_amdgcn_fence(__ATOMIC_RELEASE, "wavefront"); __builtin_amdgcn_wave_barrier();
      }
    }
  }
  grid.sync();

  gemm_f32<false>(ws + W_CQN, 256, p.w_uq, 768, ws + W_Q, 768, NT, 768, 256, sm);
  gemm_f32<false>(p.out + O_CKVP, 128, p.w_uk, 512, ws + W_KN, 512, NP, 512, 128, sm);
  gemm_f32<false>(p.out + O_CKVP, 128, p.w_uv, 512, ws + W_V, 512, NP, 512, 128, sm);
  grid.sync();

  for (int i = gtid; i < NT * 8 * 16; i += NTH) {
    const int j = i & 15, h = (i >> 4) & 7, row = i >> 7;
    const int pos = row < NP ? (row % SEQ) : PAST + ((row - NP) & 7);
    const float inv = 1.0f / powf(10000.0f, (float)j * (2.0f / 32.0f));
    const float ang = (float)pos * inv; const float c = cosf(ang), s = sinf(ang);
    float* q = ws + W_Q + (size_t)row * 768 + h * 96 + 64;
    const float x1 = q[j], x2 = q[16 + j];
    q[j] = x1 * c - x2 * s; q[16 + j] = x2 * c + x1 * s;
  }
  for (int h = 0; h < 8; ++h)
    gemm_f32<true>(ws + W_Q + (size_t)NP * 768 + h * 96, 768, p.w_uk + h * 64, 512, ws + W_QLAT + h * 128, 1024, NS, 128, 64, sm);
  grid.sync();

  {
    const float QSC = MLA_SCALE * 1.4426950408889634f;
    for (size_t i = gtid; i < (size_t)NP * 768 / 4; i += NTH) {
      const float4 v = *(const float4*)(ws + W_Q + i * 4);
      *(uint2*)(wb + B_QP + i * 4) = make_uint2(pk2(v.x * QSC, v.y * QSC), pk2(v.z * QSC, v.w * QSC));
    }
    for (size_t i = gtid; i < (size_t)NP * 8 * 24; i += NTH) {
      const int g4 = (int)(i % 24), h = (int)((i / 24) & 7); const size_t row = i / 192;
      const float4 v = g4 < 16 ? *(const float4*)(ws + W_KN + row * 512 + h * 64 + g4 * 4) : *(const float4*)(p.out + O_KPEP + row * 32 + (g4 - 16) * 4);
      *(uint2*)(wb + B_KP + row * 768 + h * 96 + g4 * 4) = make_uint2(pk2(v.x, v.y), pk2(v.z, v.w));
    }
    for (size_t i = gtid; i < (size_t)NS * 8 * 40; i += NTH) {
      const int g4 = (int)(i % 40); const size_t rh = i / 40, srow = rh >> 3; const int h = (int)(rh & 7);
      const float4 v = g4 < 32 ? *(const float4*)(ws + W_QLAT + srow * 1024 + h * 128 + g4 * 4) : *(const float4*)(ws + W_Q + (NP + srow) * 768 + h * 96 + 64 + (g4 - 32) * 4);
      *(uint2*)(wb + B_QS + rh * 160 + g4 * 4) = make_uint2(pk2(v.x * QSC, v.y * QSC), pk2(v.z * QSC, v.w * QSC));
    }
    {
      const float XSC = X_SCALE * 1.4426950408889634f;
      for (size_t i = gtid; i < (size_t)NP * 64; i += NTH) {
        const size_t row = i >> 6; const int g4 = (int)(i & 63);
        const float4 v = *(const float4*)(ws + W_PROJ + row * INC + C_QX + g4 * 4);
        *(uint2*)(wb + B_QX + row * 256 + g4 * 4) = make_uint2(pk2(v.x * XSC, v.y * XSC), pk2(v.z * XSC, v.w * XSC));
      }
      for (size_t i = gtid; i < (size_t)4 * 256 * 256; i += NTH) {
        wb[B_KM + i] = (bf16)f2bf(p.out[O_MKP + i]);
        const size_t b_ = i >> 16, c = (i >> 8) & 255, m_ = i & 255;
        wb[B_VMT + i] = (bf16)f2bf(p.out[O_MVP + (b_ * 256 + m_) * 256 + c]);
      }
    }
    for (size_t i = gtid; i < (size_t)512 * NP; i += NTH) {
      const size_t c = i / NP, row = i % NP;
      wb[B_VT + i] = (bf16)f2bf(ws[W_V + row * 512 + c]);
    }
  }
  grid.sync();

  {
    unsigned* qctr = (unsigned*)(p.ws + W_CTL);
    volatile unsigned* qslot = (volatile unsigned*)(lds + LDS_BYTES - 16);
    constexpr int Q_RW = 32, Q_PA = 512, Q_SA = 256, Q_MA = 256, Q_TOT = Q_RW + Q_PA + Q_SA + Q_MA;
    for (;;) {
      if (tid == 0) *qslot = atomicAdd(qctr, 1u);
      __syncthreads();
      int item = (int)*qslot;
      __syncthreads();
      item = __builtin_amdgcn_readfirstlane(item);
      if (item >= Q_TOT) break;
      if (item < Q_RW) { rw::rwkv_prompt_item(lds, p, item); continue; }
      item -= Q_RW;
      if (item < Q_PA) {
        const int bh = item & 31, qb = 15 - (item >> 5);
        const int b = bh >> 3, h = bh & 7;
        const size_t row0 = (size_t)b * SEQ + 256 * qb;
        auto out = [&](int ql, int dv0, float4 v) {
          const size_t row = row0 + ql;
          const float4 g = *(const float4*)(ws + W_PROJ + row * INC + C_GMLA + h * 64 + dv0);
          *(float4*)(ws + W_MIX + row * 1024 + h * 64 + dv0) = make_float4(v.x * silu(g.x), v.y * silu(g.y), v.z * silu(g.z), v.w * silu(g.w));
        };
        pa::attn_unit<96, true>(lds, wb + B_QP + row0 * 768 + h * 96, 768, wb + B_KP + (size_t)b * SEQ * 768 + h * 96, 768,
                                wb + B_VT + (size_t)(h * 64) * NP + (size_t)b * SEQ, NP, 4 * qb + 4, 256 * qb, out);
        continue;
      }
      item -= Q_PA;
      if (item < Q_SA) { sa::sample_attn_item(lds, p, wb + B_QS, ws + W_PO, ws + W_PML, item); continue; }
      item -= Q_SA;
      {
        const int qb = item & 15, h = (item >> 4) & 3, b = item >> 6;
        const size_t row0 = (size_t)b * SEQ + 256 * qb;
        auto out = [&](int ql, int dv0, float4 v) {
          const size_t row = row0 + ql;
          const float4 g = *(const float4*)(ws + W_PROJ + row * INC + C_GX + h * 64 + dv0);
          *(float4*)(ws + W_MIX + row * 1024 + 768 + h * 64 + dv0) = make_float4(v.x * silu(g.x), v.y * silu(g.y), v.z * silu(g.z), v.w * silu(g.w));
        };
        pa::attn_unit<64, false>(lds, wb + B_QX + row0 * 256 + h * 64, 256, wb + B_KM + (size_t)b * 65536 + h * 64, 256,
                                 wb + B_VMT + (size_t)b * 65536 + (size_t)(h * 64) * 256, 256, 4, 0, out);
      }
    }
    __syncthreads();
  }
  {
    constexpr int N_RS = 512, N_MA = 4 * (NS / 2);
    constexpr int TOT = N_RS + N_MA;
    float* wsm = sm + wv * 320;
    for (int it = gw; it < TOT; it += NGW) {
      int i = __builtin_amdgcn_readfirstlane(it);
      if (i < N_RS) { rwkv_scan_wave(p, false, i >> 2, i & 3, lane, wsm); continue; }
      i -= N_RS;
      mem_attn_wave(p, i, lane, wsm);
    }
  }
  grid.sync();

  for (int i = gtid; i < NS * 512; i += NTH) {
    const int c = i & 511, srow = i >> 9, h = c >> 6;
    const int db_ = srow >> 3, qi = (srow & 7) * 8 + h;
    const float* ml0 = ws + W_PML + ((size_t)(2 * db_) * 64 + qi) * 2; const float* ml1 = ml0 + 128;
    const float M_ = fmaxf(ml0[0], ml1[0]), w0_ = exp2f(ml0[0] - M_), w1_ = exp2f(ml1[0] - M_);
    const float invL = 1.f / (ml0[1] * w0_ + ml1[1] * w1_);
    const float* po0 = ws + W_PO + ((size_t)(2 * db_) * 64 + qi) * 128; const float* po1 = po0 + 64 * 128;
    float acc = 0.f;
#pragma unroll 4
    for (int k = 0; k < 128; ++k) acc += (po0[k] * w0_ + po1[k] * w1_) * p.w_uv[k * 512 + c];
    acc *= invL;
    const int row = NP + srow;
    const float g = ws[W_PROJ + (size_t)row * INC + C_GMLA + c];
    ws[W_MIX + (size_t)row * 1024 + c] = acc * silu(g);
  }
  for (int it = gw; it < NP * 4; it += NGW) {
    const int row = it >> 2, h = it & 3;
    const size_t off = (size_t)row * 256 + h * 64 + lane;
    const float y = ws[W_Y + off];
    const float mean = wave_sum(y) * (1.f / 64.f), d = y - mean, var = wave_sum(d * d) * (1.f / 64.f);
    const float yn = d * rsqrtf(var + GN_EPS) * p.lnx_g[h * 64 + lane] + p.lnx_b[h * 64 + lane];
    const float bsum = wave_sum(ws[W_R + off] * ws[W_KF + off] * p.r_k[h * 64 + lane]);
    const float o = yn + bsum * ws[W_VV + off];
    const float g = ws[W_PROJ + (size_t)row * INC + C_GRWKV + h * 64 + lane];
    ws[W_MIX + (size_t)row * 1024 + 512 + h * 64 + lane] = o * silu(g);
  }
  grid.sync();
  for (size_t i = gtid; i < (size_t)NT * 1024 / 4; i += NTH) {
    const float4 v = *(const float4*)(ws + W_MIX + i * 4);
    uint2 o; o.x = pk2(v.x, v.y); o.y = pk2(v.z, v.w);
    *(uint2*)(wb + B_MIX + i * 4) = o;
  }
  grid.sync();

  {
    pg8::Gemm g{wb + B_MIX, wb + B_WOUT, NT, 1024, 1024}; pg8::StaticOrder S; S.init(NT, 1024, (int)gridDim.x, (int)blockIdx.x);
    pg8::EpiF32 E{p.out, 1024, 1024, 0, 0, p.x_prompt, p.x_sample, NP};
    pg8::gemm_phase<pg8::EpiF32, pg8::StaticOrder, true, true>((PG8_LAS unsigned char*)lds, g, S, E);
  }
  grid.sync();

  for (int r = gw; r < NT; r += NGW) {
    float* y = p.out + (size_t)r * 1024;
    float v[16]; float ss = 0.f;
#pragma unroll
    for (int i = 0; i < 16; ++i) { v[i] = y[lane + 64 * i]; ss += v[i] * v[i]; }
    const float rs = rsqrtf(wave_sum(ss) * (1.f / 1024.f) + RMS_EPS);
#pragma unroll
    for (int i = 0; i < 16; ++i) y[lane + 64 * i] = v[i] * rs * p.final_g[lane + 64 * i];
  }
}

extern "C" void kernel_launch(void* const* d_in, const int* in_sizes, int n_in, void* d_out,
                              int out_size, void* d_ws, size_t ws_size, hipStream_t stream) {
  static int grid_blocks = 0;
  if (!grid_blocks) {
    int dev = 0, cus = 0, per_cu = 0;
    (void)hipGetDevice(&dev);
    (void)hipDeviceGetAttribute(&cus, hipDeviceAttributeMultiprocessorCount, dev);
    (void)hipFuncSetAttribute((const void*)fwd_megakernel, hipFuncAttributeMaxDynamicSharedMemorySize, LDS_BYTES);
    (void)hipOccupancyMaxActiveBlocksPerMultiprocessor(&per_cu, fwd_megakernel, 512, LDS_BYTES);
    if (per_cu < 1) per_cu = 1;
    grid_blocks = cus;
    if (ws_size < WS_BYTES) fprintf(stderr, "workspace too small: %zu < %zu\n", ws_size, (size_t)WS_BYTES);
  }
  Params p{};
  const float** pf = (const float**)&p;
  (void)pf;
  p.x_prompt = (const float*)d_in[0]; p.x_sample = (const float*)d_in[1]; p.mem_prompt = (const float*)d_in[2];
  p.cache_ckv = (const float*)d_in[3]; p.cache_kpe = (const float*)d_in[4]; p.page_table = (const int*)d_in[5];
  p.state_wkv = (const float*)d_in[6]; p.state_shift = (const float*)d_in[7]; p.cache_mem_k = (const float*)d_in[8];
  p.cache_mem_v = (const float*)d_in[9]; p.ln_g = (const float*)d_in[10]; p.w_in = (const float*)d_in[11];
  p.q_norm_g = (const float*)d_in[12]; p.kv_norm_g = (const float*)d_in[13]; p.w_uq = (const float*)d_in[14];
  p.w_uk = (const float*)d_in[15]; p.w_uv = (const float*)d_in[16]; p.shift_mu = (const float*)d_in[17];
  p.w0 = (const float*)d_in[18]; p.w_up = (const float*)d_in[19]; p.a0 = (const float*)d_in[20]; p.a_up = (const float*)d_in[21];
  p.k_k = (const float*)d_in[22]; p.k_a = (const float*)d_in[23]; p.r_k = (const float*)d_in[24]; p.lnx_g = (const float*)d_in[25];
  p.lnx_b = (const float*)d_in[26]; p.mem_norm_g = (const float*)d_in[27]; p.w_mem_kv = (const float*)d_in[28];
  p.w_out = (const float*)d_in[29]; p.final_g = (const float*)d_in[30];
  p.out = (float*)d_out; p.ws = (float*)d_ws;
  void* args[] = {&p};
  hipError_t e = hipLaunchCooperativeKernel((void*)fwd_megakernel, dim3(grid_blocks), dim3(512), args, LDS_BYTES, stream);
  if (e != hipSuccess) fprintf(stderr, "cooperative launch failed: %s (grid %d)\n", hipGetErrorString(e), grid_blocks);
}
```

```cpp
#include <hip/hip_runtime.h>
#include <hip/hip_cooperative_groups.h>
#include <cstdio>
#include <cstdint>
namespace cg = cooperative_groups;
namespace pg8 {
#define PG8_LAS __attribute__((address_space(3)))
typedef unsigned short bf16_t;
typedef short bf16x8 __attribute__((ext_vector_type(8)));
typedef float f32x4 __attribute__((ext_vector_type(4)));
typedef unsigned u32x4 __attribute__((ext_vector_type(4)));
constexpr int BM = 256, BK = 64, HALF = 128, HTB = HALF * BK * 2  , STAGE_BYTES = 8 * HTB, NXCD = 8, WGM = 8;

__host__ __device__ __forceinline__ int lds_byte(int r, int c) { const int st = (r >> 4) * 2 + (c >> 5), rr = r & 15, cc = c & 31, ob = rr * 64 + cc * 2; return st * 1024 + (ob ^ (((ob >> 9) & 1) << 5)); }
__host__ __device__ __forceinline__ void stage_rc(int b, int& R, int& C) { const int st = b / 1024, sb = b % 1024, swz = sb ^ (((sb >> 9) & 1) << 5); R = (st >> 1) * 16 + swz / 64; C = (st & 1) * 32 + (swz % 64) / 2; }
__host__ __device__ __forceinline__ int perm32(int rho) { const int n = rho >> 4, i = rho & 15; return 8 * (i >> 2) + 4 * n + (i & 3); }

struct Unit { int pm, pn; };
struct Gemm { const bf16_t* A; const bf16_t* Bt; int M, N, K; };

struct StaticOrder {
    int nM, nN, nwg, G, c;
    __host__ __device__ void init(int M, int N, int G_, int c_) { nM = M / BM; nN = N / BM; nwg = nM * nN; G = G_; c = c_; }
    __host__ __device__ bool next(int i, Unit& u) const {
        const long L = (long)i * G + c; if (L >= nwg) return false;
        int wgid = (int)L; { const int q = nwg / NXCD, r = nwg % NXCD, xcd = wgid % NXCD, off = wgid / NXCD; wgid = (xcd < r ? xcd * (q + 1) : r * (q + 1) + (xcd - r) * q) + off; }
        const int nig = WGM * nN, gid = wgid / nig, fm = gid * WGM, gsz = (nM - fm) < WGM ? (nM - fm) : WGM;
        u.pm = fm + ((wgid % nig) % gsz); u.pn = (wgid % nig) / gsz; return true;
    }
    __device__ __forceinline__ void a_ready(const Unit&) const {}
    __device__ __forceinline__ void done(const Unit&) const {}
};
__device__ __forceinline__ unsigned cvt_pk_bf16(float lo, float hi) { unsigned r; asm volatile("v_cvt_pk_bf16_f32 %0, %1, %2" : "=v"(r) : "v"(lo), "v"(hi)); return r; }
typedef float f32x2 __attribute__((ext_vector_type(2)));
template <class Epi, class Sched, bool ALIGN_EPI = false, bool SP2 = false>
__device__ __forceinline__ void gemm_phase(PG8_LAS unsigned char* lds, const Gemm g, const Sched& S, const Epi& E) {
    int tid_ = threadIdx.x; asm volatile("" : "+v"(tid_));
    const int tid = tid_, wid = __builtin_amdgcn_readfirstlane(tid >> 6), lane = tid & 63, wr = wid >> 2, wc = wid & 3, fr = lane & 15, fq = lane >> 4;
    const int K = g.K, nt = K / BK;
    unsigned voffA[2], voffB[2];
#pragma unroll
    for (int i = 0; i < 2; ++i) { int R, C; stage_rc(tid * 16 + i * 8192, R, C); const int Rb = Epi::PERM ? ((R & ~31) + perm32(R & 31)) : R;
        voffA[i] = (unsigned)(R * K + C) * 2u; voffB[i] = (unsigned)(Rb * K + C) * 2u; }
    const size_t kstep = (size_t)(BK * 2);
    const size_t hstep = (size_t)HALF * K * 2;
    const size_t tstep = 2 * hstep;
    const unsigned ldsw = (unsigned)wid * 1024u;
    const int aoff = lds_byte(wr * 64 + fr, fq * 8), boff = lds_byte(wc * 32 + fr, fq * 8);
#define PG8_SA(b, h) (((b) * 2 + (h)) * HTB)
#define PG8_SB(b, h) ((4 + (b) * 2 + (h)) * HTB)
#define PG8_STAGE(bufoff, gbase, voff) do { _Pragma("unroll") for (int _i = 0; _i < 2; ++_i) \
        __builtin_amdgcn_global_load_lds((const unsigned*)((const char*)(gbase) + (voff)[_i]), (PG8_LAS unsigned*)(lds + (bufoff) + ldsw + _i * 8192), 16, 0, 0); } while (0)
#define PG8_LDA(dst, b, h) do { _Pragma("unroll") for (int m = 0; m < 4; ++m) _Pragma("unroll") for (int k = 0; k < 2; ++k) dst[m][k] = *(const PG8_LAS bf16x8*)(lds + PG8_SA(b, h) + aoff + m * 2048 + k * 1024); } while (0)
#define PG8_LDB(dst, b, h) do { _Pragma("unroll") for (int n = 0; n < 2; ++n) _Pragma("unroll") for (int k = 0; k < 2; ++k) dst[n][k] = *(const PG8_LAS bf16x8*)(lds + PG8_SB(b, h) + boff + n * 2048 + k * 1024); } while (0)
#define PG8_MMA(ai, bj, At, Bt) do { __builtin_amdgcn_s_setprio(1); _Pragma("unroll") for (int m = 0; m < 4; ++m) _Pragma("unroll") for (int n = 0; n < 2; ++n) _Pragma("unroll") for (int k = 0; k < 2; ++k) \
        acc[ai][bj][m][n] = __builtin_amdgcn_mfma_f32_16x16x32_bf16(Bt[n][k], At[m][k], acc[ai][bj][m][n], 0, 0, 0); __builtin_amdgcn_s_setprio(0); } while (0)
#define PG8_WAIT_V(n) asm volatile("s_waitcnt vmcnt(" #n ")" ::: "memory")
#define PG8_WAIT_L(n) asm volatile("s_waitcnt lgkmcnt(" #n ")" ::: "memory")
#define PG8_BAR __builtin_amdgcn_s_barrier()
#define PG8_SCHED __builtin_amdgcn_sched_barrier(0)
    Unit cur, nxt; int ui = 0;
    if (!S.next(0, cur)) return;
    f32x4 acc[2][2][4][2];
#pragma unroll
    for (int a = 0; a < 2; ++a)
#pragma unroll
        for (int b = 0; b < 2; ++b)
#pragma unroll
            for (int m = 0; m < 4; ++m)
#pragma unroll
                for (int n = 0; n < 2; ++n) acc[a][b][m][n] = (f32x4){0.f, 0.f, 0.f, 0.f};
    bf16x8 At[4][2], B0[2][2], B1[2][2];
    const char* cA = (const char*)g.A + (size_t)cur.pm * tstep; const char* cB = (const char*)g.Bt + (size_t)cur.pn * tstep;
    S.a_ready(cur);
    if constexpr (SP2) {
        PG8_STAGE(PG8_SB(0, 0), cB, voffB); PG8_STAGE(PG8_SB(0, 1), cB + hstep, voffB); PG8_STAGE(PG8_SA(0, 0), cA, voffA); PG8_STAGE(PG8_SA(0, 1), cA + hstep, voffA);
        if (wr == 1) PG8_BAR;
        PG8_WAIT_V(2); PG8_BAR;
        PG8_STAGE(PG8_SB(1, 0), cB + kstep, voffB); PG8_STAGE(PG8_SA(1, 0), cA + kstep, voffA); PG8_STAGE(PG8_SB(1, 1), cB + hstep + kstep, voffB);
        PG8_WAIT_V(6); PG8_BAR;
    } else {
        PG8_STAGE(PG8_SB(0, 0), cB, voffB); PG8_STAGE(PG8_SA(0, 0), cA, voffA); PG8_STAGE(PG8_SB(0, 1), cB + hstep, voffB); PG8_STAGE(PG8_SA(0, 1), cA + hstep, voffA);
        if (wr == 1) PG8_BAR;
        PG8_WAIT_V(4); PG8_BAR;
        PG8_STAGE(PG8_SB(1, 0), cB + kstep, voffB); PG8_STAGE(PG8_SA(1, 0), cA + kstep, voffA); PG8_STAGE(PG8_SB(1, 1), cB + hstep + kstep, voffB);
        PG8_WAIT_V(6); PG8_BAR;
    }
    for (;;) {
        const bool has_next = S.next(ui + 1, nxt);
        const char* nA = has_next ? (const char*)g.A + (size_t)nxt.pm * tstep : cA; const char* nB = has_next ? (const char*)g.Bt + (size_t)nxt.pn * tstep : cB;
        for (int t = 0; t < nt; t += 2) {
            const bool last = (t == nt - 2);
            const char* a1 = cA + (size_t)(t + 1) * kstep;
            const char* a2 = last ? nA : cA + (size_t)(t + 2) * kstep; const char* b2 = last ? nB : cB + (size_t)(t + 2) * kstep;
            const char* a3 = a2 + kstep; const char* b3 = b2 + kstep;
            if (last && has_next) S.a_ready(nxt);
            if constexpr (SP2) {
            PG8_LDB(B0, 0, 0); PG8_LDB(B1, 0, 1); PG8_SCHED; PG8_LDA(At, 0, 0); PG8_STAGE(PG8_SA(1, 1), a1 + hstep, voffA);
            PG8_WAIT_V(8); PG8_WAIT_L(0); PG8_BAR; PG8_MMA(0, 0, At, B0); PG8_MMA(0, 1, At, B1); PG8_BAR; PG8_SCHED;
            PG8_LDA(At, 0, 1); PG8_STAGE(PG8_SB(0, 0), b2, voffB); PG8_STAGE(PG8_SB(0, 1), b2 + hstep, voffB); PG8_STAGE(PG8_SA(0, 0), a2, voffA);
            PG8_WAIT_V(8); PG8_WAIT_L(0); PG8_BAR; PG8_MMA(1, 0, At, B0); PG8_MMA(1, 1, At, B1); PG8_BAR; PG8_SCHED;
            PG8_LDB(B0, 1, 0); PG8_LDB(B1, 1, 1); PG8_SCHED; PG8_LDA(At, 1, 0); PG8_STAGE(PG8_SA(0, 1), a2 + hstep, voffA);
            PG8_WAIT_V(8); PG8_WAIT_L(0); PG8_BAR; PG8_MMA(0, 0, At, B0); PG8_MMA(0, 1, At, B1); PG8_BAR; PG8_SCHED;
            PG8_LDA(At, 1, 1); PG8_STAGE(PG8_SB(1, 0), b3, voffB); PG8_STAGE(PG8_SB(1, 1), b3 + hstep, voffB); PG8_STAGE(PG8_SA(1, 0), a3, voffA);
            PG8_WAIT_V(8); PG8_WAIT_L(0); PG8_BAR; PG8_MMA(1, 0, At, B0); PG8_MMA(1, 1, At, B1); PG8_BAR; PG8_SCHED;
            } else {
            PG8_LDB(B0, 0, 0); PG8_SCHED; PG8_LDA(At, 0, 0); PG8_STAGE(PG8_SA(1, 1), a1 + hstep, voffA);
            PG8_WAIT_L(8); PG8_BAR; PG8_WAIT_L(0); PG8_MMA(0, 0, At, B0); PG8_BAR; PG8_SCHED;
            PG8_LDB(B1, 0, 1); PG8_STAGE(PG8_SB(0, 0), b2, voffB);
            PG8_BAR; PG8_WAIT_L(0); PG8_MMA(0, 1, At, B1); PG8_BAR;
            PG8_LDA(At, 0, 1); PG8_STAGE(PG8_SA(0, 0), a2, voffA);
            PG8_BAR; PG8_WAIT_L(0); PG8_MMA(1, 0, At, B0); PG8_BAR; PG8_SCHED;
            PG8_STAGE(PG8_SB(0, 1), b2 + hstep, voffB);
            PG8_WAIT_V(6); PG8_BAR; PG8_MMA(1, 1, At, B1); PG8_BAR;
            PG8_LDB(B0, 1, 0); PG8_SCHED; PG8_LDA(At, 1, 0); PG8_STAGE(PG8_SA(0, 1), a2 + hstep, voffA);
            PG8_WAIT_L(8); PG8_BAR; PG8_WAIT_L(0); PG8_MMA(0, 0, At, B0); PG8_BAR; PG8_SCHED;
            PG8_LDB(B1, 1, 1); PG8_STAGE(PG8_SB(1, 0), b3, voffB);
            PG8_BAR; PG8_WAIT_L(0); PG8_MMA(0, 1, At, B1); PG8_BAR;
            PG8_LDA(At, 1, 1); PG8_STAGE(PG8_SA(1, 0), a3, voffA);
            PG8_BAR; PG8_WAIT_L(0); PG8_MMA(1, 0, At, B0); PG8_BAR; PG8_SCHED;
            PG8_STAGE(PG8_SB(1, 1), b3 + hstep, voffB);
            PG8_WAIT_V(6); PG8_BAR; PG8_MMA(1, 1, At, B1); PG8_BAR;
            }
        }
        if constexpr (ALIGN_EPI) { if (wr == 0) PG8_BAR; }
        if constexpr (!Epi::AFTER_DRAIN) { E(acc, cur, wr, wc, fr, fq); S.done(cur); }
        if (!has_next) break;
#pragma unroll
        for (int a = 0; a < 2; ++a)
#pragma unroll
            for (int b = 0; b < 2; ++b)
#pragma unroll
                for (int m = 0; m < 4; ++m)
#pragma unroll
                    for (int n = 0; n < 2; ++n) acc[a][b][m][n] = (f32x4){0.f, 0.f, 0.f, 0.f};
        cur = nxt; cA = nA; cB = nB; ++ui;
        if constexpr (ALIGN_EPI) { if (wr == 1) PG8_BAR; }
    }
    PG8_WAIT_V(0);
    if constexpr (!ALIGN_EPI) { if (wr == 0) PG8_BAR; }
    PG8_BAR;
    if constexpr (Epi::AFTER_DRAIN) { E.fused(acc, cur, wr, wc, fr, fq, lds, wid, lane); S.done(cur); }
#undef PG8_SA
#undef PG8_SB
#undef PG8_STAGE
#undef PG8_LDA
#undef PG8_LDB
#undef PG8_MMA
#undef PG8_WAIT_V
#undef PG8_WAIT_L
#undef PG8_BAR
#undef PG8_SCHED
}
}

namespace pg8 {
struct EpiF32 {
  static constexpr bool PERM = false, AFTER_DRAIN = false;
  float* C; int ldc; int ncols; int split_cols; size_t split_stride; const float* r0; const float* r1; int nr0;
  __device__ __forceinline__ void operator()(const f32x4 (&acc)[2][2][4][2], const Unit& u, int wr, int wc, int fr0, int fq0) const {
    int fr = fr0, fq = fq0; asm volatile("" : "+v"(fr), "+v"(fq));
    const int row0 = u.pm * BM + wr * 64 + fr; int colt = u.pn * BM; float* base = C;
    if (split_cols) { const int t = colt / split_cols; base += (size_t)t * split_stride; colt -= t * split_cols; }
    const int col0 = colt + wc * 32 + 4 * fq;
#pragma unroll
    for (int ai = 0; ai < 2; ++ai)
#pragma unroll
      for (int m = 0; m < 4; ++m) {
        const int row = row0 + ai * HALF + m * 16;
        const float* rr = r0 ? (row < nr0 ? r0 + (size_t)row * ldc : r1 + (size_t)(row - nr0) * ldc) : nullptr;
#pragma unroll
        for (int bj = 0; bj < 2; ++bj)
#pragma unroll
          for (int n = 0; n < 2; ++n) {
            const int col = col0 + bj * HALF + n * 16;
            if (col < ncols) { f32x4 v = acc[ai][bj][m][n]; if (rr) v += *(const f32x4*)(rr + col); *(f32x4*)(base + (size_t)row * ldc + col) = v; }
          }
      }
  }
};
}

constexpr int DM = 1024, BATCH = 4, SEQ = 4096, DB = 128, DT = 8, PAST = 8192, PAGE = 128, NPG = 64, NMEM = 256;
constexpr int NP = BATCH * SEQ, NS = DB * DT, NT = NP + NS;
constexpr int INC = 2592;
constexpr int C_CQ = 0, C_CKV = 256, C_KR = 384, C_GMLA = 416, C_Z = 928, C_GRWKV = 1824, C_QX = 2080, C_GX = 2336;
constexpr float MLA_SCALE = 0.10206207261596575f;
constexpr float X_SCALE = 0.125f;
constexpr float RMS_EPS = 1e-6f, GN_EPS = 64e-5f;
constexpr size_t O_YP = 0, O_YS = 16777216, O_CKVP = 17825792, O_KPEP = 19922944, O_WKVP = 20447232, O_SHP = 20512768,
                 O_MKP = 20516352, O_MVP = 20778496, O_CKVS = 21040640, O_KPES = 21171712, O_WKVS = 21204480, O_SHS = 23301632;
constexpr size_t W_H = 0;
constexpr size_t W_HM = W_H + (size_t)NT * 1024;
constexpr size_t W_PROJ = W_HM + (size_t)1024 * 1024;
constexpr size_t W_CQN = W_PROJ + (size_t)NT * INC;
constexpr size_t W_Q = W_CQN + (size_t)NT * 256;
constexpr size_t W_KN = W_Q + (size_t)NT * 768;
constexpr size_t W_V = W_KN + (size_t)NP * 512;
constexpr size_t W_QLAT = W_V + (size_t)NP * 512;
constexpr size_t W_OLAT = W_QLAT + (size_t)NS * 1024;
constexpr size_t W_R = W_OLAT + (size_t)NS * 1024;
constexpr size_t W_W = W_R + (size_t)NT * 256;
constexpr size_t W_KF = W_W + (size_t)NT * 256;
constexpr size_t W_VV = W_KF + (size_t)NT * 256;
constexpr size_t W_KK = W_VV + (size_t)NT * 256;
constexpr size_t W_BB = W_KK + (size_t)NT * 256;
constexpr size_t W_MIX = W_BB + (size_t)NT * 256;
constexpr size_t W_PO = W_MIX + (size_t)NT * 1024;
constexpr size_t W_PML = W_PO + (size_t)256 * 64 * 128;
constexpr size_t W_Y = W_PML + (size_t)256 * 64 * 2;
constexpr size_t W_CTL = W_Y + (size_t)NP * 256;
constexpr size_t W_CS = W_CTL + 64;
constexpr size_t W_END = W_CS + (size_t)4104 * 32;
constexpr int INCP = 2816;
constexpr size_t B_H = 0;
constexpr size_t B_HM = B_H + (size_t)NT * 1024;
constexpr size_t B_WIN = B_HM + (size_t)1024 * 1024;
constexpr size_t B_WMEM = B_WIN + (size_t)INCP * 1024;
constexpr size_t B_WOUT = B_WMEM + (size_t)512 * 1024;
constexpr size_t B_MIX = B_WOUT + (size_t)1024 * 1024;
constexpr size_t B_QP = B_MIX + (size_t)NT * 1024;
constexpr size_t B_KP = B_QP + (size_t)NP * 768;
constexpr size_t B_VT = B_KP + (size_t)NP * 768;
constexpr size_t B_QS = B_VT + (size_t)512 * NP;
constexpr size_t B_QX = B_QS + (size_t)NS * 8 * 160;
constexpr size_t B_KM = B_QX + (size_t)NP * 256;
constexpr size_t B_VMT = B_KM + (size_t)4 * 256 * 256;
constexpr size_t B_CQN = B_VMT + (size_t)4 * 256 * 256;
constexpr size_t B_CKVN = B_CQN + (size_t)NT * 256;
constexpr size_t B_WUQ = B_CKVN + (size_t)NP * 128;
constexpr size_t B_WQL = B_WUQ + (size_t)768 * 256;
constexpr size_t B_WUK = B_WQL + (size_t)1024 * 256;
constexpr size_t B_WUV = B_WUK + (size_t)512 * 128;
constexpr size_t B_END = B_WUV + (size_t)512 * 128;
constexpr size_t WS_BYTES = W_END * 4 + B_END * 2;
constexpr int LDS_BYTES = 147456;

struct Params {
  const float* x_prompt; const float* x_sample; const float* mem_prompt; const float* cache_ckv; const float* cache_kpe;
  const int* page_table; const float* state_wkv; const float* state_shift; const float* cache_mem_k; const float* cache_mem_v;
  const float* ln_g; const float* w_in; const float* q_norm_g; const float* kv_norm_g; const float* w_uq; const float* w_uk;
  const float* w_uv; const float* shift_mu; const float* w0; const float* w_up; const float* a0; const float* a_up;
  const float* k_k; const float* k_a; const float* r_k; const float* lnx_g; const float* lnx_b; const float* mem_norm_g;
  const float* w_mem_kv; const float* w_out; const float* final_g;
  float* out; float* ws;
};

__device__ __forceinline__ float wave_sum(float v) {
#pragma unroll
  for (int o = 1; o < 64; o <<= 1) v += __shfl_xor(v, o);
  return v;
}
__device__ __forceinline__ float wave_max(float v) {
#pragma unroll
  for (int o = 1; o < 64; o <<= 1) v = fmaxf(v, __shfl_xor(v, o));
  return v;
}
__device__ __forceinline__ float silu(float x) { return x / (1.f + expf(-x)); }
__device__ __forceinline__ const float* xrow(const Params& p, int row) {
  return row < NP ? p.x_prompt + (size_t)row * DM : p.x_sample + (size_t)(row - NP) * DM;
}
__device__ __forceinline__ float* ckv_out_row(const Params& p, int row) {
  return row < NP ? p.out + O_CKVP + (size_t)row * 128 : p.out + O_CKVS + (size_t)(row - NP) * 128;
}
__device__ __forceinline__ float* kpe_out_row(const Params& p, int row) {
  return row < NP ? p.out + O_KPEP + (size_t)row * 32 : p.out + O_KPES + (size_t)(row - NP) * 32;
}

template <bool BT>
__device__ __forceinline__ void gemm_f32(const float* __restrict__ A, int lda, const float* __restrict__ B, int ldb, float* __restrict__ C, int ldc,
                         int M, int N, int K, float* sm) {
  const int tid = threadIdx.x, tx = tid & 15, ty = tid >> 4;
  float(*As)[68] = (float(*)[68])sm;
  float(*Bs)[68] = (float(*)[68])(sm + 16 * 68);
  const int tm = M / 64, tn = (N + 63) / 64;
  for (int tile = blockIdx.x; tile < tm * tn; tile += gridDim.x) {
    const int m0 = (tile / tn) * 64, n0 = (tile % tn) * 64;
    float acc[2][4];
#pragma unroll
    for (int i = 0; i < 2; ++i)
#pragma unroll
      for (int j = 0; j < 4; ++j) acc[i][j] = 0.f;
    for (int k0 = 0; k0 < K; k0 += 16) {
      for (int i = tid; i < 1024; i += 512) { const int r = i >> 4, kk = i & 15; As[kk][r] = A[(size_t)(m0 + r) * lda + k0 + kk]; }
      if (BT) {
        for (int i = tid; i < 1024; i += 512) { const int c = i >> 4, kk = i & 15; Bs[kk][c] = (n0 + c < N) ? B[(size_t)(n0 + c) * ldb + k0 + kk] : 0.f; }
      } else {
        for (int i = tid; i < 1024; i += 512) { const int kk = i >> 6, c = i & 63; Bs[kk][c] = (n0 + c < N) ? B[(size_t)(k0 + kk) * ldb + n0 + c] : 0.f; }
      }
      __syncthreads();
#pragma unroll
      for (int kk = 0; kk < 16; ++kk) {
        const float a0 = As[kk][ty * 2], a1 = As[kk][ty * 2 + 1];
        const float b0 = Bs[kk][tx * 4], b1 = Bs[kk][tx * 4 + 1], b2 = Bs[kk][tx * 4 + 2], b3 = Bs[kk][tx * 4 + 3];
        acc[0][0] += a0 * b0; acc[0][1] += a0 * b1; acc[0][2] += a0 * b2; acc[0][3] += a0 * b3;
        acc[1][0] += a1 * b0; acc[1][1] += a1 * b1; acc[1][2] += a1 * b2; acc[1][3] += a1 * b3;
      }
      __syncthreads();
    }
#pragma unroll
    for (int i = 0; i < 2; ++i)
#pragma unroll
      for (int j = 0; j < 4; ++j) { const int col = n0 + tx * 4 + j; if (col < N) C[(size_t)(m0 + ty * 2 + i) * ldc + col] = acc[i][j]; }
  }
}

template <int D1, int D2, int DV>
__device__ __forceinline__ void attn_row_tile(const float* wsm, const float* k1, const float* k2, const float* v, bool valid, int lane,
                                              float& m, float& l, float& o0, float& o1) {
  float sc = 0.f;
#pragma unroll 4
  for (int c = 0; c < D1; c += 4) { const float4 kv = *(const float4*)(k1 + c); sc += wsm[c] * kv.x + wsm[c + 1] * kv.y + wsm[c + 2] * kv.z + wsm[c + 3] * kv.w; }
  if (D2 > 0)
#pragma unroll 4
  for (int c = 0; c < D2; c += 4) { const float4 kv = *(const float4*)(k2 + c); sc += wsm[D1 + c] * kv.x + wsm[D1 + c + 1] * kv.y + wsm[D1 + c + 2] * kv.z + wsm[D1 + c + 3] * kv.w; }
  sc = valid ? sc : -1e30f;
  const float tmax = wave_max(sc), mn = fmaxf(m, tmax), alpha = expf(m - mn), pj = valid ? expf(sc - mn) : 0.f;
  l = l * alpha + wave_sum(pj); o0 *= alpha; o1 *= alpha;
  const unsigned long long pa = (unsigned long long)(uintptr_t)v;
  const int plo = (int)(unsigned)(pa & 0xffffffffull), phi = (int)(unsigned)(pa >> 32);
#pragma unroll 2
  for (int j = 0; j < 64; ++j) {
    const float pjj = __shfl(pj, j);
    const unsigned lo = (unsigned)__shfl(plo, j), hi = (unsigned)__shfl(phi, j);
    const float* vj = (const float*)(uintptr_t)(((unsigned long long)hi << 32) | lo);
    o0 += pjj * vj[lane];
    if (DV > 64) o1 += pjj * vj[64 + lane];
  }
  m = mn;
}

__device__ __forceinline__ void prompt_attn_wave(const Params& p, int bh, int qb, int lane, float* wsm) {
  const int b = bh >> 3, h = bh & 7;
  const float* Q = p.ws + W_Q; const float* KN = p.ws + W_KN; const float* V = p.ws + W_V; const float* KPE = p.out + O_KPEP;
  for (int qi = 0; qi < 64; ++qi) {
    const int s = qb * 64 + qi, row = b * SEQ + s;
    wsm[lane] = Q[(size_t)row * 768 + h * 96 + lane] * MLA_SCALE;
    if (lane < 32) wsm[64 + lane] = Q[(size_t)row * 768 + h * 96 + 64 + lane] * MLA_SCALE;
    float m = -1e30f, l = 0.f, o0 = 0.f, o1 = 0.f;
    for (int tile = 0; tile <= qb; ++tile) {
      const int j = tile * 64 + lane;
      const size_t krow = (size_t)b * SEQ + j;
      attn_row_tile<64, 32, 64>(wsm, KN + krow * 512 + h * 64, KPE + krow * 32, V + krow * 512 + h * 64, j <= s, lane, m, l, o0, o1);
    }
    const float g = p.ws[W_PROJ + (size_t)row * INC + C_GMLA + h * 64 + lane];
    p.ws[W_MIX + (size_t)row * 1024 + h * 64 + lane] = o0 / l * silu(g);
  }
}

__device__ __forceinline__ void sample_attn_wave(const Params& p, int rowid  , int lane, float* wsm) {
  const int h = rowid & 7, t = (rowid >> 3) & 7, db = rowid >> 6;
  const int srow = db * 8 + t, row = NP + srow;
  const float* QLAT = p.ws + W_QLAT; const float* Q = p.ws + W_Q;
  wsm[lane] = QLAT[(size_t)srow * 1024 + h * 128 + lane] * MLA_SCALE;
  wsm[64 + lane] = QLAT[(size_t)srow * 1024 + h * 128 + 64 + lane] * MLA_SCALE;
  if (lane < 32) wsm[128 + lane] = Q[(size_t)row * 768 + h * 96 + 64 + lane] * MLA_SCALE;
  float m = -1e30f, l = 0.f, o0 = 0.f, o1 = 0.f;
  for (int tile = 0; tile <= 128; ++tile) {
    const float* ckv; const float* kpe; bool valid;
    if (tile < 128) {
      const int k = tile * 64 + lane;
      const int page = p.page_table[db * NPG + (k >> 7)];
      const size_t base = (size_t)page * PAGE + (k & 127);
      ckv = p.cache_ckv + base * 128; kpe = p.cache_kpe + base * 32; valid = true;
    } else {
      const int u = lane < 8 ? lane : 0;
      valid = (lane < 8) && (lane <= t);
      ckv = p.out + O_CKVS + (size_t)(db * 8 + u) * 128; kpe = p.out + O_KPES + (size_t)(db * 8 + u) * 32;
    }
    attn_row_tile<128, 32, 128>(wsm, ckv, kpe, ckv, valid, lane, m, l, o0, o1);
  }
  float* OLAT = p.ws + W_OLAT;
  OLAT[(size_t)srow * 1024 + h * 128 + lane] = o0 / l;
  OLAT[(size_t)srow * 1024 + h * 128 + 64 + lane] = o1 / l;
}

__device__ __forceinline__ void mem_attn_wave(const Params& p, int item, int lane, float* wsm) {
  const int h = item / (NS / 2), r0 = NP + (item - h * (NS / 2)) * 2;
  for (int ri = 0; ri < 2; ++ri) {
    const int row = r0 + ri;
    const int db = (row - NP) >> 3;
    const float* kbase = p.cache_mem_k + (size_t)db * 256 * 256 + h * 64; const float* vbase = p.cache_mem_v + (size_t)db * 256 * 256 + h * 64;
    wsm[lane] = p.ws[W_PROJ + (size_t)row * INC + C_QX + h * 64 + lane] * X_SCALE;
    float m = -1e30f, l = 0.f, o0 = 0.f, o1 = 0.f;
    for (int tile = 0; tile < 4; ++tile) {
      const int j = tile * 64 + lane;
      attn_row_tile<64, 0, 64>(wsm, kbase + (size_t)j * 256, nullptr, vbase + (size_t)j * 256, true, lane, m, l, o0, o1);
    }
    const float g = p.ws[W_PROJ + (size_t)row * INC + C_GX + h * 64 + lane];
    p.ws[W_MIX + (size_t)row * 1024 + 768 + h * 64 + lane] = o0 / l * silu(g);
  }
}

#define CBAR() asm volatile("" ::: "memory")
__device__ __forceinline__ void rwkv_scan_wave(const Params& p, bool prompt, int bi, int h, int lane, float* wsm  ) {
  float S[64];
  const float* s0 = p.state_wkv + ((size_t)(bi * 4 + h) * 64 + lane) * 64;
#pragma unroll
  for (int k = 0; k < 64; ++k) S[k] = prompt ? 0.f : s0[k];
  const int T = prompt ? SEQ : DT, row0 = prompt ? bi * SEQ : NP + bi * DT;
  const float lg = p.lnx_g[h * 64 + lane], lb = p.lnx_b[h * 64 + lane], rk = p.r_k[h * 64 + lane];
#pragma unroll 1
  for (int t = 0; t < T; ++t) {
    const int row = row0 + t;
    const size_t off = (size_t)row * 256 + h * 64 + lane;
    const float r_l = p.ws[W_R + off], w_l = p.ws[W_W + off], kf_l = p.ws[W_KF + off], kk_l = p.ws[W_KK + off], bb_l = p.ws[W_BB + off];
    const float vv = p.ws[W_VV + off];
    wsm[lane] = kk_l; wsm[64 + lane] = w_l; wsm[128 + lane] = bb_l; wsm[192 + lane] = kf_l; wsm[256 + lane] = r_l;
    CBAR();
    float sa = 0.f;
#pragma unroll
    for (int c = 0; c < 4; ++c) {
#pragma unroll
      for (int k = 16 * c; k < 16 * c + 16; ++k) sa += S[k] * wsm[k];
      CBAR();
    }
    sa = -sa;
    float y = 0.f;
#pragma unroll
    for (int c = 0; c < 8; ++c) {
#pragma unroll
      for (int k = 8 * c; k < 8 * c + 8; ++k) { S[k] = S[k] * wsm[64 + k] + sa * wsm[128 + k] + vv * wsm[192 + k]; y += S[k] * wsm[256 + k]; }
      CBAR();
    }
    const float mean = wave_sum(y) * (1.f / 64.f), d = y - mean, var = wave_sum(d * d) * (1.f / 64.f);
    const float yn = d * rsqrtf(var + GN_EPS) * lg + lb;
    const float bsum = wave_sum(r_l * kf_l * rk);
    const float o = yn + bsum * vv;
    const float g = p.ws[W_PROJ + (size_t)row * INC + C_GRWKV + h * 64 + lane];
    p.ws[W_MIX + (size_t)row * 1024 + 512 + h * 64 + lane] = o * silu(g);
    CBAR();
  }
  float* so = prompt ? p.out + O_WKVP + ((size_t)(bi * 4 + h) * 64 + lane) * 64 : p.out + O_WKVS + ((size_t)(bi * 4 + h) * 64 + lane) * 64;
#pragma unroll
  for (int k = 0; k < 64; ++k) so[k] = S[k];
}


namespace pg8 {
typedef unsigned u32x2 __attribute__((ext_vector_type(2)));
template <class F> struct EpiBf16F {
  static constexpr bool PERM = true, AFTER_DRAIN = false;
  F f; float scale;
  __device__ __forceinline__ void operator()(const f32x4 (&acc)[2][2][4][2], const Unit& u, int wr, int wc, int fr, int fq) const {
    int fr_ = fr, fq_ = fq; asm volatile("" : "+v"(fr_), "+v"(fq_));
    const int row0 = u.pm * BM + wr * 64 + fr_, col0 = u.pn * BM + wc * 32 + 8 * fq_;
#pragma unroll
    for (int ai = 0; ai < 2; ++ai)
#pragma unroll
      for (int m = 0; m < 4; ++m)
#pragma unroll
        for (int bj = 0; bj < 2; ++bj) {
          bf16_t* dst = f(row0 + ai * HALF + m * 16, col0 + bj * HALF);
          if (dst) { const f32x4 v0 = acc[ai][bj][m][0] * scale, v1 = acc[ai][bj][m][1] * scale;
            u32x4 w; w.x = cvt_pk_bf16(v0[0], v0[1]); w.y = cvt_pk_bf16(v0[2], v0[3]); w.z = cvt_pk_bf16(v1[0], v1[1]); w.w = cvt_pk_bf16(v1[2], v1[3]);
            *(u32x4*)dst = w; }
        }
  }
};
struct EpiQ {
  static constexpr bool PERM = false, AFTER_DRAIN = false;
  bf16_t* Qp; bf16_t* Qs; const float* CS; float scale; int np;
  __device__ __forceinline__ void operator()(const f32x4 (&acc)[2][2][4][2], const Unit& u, int wr, int wc, int fr0, int fq0) const {
    int fr = fr0, fq = fq0; asm volatile("" : "+v"(fr), "+v"(fq));
    const int row0 = u.pm * BM + wr * 64 + fr;
    if (u.pn < 2) {
      if (u.pm * BM >= np) return;
#pragma unroll
      for (int ai = 0; ai < 2; ++ai)
#pragma unroll
        for (int m = 0; m < 4; ++m) {
          const int row = row0 + ai * HALF + m * 16;
#pragma unroll
          for (int bj = 0; bj < 2; ++bj)
#pragma unroll
            for (int n = 0; n < 2; ++n) {
              const int col = u.pn * BM + bj * HALF + wc * 32 + 16 * n + 4 * fq, head = col >> 6, d = col & 63;
              const f32x4 v = acc[ai][bj][m][n] * scale;
              *(u32x2*)(Qp + (size_t)row * 768 + head * 96 + d) = (u32x2){cvt_pk_bf16(v[0], v[1]), cvt_pk_bf16(v[2], v[3])};
            }
        }
    } else {
#pragma unroll
      for (int ai = 0; ai < 2; ++ai)
#pragma unroll
        for (int m = 0; m < 4; ++m) {
          const int row = row0 + ai * HALF + m * 16;
          const bool pr = row < np;
          const int pi = pr ? (row & 4095) : 4096 + ((row - np) & 7);
#pragma unroll
          for (int n = 0; n < 2; ++n) {
            const int head = 2 * wc + n, j = 4 * fq;
            const f32x4 cs0 = *(const f32x4*)(CS + ((size_t)pi * 16 + j) * 2), cs1 = *(const f32x4*)(CS + ((size_t)pi * 16 + j) * 2 + 4);
            const f32x4 x1 = acc[ai][0][m][n], x2 = acc[ai][1][m][n];
            f32x4 y1, y2;
            y1[0] = x1[0] * cs0[0] - x2[0] * cs0[1]; y2[0] = x2[0] * cs0[0] + x1[0] * cs0[1];
            y1[1] = x1[1] * cs0[2] - x2[1] * cs0[3]; y2[1] = x2[1] * cs0[2] + x1[1] * cs0[3];
            y1[2] = x1[2] * cs1[0] - x2[2] * cs1[1]; y2[2] = x2[2] * cs1[0] + x1[2] * cs1[1];
            y1[3] = x1[3] * cs1[2] - x2[3] * cs1[3]; y2[3] = x2[3] * cs1[2] + x1[3] * cs1[3];
            y1 = y1 * scale; y2 = y2 * scale;
            bf16_t* dst = pr ? Qp + (size_t)row * 768 + head * 96 + 64 + j : Qs + ((size_t)(row - np) * 8 + head) * 160 + 128 + j;
            *(u32x2*)dst = (u32x2){cvt_pk_bf16(y1[0], y1[1]), cvt_pk_bf16(y1[2], y1[3])};
            *(u32x2*)(dst + 16) = (u32x2){cvt_pk_bf16(y2[0], y2[1]), cvt_pk_bf16(y2[2], y2[3])};
          }
        }
    }
  }
};
}
typedef unsigned short bf16;
#define LAS __attribute__((address_space(3)))
namespace pa {
typedef short bf16x8 __attribute__((ext_vector_type(8)));
typedef short s16x4 __attribute__((ext_vector_type(4)));
typedef float f32x16 __attribute__((ext_vector_type(16)));
typedef unsigned u32x4 __attribute__((ext_vector_type(4)));
typedef unsigned u32x2 __attribute__((ext_vector_type(2)));
typedef float f32x2_t __attribute__((ext_vector_type(2)));
typedef __bf16 bf16x2_t __attribute__((ext_vector_type(2)));
constexpr int KSTR = 208, VSTR = 136, KBYTES = 64 * KSTR, VBYTES = 64 * VSTR, STG = KBYTES + VBYTES;
__device__ __forceinline__ unsigned cvtpk(float lo, float hi) { f32x2_t v = {lo, hi}; bf16x2_t b = __builtin_convertvector(v, bf16x2_t); return __builtin_bit_cast(unsigned, b); }
__device__ __forceinline__ int crow(int r, int hi) { return (r & 3) + 8 * (r >> 2) + 4 * hi; }
__device__ __forceinline__ float swap_max(float v) { auto rr = __builtin_amdgcn_permlane32_swap(__float_as_uint(v), __float_as_uint(v), false, false); return fmaxf(__uint_as_float(rr[0]), __uint_as_float(rr[1])); }
__device__ __forceinline__ float swap_sum(float v) { auto rr = __builtin_amdgcn_permlane32_swap(__float_as_uint(v), __float_as_uint(v), false, false); return __uint_as_float(rr[0]) + __uint_as_float(rr[1]); }

template <int DQK, bool CAUSAL, class Out>
__device__ __forceinline__ void attn_unit(unsigned char* lds, const bf16* Qb, int qs, const bf16* Kb, int ks, const bf16* Vb, int vs, int ntiles, int qpos0, const Out& out) {
  int tid_ = threadIdx.x; asm volatile("" : "+v"(tid_));
  const int tid = tid_, lane = tid & 63, wid = __builtin_amdgcn_readfirstlane(tid >> 6), r32 = lane & 31, hi = lane >> 5;
  constexpr int CPR = DQK / 8, NKC = 64 * CPR, KS = DQK / 16;
  bf16x8 qf[KS];
#pragma unroll
  for (int s = 0; s < KS; ++s) qf[s] = *(const bf16x8*)(Qb + (size_t)(wid * 32 + r32) * qs + 16 * s + 8 * hi);
  u32x4 kreg0, kreg1, vreg;
  const int kc0 = tid, kc1 = tid + 512;
  const int krow0 = kc0 / CPR, kcc0 = kc0 % CPR, krow1 = kc1 / CPR, kcc1 = kc1 % CPR;
  const int vdv = tid >> 3, vcc = tid & 7;
#define PA_GLOAD(t) do { kreg0 = *(const u32x4*)(Kb + (size_t)(64 * (t) + krow0) * ks + kcc0 * 8); \
    if (kc1 < NKC) kreg1 = *(const u32x4*)(Kb + (size_t)(64 * (t) + krow1) * ks + kcc1 * 8); \
    vreg = *(const u32x4*)(Vb + (size_t)vdv * vs + 64 * (t) + vcc * 8); } while (0)
#define PA_LSTORE(buf) do { unsigned char* b_ = lds + (buf) * STG; *(u32x4*)(b_ + krow0 * KSTR + kcc0 * 16) = kreg0; \
    if (kc1 < NKC) *(u32x4*)(b_ + krow1 * KSTR + kcc1 * 16) = kreg1; \
    *(u32x2*)(b_ + KBYTES + vdv * VSTR + vcc * 16) = (u32x2){vreg.x, vreg.y}; *(u32x2*)(b_ + KBYTES + vdv * VSTR + vcc * 16 + 8) = (u32x2){vreg.z, vreg.w}; } while (0)
  PA_GLOAD(0); PA_LSTORE(0); __syncthreads();
  f32x16 o0, o1;
#pragma unroll
  for (int r = 0; r < 16; ++r) { o0[r] = 0.f; o1[r] = 0.f; }
  float m = -1e30f, l = 0.f;
  const int qlo = qpos0 + 32 * wid;
  for (int t = 0; t < ntiles; ++t) {
    if (t + 1 < ntiles) PA_GLOAD(t + 1);
    const unsigned char* kb = lds + (t & 1) * STG; const unsigned char* vb = kb + KBYTES;
    const bool active = !CAUSAL || (64 * t <= qlo + 31);
    if (active) {
      f32x16 p0, p1;
#pragma unroll
      for (int r = 0; r < 16; ++r) { p0[r] = 0.f; p1[r] = 0.f; }
#pragma unroll
      for (int s = 0; s < KS; ++s) {
        const bf16x8 a0 = *(const bf16x8*)(kb + r32 * KSTR + (16 * s + 8 * hi) * 2);
        const bf16x8 a1 = *(const bf16x8*)(kb + (32 + r32) * KSTR + (16 * s + 8 * hi) * 2);
        p0 = __builtin_amdgcn_mfma_f32_32x32x16_bf16(a0, qf[s], p0, 0, 0, 0);
        p1 = __builtin_amdgcn_mfma_f32_32x32x16_bf16(a1, qf[s], p1, 0, 0, 0);
      }
      if (CAUSAL && (64 * t + 63 > qlo)) {
        const int q = qlo + r32;
#pragma unroll
        for (int r = 0; r < 16; ++r) { const int key = 64 * t + crow(r, hi); if (key > q) p0[r] = -1e30f; if (key + 32 > q) p1[r] = -1e30f; }
      }
      float mx = fmaxf(p0[0], p1[0]);
#pragma unroll
      for (int r = 1; r < 16; ++r) mx = fmaxf(mx, fmaxf(p0[r], p1[r]));
      mx = swap_max(mx);
      const float mn = fmaxf(m, mx), alpha = __builtin_amdgcn_exp2f(m - mn);
      m = mn;
      float ps = 0.f;
#pragma unroll
      for (int r = 0; r < 16; ++r) { p0[r] = __builtin_amdgcn_exp2f(p0[r] - mn); p1[r] = __builtin_amdgcn_exp2f(p1[r] - mn); ps += p0[r] + p1[r]; }
      l = l * alpha + ps;
#pragma unroll
      for (int r = 0; r < 16; ++r) { o0[r] *= alpha; o1[r] *= alpha; }
      bf16x8 pb[4];
#pragma unroll
      for (int k = 0; k < 4; ++k) {
        u32x4 w;
        if (k < 2) { w.x = cvtpk(p0[8 * k], p0[8 * k + 1]); w.y = cvtpk(p0[8 * k + 2], p0[8 * k + 3]); w.z = cvtpk(p0[8 * k + 4], p0[8 * k + 5]); w.w = cvtpk(p0[8 * k + 6], p0[8 * k + 7]); }
        else { const int kk = k - 2; w.x = cvtpk(p1[8 * kk], p1[8 * kk + 1]); w.y = cvtpk(p1[8 * kk + 2], p1[8 * kk + 3]); w.z = cvtpk(p1[8 * kk + 4], p1[8 * kk + 5]); w.w = cvtpk(p1[8 * kk + 6], p1[8 * kk + 7]); }
        pb[k] = __builtin_bit_cast(bf16x8, w);
      }
#pragma unroll
      for (int k = 0; k < 4; ++k) {
#pragma unroll
        for (int d = 0; d < 2; ++d) {
          const unsigned char* vp = vb + (32 * d + r32) * VSTR + (16 * k + 4 * hi) * 2;
          const u32x2 lo = *(const u32x2*)vp, hi2 = *(const u32x2*)(vp + 16);
          const u32x4 w = {lo.x, lo.y, hi2.x, hi2.y};
          const bf16x8 va = __builtin_bit_cast(bf16x8, w);
          if (d == 0) o0 = __builtin_amdgcn_mfma_f32_32x32x16_bf16(va, pb[k], o0, 0, 0, 0);
          else o1 = __builtin_amdgcn_mfma_f32_32x32x16_bf16(va, pb[k], o1, 0, 0, 0);
        }
      }
    }
    if (t + 1 < ntiles) PA_LSTORE((t + 1) & 1);
    __syncthreads();
  }
#undef PA_GLOAD
#undef PA_LSTORE
  const float inv = 1.f / swap_sum(l);
#pragma unroll
  for (int g = 0; g < 4; ++g) {
    out(32 * wid + r32, 8 * g + 4 * hi, make_float4(o0[4 * g] * inv, o0[4 * g + 1] * inv, o0[4 * g + 2] * inv, o0[4 * g + 3] * inv));
    out(32 * wid + r32, 32 + 8 * g + 4 * hi, make_float4(o1[4 * g] * inv, o1[4 * g + 1] * inv, o1[4 * g + 2] * inv, o1[4 * g + 3] * inv));
  }
}
}

namespace sa {
using pa::bf16x8; using pa::f32x16; using pa::u32x4; using pa::u32x2; using pa::cvtpk; using pa::crow; using pa::swap_max; using pa::swap_sum;
typedef float f32x4 __attribute__((ext_vector_type(4)));
typedef short v4i16_t __attribute__((ext_vector_type(4)));
constexpr int KVSTR = 336, TILE = 64 * KVSTR;
__device__ __forceinline__ void sample_attn_item(unsigned char* lds, const Params& p, const bf16* Qs, float* PO, float* PML, int item) {
  const int db = item >> 1, half = item & 1;
  int tid_ = threadIdx.x; asm volatile("" : "+v"(tid_));
  const int tid = tid_, lane = tid & 63, wid = __builtin_amdgcn_readfirstlane(tid >> 6), r32 = lane & 31, hi = lane >> 5;
  const int qt = wid >> 2, ct = wid & 3;
  bf16x8 qf[10];
#pragma unroll
  for (int s = 0; s < 10; ++s) qf[s] = *(const bf16x8*)(Qs + (size_t)(db * 64 + 32 * qt + r32) * 160 + 16 * s + 8 * hi);
  const int ntiles = 64 + half;
  f32x4 st0, st1, st2, st3, sp;
  const f32x4 zero4 = {0.f, 0.f, 0.f, 0.f};
#define SA_GLOAD(t) do { if ((t) < 64) { const int key0_ = 4096 * half + 64 * (t); const int page_ = p.page_table[db * NPG + (key0_ >> 7)]; \
      const size_t base_ = (size_t)page_ * PAGE + (key0_ & 127); const float* ck_ = p.cache_ckv + base_ * 128; const float* kp_ = p.cache_kpe + base_ * 32; \
      st0 = *(const f32x4*)(ck_ + (size_t)(tid) * 4); st1 = *(const f32x4*)(ck_ + (size_t)(tid + 512) * 4); st2 = *(const f32x4*)(ck_ + (size_t)(tid + 1024) * 4); st3 = *(const f32x4*)(ck_ + (size_t)(tid + 1536) * 4); \
      sp = *(const f32x4*)(kp_ + (size_t)tid * 4); \
    } else { const float* ck_ = p.out + O_CKVS + (size_t)db * 8 * 128; const float* kp_ = p.out + O_KPES + (size_t)db * 8 * 32; \
      st0 = (tid < 256) ? *(const f32x4*)(ck_ + (size_t)tid * 4) : zero4; st1 = zero4; st2 = zero4; st3 = zero4; \
      sp = (tid < 64) ? *(const f32x4*)(kp_ + (size_t)tid * 4) : zero4; } } while (0)
#define SA_ST1(buf, f_, v_) do { const int key_ = (f_) >> 5, c4_ = (f_) & 31; *(u32x2*)(lds + (buf) * TILE + key_ * KVSTR + c4_ * 8) = (u32x2){cvtpk((v_).x, (v_).y), cvtpk((v_).z, (v_).w)}; } while (0)
#define SA_LSTORE(buf) do { SA_ST1(buf, tid, st0); SA_ST1(buf, tid + 512, st1); SA_ST1(buf, tid + 1024, st2); SA_ST1(buf, tid + 1536, st3); \
    { const int key_ = tid >> 3, c4_ = tid & 7; *(u32x2*)(lds + (buf) * TILE + key_ * KVSTR + 256 + c4_ * 8) = (u32x2){cvtpk(sp.x, sp.y), cvtpk(sp.z, sp.w)}; } } while (0)
  SA_GLOAD(0); SA_LSTORE(0); __syncthreads();
  f32x16 o;
#pragma unroll
  for (int r = 0; r < 16; ++r) o[r] = 0.f;
  float m = -1e30f, l = 0.f;
  const int tq = (32 * qt + r32) >> 3;
  for (int t = 0; t < ntiles; ++t) {
    if (t + 1 < ntiles) SA_GLOAD(t + 1);
    const unsigned char* kb = lds + (t & 1) * TILE;
    f32x16 p0, p1;
#pragma unroll
    for (int r = 0; r < 16; ++r) { p0[r] = 0.f; p1[r] = 0.f; }
#pragma unroll
    for (int s = 0; s < 10; ++s) {
      const bf16x8 a0 = *(const bf16x8*)(kb + r32 * KVSTR + (16 * s + 8 * hi) * 2);
      const bf16x8 a1 = *(const bf16x8*)(kb + (32 + r32) * KVSTR + (16 * s + 8 * hi) * 2);
      p0 = __builtin_amdgcn_mfma_f32_32x32x16_bf16(a0, qf[s], p0, 0, 0, 0);
      p1 = __builtin_amdgcn_mfma_f32_32x32x16_bf16(a1, qf[s], p1, 0, 0, 0);
    }
    if (t == 64) {
#pragma unroll
      for (int r = 0; r < 16; ++r) { const int u = crow(r, hi); if (!(u < 8 && u <= tq)) p0[r] = -1e30f; p1[r] = -1e30f; }
    }
    float mx = fmaxf(p0[0], p1[0]);
#pragma unroll
    for (int r = 1; r < 16; ++r) mx = fmaxf(mx, fmaxf(p0[r], p1[r]));
    mx = swap_max(mx);
    const float mn = fmaxf(m, mx), alpha = __builtin_amdgcn_exp2f(m - mn);
    m = mn;
    float ps = 0.f;
#pragma unroll
    for (int r = 0; r < 16; ++r) { p0[r] = __builtin_amdgcn_exp2f(p0[r] - mn); p1[r] = __builtin_amdgcn_exp2f(p1[r] - mn); ps += p0[r] + p1[r]; }
    l = l * alpha + ps;
#pragma unroll
    for (int r = 0; r < 16; ++r) o[r] *= alpha;
    bf16x8 pb[4];
#pragma unroll
    for (int k = 0; k < 4; ++k) {
      u32x4 w;
      if (k < 2) { w.x = cvtpk(p0[8 * k], p0[8 * k + 1]); w.y = cvtpk(p0[8 * k + 2], p0[8 * k + 3]); w.z = cvtpk(p0[8 * k + 4], p0[8 * k + 5]); w.w = cvtpk(p0[8 * k + 6], p0[8 * k + 7]); }
      else { const int kk = k - 2; w.x = cvtpk(p1[8 * kk], p1[8 * kk + 1]); w.y = cvtpk(p1[8 * kk + 2], p1[8 * kk + 3]); w.z = cvtpk(p1[8 * kk + 4], p1[8 * kk + 5]); w.w = cvtpk(p1[8 * kk + 6], p1[8 * kk + 7]); }
      pb[k] = __builtin_bit_cast(bf16x8, w);
    }
    {
      const int g = lane >> 4, i = lane & 15;
      const LAS unsigned char* vbase = (const LAS unsigned char*)kb + (4 * (g >> 1) + (i >> 2)) * KVSTR + (32 * ct + 16 * (g & 1) + 4 * (i & 3)) * 2;
#pragma unroll
      for (int k = 0; k < 4; ++k) {
        const v4i16_t lo = __builtin_amdgcn_ds_read_tr16_b64_v4i16((LAS v4i16_t*)(vbase + (16 * k) * KVSTR));
        const v4i16_t hi4 = __builtin_amdgcn_ds_read_tr16_b64_v4i16((LAS v4i16_t*)(vbase + (16 * k + 8) * KVSTR));
        const bf16x8 va = {lo[0], lo[1], lo[2], lo[3], hi4[0], hi4[1], hi4[2], hi4[3]};
        o = __builtin_amdgcn_mfma_f32_32x32x16_bf16(va, pb[k], o, 0, 0, 0);
      }
    }
    if (t + 1 < ntiles) SA_LSTORE((t + 1) & 1);
    __syncthreads();
  }
#undef SA_GLOAD
#undef SA_ST1
#undef SA_LSTORE
  const float lt = swap_sum(l);
  const int q = 32 * qt + r32;
  if (ct == 0 && hi == 0) { PML[((size_t)item * 64 + q) * 2] = m; PML[((size_t)item * 64 + q) * 2 + 1] = lt; }
#pragma unroll
  for (int g4 = 0; g4 < 4; ++g4) {
    const int c0 = 32 * ct + 8 * g4 + 4 * hi;
    *(f32x4*)(PO + ((size_t)item * 64 + q) * 128 + c0) = (f32x4){o[4 * g4], o[4 * g4 + 1], o[4 * g4 + 2], o[4 * g4 + 3]};
  }
}
}

namespace rw {
typedef float f32x4 __attribute__((ext_vector_type(4)));
constexpr int CH = 32, STEPF = 384, CHF = CH * STEPF;
__device__ __forceinline__ float dpp_sum16(float v) {
  v += __int_as_float(__builtin_amdgcn_update_dpp(0, __float_as_int(v), 0xB1, 0xF, 0xF, true));
  v += __int_as_float(__builtin_amdgcn_update_dpp(0, __float_as_int(v), 0x4E, 0xF, 0xF, true));
  v += __int_as_float(__builtin_amdgcn_update_dpp(0, __float_as_int(v), 0x141, 0xF, 0xF, true));
  v += __int_as_float(__builtin_amdgcn_update_dpp(0, __float_as_int(v), 0x140, 0xF, 0xF, true));
  return v;
}
__device__ __forceinline__ void rwkv_prompt_item(unsigned char* lds, const Params& p, int item) {
  const int bh = item >> 1, half = item & 1, b = bh >> 2, h = bh & 3;
  int tid_ = threadIdx.x; asm volatile("" : "+v"(tid_));
  const int tid = tid_, sub = tid & 15, vl = tid >> 4, v = 32 * half + vl;
  float* L = (float*)lds; float* yb = L + 2 * CHF;
  const float* ws = p.ws;
  const size_t rowbase = (size_t)b * SEQ;
  const int ls = tid >> 4, lk4 = tid & 15;
  f32x4 g0, g1, g2, g3, g4, g5;
#define RW_GLOAD(c) do { const size_t off_ = (rowbase + (size_t)(c) * CH + ls) * 256 + h * 64 + lk4 * 4; \
    g0 = *(const f32x4*)(ws + W_KK + off_); g1 = *(const f32x4*)(ws + W_W + off_); g2 = *(const f32x4*)(ws + W_BB + off_); \
    g3 = *(const f32x4*)(ws + W_KF + off_); g4 = *(const f32x4*)(ws + W_R + off_); g5 = *(const f32x4*)(ws + W_VV + off_); } while (0)
#define RW_LSTORE(buf) do { float* b_ = L + (buf) * CHF + ls * STEPF + lk4 * 4; *(f32x4*)(b_) = g0; *(f32x4*)(b_ + 64) = g1; *(f32x4*)(b_ + 128) = g2; \
    *(f32x4*)(b_ + 192) = g3; *(f32x4*)(b_ + 256) = g4; *(f32x4*)(b_ + 320) = g5; } while (0)
  float S0 = 0.f, S1 = 0.f, S2 = 0.f, S3 = 0.f;
  RW_GLOAD(0); RW_LSTORE(0); __syncthreads();
  constexpr int NCH = SEQ / CH;
  for (int c = 0; c < NCH; ++c) {
    if (c + 1 < NCH) RW_GLOAD(c + 1);
    const float* cb = L + (c & 1) * CHF;
    float* ybc = yb + (c & 1) * (CH * 32);
#pragma unroll 4
    for (int s = 0; s < CH; ++s) {
      const float* sb = cb + s * STEPF;
      const f32x4 kk = *(const f32x4*)(sb + 4 * sub), w = *(const f32x4*)(sb + 64 + 4 * sub), bb = *(const f32x4*)(sb + 128 + 4 * sub);
      const f32x4 kf = *(const f32x4*)(sb + 192 + 4 * sub), r = *(const f32x4*)(sb + 256 + 4 * sub);
      const float vv = sb[320 + v];
      float dot = (S0 * kk.x + S1 * kk.y) + (S2 * kk.z + S3 * kk.w);
      dot = dpp_sum16(dot);
      const float sa = -dot;
      S0 = S0 * w.x + (sa * bb.x + vv * kf.x); S1 = S1 * w.y + (sa * bb.y + vv * kf.y);
      S2 = S2 * w.z + (sa * bb.z + vv * kf.z); S3 = S3 * w.w + (sa * bb.w + vv * kf.w);
      float y = (S0 * r.x + S1 * r.y) + (S2 * r.z + S3 * r.w);
      y = dpp_sum16(y);
      if (sub == 0) ybc[s * 32 + vl] = y;
    }
    if (c + 1 < NCH) RW_LSTORE((c + 1) & 1);
    __syncthreads();
#pragma unroll
    for (int i = 0; i < 2; ++i) { const int f = tid + 512 * i, s = f >> 5, vv_ = f & 31;
      p.ws[W_Y + (rowbase + (size_t)c * CH + s) * 256 + h * 64 + 32 * half + vv_] = ybc[s * 32 + vv_]; }
  }
#undef RW_GLOAD
#undef RW_LSTORE
  *(f32x4*)(p.out + O_WKVP + ((size_t)(b * 4 + h) * 64 + v) * 64 + 4 * sub) = (f32x4){S0, S1, S2, S3};
  __syncthreads();
}
}

typedef unsigned v4u __attribute__((ext_vector_type(4)));
__device__ __forceinline__ unsigned f2bf(float f) { unsigned u = __builtin_bit_cast(unsigned, f); return (u + 0x7fffu + ((u >> 16) & 1u)) >> 16; }
__device__ __forceinline__ unsigned pk2(float lo, float hi) { return f2bf(lo) | (f2bf(hi) << 16); }
__device__ __forceinline__ void p0_transpose_item(const float* W, int K, int N, bf16* WT, int row_off, LAS float* scr, int item, int lane) {
  const int nblk = N / 32, kb = item / nblk, nb = item % nblk, k0 = 64 * kb, n0 = 32 * nb;
#pragma unroll 8
  for (int i = 0; i < 32; ++i) { const int kk = 2 * i + (lane >> 5); scr[kk * 33 + (lane & 31)] = W[(size_t)(k0 + kk) * N + n0 + (lane & 31)]; }
  asm volatile("s_waitcnt lgkmcnt(0)" ::: "memory");
  const int c = lane & 7;
#pragma unroll
  for (int j = 0; j < 4; ++j) { const int n = (lane >> 3) + 8 * j; const LAS float* s = scr + (8 * c) * 33 + n;
    v4u o; o.x = pk2(s[0 * 33], s[1 * 33]); o.y = pk2(s[2 * 33], s[3 * 33]); o.z = pk2(s[4 * 33], s[5 * 33]); o.w = pk2(s[6 * 33], s[7 * 33]);
    *(v4u*)(WT + (size_t)(row_off + n0 + n) * K + k0 + 8 * c) = o; }
  asm volatile("s_waitcnt lgkmcnt(0)" ::: "memory");
}

__global__ void __launch_bounds__(512) fwd_megakernel(Params p) {
  cg::grid_group grid = cg::this_grid();
  extern __shared__ __attribute__((aligned(16))) unsigned char lds[];
  float* sm = (float*)lds;
  bf16* wb = (bf16*)(p.ws + W_END);
  float* ws = p.ws;
#define PH_IDS int tid = threadIdx.x; asm volatile("" : "+v"(tid)); const int lane = tid & 63, wv = tid >> 6; const int gw = blockIdx.x * 8 + wv, NGW = gridDim.x * 8; \
  const int gtid = blockIdx.x * 512 + tid, NTH = gridDim.x * 512; (void)lane; (void)wv; (void)gw; (void)NGW; (void)gtid; (void)NTH;
  { PH_IDS

  {
    LAS float* scr = (LAS float*)((LAS unsigned char*)lds + wv * 16384);
    constexpr int I_IN = 16 * (INC / 32), I_MEM = 16 * (512 / 32), I_OUT = 16 * (1024 / 32);
    for (int it = gw; it < I_IN + I_MEM + I_OUT; it += NGW) {
      int r = it;
      if (r < I_IN) { p0_transpose_item(p.w_in, 1024, INC, wb + B_WIN, 0, scr, r, lane); continue; } r -= I_IN;
      if (r < I_MEM) { p0_transpose_item(p.w_mem_kv, 1024, 512, wb + B_WMEM, 0, scr, r, lane); continue; } r -= I_MEM;
      p0_transpose_item(p.w_out, 1024, 1024, wb + B_WOUT, 0, scr, r, lane);
    }
    if (gtid < 64) ((unsigned*)(p.ws + W_CTL))[gtid] = 0u;
    for (int it = gw; it < 64; it += NGW) {
      if (it < 32) p0_transpose_item(p.w_uk, 128, 512, wb + B_WUK, 0, scr, it, lane);
      else p0_transpose_item(p.w_uv, 128, 512, wb + B_WUV, 0, scr, it - 32, lane);
    }
    for (int i = gtid; i < 768 * 256; i += NTH) {
      const int n = i >> 8, k = i & 255;
      const int orig = n < 512 ? (n >> 6) * 96 + (n & 63) : (n < 640 ? ((n - 512) >> 4) * 96 + 64 + ((n - 512) & 15) : ((n - 640) >> 4) * 96 + 80 + ((n - 640) & 15));
      wb[B_WUQ + i] = (bf16)f2bf(p.w_uq[(size_t)k * 768 + orig]);
    }
    for (int i = gtid; i < 1024 * 256; i += NTH) {
      const int n = i >> 8, k = i & 255, h = n >> 7, c = n & 127;
      const float* a = p.w_uq + (size_t)k * 768 + h * 96; const float* b = p.w_uk + (size_t)c * 512 + h * 64;
      float acc = 0.f;
#pragma unroll 8
      for (int d = 0; d < 64; ++d) acc += a[d] * b[d];
      wb[B_WQL + i] = (bf16)f2bf(acc);
    }
    for (int i = gtid; i < 4104 * 16; i += NTH) {
      const int pi = i >> 4, j = i & 15; const int pos = pi < 4096 ? pi : PAST + (pi - 4096);
      const float inv = 1.0f / powf(10000.0f, (float)j * (2.0f / 32.0f));
      const float ang = (float)pos * inv;
      p.ws[W_CS + (size_t)i * 2] = cosf(ang); p.ws[W_CS + (size_t)i * 2 + 1] = sinf(ang);
    }
    for (int i = gtid; i < (INCP - INC) * 1024 / 8; i += NTH) ((v4u*)(wb + B_WIN + (size_t)INC * 1024))[i] = (v4u){0u, 0u, 0u, 0u};
  }
  for (int r = gw; r < NT + 1024; r += NGW) {
    const float* src; const float* g; bf16* dst;
    if (r < NT) { src = xrow(p, r); g = p.ln_g; dst = wb + B_H + (size_t)r * 1024; }
    else { src = p.mem_prompt + (size_t)(r - NT) * 1024; g = p.mem_norm_g; dst = wb + B_HM + (size_t)(r - NT) * 1024; }
    float4 v[4]; float ss = 0.f;
#pragma unroll
    for (int i = 0; i < 4; ++i) { v[i] = *(const float4*)(src + 4 * lane + 256 * i); ss += v[i].x * v[i].x + v[i].y * v[i].y + v[i].z * v[i].z + v[i].w * v[i].w; }
    const float rs = rsqrtf(wave_sum(ss) * (1.f / 1024.f) + RMS_EPS);
#pragma unroll
    for (int i = 0; i < 4; ++i) {
      const float4 gg = *(const float4*)(g + 4 * lane + 256 * i);
      uint2 o; o.x = pk2(v[i].x * rs * gg.x, v[i].y * rs * gg.y); o.y = pk2(v[i].z * rs * gg.z, v[i].w * rs * gg.w);
      *(uint2*)(dst + 4 * lane + 256 * i) = o;
    }
  }
  }
  grid.sync();
  { PH_IDS

  {
    pg8::Gemm g{wb + B_H, wb + B_WIN, NT, INCP, 1024}; pg8::StaticOrder S; S.init(NT, INCP, (int)gridDim.x, (int)blockIdx.x);
    pg8::EpiF32 E{ws + W_PROJ, INC, INC, 0, 0, nullptr, nullptr, 0};
    pg8::gemm_phase<pg8::EpiF32, pg8::StaticOrder, true, true>((PG8_LAS unsigned char*)lds, g, S, E);
  }
  {
    pg8::Gemm g{wb + B_HM, wb + B_WMEM, 1024, 512, 1024}; pg8::StaticOrder S; S.init(1024, 512, (int)gridDim.x, (int)((blockIdx.x + 20) % gridDim.x));
    pg8::EpiF32 E{p.out + O_MKP, 256, 256, 256, O_MVP - O_MKP, nullptr, nullptr, 0};
    pg8::gemm_phase<pg8::EpiF32, pg8::StaticOrder, true, true>((PG8_LAS unsigned char*)lds, g, S, E);
  }
  }
  grid.sync();
  { PH_IDS

  for (size_t i = gtid; i < (size_t)4 * 256 * 256; i += NTH) {
    wb[B_KM + i] = (bf16)f2bf(p.out[O_MKP + i]);
    const size_t b_ = i >> 16, c = (i >> 8) & 255, m_ = i & 255;
    wb[B_VMT + i] = (bf16)f2bf(p.out[O_MVP + (b_ * 256 + m_) * 256 + c]);
  }
  {
    float* tds = sm + wv * 128;
    for (int row = gw; row < NT; row += NGW) {
      const float* pr = ws + W_PROJ + (size_t)row * INC;
      {
        float v[4]; float ss = 0.f;
#pragma unroll
        for (int i = 0; i < 4; ++i) { v[i] = pr[C_CQ + lane + 64 * i]; ss += v[i] * v[i]; }
        const float rs = rsqrtf(wave_sum(ss) * (1.f / 256.f) + RMS_EPS);
#pragma unroll
        for (int i = 0; i < 4; ++i) wb[B_CQN + (size_t)row * 256 + lane + 64 * i] = (bf16)f2bf(v[i] * rs * p.q_norm_g[lane + 64 * i]);
      }
      {
        const float v0 = pr[C_CKV + lane], v1 = pr[C_CKV + 64 + lane];
        const float rs = rsqrtf(wave_sum(v0 * v0 + v1 * v1) * (1.f / 128.f) + RMS_EPS);
        float* o = ckv_out_row(p, row);
        const float c0 = v0 * rs * p.kv_norm_g[lane], c1 = v1 * rs * p.kv_norm_g[64 + lane];
        o[lane] = c0; o[64 + lane] = c1;
        if (row < NP) { wb[B_CKVN + (size_t)row * 128 + lane] = (bf16)f2bf(c0); wb[B_CKVN + (size_t)row * 128 + 64 + lane] = (bf16)f2bf(c1); }
      }
      const int pos = row < NP ? (row % SEQ) : PAST + ((row - NP) & 7);
      if (lane < 16) {
        const float inv = 1.0f / powf(10000.0f, (float)lane * (2.0f / 32.0f));
        const float ang = (float)pos * inv; const float c = cosf(ang), s = sinf(ang);
        const float x1 = pr[C_KR + lane], x2 = pr[C_KR + 16 + lane];
        float* o = kpe_out_row(p, row);
        const float y1 = x1 * c - x2 * s, y2 = x2 * c + x1 * s;
        o[lane] = y1; o[16 + lane] = y2;
        if (row < NP) {
          const bf16 b1 = (bf16)f2bf(y1), b2 = (bf16)f2bf(y2);
#pragma unroll
          for (int hh = 0; hh < 8; ++hh) { wb[B_KP + (size_t)row * 768 + hh * 96 + 64 + lane] = b1; wb[B_KP + (size_t)row * 768 + hh * 96 + 80 + lane] = b2; }
        }
      }
      if (row < NP) {
        const float XSC = X_SCALE * 1.4426950408889634f;
        const float4 v = *(const float4*)(pr + C_QX + lane * 4);
        *(uint2*)(wb + B_QX + (size_t)row * 256 + lane * 4) = make_uint2(pk2(v.x * XSC, v.y * XSC), pk2(v.z * XSC, v.w * XSC));
      }
      if (row < NP) { if ((row % SEQ) == SEQ - 1) { const int b = row / SEQ; for (int i = lane; i < 896; i += 64) p.out[O_SHP + (size_t)b * 896 + i] = pr[C_Z + i]; } }
      else { if (((row - NP) & 7) == 7) { const int db = (row - NP) >> 3; for (int i = lane; i < 896; i += 64) p.out[O_SHS + (size_t)db * 896 + i] = pr[C_Z + i]; } }
      {
        const bool first = row < NP ? ((row % SEQ) == 0) : (((row - NP) & 7) == 0);
        const float* prev = first ? (row < NP ? nullptr : p.state_shift + (size_t)((row - NP) >> 3) * 896 - C_Z) : pr - INC;
        auto zmix = [&](int i) -> float { const float z = pr[C_Z + i]; const float pv = prev ? prev[C_Z + i] : 0.f; return z + (pv - z) * p.shift_mu[i]; };
        tds[lane] = tanhf(zmix(768 + lane)); tds[64 + lane] = zmix(832 + lane);
        __builtin_amdgcn_fence(__ATOMIC_RELEASE, "wavefront"); __builtin_amdgcn_wave_barrier();
#pragma unroll 1
        for (int hh = 0; hh < 4; ++hh) {
          const int c = hh * 64 + lane;
          float u = p.w0[c], au = p.a0[c];
#pragma unroll 4
          for (int j = 0; j < 64; ++j) { u += tds[j] * p.w_up[j * 256 + c]; au += tds[64 + j] * p.a_up[j * 256 + c]; }
          const float nu = -u;
          const float sp = fmaxf(nu, 0.f) + log1pf(expf(-fabsf(nu)));
          const float wl = -sp - 0.5f;
          const float decay = expf(-expf(wl));
          const float a = 1.f / (1.f + expf(-au));
          const float k = zmix(256 + c), r = zmix(c), v = zmix(512 + c);
          float kk = k * p.k_k[c];
          const float nrm = fmaxf(sqrtf(wave_sum(kk * kk)), 1e-12f);
          kk = kk / nrm;
          const float kf = k * (1.f + (a - 1.f) * p.k_a[c]);
          const size_t o = (size_t)row * 256 + c;
          ws[W_R + o] = r; ws[W_W + o] = decay; ws[W_KF + o] = kf; ws[W_VV + o] = v; ws[W_KK + o] = kk; ws[W_BB + o] = kk * a;
        }
        __builtin_amdgcn_fence(__ATOMIC_RELEASE, "wavefront"); __builtin_amdgcn_wave_barrier();
      }
    }
  }
  }
  grid.sync();
  { PH_IDS

  {
    const float QSC = MLA_SCALE * 1.4426950408889634f;
    const int G = (int)gridDim.x, bx = (int)blockIdx.x;
    {
      pg8::Gemm g{wb + B_CQN, wb + B_WUQ, NT, 768, 256}; pg8::StaticOrder S; S.init(NT, 768, G, bx);
      pg8::EpiQ E{wb + B_QP, wb + B_QS, ws + W_CS, QSC, NP};
      pg8::gemm_phase<pg8::EpiQ, pg8::StaticOrder, true, true>((PG8_LAS unsigned char*)lds, g, S, E);
    }
    {
      bf16* Qs = wb + B_QS;
      auto f = [=](int row, int col) -> bf16* { return Qs + ((size_t)row * 8 + (col >> 7)) * 160 + (col & 127); };
      pg8::Gemm g{wb + B_CQN + (size_t)NP * 256, wb + B_WQL, NS, 1024, 256}; pg8::StaticOrder S; S.init(NS, 1024, G, (bx + G - 204 % G) % G);
      pg8::EpiBf16F<decltype(f)> E{f, QSC};
      pg8::gemm_phase<pg8::EpiBf16F<decltype(f)>, pg8::StaticOrder, true, true>((PG8_LAS unsigned char*)lds, g, S, E);
    }
    {
      bf16* Kp = wb + B_KP;
      auto f = [=](int row, int col) -> bf16* { return Kp + (size_t)row * 768 + (col >> 6) * 96 + (col & 63); };
      pg8::Gemm g{wb + B_CKVN, wb + B_WUK, NP, 512, 128}; pg8::StaticOrder S; S.init(NP, 512, G, (bx + G - 220 % G) % G);
      pg8::EpiBf16F<decltype(f)> E{f, 1.f};
      pg8::gemm_phase<pg8::EpiBf16F<decltype(f)>, pg8::StaticOrder, true, true>((PG8_LAS unsigned char*)lds, g, S, E);
    }
    {
      bf16* Vt = wb + B_VT;
      auto f = [=](int row, int col) -> bf16* { return Vt + (size_t)row * NP + col; };
      pg8::Gemm g{wb + B_WUV, wb + B_CKVN, 512, NP, 128}; pg8::StaticOrder S; S.init(512, NP, G, (bx + G - 92 % G) % G);
      pg8::EpiBf16F<decltype(f)> E{f, 1.f};
      pg8::gemm_phase<pg8::EpiBf16F<decltype(f)>, pg8::StaticOrder, true, true>((PG8_LAS unsigned char*)lds, g, S, E);
    }
  }
  }
  grid.sync();
  { PH_IDS

  {
    unsigned* qctr = (unsigned*)(p.ws + W_CTL);
    volatile unsigned* qslot = (volatile unsigned*)(lds + LDS_BYTES - 16);
    constexpr int Q_RW = 32, Q_PA = 512, Q_SA = 256, Q_MA = 256, Q_TOT = Q_RW + Q_PA + Q_SA + Q_MA;
    for (;;) {
      if (tid == 0) *qslot = atomicAdd(qctr, 1u);
      __syncthreads();
      int item = (int)*qslot;
      __syncthreads();
      item = __builtin_amdgcn_readfirstlane(item);
      if (item >= Q_TOT) break;
      if (item < Q_RW) { rw::rwkv_prompt_item(lds, p, item); continue; }
      item -= Q_RW;
      if (item < Q_PA) {
        const int bh = item & 31, qb = 15 - (item >> 5);
        const int b = bh >> 3, h = bh & 7;
        const size_t row0 = (size_t)b * SEQ + 256 * qb;
        auto out = [&](int ql, int dv0, float4 v) {
          const size_t row = row0 + ql;
          const float4 g = *(const float4*)(ws + W_PROJ + row * INC + C_GMLA + h * 64 + dv0);
          *(float4*)(ws + W_MIX + row * 1024 + h * 64 + dv0) = make_float4(v.x * silu(g.x), v.y * silu(g.y), v.z * silu(g.z), v.w * silu(g.w));
        };
        pa::attn_unit<96, true>(lds, wb + B_QP + row0 * 768 + h * 96, 768, wb + B_KP + (size_t)b * SEQ * 768 + h * 96, 768,
                                wb + B_VT + (size_t)(h * 64) * NP + (size_t)b * SEQ, NP, 4 * qb + 4, 256 * qb, out);
        continue;
      }
      item -= Q_PA;
      if (item < Q_SA) { sa::sample_attn_item(lds, p, wb + B_QS, ws + W_PO, ws + W_PML, item); continue; }
      item -= Q_SA;
      {
        const int qb = item & 15, h = (item >> 4) & 3, b = item >> 6;
        const size_t row0 = (size_t)b * SEQ + 256 * qb;
        auto out = [&](int ql, int dv0, float4 v) {
          const size_t row = row0 + ql;
          const float4 g = *(const float4*)(ws + W_PROJ + row * INC + C_GX + h * 64 + dv0);
          *(float4*)(ws + W_MIX + row * 1024 + 768 + h * 64 + dv0) = make_float4(v.x * silu(g.x), v.y * silu(g.y), v.z * silu(g.z), v.w * silu(g.w));
        };
        pa::attn_unit<64, false>(lds, wb + B_QX + row0 * 256 + h * 64, 256, wb + B_KM + (size_t)b * 65536 + h * 64, 256,
                                 wb + B_VMT + (size_t)b * 65536 + (size_t)(h * 64) * 256, 256, 4, 0, out);
      }
    }
    __syncthreads();
  }
  {
    constexpr int N_RS = 512, N_MA = 4 * (NS / 2);
    constexpr int TOT = N_RS + N_MA;
    float* wsm = sm + wv * 320;
    for (int it = gw; it < TOT; it += NGW) {
      int i = __builtin_amdgcn_readfirstlane(it);
      if (i < N_RS) { rwkv_scan_wave(p, false, i >> 2, i & 3, lane, wsm); continue; }
      i -= N_RS;
      mem_attn_wave(p, i, lane, wsm);
    }
  }
  }
  grid.sync();
  { PH_IDS

  for (int i = gtid; i < NS * 512; i += NTH) {
    const int c = i & 511, srow = i >> 9, h = c >> 6;
    const int db_ = srow >> 3, qi = (srow & 7) * 8 + h;
    const float* ml0 = ws + W_PML + ((size_t)(2 * db_) * 64 + qi) * 2; const float* ml1 = ml0 + 128;
    const float M_ = fmaxf(ml0[0], ml1[0]), w0_ = exp2f(ml0[0] - M_), w1_ = exp2f(ml1[0] - M_);
    const float invL = 1.f / (ml0[1] * w0_ + ml1[1] * w1_);
    const float* po0 = ws + W_PO + ((size_t)(2 * db_) * 64 + qi) * 128; const float* po1 = po0 + 64 * 128;
    float acc = 0.f;
#pragma unroll 4
    for (int k = 0; k < 128; ++k) acc += (po0[k] * w0_ + po1[k] * w1_) * p.w_uv[k * 512 + c];
    acc *= invL;
    const int row = NP + srow;
    const float g = ws[W_PROJ + (size_t)row * INC + C_GMLA + c];
    ws[W_MIX + (size_t)row * 1024 + c] = acc * silu(g);
  }
  for (int it = gw; it < NP * 4; it += NGW) {
    const int row = it >> 2, h = it & 3;
    const size_t off = (size_t)row * 256 + h * 64 + lane;
    const float y = ws[W_Y + off];
    const float mean = wave_sum(y) * (1.f / 64.f), d = y - mean, var = wave_sum(d * d) * (1.f / 64.f);
    const float yn = d * rsqrtf(var + GN_EPS) * p.lnx_g[h * 64 + lane] + p.lnx_b[h * 64 + lane];
    const float bsum = wave_sum(ws[W_R + off] * ws[W_KF + off] * p.r_k[h * 64 + lane]);
    const float o = yn + bsum * ws[W_VV + off];
    const float g = ws[W_PROJ + (size_t)row * INC + C_GRWKV + h * 64 + lane];
    ws[W_MIX + (size_t)row * 1024 + 512 + h * 64 + lane] = o * silu(g);
  }
  }
  grid.sync();
  { PH_IDS
  for (size_t i = gtid; i < (size_t)NT * 1024 / 4; i += NTH) {
    const float4 v = *(const float4*)(ws + W_MIX + i * 4);
    uint2 o; o.x = pk2(v.x, v.y); o.y = pk2(v.z, v.w);
    *(uint2*)(wb + B_MIX + i * 4) = o;
  }
  }
  grid.sync();
  { PH_IDS

  {
    pg8::Gemm g{wb + B_MIX, wb + B_WOUT, NT, 1024, 1024}; pg8::StaticOrder S; S.init(NT, 1024, (int)gridDim.x, (int)blockIdx.x);
    pg8::EpiF32 E{p.out, 1024, 1024, 0, 0, p.x_prompt, p.x_sample, NP};
    pg8::gemm_phase<pg8::EpiF32, pg8::StaticOrder, true, true>((PG8_LAS unsigned char*)lds, g, S, E);
  }
  }
  grid.sync();
  { PH_IDS

  for (int r = gw; r < NT; r += NGW) {
    float* y = p.out + (size_t)r * 1024;
    float v[16]; float ss = 0.f;
#pragma unroll
    for (int i = 0; i < 16; ++i) { v[i] = y[lane + 64 * i]; ss += v[i] * v[i]; }
    const float rs = rsqrtf(wave_sum(ss) * (1.f / 1024.f) + RMS_EPS);
#pragma unroll
    for (int i = 0; i < 16; ++i) y[lane + 64 * i] = v[i] * rs * p.final_g[lane + 64 * i];
  }
  }
#undef PH_IDS
}

extern "C" void kernel_launch(void* const* d_in, const int* in_sizes, int n_in, void* d_out,
                              int out_size, void* d_ws, size_t ws_size, hipStream_t stream) {
  static int grid_blocks = 0;
  if (!grid_blocks) {
    int dev = 0, cus = 0, per_cu = 0;
    (void)hipGetDevice(&dev);
    (void)hipDeviceGetAttribute(&cus, hipDeviceAttributeMultiprocessorCount, dev);
    (void)hipFuncSetAttribute((const void*)fwd_megakernel, hipFuncAttributeMaxDynamicSharedMemorySize, LDS_BYTES);
    (void)hipOccupancyMaxActiveBlocksPerMultiprocessor(&per_cu, fwd_megakernel, 512, LDS_BYTES);
    if (per_cu < 1) per_cu = 1;
    grid_blocks = cus;
    if (ws_size < WS_BYTES) fprintf(stderr, "workspace too small: %zu < %zu\n", ws_size, (size_t)WS_BYTES);
  }
  Params p{};
  const float** pf = (const float**)&p;
  (void)pf;
  p.x_prompt = (const float*)d_in[0]; p.x_sample = (const float*)d_in[1]; p.mem_prompt = (const float*)d_in[2];
  p.cache_ckv = (const float*)d_in[3]; p.cache_kpe = (const float*)d_in[4]; p.page_table = (const int*)d_in[5];
  p.state_wkv = (const float*)d_in[6]; p.state_shift = (const float*)d_in[7]; p.cache_mem_k = (const float*)d_in[8];
  p.cache_mem_v = (const float*)d_in[9]; p.ln_g = (const float*)d_in[10]; p.w_in = (const float*)d_in[11];
  p.q_norm_g = (const float*)d_in[12]; p.kv_norm_g = (const float*)d_in[13]; p.w_uq = (const float*)d_in[14];
  p.w_uk = (const float*)d_in[15]; p.w_uv = (const float*)d_in[16]; p.shift_mu = (const float*)d_in[17];
  p.w0 = (const float*)d_in[18]; p.w_up = (const float*)d_in[19]; p.a0 = (const float*)d_in[20]; p.a_up = (const float*)d_in[21];
  p.k_k = (const float*)d_in[22]; p.k_a = (const float*)d_in[23]; p.r_k = (const float*)d_in[24]; p.lnx_g = (const float*)d_in[25];
  p.lnx_b = (const float*)d_in[26]; p.mem_norm_g = (const float*)d_in[27]; p.w_mem_kv = (const float*)d_in[28];
  p.w_out = (const float*)d_in[29]; p.final_g = (const float*)d_in[30];
  p.out = (float*)d_out; p.ws = (float*)d_ws;
  void* args[] = {&p};
  hipError_t e = hipLaunchCooperativeKernel((void*)fwd_megakernel, dim3(grid_blocks), dim3(512), args, LDS_BYTES, stream);
  if (e != hipSuccess) fprintf(stderr, "cooperative launch failed: %s (grid %d)\n", hipGetErrorString(e), grid_blocks);
}
```

```cpp
#include <hip/hip_runtime.h>
#include <hip/hip_cooperative_groups.h>
#include <cstdio>
#include <cstdint>
namespace cg = cooperative_groups;

__device__ __forceinline__ int mk_tid(int wid_s) { int z; asm volatile("s_mov_b32 %0, 0" : "=s"(z)); return wid_s * 64 + (int)__builtin_amdgcn_mbcnt_hi(~0u, __builtin_amdgcn_mbcnt_lo(~0u, (unsigned)z)); }
namespace pg8 {
#define PG8_LAS __attribute__((address_space(3)))
typedef unsigned short bf16_t;
typedef short bf16x8 __attribute__((ext_vector_type(8)));
typedef float f32x4 __attribute__((ext_vector_type(4)));
typedef unsigned u32x4 __attribute__((ext_vector_type(4)));
constexpr int BM = 256, BK = 64, HALF = 128, HTB = HALF * BK * 2  , STAGE_BYTES = 8 * HTB, NXCD = 8, WGM = 8;

__host__ __device__ __forceinline__ int lds_byte(int r, int c) { const int st = (r >> 4) * 2 + (c >> 5), rr = r & 15, cc = c & 31, ob = rr * 64 + cc * 2; return st * 1024 + (ob ^ (((ob >> 9) & 1) << 5)); }
__host__ __device__ __forceinline__ void stage_rc(int b, int& R, int& C) { const int st = b / 1024, sb = b % 1024, swz = sb ^ (((sb >> 9) & 1) << 5); R = (st >> 1) * 16 + swz / 64; C = (st & 1) * 32 + (swz % 64) / 2; }
__host__ __device__ __forceinline__ int perm32(int rho) { const int n = rho >> 4, i = rho & 15; return 8 * (i >> 2) + 4 * n + (i & 3); }

struct Unit { int pm, pn; };
struct Gemm { const bf16_t* A; const bf16_t* Bt; int M, N, K; };

struct StaticOrder {
    int nM, nN, nwg, G, c;
    __host__ __device__ void init(int M, int N, int G_, int c_) { nM = M / BM; nN = N / BM; nwg = nM * nN; G = G_; c = c_; }
    __host__ __device__ bool next(int i, Unit& u) const {
        const long L = (long)i * G + c; if (L >= nwg) return false;
        int wgid = (int)L; { const int q = nwg / NXCD, r = nwg % NXCD, xcd = wgid % NXCD, off = wgid / NXCD; wgid = (xcd < r ? xcd * (q + 1) : r * (q + 1) + (xcd - r) * q) + off; }
        const int nig = WGM * nN, gid = wgid / nig, fm = gid * WGM, gsz = (nM - fm) < WGM ? (nM - fm) : WGM;
        u.pm = fm + ((wgid % nig) % gsz); u.pn = (wgid % nig) / gsz; return true;
    }
    __device__ __forceinline__ void a_ready(const Unit&) const {}
    __device__ __forceinline__ void done(const Unit&) const {}
};
__device__ __forceinline__ unsigned cvt_pk_bf16(float lo, float hi) { unsigned r; asm volatile("v_cvt_pk_bf16_f32 %0, %1, %2" : "=v"(r) : "v"(lo), "v"(hi)); return r; }
typedef float f32x2 __attribute__((ext_vector_type(2)));
template <class Epi, class Sched, bool ALIGN_EPI = false, bool SP2 = false>
__device__ __forceinline__ void gemm_phase(PG8_LAS unsigned char* lds, const Gemm g, const Sched& S, const Epi& E, int wid_s) {
    const int tid = mk_tid(wid_s), wid = wid_s, lane = tid & 63, wr = wid >> 2, wc = wid & 3, fr = lane & 15, fq = lane >> 4;
    const int K = g.K, nt = K / BK;
    unsigned voffA[2], voffB[2];
#pragma unroll
    for (int i = 0; i < 2; ++i) { int R, C; stage_rc(tid * 16 + i * 8192, R, C); const int Rb = Epi::PERM ? ((R & ~31) + perm32(R & 31)) : R;
        voffA[i] = (unsigned)(R * K + C) * 2u; voffB[i] = (unsigned)(Rb * K + C) * 2u; }
    const size_t kstep = (size_t)(BK * 2);
    const size_t hstep = (size_t)HALF * K * 2;
    const size_t tstep = 2 * hstep;
    const unsigned ldsw = (unsigned)wid * 1024u;
    const int aoff = lds_byte(wr * 64 + fr, fq * 8), boff = lds_byte(wc * 32 + fr, fq * 8);
#define PG8_SA(b, h) (((b) * 2 + (h)) * HTB)
#define PG8_SB(b, h) ((4 + (b) * 2 + (h)) * HTB)
#define PG8_STAGE(bufoff, gbase, voff) do { _Pragma("unroll") for (int _i = 0; _i < 2; ++_i) \
        __builtin_amdgcn_global_load_lds((const unsigned*)((const char*)(gbase) + (voff)[_i]), (PG8_LAS unsigned*)(lds + (bufoff) + ldsw + _i * 8192), 16, 0, 0); } while (0)
#define PG8_LDA(dst, b, h) do { _Pragma("unroll") for (int m = 0; m < 4; ++m) _Pragma("unroll") for (int k = 0; k < 2; ++k) dst[m][k] = *(const PG8_LAS bf16x8*)(lds + PG8_SA(b, h) + aoff + m * 2048 + k * 1024); } while (0)
#define PG8_LDB(dst, b, h) do { _Pragma("unroll") for (int n = 0; n < 2; ++n) _Pragma("unroll") for (int k = 0; k < 2; ++k) dst[n][k] = *(const PG8_LAS bf16x8*)(lds + PG8_SB(b, h) + boff + n * 2048 + k * 1024); } while (0)
#define PG8_MMA(ai, bj, At, Bt) do { __builtin_amdgcn_s_setprio(1); _Pragma("unroll") for (int m = 0; m < 4; ++m) _Pragma("unroll") for (int n = 0; n < 2; ++n) _Pragma("unroll") for (int k = 0; k < 2; ++k) \
        acc[ai][bj][m][n] = __builtin_amdgcn_mfma_f32_16x16x32_bf16(Bt[n][k], At[m][k], acc[ai][bj][m][n], 0, 0, 0); __builtin_amdgcn_s_setprio(0); } while (0)
#define PG8_WAIT_V(n) asm volatile("s_waitcnt vmcnt(" #n ")" ::: "memory")
#define PG8_WAIT_L(n) asm volatile("s_waitcnt lgkmcnt(" #n ")" ::: "memory")
#define PG8_BAR __builtin_amdgcn_s_barrier()
#define PG8_SCHED __builtin_amdgcn_sched_barrier(0)
    Unit cur, nxt; int ui = 0;
    if (!S.next(0, cur)) return;
    f32x4 acc[2][2][4][2];
#pragma unroll
    for (int a = 0; a < 2; ++a)
#pragma unroll
        for (int b = 0; b < 2; ++b)
#pragma unroll
            for (int m = 0; m < 4; ++m)
#pragma unroll
                for (int n = 0; n < 2; ++n) acc[a][b][m][n] = (f32x4){0.f, 0.f, 0.f, 0.f};
    bf16x8 At[4][2], B0[2][2], B1[2][2];
    const char* cA = (const char*)g.A + (size_t)cur.pm * tstep; const char* cB = (const char*)g.Bt + (size_t)cur.pn * tstep;
    S.a_ready(cur);
    if constexpr (SP2) {
        PG8_STAGE(PG8_SB(0, 0), cB, voffB); PG8_STAGE(PG8_SB(0, 1), cB + hstep, voffB); PG8_STAGE(PG8_SA(0, 0), cA, voffA); PG8_STAGE(PG8_SA(0, 1), cA + hstep, voffA);
        if (wr == 1) PG8_BAR;
        PG8_WAIT_V(2); PG8_BAR;
        PG8_STAGE(PG8_SB(1, 0), cB + kstep, voffB); PG8_STAGE(PG8_SA(1, 0), cA + kstep, voffA); PG8_STAGE(PG8_SB(1, 1), cB + hstep + kstep, voffB);
        PG8_WAIT_V(6); PG8_BAR;
    } else {
        PG8_STAGE(PG8_SB(0, 0), cB, voffB); PG8_STAGE(PG8_SA(0, 0), cA, voffA); PG8_STAGE(PG8_SB(0, 1), cB + hstep, voffB); PG8_STAGE(PG8_SA(0, 1), cA + hstep, voffA);
        if (wr == 1) PG8_BAR;
        PG8_WAIT_V(4); PG8_BAR;
        PG8_STAGE(PG8_SB(1, 0), cB + kstep, voffB); PG8_STAGE(PG8_SA(1, 0), cA + kstep, voffA); PG8_STAGE(PG8_SB(1, 1), cB + hstep + kstep, voffB);
        PG8_WAIT_V(6); PG8_BAR;
    }
    for (;;) {
        const bool has_next = S.next(ui + 1, nxt);
        const char* nA = has_next ? (const char*)g.A + (size_t)nxt.pm * tstep : cA; const char* nB = has_next ? (const char*)g.Bt + (size_t)nxt.pn * tstep : cB;
        for (int t = 0; t < nt; t += 2) {
            const bool last = (t == nt - 2);
            const char* a1 = cA + (size_t)(t + 1) * kstep;
            const char* a2 = last ? nA : cA + (size_t)(t + 2) * kstep; const char* b2 = last ? nB : cB + (size_t)(t + 2) * kstep;
            const char* a3 = a2 + kstep; const char* b3 = b2 + kstep;
            if (last && has_next) S.a_ready(nxt);
            if constexpr (SP2) {
            PG8_LDB(B0, 0, 0); PG8_LDB(B1, 0, 1); PG8_SCHED; PG8_LDA(At, 0, 0); PG8_STAGE(PG8_SA(1, 1), a1 + hstep, voffA);
            PG8_WAIT_V(8); PG8_WAIT_L(0); PG8_BAR; PG8_MMA(0, 0, At, B0); PG8_MMA(0, 1, At, B1); PG8_BAR; PG8_SCHED;
            PG8_LDA(At, 0, 1); PG8_STAGE(PG8_SB(0, 0), b2, voffB); PG8_STAGE(PG8_SB(0, 1), b2 + hstep, voffB); PG8_STAGE(PG8_SA(0, 0), a2, voffA);
            PG8_WAIT_V(8); PG8_WAIT_L(0); PG8_BAR; PG8_MMA(1, 0, At, B0); PG8_MMA(1, 1, At, B1); PG8_BAR; PG8_SCHED;
            PG8_LDB(B0, 1, 0); PG8_LDB(B1, 1, 1); PG8_SCHED; PG8_LDA(At, 1, 0); PG8_STAGE(PG8_SA(0, 1), a2 + hstep, voffA);
            PG8_WAIT_V(8); PG8_WAIT_L(0); PG8_BAR; PG8_MMA(0, 0, At, B0); PG8_MMA(0, 1, At, B1); PG8_BAR; PG8_SCHED;
            PG8_LDA(At, 1, 1); PG8_STAGE(PG8_SB(1, 0), b3, voffB); PG8_STAGE(PG8_SB(1, 1), b3 + hstep, voffB); PG8_STAGE(PG8_SA(1, 0), a3, voffA);
            PG8_WAIT_V(8); PG8_WAIT_L(0); PG8_BAR; PG8_MMA(1, 0, At, B0); PG8_MMA(1, 1, At, B1); PG8_BAR; PG8_SCHED;
            } else {
            PG8_LDB(B0, 0, 0); PG8_SCHED; PG8_LDA(At, 0, 0); PG8_STAGE(PG8_SA(1, 1), a1 + hstep, voffA);
            PG8_WAIT_L(8); PG8_BAR; PG8_WAIT_L(0); PG8_MMA(0, 0, At, B0); PG8_BAR; PG8_SCHED;
            PG8_LDB(B1, 0, 1); PG8_STAGE(PG8_SB(0, 0), b2, voffB);
            PG8_BAR; PG8_WAIT_L(0); PG8_MMA(0, 1, At, B1); PG8_BAR;
            PG8_LDA(At, 0, 1); PG8_STAGE(PG8_SA(0, 0), a2, voffA);
            PG8_BAR; PG8_WAIT_L(0); PG8_MMA(1, 0, At, B0); PG8_BAR; PG8_SCHED;
            PG8_STAGE(PG8_SB(0, 1), b2 + hstep, voffB);
            PG8_WAIT_V(6); PG8_BAR; PG8_MMA(1, 1, At, B1); PG8_BAR;
            PG8_LDB(B0, 1, 0); PG8_SCHED; PG8_LDA(At, 1, 0); PG8_STAGE(PG8_SA(0, 1), a2 + hstep, voffA);
            PG8_WAIT_L(8); PG8_BAR; PG8_WAIT_L(0); PG8_MMA(0, 0, At, B0); PG8_BAR; PG8_SCHED;
            PG8_LDB(B1, 1, 1); PG8_STAGE(PG8_SB(1, 0), b3, voffB);
            PG8_BAR; PG8_WAIT_L(0); PG8_MMA(0, 1, At, B1); PG8_BAR;
            PG8_LDA(At, 1, 1); PG8_STAGE(PG8_SA(1, 0), a3, voffA);
            PG8_BAR; PG8_WAIT_L(0); PG8_MMA(1, 0, At, B0); PG8_BAR; PG8_SCHED;
            PG8_STAGE(PG8_SB(1, 1), b3 + hstep, voffB);
            PG8_WAIT_V(6); PG8_BAR; PG8_MMA(1, 1, At, B1); PG8_BAR;
            }
        }
        if constexpr (ALIGN_EPI) { if (wr == 0) PG8_BAR; }
        if constexpr (!Epi::AFTER_DRAIN) { E(acc, cur, wr, wc, fr, fq); S.done(cur); }
        if (!has_next) break;
#pragma unroll
        for (int a = 0; a < 2; ++a)
#pragma unroll
            for (int b = 0; b < 2; ++b)
#pragma unroll
                for (int m = 0; m < 4; ++m)
#pragma unroll
                    for (int n = 0; n < 2; ++n) acc[a][b][m][n] = (f32x4){0.f, 0.f, 0.f, 0.f};
        cur = nxt; cA = nA; cB = nB; ++ui;
        if constexpr (ALIGN_EPI) { if (wr == 1) PG8_BAR; }
    }
    PG8_WAIT_V(0);
    if constexpr (!ALIGN_EPI) { if (wr == 0) PG8_BAR; }
    PG8_BAR;
    if constexpr (Epi::AFTER_DRAIN) { E.fused(acc, cur, wr, wc, fr, fq, lds, wid, lane); S.done(cur); }
#undef PG8_SA
#undef PG8_SB
#undef PG8_STAGE
#undef PG8_LDA
#undef PG8_LDB
#undef PG8_MMA
#undef PG8_WAIT_V
#undef PG8_WAIT_L
#undef PG8_BAR
#undef PG8_SCHED
}
}

namespace pg8 {
struct EpiF32 {
  static constexpr bool PERM = false, AFTER_DRAIN = false;
  float* C; int ldc; int ncols; int split_cols; size_t split_stride; const float* r0; const float* r1; int nr0;
  __device__ __forceinline__ void operator()(const f32x4 (&acc)[2][2][4][2], const Unit& u, int wr, int wc, int fr0, int fq0) const {
    int fr = fr0, fq = fq0; asm volatile("" : "+v"(fr), "+v"(fq));
    const int row0 = u.pm * BM + wr * 64 + fr; int colt = u.pn * BM; float* base = C;
    if (split_cols) { const int t = colt / split_cols; base += (size_t)t * split_stride; colt -= t * split_cols; }
    const int col0 = colt + wc * 32 + 4 * fq;
#pragma unroll
    for (int ai = 0; ai < 2; ++ai)
#pragma unroll
      for (int m = 0; m < 4; ++m) {
        const int row = row0 + ai * HALF + m * 16;
        const float* rr = r0 ? (row < nr0 ? r0 + (size_t)row * ldc : r1 + (size_t)(row - nr0) * ldc) : nullptr;
#pragma unroll
        for (int bj = 0; bj < 2; ++bj)
#pragma unroll
          for (int n = 0; n < 2; ++n) {
            const int col = col0 + bj * HALF + n * 16;
            if (col < ncols) { f32x4 v = acc[ai][bj][m][n]; if (rr) v += *(const f32x4*)(rr + col); *(f32x4*)(base + (size_t)row * ldc + col) = v; }
          }
      }
  }
};
}

constexpr int DM = 1024, BATCH = 4, SEQ = 4096, DB = 128, DT = 8, PAST = 8192, PAGE = 128, NPG = 64, NMEM = 256;
constexpr int NP = BATCH * SEQ, NS = DB * DT, NT = NP + NS;
constexpr int INC = 2592;
constexpr int C_CQ = 0, C_CKV = 256, C_KR = 384, C_GMLA = 416, C_Z = 928, C_GRWKV = 1824, C_QX = 2080, C_GX = 2336;
constexpr float MLA_SCALE = 0.10206207261596575f;
constexpr float X_SCALE = 0.125f;
constexpr float RMS_EPS = 1e-6f, GN_EPS = 64e-5f;
constexpr size_t O_YP = 0, O_YS = 16777216, O_CKVP = 17825792, O_KPEP = 19922944, O_WKVP = 20447232, O_SHP = 20512768,
                 O_MKP = 20516352, O_MVP = 20778496, O_CKVS = 21040640, O_KPES = 21171712, O_WKVS = 21204480, O_SHS = 23301632;
constexpr size_t W_H = 0;
constexpr size_t W_HM = W_H + (size_t)NT * 1024;
constexpr size_t W_PROJ = W_HM + (size_t)1024 * 1024;
constexpr size_t W_CQN = W_PROJ + (size_t)NT * INC;
constexpr size_t W_Q = W_CQN + (size_t)NT * 256;
constexpr size_t W_KN = W_Q + (size_t)NT * 768;
constexpr size_t W_V = W_KN + (size_t)NP * 512;
constexpr size_t W_QLAT = W_V + (size_t)NP * 512;
constexpr size_t W_OLAT = W_QLAT + (size_t)NS * 1024;
constexpr size_t W_R = W_OLAT + (size_t)NS * 1024;
constexpr size_t W_W = W_R + (size_t)NT * 256;
constexpr size_t W_KF = W_W + (size_t)NT * 256;
constexpr size_t W_VV = W_KF + (size_t)NT * 256;
constexpr size_t W_KK = W_VV + (size_t)NT * 256;
constexpr size_t W_BB = W_KK + (size_t)NT * 256;
constexpr size_t W_MIX = W_BB + (size_t)NT * 256;
constexpr size_t W_PO = W_MIX + (size_t)NT * 1024;
constexpr size_t W_PML = W_PO + (size_t)256 * 64 * 128;
constexpr size_t W_Y = W_PML + (size_t)256 * 64 * 2;
constexpr size_t W_CTL = W_Y + (size_t)NP * 256;
constexpr size_t W_CS = W_CTL + 64;
constexpr size_t W_END = W_CS + (size_t)4104 * 32;
constexpr int INCP = 2816;
constexpr size_t B_H = 0;
constexpr size_t B_HM = B_H + (size_t)NT * 1024;
constexpr size_t B_WIN = B_HM + (size_t)1024 * 1024;
constexpr size_t B_WMEM = B_WIN + (size_t)INCP * 1024;
constexpr size_t B_WOUT = B_WMEM + (size_t)512 * 1024;
constexpr size_t B_MIX = B_WOUT + (size_t)1024 * 1024;
constexpr size_t B_QP = B_MIX + (size_t)NT * 1024;
constexpr size_t B_KP = B_QP + (size_t)NP * 768;
constexpr size_t B_VT = B_KP + (size_t)NP * 768;
constexpr size_t B_QS = B_VT + (size_t)512 * NP;
constexpr size_t B_QX = B_QS + (size_t)NS * 8 * 160;
constexpr size_t B_KM = B_QX + (size_t)NP * 256;
constexpr size_t B_VMT = B_KM + (size_t)4 * 256 * 256;
constexpr size_t B_CQN = B_VMT + (size_t)4 * 256 * 256;
constexpr size_t B_CKVN = B_CQN + (size_t)NT * 256;
constexpr size_t B_WUQ = B_CKVN + (size_t)NP * 128;
constexpr size_t B_WQL = B_WUQ + (size_t)768 * 256;
constexpr size_t B_WUK = B_WQL + (size_t)1024 * 256;
constexpr size_t B_WUV = B_WUK + (size_t)512 * 128;
constexpr size_t B_OLAT = B_WUV + (size_t)512 * 128;
constexpr size_t B_WUVBD = B_OLAT + (size_t)NS * 1024;
constexpr size_t B_END = B_WUVBD + (size_t)512 * 1024;
constexpr size_t WS_BYTES = W_END * 4 + B_END * 2;
constexpr int LDS_BYTES = 147456;

struct Params {
  const float* x_prompt; const float* x_sample; const float* mem_prompt; const float* cache_ckv; const float* cache_kpe;
  const int* page_table; const float* state_wkv; const float* state_shift; const float* cache_mem_k; const float* cache_mem_v;
  const float* ln_g; const float* w_in; const float* q_norm_g; const float* kv_norm_g; const float* w_uq; const float* w_uk;
  const float* w_uv; const float* shift_mu; const float* w0; const float* w_up; const float* a0; const float* a_up;
  const float* k_k; const float* k_a; const float* r_k; const float* lnx_g; const float* lnx_b; const float* mem_norm_g;
  const float* w_mem_kv; const float* w_out; const float* final_g;
  float* out; float* ws;
};

__device__ __forceinline__ unsigned f2bf(float f);
__device__ __forceinline__ unsigned pk2(float lo, float hi);
typedef unsigned short bf16;
__device__ __forceinline__ float wave_sum(float v) {
#pragma unroll
  for (int o = 1; o < 64; o <<= 1) v += __shfl_xor(v, o);
  return v;
}
__device__ __forceinline__ float wave_max(float v) {
#pragma unroll
  for (int o = 1; o < 64; o <<= 1) v = fmaxf(v, __shfl_xor(v, o));
  return v;
}
__device__ __forceinline__ float silu(float x) { return x / (1.f + expf(-x)); }
__device__ __forceinline__ const float* xrow(const Params& p, int row) {
  return row < NP ? p.x_prompt + (size_t)row * DM : p.x_sample + (size_t)(row - NP) * DM;
}
__device__ __forceinline__ float* ckv_out_row(const Params& p, int row) {
  return row < NP ? p.out + O_CKVP + (size_t)row * 128 : p.out + O_CKVS + (size_t)(row - NP) * 128;
}
__device__ __forceinline__ float* kpe_out_row(const Params& p, int row) {
  return row < NP ? p.out + O_KPEP + (size_t)row * 32 : p.out + O_KPES + (size_t)(row - NP) * 32;
}

template <bool BT>
__device__ __forceinline__ void gemm_f32(const float* __restrict__ A, int lda, const float* __restrict__ B, int ldb, float* __restrict__ C, int ldc,
                         int M, int N, int K, float* sm) {
  const int tid = threadIdx.x, tx = tid & 15, ty = tid >> 4;
  float(*As)[68] = (float(*)[68])sm;
  float(*Bs)[68] = (float(*)[68])(sm + 16 * 68);
  const int tm = M / 64, tn = (N + 63) / 64;
  for (int tile = blockIdx.x; tile < tm * tn; tile += gridDim.x) {
    const int m0 = (tile / tn) * 64, n0 = (tile % tn) * 64;
    float acc[2][4];
#pragma unroll
    for (int i = 0; i < 2; ++i)
#pragma unroll
      for (int j = 0; j < 4; ++j) acc[i][j] = 0.f;
    for (int k0 = 0; k0 < K; k0 += 16) {
      for (int i = tid; i < 1024; i += 512) { const int r = i >> 4, kk = i & 15; As[kk][r] = A[(size_t)(m0 + r) * lda + k0 + kk]; }
      if (BT) {
        for (int i = tid; i < 1024; i += 512) { const int c = i >> 4, kk = i & 15; Bs[kk][c] = (n0 + c < N) ? B[(size_t)(n0 + c) * ldb + k0 + kk] : 0.f; }
      } else {
        for (int i = tid; i < 1024; i += 512) { const int kk = i >> 6, c = i & 63; Bs[kk][c] = (n0 + c < N) ? B[(size_t)(k0 + kk) * ldb + n0 + c] : 0.f; }
      }
      __syncthreads();
#pragma unroll
      for (int kk = 0; kk < 16; ++kk) {
        const float a0 = As[kk][ty * 2], a1 = As[kk][ty * 2 + 1];
        const float b0 = Bs[kk][tx * 4], b1 = Bs[kk][tx * 4 + 1], b2 = Bs[kk][tx * 4 + 2], b3 = Bs[kk][tx * 4 + 3];
        acc[0][0] += a0 * b0; acc[0][1] += a0 * b1; acc[0][2] += a0 * b2; acc[0][3] += a0 * b3;
        acc[1][0] += a1 * b0; acc[1][1] += a1 * b1; acc[1][2] += a1 * b2; acc[1][3] += a1 * b3;
      }
      __syncthreads();
    }
#pragma unroll
    for (int i = 0; i < 2; ++i)
#pragma unroll
      for (int j = 0; j < 4; ++j) { const int col = n0 + tx * 4 + j; if (col < N) C[(size_t)(m0 + ty * 2 + i) * ldc + col] = acc[i][j]; }
  }
}

template <int D1, int D2, int DV>
__device__ __forceinline__ void attn_row_tile(const float* wsm, const float* k1, const float* k2, const float* v, bool valid, int lane,
                                              float& m, float& l, float& o0, float& o1) {
  float sc = 0.f;
#pragma unroll 4
  for (int c = 0; c < D1; c += 4) { const float4 kv = *(const float4*)(k1 + c); sc += wsm[c] * kv.x + wsm[c + 1] * kv.y + wsm[c + 2] * kv.z + wsm[c + 3] * kv.w; }
  if (D2 > 0)
#pragma unroll 4
  for (int c = 0; c < D2; c += 4) { const float4 kv = *(const float4*)(k2 + c); sc += wsm[D1 + c] * kv.x + wsm[D1 + c + 1] * kv.y + wsm[D1 + c + 2] * kv.z + wsm[D1 + c + 3] * kv.w; }
  sc = valid ? sc : -1e30f;
  const float tmax = wave_max(sc), mn = fmaxf(m, tmax), alpha = expf(m - mn), pj = valid ? expf(sc - mn) : 0.f;
  l = l * alpha + wave_sum(pj); o0 *= alpha; o1 *= alpha;
  const unsigned long long pa = (unsigned long long)(uintptr_t)v;
  const int plo = (int)(unsigned)(pa & 0xffffffffull), phi = (int)(unsigned)(pa >> 32);
#pragma unroll 2
  for (int j = 0; j < 64; ++j) {
    const float pjj = __shfl(pj, j);
    const unsigned lo = (unsigned)__shfl(plo, j), hi = (unsigned)__shfl(phi, j);
    const float* vj = (const float*)(uintptr_t)(((unsigned long long)hi << 32) | lo);
    o0 += pjj * vj[lane];
    if (DV > 64) o1 += pjj * vj[64 + lane];
  }
  m = mn;
}

__device__ __forceinline__ void prompt_attn_wave(const Params& p, int bh, int qb, int lane, float* wsm) {
  const int b = bh >> 3, h = bh & 7;
  const float* Q = p.ws + W_Q; const float* KN = p.ws + W_KN; const float* V = p.ws + W_V; const float* KPE = p.out + O_KPEP;
  for (int qi = 0; qi < 64; ++qi) {
    const int s = qb * 64 + qi, row = b * SEQ + s;
    wsm[lane] = Q[(size_t)row * 768 + h * 96 + lane] * MLA_SCALE;
    if (lane < 32) wsm[64 + lane] = Q[(size_t)row * 768 + h * 96 + 64 + lane] * MLA_SCALE;
    float m = -1e30f, l = 0.f, o0 = 0.f, o1 = 0.f;
    for (int tile = 0; tile <= qb; ++tile) {
      const int j = tile * 64 + lane;
      const size_t krow = (size_t)b * SEQ + j;
      attn_row_tile<64, 32, 64>(wsm, KN + krow * 512 + h * 64, KPE + krow * 32, V + krow * 512 + h * 64, j <= s, lane, m, l, o0, o1);
    }
    const float g = p.ws[W_PROJ + (size_t)row * INC + C_GMLA + h * 64 + lane];
    p.ws[W_MIX + (size_t)row * 1024 + h * 64 + lane] = o0 / l * silu(g);
  }
}

__device__ __forceinline__ void sample_attn_wave(const Params& p, int rowid  , int lane, float* wsm) {
  const int h = rowid & 7, t = (rowid >> 3) & 7, db = rowid >> 6;
  const int srow = db * 8 + t, row = NP + srow;
  const float* QLAT = p.ws + W_QLAT; const float* Q = p.ws + W_Q;
  wsm[lane] = QLAT[(size_t)srow * 1024 + h * 128 + lane] * MLA_SCALE;
  wsm[64 + lane] = QLAT[(size_t)srow * 1024 + h * 128 + 64 + lane] * MLA_SCALE;
  if (lane < 32) wsm[128 + lane] = Q[(size_t)row * 768 + h * 96 + 64 + lane] * MLA_SCALE;
  float m = -1e30f, l = 0.f, o0 = 0.f, o1 = 0.f;
  for (int tile = 0; tile <= 128; ++tile) {
    const float* ckv; const float* kpe; bool valid;
    if (tile < 128) {
      const int k = tile * 64 + lane;
      const int page = p.page_table[db * NPG + (k >> 7)];
      const size_t base = (size_t)page * PAGE + (k & 127);
      ckv = p.cache_ckv + base * 128; kpe = p.cache_kpe + base * 32; valid = true;
    } else {
      const int u = lane < 8 ? lane : 0;
      valid = (lane < 8) && (lane <= t);
      ckv = p.out + O_CKVS + (size_t)(db * 8 + u) * 128; kpe = p.out + O_KPES + (size_t)(db * 8 + u) * 32;
    }
    attn_row_tile<128, 32, 128>(wsm, ckv, kpe, ckv, valid, lane, m, l, o0, o1);
  }
  float* OLAT = p.ws + W_OLAT;
  OLAT[(size_t)srow * 1024 + h * 128 + lane] = o0 / l;
  OLAT[(size_t)srow * 1024 + h * 128 + 64 + lane] = o1 / l;
}

__device__ __forceinline__ void mem_attn_wave(const Params& p, int item, int lane, float* wsm) {
  const int h = item / (NS / 2), r0 = NP + (item - h * (NS / 2)) * 2;
  for (int ri = 0; ri < 2; ++ri) {
    const int row = r0 + ri;
    const int db = (row - NP) >> 3;
    const float* kbase = p.cache_mem_k + (size_t)db * 256 * 256 + h * 64; const float* vbase = p.cache_mem_v + (size_t)db * 256 * 256 + h * 64;
    wsm[lane] = p.ws[W_PROJ + (size_t)row * INC + C_QX + h * 64 + lane] * X_SCALE;
    float m = -1e30f, l = 0.f, o0 = 0.f, o1 = 0.f;
    for (int tile = 0; tile < 4; ++tile) {
      const int j = tile * 64 + lane;
      attn_row_tile<64, 0, 64>(wsm, kbase + (size_t)j * 256, nullptr, vbase + (size_t)j * 256, true, lane, m, l, o0, o1);
    }
    const float g = p.ws[W_PROJ + (size_t)row * INC + C_GX + h * 64 + lane];
    ((bf16*)(p.ws + W_END))[B_MIX + (size_t)row * 1024 + 768 + h * 64 + lane] = (bf16)f2bf(o0 / l * silu(g));
  }
}

#define CBAR() asm volatile("" ::: "memory")
__device__ __forceinline__ void rwkv_scan_wave(const Params& p, bool prompt, int bi, int h, int lane, float* wsm  ) {
  float S[64];
  const float* s0 = p.state_wkv + ((size_t)(bi * 4 + h) * 64 + lane) * 64;
#pragma unroll
  for (int k = 0; k < 64; ++k) S[k] = prompt ? 0.f : s0[k];
  const int T = prompt ? SEQ : DT, row0 = prompt ? bi * SEQ : NP + bi * DT;
  const float lg = p.lnx_g[h * 64 + lane], lb = p.lnx_b[h * 64 + lane], rk = p.r_k[h * 64 + lane];
#pragma unroll 1
  for (int t = 0; t < T; ++t) {
    const int row = row0 + t;
    const size_t off = (size_t)row * 256 + h * 64 + lane;
    const float r_l = p.ws[W_R + off], w_l = p.ws[W_W + off], kf_l = p.ws[W_KF + off], kk_l = p.ws[W_KK + off], bb_l = p.ws[W_BB + off];
    const float vv = p.ws[W_VV + off];
    wsm[lane] = kk_l; wsm[64 + lane] = w_l; wsm[128 + lane] = bb_l; wsm[192 + lane] = kf_l; wsm[256 + lane] = r_l;
    CBAR();
    float sa = 0.f;
#pragma unroll
    for (int c = 0; c < 4; ++c) {
#pragma unroll
      for (int k = 16 * c; k < 16 * c + 16; ++k) sa += S[k] * wsm[k];
      CBAR();
    }
    sa = -sa;
    float y = 0.f;
#pragma unroll
    for (int c = 0; c < 8; ++c) {
#pragma unroll
      for (int k = 8 * c; k < 8 * c + 8; ++k) { S[k] = S[k] * wsm[64 + k] + sa * wsm[128 + k] + vv * wsm[192 + k]; y += S[k] * wsm[256 + k]; }
      CBAR();
    }
    const float mean = wave_sum(y) * (1.f / 64.f), d = y - mean, var = wave_sum(d * d) * (1.f / 64.f);
    const float yn = d * rsqrtf(var + GN_EPS) * lg + lb;
    const float bsum = wave_sum(r_l * kf_l * rk);
    const float o = yn + bsum * vv;
    const float g = p.ws[W_PROJ + (size_t)row * INC + C_GRWKV + h * 64 + lane];
    ((bf16*)(p.ws + W_END))[B_MIX + (size_t)row * 1024 + 512 + h * 64 + lane] = (bf16)f2bf(o * silu(g));
    CBAR();
  }
  float* so = prompt ? p.out + O_WKVP + ((size_t)(bi * 4 + h) * 64 + lane) * 64 : p.out + O_WKVS + ((size_t)(bi * 4 + h) * 64 + lane) * 64;
#pragma unroll
  for (int k = 0; k < 64; ++k) so[k] = S[k];
}


namespace pg8 {
typedef unsigned u32x2 __attribute__((ext_vector_type(2)));
template <class F> struct EpiBf16F {
  static constexpr bool PERM = true, AFTER_DRAIN = false;
  F f; float scale;
  __device__ __forceinline__ void operator()(const f32x4 (&acc)[2][2][4][2], const Unit& u, int wr, int wc, int fr, int fq) const {
    int fr_ = fr, fq_ = fq; asm volatile("" : "+v"(fr_), "+v"(fq_));
    const int row0 = u.pm * BM + wr * 64 + fr_, col0 = u.pn * BM + wc * 32 + 8 * fq_;
#pragma unroll
    for (int ai = 0; ai < 2; ++ai)
#pragma unroll
      for (int m = 0; m < 4; ++m)
#pragma unroll
        for (int bj = 0; bj < 2; ++bj) {
          bf16_t* dst = f(row0 + ai * HALF + m * 16, col0 + bj * HALF);
          if (dst) { const f32x4 v0 = acc[ai][bj][m][0] * scale, v1 = acc[ai][bj][m][1] * scale;
            u32x4 w; w.x = cvt_pk_bf16(v0[0], v0[1]); w.y = cvt_pk_bf16(v0[2], v0[3]); w.z = cvt_pk_bf16(v1[0], v1[1]); w.w = cvt_pk_bf16(v1[2], v1[3]);
            *(u32x4*)dst = w; }
        }
  }
};
struct EpiQ {
  static constexpr bool PERM = false, AFTER_DRAIN = false;
  bf16_t* Qp; bf16_t* Qs; const float* CS; float scale; int np;
  __device__ __forceinline__ void operator()(const f32x4 (&acc)[2][2][4][2], const Unit& u, int wr, int wc, int fr0, int fq0) const {
    int fr = fr0, fq = fq0; asm volatile("" : "+v"(fr), "+v"(fq));
    const int row0 = u.pm * BM + wr * 64 + fr;
    if (u.pn < 2) {
      if (u.pm * BM >= np) return;
#pragma unroll
      for (int ai = 0; ai < 2; ++ai)
#pragma unroll
        for (int m = 0; m < 4; ++m) {
          const int row = row0 + ai * HALF + m * 16;
#pragma unroll
          for (int bj = 0; bj < 2; ++bj)
#pragma unroll
            for (int n = 0; n < 2; ++n) {
              const int col = u.pn * BM + bj * HALF + wc * 32 + 16 * n + 4 * fq, head = col >> 6, d = col & 63;
              const f32x4 v = acc[ai][bj][m][n] * scale;
              *(u32x2*)(Qp + (size_t)row * 768 + head * 96 + d) = (u32x2){cvt_pk_bf16(v[0], v[1]), cvt_pk_bf16(v[2], v[3])};
            }
        }
    } else {
#pragma unroll
      for (int ai = 0; ai < 2; ++ai)
#pragma unroll
        for (int m = 0; m < 4; ++m) {
          const int row = row0 + ai * HALF + m * 16;
          const bool pr = row < np;
          const int pi = pr ? (row & 4095) : 4096 + ((row - np) & 7);
#pragma unroll
          for (int n = 0; n < 2; ++n) {
            const int head = 2 * wc + n, j = 4 * fq;
            const f32x4 cs0 = *(const f32x4*)(CS + ((size_t)pi * 16 + j) * 2), cs1 = *(const f32x4*)(CS + ((size_t)pi * 16 + j) * 2 + 4);
            const f32x4 x1 = acc[ai][0][m][n], x2 = acc[ai][1][m][n];
            f32x4 y1, y2;
            y1[0] = x1[0] * cs0[0] - x2[0] * cs0[1]; y2[0] = x2[0] * cs0[0] + x1[0] * cs0[1];
            y1[1] = x1[1] * cs0[2] - x2[1] * cs0[3]; y2[1] = x2[1] * cs0[2] + x1[1] * cs0[3];
            y1[2] = x1[2] * cs1[0] - x2[2] * cs1[1]; y2[2] = x2[2] * cs1[0] + x1[2] * cs1[1];
            y1[3] = x1[3] * cs1[2] - x2[3] * cs1[3]; y2[3] = x2[3] * cs1[2] + x1[3] * cs1[3];
            y1 = y1 * scale; y2 = y2 * scale;
            bf16_t* dst = pr ? Qp + (size_t)row * 768 + head * 96 + 64 + j : Qs + ((size_t)(row - np) * 8 + head) * 160 + 128 + j;
            *(u32x2*)dst = (u32x2){cvt_pk_bf16(y1[0], y1[1]), cvt_pk_bf16(y1[2], y1[3])};
            *(u32x2*)(dst + 16) = (u32x2){cvt_pk_bf16(y2[0], y2[1]), cvt_pk_bf16(y2[2], y2[3])};
          }
        }
    }
  }
};
}

namespace pg8 {
struct EpiGateBf16 {
  static constexpr bool PERM = true, AFTER_DRAIN = false;
  bf16_t* O; int ldo; const float* G; int ldg;
  __device__ __forceinline__ float sl(float x) const { return x / (1.f + __expf(-x)); }
  __device__ __forceinline__ void operator()(const f32x4 (&acc)[2][2][4][2], const Unit& u, int wr, int wc, int fr0, int fq0) const {
    int fr = fr0, fq = fq0; asm volatile("" : "+v"(fr), "+v"(fq));
    const int row0 = u.pm * BM + wr * 64 + fr, col0 = u.pn * BM + wc * 32 + 8 * fq;
#pragma unroll
    for (int ai = 0; ai < 2; ++ai)
#pragma unroll
      for (int m = 0; m < 4; ++m)
#pragma unroll
        for (int bj = 0; bj < 2; ++bj) {
          const int row = row0 + ai * HALF + m * 16, col = col0 + bj * HALF;
          const f32x4 g0 = *(const f32x4*)(G + (size_t)row * ldg + col), g1 = *(const f32x4*)(G + (size_t)row * ldg + col + 4);
          const f32x4 v0 = acc[ai][bj][m][0], v1 = acc[ai][bj][m][1];
          u32x4 w; w.x = cvt_pk_bf16(v0[0] * sl(g0[0]), v0[1] * sl(g0[1])); w.y = cvt_pk_bf16(v0[2] * sl(g0[2]), v0[3] * sl(g0[3]));
          w.z = cvt_pk_bf16(v1[0] * sl(g1[0]), v1[1] * sl(g1[1])); w.w = cvt_pk_bf16(v1[2] * sl(g1[2]), v1[3] * sl(g1[3]));
          *(u32x4*)(O + (size_t)row * ldo + col) = w;
        }
  }
};
}
#define LAS __attribute__((address_space(3)))
namespace pa {
typedef short bf16x8 __attribute__((ext_vector_type(8)));
typedef short s16x4 __attribute__((ext_vector_type(4)));
typedef float f32x16 __attribute__((ext_vector_type(16)));
typedef unsigned u32x4 __attribute__((ext_vector_type(4)));
typedef unsigned u32x2 __attribute__((ext_vector_type(2)));
typedef float f32x2_t __attribute__((ext_vector_type(2)));
typedef __bf16 bf16x2_t __attribute__((ext_vector_type(2)));
constexpr int KSTR = 208, VSTR = 136, KBYTES = 64 * KSTR, VBYTES = 64 * VSTR, STG = KBYTES + VBYTES;
__device__ __forceinline__ unsigned cvtpk(float lo, float hi) { f32x2_t v = {lo, hi}; bf16x2_t b = __builtin_convertvector(v, bf16x2_t); return __builtin_bit_cast(unsigned, b); }
__device__ __forceinline__ int crow(int r, int hi) { return (r & 3) + 8 * (r >> 2) + 4 * hi; }
__device__ __forceinline__ float swap_max(float v) { auto rr = __builtin_amdgcn_permlane32_swap(__float_as_uint(v), __float_as_uint(v), false, false); return fmaxf(__uint_as_float(rr[0]), __uint_as_float(rr[1])); }
__device__ __forceinline__ float swap_sum(float v) { auto rr = __builtin_amdgcn_permlane32_swap(__float_as_uint(v), __float_as_uint(v), false, false); return __uint_as_float(rr[0]) + __uint_as_float(rr[1]); }

template <int DQK, bool CAUSAL, class Out>
__device__ __forceinline__ void attn_unit(unsigned char* lds, const bf16* Qb, int qs, const bf16* Kb, int ks, const bf16* Vb, int vs, int ntiles, int qpos0, const Out& out, int wid_s) {
  const int tid = mk_tid(wid_s), lane = tid & 63, wid = wid_s, r32 = lane & 31, hi = lane >> 5;
  constexpr int CPR = DQK / 8, NKC = 64 * CPR, KS = DQK / 16;
  bf16x8 qf[KS];
#pragma unroll
  for (int s = 0; s < KS; ++s) qf[s] = *(const bf16x8*)(Qb + (size_t)(wid * 32 + r32) * qs + 16 * s + 8 * hi);
  u32x4 kreg0, kreg1, vreg;
  const int kc0 = tid, kc1 = tid + 512;
  const int krow0 = kc0 / CPR, kcc0 = kc0 % CPR, krow1 = kc1 / CPR, kcc1 = kc1 % CPR;
  const int vdv = tid >> 3, vcc = tid & 7;
#define PA_GLOAD(t) do { kreg0 = *(const u32x4*)(Kb + (size_t)(64 * (t) + krow0) * ks + kcc0 * 8); \
    if (kc1 < NKC) kreg1 = *(const u32x4*)(Kb + (size_t)(64 * (t) + krow1) * ks + kcc1 * 8); \
    vreg = *(const u32x4*)(Vb + (size_t)vdv * vs + 64 * (t) + vcc * 8); } while (0)
#define PA_LSTORE(buf) do { unsigned char* b_ = lds + (buf) * STG; *(u32x4*)(b_ + krow0 * KSTR + kcc0 * 16) = kreg0; \
    if (kc1 < NKC) *(u32x4*)(b_ + krow1 * KSTR + kcc1 * 16) = kreg1; \
    *(u32x2*)(b_ + KBYTES + vdv * VSTR + vcc * 16) = (u32x2){vreg.x, vreg.y}; *(u32x2*)(b_ + KBYTES + vdv * VSTR + vcc * 16 + 8) = (u32x2){vreg.z, vreg.w}; } while (0)
  PA_GLOAD(0); PA_LSTORE(0); __syncthreads();
  f32x16 o0, o1;
#pragma unroll
  for (int r = 0; r < 16; ++r) { o0[r] = 0.f; o1[r] = 0.f; }
  float m = -1e30f, l = 0.f;
  const int qlo = qpos0 + 32 * wid;
  for (int t = 0; t < ntiles; ++t) {
    if (t + 1 < ntiles) PA_GLOAD(t + 1);
    const unsigned char* kb = lds + (t & 1) * STG; const unsigned char* vb = kb + KBYTES;
    const bool active = !CAUSAL || (64 * t <= qlo + 31);
    if (active) {
      f32x16 p0, p1;
#pragma unroll
      for (int r = 0; r < 16; ++r) { p0[r] = 0.f; p1[r] = 0.f; }
#pragma unroll
      for (int s = 0; s < KS; ++s) {
        const bf16x8 a0 = *(const bf16x8*)(kb + r32 * KSTR + (16 * s + 8 * hi) * 2);
        const bf16x8 a1 = *(const bf16x8*)(kb + (32 + r32) * KSTR + (16 * s + 8 * hi) * 2);
        p0 = __builtin_amdgcn_mfma_f32_32x32x16_bf16(a0, qf[s], p0, 0, 0, 0);
        p1 = __builtin_amdgcn_mfma_f32_32x32x16_bf16(a1, qf[s], p1, 0, 0, 0);
      }
      if (CAUSAL && (64 * t + 63 > qlo)) {
        const int q = qlo + r32;
#pragma unroll
        for (int r = 0; r < 16; ++r) { const int key = 64 * t + crow(r, hi); if (key > q) p0[r] = -1e30f; if (key + 32 > q) p1[r] = -1e30f; }
      }
      float mx = fmaxf(p0[0], p1[0]);
#pragma unroll
      for (int r = 1; r < 16; ++r) mx = fmaxf(mx, fmaxf(p0[r], p1[r]));
      mx = swap_max(mx);
      const float mn = fmaxf(m, mx), alpha = __builtin_amdgcn_exp2f(m - mn);
      m = mn;
      float ps = 0.f;
#pragma unroll
      for (int r = 0; r < 16; ++r) { p0[r] = __builtin_amdgcn_exp2f(p0[r] - mn); p1[r] = __builtin_amdgcn_exp2f(p1[r] - mn); ps += p0[r] + p1[r]; }
      l = l * alpha + ps;
#pragma unroll
      for (int r = 0; r < 16; ++r) { o0[r] *= alpha; o1[r] *= alpha; }
      bf16x8 pb[4];
#pragma unroll
      for (int k = 0; k < 4; ++k) {
        u32x4 w;
        if (k < 2) { w.x = cvtpk(p0[8 * k], p0[8 * k + 1]); w.y = cvtpk(p0[8 * k + 2], p0[8 * k + 3]); w.z = cvtpk(p0[8 * k + 4], p0[8 * k + 5]); w.w = cvtpk(p0[8 * k + 6], p0[8 * k + 7]); }
        else { const int kk = k - 2; w.x = cvtpk(p1[8 * kk], p1[8 * kk + 1]); w.y = cvtpk(p1[8 * kk + 2], p1[8 * kk + 3]); w.z = cvtpk(p1[8 * kk + 4], p1[8 * kk + 5]); w.w = cvtpk(p1[8 * kk + 6], p1[8 * kk + 7]); }
        pb[k] = __builtin_bit_cast(bf16x8, w);
      }
#pragma unroll
      for (int k = 0; k < 4; ++k) {
#pragma unroll
        for (int d = 0; d < 2; ++d) {
          const unsigned char* vp = vb + (32 * d + r32) * VSTR + (16 * k + 4 * hi) * 2;
          const u32x2 lo = *(const u32x2*)vp, hi2 = *(const u32x2*)(vp + 16);
          const u32x4 w = {lo.x, lo.y, hi2.x, hi2.y};
          const bf16x8 va = __builtin_bit_cast(bf16x8, w);
          if (d == 0) o0 = __builtin_amdgcn_mfma_f32_32x32x16_bf16(va, pb[k], o0, 0, 0, 0);
          else o1 = __builtin_amdgcn_mfma_f32_32x32x16_bf16(va, pb[k], o1, 0, 0, 0);
        }
      }
    }
    if (t + 1 < ntiles) PA_LSTORE((t + 1) & 1);
    __syncthreads();
  }
#undef PA_GLOAD
#undef PA_LSTORE
  const float inv = 1.f / swap_sum(l);
#pragma unroll
  for (int g = 0; g < 4; ++g) {
    out(32 * wid + r32, 8 * g + 4 * hi, make_float4(o0[4 * g] * inv, o0[4 * g + 1] * inv, o0[4 * g + 2] * inv, o0[4 * g + 3] * inv));
    out(32 * wid + r32, 32 + 8 * g + 4 * hi, make_float4(o1[4 * g] * inv, o1[4 * g + 1] * inv, o1[4 * g + 2] * inv, o1[4 * g + 3] * inv));
  }
}
}

namespace sa {
using pa::bf16x8; using pa::f32x16; using pa::u32x4; using pa::u32x2; using pa::cvtpk; using pa::crow; using pa::swap_max; using pa::swap_sum;
typedef float f32x4 __attribute__((ext_vector_type(4)));
typedef short v4i16_t __attribute__((ext_vector_type(4)));
constexpr int KVSTR = 336, TILE = 64 * KVSTR;
__device__ __forceinline__ void sample_attn_item(unsigned char* lds, const Params& p, const bf16* Qs, float* PO, float* PML, int item, int wid_s) {
  const int db = item >> 1, half = item & 1;
  const int tid = mk_tid(wid_s), lane = tid & 63, wid = wid_s, r32 = lane & 31, hi = lane >> 5;
  const int qt = wid >> 2, ct = wid & 3;
  bf16x8 qf[10];
#pragma unroll
  for (int s = 0; s < 10; ++s) qf[s] = *(const bf16x8*)(Qs + (size_t)(db * 64 + 32 * qt + r32) * 160 + 16 * s + 8 * hi);
  const int ntiles = 64 + half;
  f32x4 st0, st1, st2, st3, sp;
  const f32x4 zero4 = {0.f, 0.f, 0.f, 0.f};
#define SA_GLOAD(t) do { if ((t) < 64) { const int key0_ = 4096 * half + 64 * (t); const int page_ = p.page_table[db * NPG + (key0_ >> 7)]; \
      const size_t base_ = (size_t)page_ * PAGE + (key0_ & 127); const float* ck_ = p.cache_ckv + base_ * 128; const float* kp_ = p.cache_kpe + base_ * 32; \
      st0 = *(const f32x4*)(ck_ + (size_t)(tid) * 4); st1 = *(const f32x4*)(ck_ + (size_t)(tid + 512) * 4); st2 = *(const f32x4*)(ck_ + (size_t)(tid + 1024) * 4); st3 = *(const f32x4*)(ck_ + (size_t)(tid + 1536) * 4); \
      sp = *(const f32x4*)(kp_ + (size_t)tid * 4); \
    } else { const float* ck_ = p.out + O_CKVS + (size_t)db * 8 * 128; const float* kp_ = p.out + O_KPES + (size_t)db * 8 * 32; \
      st0 = (tid < 256) ? *(const f32x4*)(ck_ + (size_t)tid * 4) : zero4; st1 = zero4; st2 = zero4; st3 = zero4; \
      sp = (tid < 64) ? *(const f32x4*)(kp_ + (size_t)tid * 4) : zero4; } } while (0)
#define SA_ST1(buf, f_, v_) do { const int key_ = (f_) >> 5, c4_ = (f_) & 31; *(u32x2*)(lds + (buf) * TILE + key_ * KVSTR + c4_ * 8) = (u32x2){cvtpk((v_).x, (v_).y), cvtpk((v_).z, (v_).w)}; } while (0)
#define SA_LSTORE(buf) do { SA_ST1(buf, tid, st0); SA_ST1(buf, tid + 512, st1); SA_ST1(buf, tid + 1024, st2); SA_ST1(buf, tid + 1536, st3); \
    { const int key_ = tid >> 3, c4_ = tid & 7; *(u32x2*)(lds + (buf) * TILE + key_ * KVSTR + 256 + c4_ * 8) = (u32x2){cvtpk(sp.x, sp.y), cvtpk(sp.z, sp.w)}; } } while (0)
  SA_GLOAD(0); SA_LSTORE(0); __syncthreads();
  f32x16 o;
#pragma unroll
  for (int r = 0; r < 16; ++r) o[r] = 0.f;
  float m = -1e30f, l = 0.f;
  const int tq = (32 * qt + r32) >> 3;
  for (int t = 0; t < ntiles; ++t) {
    if (t + 1 < ntiles) SA_GLOAD(t + 1);
    const unsigned char* kb = lds + (t & 1) * TILE;
    f32x16 p0, p1;
#pragma unroll
    for (int r = 0; r < 16; ++r) { p0[r] = 0.f; p1[r] = 0.f; }
#pragma unroll
    for (int s = 0; s < 10; ++s) {
      const bf16x8 a0 = *(const bf16x8*)(kb + r32 * KVSTR + (16 * s + 8 * hi) * 2);
      const bf16x8 a1 = *(const bf16x8*)(kb + (32 + r32) * KVSTR + (16 * s + 8 * hi) * 2);
      p0 = __builtin_amdgcn_mfma_f32_32x32x16_bf16(a0, qf[s], p0, 0, 0, 0);
      p1 = __builtin_amdgcn_mfma_f32_32x32x16_bf16(a1, qf[s], p1, 0, 0, 0);
    }
    if (t == 64) {
#pragma unroll
      for (int r = 0; r < 16; ++r) { const int u = crow(r, hi); if (!(u < 8 && u <= tq)) p0[r] = -1e30f; p1[r] = -1e30f; }
    }
    float mx = fmaxf(p0[0], p1[0]);
#pragma unroll
    for (int r = 1; r < 16; ++r) mx = fmaxf(mx, fmaxf(p0[r], p1[r]));
    mx = swap_max(mx);
    const float mn = fmaxf(m, mx), alpha = __builtin_amdgcn_exp2f(m - mn);
    m = mn;
    float ps = 0.f;
#pragma unroll
    for (int r = 0; r < 16; ++r) { p0[r] = __builtin_amdgcn_exp2f(p0[r] - mn); p1[r] = __builtin_amdgcn_exp2f(p1[r] - mn); ps += p0[r] + p1[r]; }
    l = l * alpha + ps;
#pragma unroll
    for (int r = 0; r < 16; ++r) o[r] *= alpha;
    bf16x8 pb[4];
#pragma unroll
    for (int k = 0; k < 4; ++k) {
      u32x4 w;
      if (k < 2) { w.x = cvtpk(p0[8 * k], p0[8 * k + 1]); w.y = cvtpk(p0[8 * k + 2], p0[8 * k + 3]); w.z = cvtpk(p0[8 * k + 4], p0[8 * k + 5]); w.w = cvtpk(p0[8 * k + 6], p0[8 * k + 7]); }
      else { const int kk = k - 2; w.x = cvtpk(p1[8 * kk], p1[8 * kk + 1]); w.y = cvtpk(p1[8 * kk + 2], p1[8 * kk + 3]); w.z = cvtpk(p1[8 * kk + 4], p1[8 * kk + 5]); w.w = cvtpk(p1[8 * kk + 6], p1[8 * kk + 7]); }
      pb[k] = __builtin_bit_cast(bf16x8, w);
    }
    {
      const int g = lane >> 4, i = lane & 15;
      const LAS unsigned char* vbase = (const LAS unsigned char*)kb + (4 * (g >> 1) + (i >> 2)) * KVSTR + (32 * ct + 16 * (g & 1) + 4 * (i & 3)) * 2;
#pragma unroll
      for (int k = 0; k < 4; ++k) {
        const v4i16_t lo = __builtin_amdgcn_ds_read_tr16_b64_v4i16((LAS v4i16_t*)(vbase + (16 * k) * KVSTR));
        const v4i16_t hi4 = __builtin_amdgcn_ds_read_tr16_b64_v4i16((LAS v4i16_t*)(vbase + (16 * k + 8) * KVSTR));
        const bf16x8 va = {lo[0], lo[1], lo[2], lo[3], hi4[0], hi4[1], hi4[2], hi4[3]};
        o = __builtin_amdgcn_mfma_f32_32x32x16_bf16(va, pb[k], o, 0, 0, 0);
      }
    }
    if (t + 1 < ntiles) SA_LSTORE((t + 1) & 1);
    __syncthreads();
  }
#undef SA_GLOAD
#undef SA_ST1
#undef SA_LSTORE
  const float lt = swap_sum(l);
  const int q = 32 * qt + r32;
  if (ct == 0 && hi == 0) { PML[((size_t)item * 64 + q) * 2] = m; PML[((size_t)item * 64 + q) * 2 + 1] = lt; }
#pragma unroll
  for (int g4 = 0; g4 < 4; ++g4) {
    const int c0 = 32 * ct + 8 * g4 + 4 * hi;
    *(f32x4*)(PO + ((size_t)item * 64 + q) * 128 + c0) = (f32x4){o[4 * g4], o[4 * g4 + 1], o[4 * g4 + 2], o[4 * g4 + 3]};
  }
}
}

namespace rw {
typedef float f32x4 __attribute__((ext_vector_type(4)));
constexpr int CH = 32, STEPF = 384, CHF = CH * STEPF;
__device__ __forceinline__ float dpp_sum16(float v) {
  v += __int_as_float(__builtin_amdgcn_update_dpp(0, __float_as_int(v), 0xB1, 0xF, 0xF, true));
  v += __int_as_float(__builtin_amdgcn_update_dpp(0, __float_as_int(v), 0x4E, 0xF, 0xF, true));
  v += __int_as_float(__builtin_amdgcn_update_dpp(0, __float_as_int(v), 0x141, 0xF, 0xF, true));
  v += __int_as_float(__builtin_amdgcn_update_dpp(0, __float_as_int(v), 0x140, 0xF, 0xF, true));
  return v;
}
__device__ __forceinline__ void rwkv_prompt_item(unsigned char* lds, const Params& p, int item, int wid_s) {
  const int bh = item >> 1, half = item & 1, b = bh >> 2, h = bh & 3;
  const int tid = mk_tid(wid_s), sub = tid & 15, vl = tid >> 4, v = 32 * half + vl;
  float* L = (float*)lds; float* yb = L + 2 * CHF;
  const float* ws = p.ws;
  const size_t rowbase = (size_t)b * SEQ;
  const int ls = tid >> 4, lk4 = tid & 15;
  f32x4 g0, g1, g2, g3, g4, g5;
#define RW_GLOAD(c) do { const size_t off_ = (rowbase + (size_t)(c) * CH + ls) * 256 + h * 64 + lk4 * 4; \
    g0 = *(const f32x4*)(ws + W_KK + off_); g1 = *(const f32x4*)(ws + W_W + off_); g2 = *(const f32x4*)(ws + W_BB + off_); \
    g3 = *(const f32x4*)(ws + W_KF + off_); g4 = *(const f32x4*)(ws + W_R + off_); g5 = *(const f32x4*)(ws + W_VV + off_); } while (0)
#define RW_LSTORE(buf) do { float* b_ = L + (buf) * CHF + ls * STEPF + lk4 * 4; *(f32x4*)(b_) = g0; *(f32x4*)(b_ + 64) = g1; *(f32x4*)(b_ + 128) = g2; \
    *(f32x4*)(b_ + 192) = g3; *(f32x4*)(b_ + 256) = g4; *(f32x4*)(b_ + 320) = g5; } while (0)
  float S0 = 0.f, S1 = 0.f, S2 = 0.f, S3 = 0.f;
  RW_GLOAD(0); RW_LSTORE(0); __syncthreads();
  constexpr int NCH = SEQ / CH;
  for (int c = 0; c < NCH; ++c) {
    if (c + 1 < NCH) RW_GLOAD(c + 1);
    const float* cb = L + (c & 1) * CHF;
    float* ybc = yb + (c & 1) * (CH * 32);
#pragma unroll 4
    for (int s = 0; s < CH; ++s) {
      const float* sb = cb + s * STEPF;
      const f32x4 kk = *(const f32x4*)(sb + 4 * sub), w = *(const f32x4*)(sb + 64 + 4 * sub), bb = *(const f32x4*)(sb + 128 + 4 * sub);
      const f32x4 kf = *(const f32x4*)(sb + 192 + 4 * sub), r = *(const f32x4*)(sb + 256 + 4 * sub);
      const float vv = sb[320 + v];
      float dot = (S0 * kk.x + S1 * kk.y) + (S2 * kk.z + S3 * kk.w);
      dot = dpp_sum16(dot);
      const float sa = -dot;
      S0 = S0 * w.x + (sa * bb.x + vv * kf.x); S1 = S1 * w.y + (sa * bb.y + vv * kf.y);
      S2 = S2 * w.z + (sa * bb.z + vv * kf.z); S3 = S3 * w.w + (sa * bb.w + vv * kf.w);
      float y = (S0 * r.x + S1 * r.y) + (S2 * r.z + S3 * r.w);
      y = dpp_sum16(y);
      if (sub == 0) ybc[s * 32 + vl] = y;
    }
    if (c + 1 < NCH) RW_LSTORE((c + 1) & 1);
    __syncthreads();
#pragma unroll
    for (int i = 0; i < 2; ++i) { const int f = tid + 512 * i, s = f >> 5, vv_ = f & 31;
      p.ws[W_Y + (rowbase + (size_t)c * CH + s) * 256 + h * 64 + 32 * half + vv_] = ybc[s * 32 + vv_]; }
  }
#undef RW_GLOAD
#undef RW_LSTORE
  *(f32x4*)(p.out + O_WKVP + ((size_t)(b * 4 + h) * 64 + v) * 64 + 4 * sub) = (f32x4){S0, S1, S2, S3};
  __syncthreads();
}
}

typedef unsigned v4u __attribute__((ext_vector_type(4)));
__device__ __forceinline__ unsigned f2bf(float f) { unsigned u = __builtin_bit_cast(unsigned, f); return (u + 0x7fffu + ((u >> 16) & 1u)) >> 16; }
__device__ __forceinline__ unsigned pk2(float lo, float hi) { return f2bf(lo) | (f2bf(hi) << 16); }
__device__ __forceinline__ void p0_transpose_item(const float* W, int K, int N, bf16* WT, int row_off, LAS float* scr, int item, int lane) {
  const int nblk = N / 32, kb = item / nblk, nb = item % nblk, k0 = 64 * kb, n0 = 32 * nb;
#pragma unroll 8
  for (int i = 0; i < 32; ++i) { const int kk = 2 * i + (lane >> 5); scr[kk * 33 + (lane & 31)] = W[(size_t)(k0 + kk) * N + n0 + (lane & 31)]; }
  asm volatile("s_waitcnt lgkmcnt(0)" ::: "memory");
  const int c = lane & 7;
#pragma unroll
  for (int j = 0; j < 4; ++j) { const int n = (lane >> 3) + 8 * j; const LAS float* s = scr + (8 * c) * 33 + n;
    v4u o; o.x = pk2(s[0 * 33], s[1 * 33]); o.y = pk2(s[2 * 33], s[3 * 33]); o.z = pk2(s[4 * 33], s[5 * 33]); o.w = pk2(s[6 * 33], s[7 * 33]);
    *(v4u*)(WT + (size_t)(row_off + n0 + n) * K + k0 + 8 * c) = o; }
  asm volatile("s_waitcnt lgkmcnt(0)" ::: "memory");
}

__global__ void __launch_bounds__(512) fwd_megakernel(Params p) {
  cg::grid_group grid = cg::this_grid();
  extern __shared__ __attribute__((aligned(16))) unsigned char lds[];
  float* sm = (float*)lds;
  bf16* wb = (bf16*)(p.ws + W_END);
  float* ws = p.ws;
  const int wid_s = __builtin_amdgcn_readfirstlane((int)(threadIdx.x >> 6));
#define PH_IDS const int tid = mk_tid(wid_s); const int lane = tid & 63, wv = tid >> 6; const int gw = blockIdx.x * 8 + wv, NGW = gridDim.x * 8; \
  const int gtid = blockIdx.x * 512 + tid, NTH = gridDim.x * 512; (void)lane; (void)wv; (void)gw; (void)NGW; (void)gtid; (void)NTH;
  { PH_IDS

  {
    LAS float* scr = (LAS float*)((LAS unsigned char*)lds + wv * 16384);
    constexpr int I_IN = 16 * (INC / 32), I_MEM = 16 * (512 / 32), I_OUT = 16 * (1024 / 32);
    for (int it = gw; it < I_IN + I_MEM + I_OUT; it += NGW) {
      int r = it;
      if (r < I_IN) { p0_transpose_item(p.w_in, 1024, INC, wb + B_WIN, 0, scr, r, lane); continue; } r -= I_IN;
      if (r < I_MEM) { p0_transpose_item(p.w_mem_kv, 1024, 512, wb + B_WMEM, 0, scr, r, lane); continue; } r -= I_MEM;
      p0_transpose_item(p.w_out, 1024, 1024, wb + B_WOUT, 0, scr, r, lane);
    }
    if (gtid < 64) ((unsigned*)(p.ws + W_CTL))[gtid] = 0u;
    for (int it = gw; it < 64; it += NGW) {
      if (it < 32) p0_transpose_item(p.w_uk, 128, 512, wb + B_WUK, 0, scr, it, lane);
      else p0_transpose_item(p.w_uv, 128, 512, wb + B_WUV, 0, scr, it - 32, lane);
    }
    for (int i = gtid; i < 768 * 256; i += NTH) {
      const int n = i >> 8, k = i & 255;
      const int orig = n < 512 ? (n >> 6) * 96 + (n & 63) : (n < 640 ? ((n - 512) >> 4) * 96 + 64 + ((n - 512) & 15) : ((n - 640) >> 4) * 96 + 80 + ((n - 640) & 15));
      wb[B_WUQ + i] = (bf16)f2bf(p.w_uq[(size_t)k * 768 + orig]);
    }
    for (int i = gtid; i < 1024 * 256; i += NTH) {
      const int n = i >> 8, k = i & 255, h = n >> 7, c = n & 127;
      const float* a = p.w_uq + (size_t)k * 768 + h * 96; const float* b = p.w_uk + (size_t)c * 512 + h * 64;
      float acc = 0.f;
#pragma unroll 8
      for (int d = 0; d < 64; ++d) acc += a[d] * b[d];
      wb[B_WQL + i] = (bf16)f2bf(acc);
    }
    for (int i = gtid; i < 512 * 1024; i += NTH) {
      const int n = i >> 10, k = i & 1023, h = n >> 6, hk = k >> 7, c = k & 127;
      wb[B_WUVBD + i] = hk == h ? (bf16)f2bf(p.w_uv[(size_t)c * 512 + n]) : (bf16)0;
    }
    for (int i = gtid; i < 4104 * 16; i += NTH) {
      const int pi = i >> 4, j = i & 15; const int pos = pi < 4096 ? pi : PAST + (pi - 4096);
      const float inv = 1.0f / powf(10000.0f, (float)j * (2.0f / 32.0f));
      const float ang = (float)pos * inv;
      p.ws[W_CS + (size_t)i * 2] = cosf(ang); p.ws[W_CS + (size_t)i * 2 + 1] = sinf(ang);
    }
    for (int i = gtid; i < (INCP - INC) * 1024 / 8; i += NTH) ((v4u*)(wb + B_WIN + (size_t)INC * 1024))[i] = (v4u){0u, 0u, 0u, 0u};
  }
  for (int r = gw; r < NT + 1024; r += NGW) {
    const float* src; const float* g; bf16* dst;
    if (r < NT) { src = xrow(p, r); g = p.ln_g; dst = wb + B_H + (size_t)r * 1024; }
    else { src = p.mem_prompt + (size_t)(r - NT) * 1024; g = p.mem_norm_g; dst = wb + B_HM + (size_t)(r - NT) * 1024; }
    float4 v[4]; float ss = 0.f;
#pragma unroll
    for (int i = 0; i < 4; ++i) { v[i] = *(const float4*)(src + 4 * lane + 256 * i); ss += v[i].x * v[i].x + v[i].y * v[i].y + v[i].z * v[i].z + v[i].w * v[i].w; }
    const float rs = rsqrtf(wave_sum(ss) * (1.f / 1024.f) + RMS_EPS);
#pragma unroll
    for (int i = 0; i < 4; ++i) {
      const float4 gg = *(const float4*)(g + 4 * lane + 256 * i);
      uint2 o; o.x = pk2(v[i].x * rs * gg.x, v[i].y * rs * gg.y); o.y = pk2(v[i].z * rs * gg.z, v[i].w * rs * gg.w);
      *(uint2*)(dst + 4 * lane + 256 * i) = o;
    }
  }
  }
  grid.sync();
  { PH_IDS

  {
    pg8::Gemm g{wb + B_H, wb + B_WIN, NT, INCP, 1024}; pg8::StaticOrder S; S.init(NT, INCP, (int)gridDim.x, (int)blockIdx.x);
    pg8::EpiF32 E{ws + W_PROJ, INC, INC, 0, 0, nullptr, nullptr, 0};
    pg8::gemm_phase<pg8::EpiF32, pg8::StaticOrder, true, true>((PG8_LAS unsigned char*)lds, g, S, E, wid_s);
  }
  {
    pg8::Gemm g{wb + B_HM, wb + B_WMEM, 1024, 512, 1024}; pg8::StaticOrder S; S.init(1024, 512, (int)gridDim.x, (int)((blockIdx.x + 20) % gridDim.x));
    pg8::EpiF32 E{p.out + O_MKP, 256, 256, 256, O_MVP - O_MKP, nullptr, nullptr, 0};
    pg8::gemm_phase<pg8::EpiF32, pg8::StaticOrder, true, true>((PG8_LAS unsigned char*)lds, g, S, E, wid_s);
  }
  }
  grid.sync();
  { PH_IDS

  for (size_t i = gtid; i < (size_t)4 * 256 * 256; i += NTH) {
    wb[B_KM + i] = (bf16)f2bf(p.out[O_MKP + i]);
    const size_t b_ = i >> 16, c = (i >> 8) & 255, m_ = i & 255;
    wb[B_VMT + i] = (bf16)f2bf(p.out[O_MVP + (b_ * 256 + m_) * 256 + c]);
  }
  {
    float* wl = sm; float* al = sm + 16384;
    float* tds = sm + 32768 + wv * 128;
    for (int i = tid; i < 4096; i += 512) { ((float4*)wl)[i] = ((const float4*)p.w_up)[i]; ((float4*)al)[i] = ((const float4*)p.a_up)[i]; }
    __syncthreads();
    for (int row = gw; row < NT; row += NGW) {
      const float* pr = ws + W_PROJ + (size_t)row * INC;
      {
        float v[4]; float ss = 0.f;
#pragma unroll
        for (int i = 0; i < 4; ++i) { v[i] = pr[C_CQ + lane + 64 * i]; ss += v[i] * v[i]; }
        const float rs = rsqrtf(wave_sum(ss) * (1.f / 256.f) + RMS_EPS);
#pragma unroll
        for (int i = 0; i < 4; ++i) wb[B_CQN + (size_t)row * 256 + lane + 64 * i] = (bf16)f2bf(v[i] * rs * p.q_norm_g[lane + 64 * i]);
      }
      {
        const float v0 = pr[C_CKV + lane], v1 = pr[C_CKV + 64 + lane];
        const float rs = rsqrtf(wave_sum(v0 * v0 + v1 * v1) * (1.f / 128.f) + RMS_EPS);
        float* o = ckv_out_row(p, row);
        const float c0 = v0 * rs * p.kv_norm_g[lane], c1 = v1 * rs * p.kv_norm_g[64 + lane];
        o[lane] = c0; o[64 + lane] = c1;
        if (row < NP) { wb[B_CKVN + (size_t)row * 128 + lane] = (bf16)f2bf(c0); wb[B_CKVN + (size_t)row * 128 + 64 + lane] = (bf16)f2bf(c1); }
      }
      const int pos = row < NP ? (row % SEQ) : PAST + ((row - NP) & 7);
      if (lane < 16) {
        const float inv = 1.0f / powf(10000.0f, (float)lane * (2.0f / 32.0f));
        const float ang = (float)pos * inv; const float c = cosf(ang), s = sinf(ang);
        const float x1 = pr[C_KR + lane], x2 = pr[C_KR + 16 + lane];
        float* o = kpe_out_row(p, row);
        const float y1 = x1 * c - x2 * s, y2 = x2 * c + x1 * s;
        o[lane] = y1; o[16 + lane] = y2;
        if (row < NP) {
          const bf16 b1 = (bf16)f2bf(y1), b2 = (bf16)f2bf(y2);
#pragma unroll
          for (int hh = 0; hh < 8; ++hh) { wb[B_KP + (size_t)row * 768 + hh * 96 + 64 + lane] = b1; wb[B_KP + (size_t)row * 768 + hh * 96 + 80 + lane] = b2; }
        }
      }
      if (row < NP) {
        const float XSC = X_SCALE * 1.4426950408889634f;
        const float4 v = *(const float4*)(pr + C_QX + lane * 4);
        *(uint2*)(wb + B_QX + (size_t)row * 256 + lane * 4) = make_uint2(pk2(v.x * XSC, v.y * XSC), pk2(v.z * XSC, v.w * XSC));
      }
      if (row < NP) { if ((row % SEQ) == SEQ - 1) { const int b = row / SEQ; for (int i = lane; i < 896; i += 64) p.out[O_SHP + (size_t)b * 896 + i] = pr[C_Z + i]; } }
      else { if (((row - NP) & 7) == 7) { const int db = (row - NP) >> 3; for (int i = lane; i < 896; i += 64) p.out[O_SHS + (size_t)db * 896 + i] = pr[C_Z + i]; } }
      {
        const bool first = row < NP ? ((row % SEQ) == 0) : (((row - NP) & 7) == 0);
        const float* prev = first ? (row < NP ? nullptr : p.state_shift + (size_t)((row - NP) >> 3) * 896 - C_Z) : pr - INC;
        auto zmix = [&](int i) -> float { const float z = pr[C_Z + i]; const float pv = prev ? prev[C_Z + i] : 0.f; return z + (pv - z) * p.shift_mu[i]; };
        tds[lane] = tanhf(zmix(768 + lane)); tds[64 + lane] = zmix(832 + lane);
        __builtin_amdgcn_fence(__ATOMIC_RELEASE, "wavefront"); __builtin_amdgcn_wave_barrier();
        float uu[4], aa[4];
#pragma unroll
        for (int hh = 0; hh < 4; ++hh) { uu[hh] = p.w0[hh * 64 + lane]; aa[hh] = p.a0[hh * 64 + lane]; }
#pragma unroll 8
        for (int j = 0; j < 64; ++j) {
          const float t_ = tds[j], a_ = tds[64 + j];
#pragma unroll
          for (int hh = 0; hh < 4; ++hh) { uu[hh] += t_ * wl[j * 256 + hh * 64 + lane]; aa[hh] += a_ * al[j * 256 + hh * 64 + lane]; }
        }
#pragma unroll
        for (int hh = 0; hh < 4; ++hh) {
          const int c = hh * 64 + lane;
          const float u = uu[hh], au = aa[hh];
          const float nu = -u;
          const float sp = fmaxf(nu, 0.f) + log1pf(expf(-fabsf(nu)));
          const float wlog = -sp - 0.5f;
          const float decay = expf(-expf(wlog));
          const float a = 1.f / (1.f + expf(-au));
          const float k = zmix(256 + c), r = zmix(c), v = zmix(512 + c);
          float kk = k * p.k_k[c];
          const float nrm = fmaxf(sqrtf(wave_sum(kk * kk)), 1e-12f);
          kk = kk / nrm;
          const float kf = k * (1.f + (a - 1.f) * p.k_a[c]);
          const size_t o = (size_t)row * 256 + c;
          ws[W_R + o] = r; ws[W_W + o] = decay; ws[W_KF + o] = kf; ws[W_VV + o] = v; ws[W_KK + o] = kk; ws[W_BB + o] = kk * a;
        }
        __builtin_amdgcn_fence(__ATOMIC_RELEASE, "wavefront"); __builtin_amdgcn_wave_barrier();
      }
    }
  }
  }
  grid.sync();
  { PH_IDS

  {
    const float QSC = MLA_SCALE * 1.4426950408889634f;
    const int G = (int)gridDim.x, bx = (int)blockIdx.x;
    {
      pg8::Gemm g{wb + B_CQN, wb + B_WUQ, NT, 768, 256}; pg8::StaticOrder S; S.init(NT, 768, G, bx);
      pg8::EpiQ E{wb + B_QP, wb + B_QS, ws + W_CS, QSC, NP};
      pg8::gemm_phase<pg8::EpiQ, pg8::StaticOrder, true, true>((PG8_LAS unsigned char*)lds, g, S, E, wid_s);
    }
    {
      bf16* Qs = wb + B_QS;
      auto f = [=](int row, int col) -> bf16* { return Qs + ((size_t)row * 8 + (col >> 7)) * 160 + (col & 127); };
      pg8::Gemm g{wb + B_CQN + (size_t)NP * 256, wb + B_WQL, NS, 1024, 256}; pg8::StaticOrder S; S.init(NS, 1024, G, (bx + G - 204 % G) % G);
      pg8::EpiBf16F<decltype(f)> E{f, QSC};
      pg8::gemm_phase<pg8::EpiBf16F<decltype(f)>, pg8::StaticOrder, true, true>((PG8_LAS unsigned char*)lds, g, S, E, wid_s);
    }
    {
      bf16* Kp = wb + B_KP;
      auto f = [=](int row, int col) -> bf16* { return Kp + (size_t)row * 768 + (col >> 6) * 96 + (col & 63); };
      pg8::Gemm g{wb + B_CKVN, wb + B_WUK, NP, 512, 128}; pg8::StaticOrder S; S.init(NP, 512, G, (bx + G - 220 % G) % G);
      pg8::EpiBf16F<decltype(f)> E{f, 1.f};
      pg8::gemm_phase<pg8::EpiBf16F<decltype(f)>, pg8::StaticOrder, true, true>((PG8_LAS unsigned char*)lds, g, S, E, wid_s);
    }
    {
      bf16* Vt = wb + B_VT;
      auto f = [=](int row, int col) -> bf16* { return Vt + (size_t)row * NP + col; };
      pg8::Gemm g{wb + B_WUV, wb + B_CKVN, 512, NP, 128}; pg8::StaticOrder S; S.init(512, NP, G, (bx + G - 92 % G) % G);
      pg8::EpiBf16F<decltype(f)> E{f, 1.f};
      pg8::gemm_phase<pg8::EpiBf16F<decltype(f)>, pg8::StaticOrder, true, true>((PG8_LAS unsigned char*)lds, g, S, E, wid_s);
    }
  }
  }
  grid.sync();
  { PH_IDS

  {
    unsigned* qctr = (unsigned*)(p.ws + W_CTL);
    volatile unsigned* qslot = (volatile unsigned*)(lds + LDS_BYTES - 16);
    constexpr int Q_RW = 32, Q_PA = 512, Q_SA = 256, Q_MA = 256, Q_TOT = Q_RW + Q_PA + Q_SA + Q_MA;
    for (;;) {
      if (tid == 0) *qslot = atomicAdd(qctr, 1u);
      __syncthreads();
      int item = (int)*qslot;
      __syncthreads();
      item = __builtin_amdgcn_readfirstlane(item);
      if (item >= Q_TOT) break;
      if (item < Q_RW) { rw::rwkv_prompt_item(lds, p, item, wid_s); continue; }
      item -= Q_RW;
      if (item < Q_PA) {
        const int bh = item & 31, qb = 15 - (item >> 5);
        const int b = bh >> 3, h = bh & 7;
        const size_t row0 = (size_t)b * SEQ + 256 * qb;
        auto out = [&](int ql, int dv0, float4 v) {
          const size_t row = row0 + ql;
          const float4 g = *(const float4*)(ws + W_PROJ + row * INC + C_GMLA + h * 64 + dv0);
          *(uint2*)(wb + B_MIX + row * 1024 + h * 64 + dv0) = make_uint2(pk2(v.x * silu(g.x), v.y * silu(g.y)), pk2(v.z * silu(g.z), v.w * silu(g.w)));
        };
        pa::attn_unit<96, true>(lds, wb + B_QP + row0 * 768 + h * 96, 768, wb + B_KP + (size_t)b * SEQ * 768 + h * 96, 768,
                                wb + B_VT + (size_t)(h * 64) * NP + (size_t)b * SEQ, NP, 4 * qb + 4, 256 * qb, out, wid_s);
        continue;
      }
      item -= Q_PA;
      if (item < Q_SA) { sa::sample_attn_item(lds, p, wb + B_QS, ws + W_PO, ws + W_PML, item, wid_s); continue; }
      item -= Q_SA;
      {
        const int qb = item & 15, h = (item >> 4) & 3, b = item >> 6;
        const size_t row0 = (size_t)b * SEQ + 256 * qb;
        auto out = [&](int ql, int dv0, float4 v) {
          const size_t row = row0 + ql;
          const float4 g = *(const float4*)(ws + W_PROJ + row * INC + C_GX + h * 64 + dv0);
          *(uint2*)(wb + B_MIX + row * 1024 + 768 + h * 64 + dv0) = make_uint2(pk2(v.x * silu(g.x), v.y * silu(g.y)), pk2(v.z * silu(g.z), v.w * silu(g.w)));
        };
        pa::attn_unit<64, false>(lds, wb + B_QX + row0 * 256 + h * 64, 256, wb + B_KM + (size_t)b * 65536 + h * 64, 256,
                                 wb + B_VMT + (size_t)b * 65536 + (size_t)(h * 64) * 256, 256, 4, 0, out, wid_s);
      }
    }
    __syncthreads();
  }
  {
    constexpr int N_RS = 512, N_MA = 4 * (NS / 2);
    constexpr int TOT = N_RS + N_MA;
    float* wsm = sm + wv * 320;
    for (int it = gw; it < TOT; it += NGW) {
      int i = __builtin_amdgcn_readfirstlane(it);
      if (i < N_RS) { rwkv_scan_wave(p, false, i >> 2, i & 3, lane, wsm); continue; }
      i -= N_RS;
      mem_attn_wave(p, i, lane, wsm);
    }
  }
  }
  grid.sync();
  { PH_IDS

  for (int i = gtid; i < NS * 8 * 32; i += NTH) {
    const int c4 = i & 31, h = (i >> 5) & 7, srow = i >> 8;
    const int db_ = srow >> 3, qi = (srow & 7) * 8 + h;
    const float* ml0 = ws + W_PML + ((size_t)(2 * db_) * 64 + qi) * 2; const float* ml1 = ml0 + 128;
    const float M_ = fmaxf(ml0[0], ml1[0]), w0_ = exp2f(ml0[0] - M_), w1_ = exp2f(ml1[0] - M_);
    const float invL = 1.f / (ml0[1] * w0_ + ml1[1] * w1_);
    const float4 a = *(const float4*)(ws + W_PO + ((size_t)(2 * db_) * 64 + qi) * 128 + c4 * 4), b2 = *(const float4*)(ws + W_PO + ((size_t)(2 * db_ + 1) * 64 + qi) * 128 + c4 * 4);
    *(uint2*)(wb + B_OLAT + (size_t)srow * 1024 + h * 128 + c4 * 4) = make_uint2(pk2((a.x * w0_ + b2.x * w1_) * invL, (a.y * w0_ + b2.y * w1_) * invL), pk2((a.z * w0_ + b2.z * w1_) * invL, (a.w * w0_ + b2.w * w1_) * invL));
  }
  for (int it = gw; it < NP * 4; it += NGW) {
    const int row = it >> 2, h = it & 3;
    const size_t off = (size_t)row * 256 + h * 64 + lane;
    const float y = ws[W_Y + off];
    const float mean = wave_sum(y) * (1.f / 64.f), d = y - mean, var = wave_sum(d * d) * (1.f / 64.f);
    const float yn = d * rsqrtf(var + GN_EPS) * p.lnx_g[h * 64 + lane] + p.lnx_b[h * 64 + lane];
    const float bsum = wave_sum(ws[W_R + off] * ws[W_KF + off] * p.r_k[h * 64 + lane]);
    const float o = yn + bsum * ws[W_VV + off];
    const float g = ws[W_PROJ + (size_t)row * INC + C_GRWKV + h * 64 + lane];
    wb[B_MIX + (size_t)row * 1024 + 512 + h * 64 + lane] = (bf16)f2bf(o * silu(g));
  }
  grid.sync();
  {
    pg8::Gemm g{wb + B_OLAT, wb + B_WUVBD, NS, 512, 1024}; pg8::StaticOrder S; S.init(NS, 512, (int)gridDim.x, (int)blockIdx.x);
    pg8::EpiGateBf16 E{wb + B_MIX + (size_t)NP * 1024, 1024, ws + W_PROJ + (size_t)NP * INC + C_GMLA, INC};
    pg8::gemm_phase<pg8::EpiGateBf16, pg8::StaticOrder, true, true>((PG8_LAS unsigned char*)lds, g, S, E, wid_s);
  }
  grid.sync();

  {
    pg8::Gemm g{wb + B_MIX, wb + B_WOUT, NT, 1024, 1024}; pg8::StaticOrder S; S.init(NT, 1024, (int)gridDim.x, (int)blockIdx.x);
    pg8::EpiF32 E{p.out, 1024, 1024, 0, 0, p.x_prompt, p.x_sample, NP};
    pg8::gemm_phase<pg8::EpiF32, pg8::StaticOrder, true, true>((PG8_LAS unsigned char*)lds, g, S, E, wid_s);
  }
  }
  grid.sync();
  { PH_IDS

  for (int r = gw; r < NT; r += NGW) {
    float* y = p.out + (size_t)r * 1024;
    float v[16]; float ss = 0.f;
#pragma unroll
    for (int i = 0; i < 16; ++i) { v[i] = y[lane + 64 * i]; ss += v[i] * v[i]; }
    const float rs = rsqrtf(wave_sum(ss) * (1.f / 1024.f) + RMS_EPS);
#pragma unroll
    for (int i = 0; i < 16; ++i) y[lane + 64 * i] = v[i] * rs * p.final_g[lane + 64 * i];
  }
  }
#undef PH_IDS
}

extern "C" void kernel_launch(void* const* d_in, const int* in_sizes, int n_in, void* d_out,
                              int out_size, void* d_ws, size_t ws_size, hipStream_t stream) {
  static int grid_blocks = 0;
  if (!grid_blocks) {
    int dev = 0, cus = 0, per_cu = 0;
    (void)hipGetDevice(&dev);
    (void)hipDeviceGetAttribute(&cus, hipDeviceAttributeMultiprocessorCount, dev);
    (void)hipFuncSetAttribute((const void*)fwd_megakernel, hipFuncAttributeMaxDynamicSharedMemorySize, LDS_BYTES);
    (void)hipOccupancyMaxActiveBlocksPerMultiprocessor(&per_cu, fwd_megakernel, 512, LDS_BYTES);
    if (per_cu < 1) per_cu = 1;
    grid_blocks = cus;
    if (ws_size < WS_BYTES) fprintf(stderr, "workspace too small: %zu < %zu\n", ws_size, (size_t)WS_BYTES);
  }
  Params p{};
  const float** pf = (const float**)&p;
  (void)pf;
  p.x_prompt = (const float*)d_in[0]; p.x_sample = (const float*)d_in[1]; p.mem_prompt = (const float*)d_in[2];
  p.cache_ckv = (const float*)d_in[3]; p.cache_kpe = (const float*)d_in[4]; p.page_table = (const int*)d_in[5];
  p.state_wkv = (const float*)d_in[6]; p.state_shift = (const float*)d_in[7]; p.cache_mem_k = (const float*)d_in[8];
  p.cache_mem_v = (const float*)d_in[9]; p.ln_g = (const float*)d_in[10]; p.w_in = (const float*)d_in[11];
  p.q_norm_g = (const float*)d_in[12]; p.kv_norm_g = (const float*)d_in[13]; p.w_uq = (const float*)d_in[14];
  p.w_uk = (const float*)d_in[15]; p.w_uv = (const float*)d_in[16]; p.shift_mu = (const float*)d_in[17];
  p.w0 = (const float*)d_in[18]; p.w_up = (const float*)d_in[19]; p.a0 = (const float*)d_in[20]; p.a_up = (const float*)d_in[21];
  p.k_k = (const float*)d_in[22]; p.k_a = (const float*)d_in[23]; p.r_k = (const float*)d_in[24]; p.lnx_g = (const float*)d_in[25];
  p.lnx_b = (const float*)d_in[26]; p.mem_norm_g = (const float*)d_in[27]; p.w_mem_kv = (const float*)d_in[28];
  p.w_out = (const float*)d_in[29]; p.final_g = (const float*)d_in[30];
  p.out = (float*)d_out; p.ws = (float*)d_ws;
  void* args[] = {&p};
  hipError_t e = hipLaunchCooperativeKernel((void*)fwd_megakernel, dim3(grid_blocks), dim3(512), args, LDS_BYTES, stream);
  if (e != hipSuccess) fprintf(stderr, "cooperative launch failed: %s (grid %d)\n", hipGetErrorString(e), grid_blocks);
}
```

```cpp
#include <hip/hip_runtime.h>
#include <hip/hip_cooperative_groups.h>
#include <cstdio>
#include <cstdint>
namespace cg = cooperative_groups;

__device__ __forceinline__ int mk_tid(int wid_s) { int z; asm volatile("s_mov_b32 %0, 0" : "=s"(z)); return wid_s * 64 + (int)__builtin_amdgcn_mbcnt_hi(~0u, __builtin_amdgcn_mbcnt_lo(~0u, (unsigned)z)); }
namespace pg8 {
#define PG8_LAS __attribute__((address_space(3)))
typedef unsigned short bf16_t;
typedef short bf16x8 __attribute__((ext_vector_type(8)));
typedef float f32x4 __attribute__((ext_vector_type(4)));
typedef unsigned u32x4 __attribute__((ext_vector_type(4)));
constexpr int BM = 256, BK = 64, HALF = 128, HTB = HALF * BK * 2  , STAGE_BYTES = 8 * HTB, NXCD = 8, WGM = 8;

__host__ __device__ __forceinline__ int lds_byte(int r, int c) { const int st = (r >> 4) * 2 + (c >> 5), rr = r & 15, cc = c & 31, ob = rr * 64 + cc * 2; return st * 1024 + (ob ^ (((ob >> 9) & 1) << 5)); }
__host__ __device__ __forceinline__ void stage_rc(int b, int& R, int& C) { const int st = b / 1024, sb = b % 1024, swz = sb ^ (((sb >> 9) & 1) << 5); R = (st >> 1) * 16 + swz / 64; C = (st & 1) * 32 + (swz % 64) / 2; }
__host__ __device__ __forceinline__ int perm32(int rho) { const int n = rho >> 4, i = rho & 15; return 8 * (i >> 2) + 4 * n + (i & 3); }

struct Unit { int pm, pn; };
struct Gemm { const bf16_t* A; const bf16_t* Bt; int M, N, K; };

struct StaticOrder {
    int nM, nN, nwg, G, c;
    __host__ __device__ void init(int M, int N, int G_, int c_) { nM = M / BM; nN = N / BM; nwg = nM * nN; G = G_; c = c_; }
    __host__ __device__ bool next(int i, Unit& u) const {
        const long L = (long)i * G + c; if (L >= nwg) return false;
        int wgid = (int)L; { const int q = nwg / NXCD, r = nwg % NXCD, xcd = wgid % NXCD, off = wgid / NXCD; wgid = (xcd < r ? xcd * (q + 1) : r * (q + 1) + (xcd - r) * q) + off; }
        const int nig = WGM * nN, gid = wgid / nig, fm = gid * WGM, gsz = (nM - fm) < WGM ? (nM - fm) : WGM;
        u.pm = fm + ((wgid % nig) % gsz); u.pn = (wgid % nig) / gsz; return true;
    }
    __device__ __forceinline__ void a_ready(const Unit&) const {}
    __device__ __forceinline__ void done(const Unit&) const {}
};
__device__ __forceinline__ unsigned cvt_pk_bf16(float lo, float hi) { unsigned r; asm volatile("v_cvt_pk_bf16_f32 %0, %1, %2" : "=v"(r) : "v"(lo), "v"(hi)); return r; }
typedef float f32x2 __attribute__((ext_vector_type(2)));
template <class Epi, class Sched, bool ALIGN_EPI = false, bool SP2 = false>
__device__ __forceinline__ void gemm_phase(PG8_LAS unsigned char* lds, const Gemm g, const Sched& S, const Epi& E, int wid_s) {
    const int tid = mk_tid(wid_s), wid = wid_s, lane = tid & 63, wr = wid >> 2, wc = wid & 3, fr = lane & 15, fq = lane >> 4;
    const int K = g.K, nt = K / BK;
    unsigned voffA[2], voffB[2];
#pragma unroll
    for (int i = 0; i < 2; ++i) { int R, C; stage_rc(tid * 16 + i * 8192, R, C); const int Rb = Epi::PERM ? ((R & ~31) + perm32(R & 31)) : R;
        voffA[i] = (unsigned)(R * K + C) * 2u; voffB[i] = (unsigned)(Rb * K + C) * 2u; }
    const size_t kstep = (size_t)(BK * 2);
    const size_t hstep = (size_t)HALF * K * 2;
    const size_t tstep = 2 * hstep;
    const unsigned ldsw = (unsigned)wid * 1024u;
    const int aoff = lds_byte(wr * 64 + fr, fq * 8), boff = lds_byte(wc * 32 + fr, fq * 8);
#define PG8_SA(b, h) (((b) * 2 + (h)) * HTB)
#define PG8_SB(b, h) ((4 + (b) * 2 + (h)) * HTB)
#define PG8_STAGE(bufoff, gbase, voff) do { _Pragma("unroll") for (int _i = 0; _i < 2; ++_i) \
        __builtin_amdgcn_global_load_lds((const unsigned*)((const char*)(gbase) + (voff)[_i]), (PG8_LAS unsigned*)(lds + (bufoff) + ldsw + _i * 8192), 16, 0, 0); } while (0)
#define PG8_LDA(dst, b, h) do { _Pragma("unroll") for (int m = 0; m < 4; ++m) _Pragma("unroll") for (int k = 0; k < 2; ++k) dst[m][k] = *(const PG8_LAS bf16x8*)(lds + PG8_SA(b, h) + aoff + m * 2048 + k * 1024); } while (0)
#define PG8_LDB(dst, b, h) do { _Pragma("unroll") for (int n = 0; n < 2; ++n) _Pragma("unroll") for (int k = 0; k < 2; ++k) dst[n][k] = *(const PG8_LAS bf16x8*)(lds + PG8_SB(b, h) + boff + n * 2048 + k * 1024); } while (0)
#define PG8_MMA(ai, bj, At, Bt) do { __builtin_amdgcn_s_setprio(1); _Pragma("unroll") for (int m = 0; m < 4; ++m) _Pragma("unroll") for (int n = 0; n < 2; ++n) _Pragma("unroll") for (int k = 0; k < 2; ++k) \
        acc[ai][bj][m][n] = __builtin_amdgcn_mfma_f32_16x16x32_bf16(Bt[n][k], At[m][k], acc[ai][bj][m][n], 0, 0, 0); __builtin_amdgcn_s_setprio(0); } while (0)
#define PG8_WAIT_V(n) asm volatile("s_waitcnt vmcnt(" #n ")" ::: "memory")
#define PG8_WAIT_L(n) asm volatile("s_waitcnt lgkmcnt(" #n ")" ::: "memory")
#define PG8_BAR __builtin_amdgcn_s_barrier()
#define PG8_SCHED __builtin_amdgcn_sched_barrier(0)
    Unit cur, nxt; int ui = 0;
    if (!S.next(0, cur)) return;
    f32x4 acc[2][2][4][2];
#pragma unroll
    for (int a = 0; a < 2; ++a)
#pragma unroll
        for (int b = 0; b < 2; ++b)
#pragma unroll
            for (int m = 0; m < 4; ++m)
#pragma unroll
                for (int n = 0; n < 2; ++n) acc[a][b][m][n] = (f32x4){0.f, 0.f, 0.f, 0.f};
    bf16x8 At[4][2], B0[2][2], B1[2][2];
    const char* cA = (const char*)g.A + (size_t)cur.pm * tstep; const char* cB = (const char*)g.Bt + (size_t)cur.pn * tstep;
    S.a_ready(cur);
    if constexpr (SP2) {
        PG8_STAGE(PG8_SB(0, 0), cB, voffB); PG8_STAGE(PG8_SB(0, 1), cB + hstep, voffB); PG8_STAGE(PG8_SA(0, 0), cA, voffA); PG8_STAGE(PG8_SA(0, 1), cA + hstep, voffA);
        if (wr == 1) PG8_BAR;
        PG8_WAIT_V(2); PG8_BAR;
        PG8_STAGE(PG8_SB(1, 0), cB + kstep, voffB); PG8_STAGE(PG8_SA(1, 0), cA + kstep, voffA); PG8_STAGE(PG8_SB(1, 1), cB + hstep + kstep, voffB);
        PG8_WAIT_V(6); PG8_BAR;
    } else {
        PG8_STAGE(PG8_SB(0, 0), cB, voffB); PG8_STAGE(PG8_SA(0, 0), cA, voffA); PG8_STAGE(PG8_SB(0, 1), cB + hstep, voffB); PG8_STAGE(PG8_SA(0, 1), cA + hstep, voffA);
        if (wr == 1) PG8_BAR;
        PG8_WAIT_V(4); PG8_BAR;
        PG8_STAGE(PG8_SB(1, 0), cB + kstep, voffB); PG8_STAGE(PG8_SA(1, 0), cA + kstep, voffA); PG8_STAGE(PG8_SB(1, 1), cB + hstep + kstep, voffB);
        PG8_WAIT_V(6); PG8_BAR;
    }
    for (;;) {
        const bool has_next = S.next(ui + 1, nxt);
        const char* nA = has_next ? (const char*)g.A + (size_t)nxt.pm * tstep : cA; const char* nB = has_next ? (const char*)g.Bt + (size_t)nxt.pn * tstep : cB;
        for (int t = 0; t < nt; t += 2) {
            const bool last = (t == nt - 2);
            const char* a1 = cA + (size_t)(t + 1) * kstep;
            const char* a2 = last ? nA : cA + (size_t)(t + 2) * kstep; const char* b2 = last ? nB : cB + (size_t)(t + 2) * kstep;
            const char* a3 = a2 + kstep; const char* b3 = b2 + kstep;
            if (last && has_next) S.a_ready(nxt);
            if constexpr (SP2) {
            PG8_LDB(B0, 0, 0); PG8_LDB(B1, 0, 1); PG8_SCHED; PG8_LDA(At, 0, 0); PG8_STAGE(PG8_SA(1, 1), a1 + hstep, voffA);
            PG8_WAIT_V(8); PG8_WAIT_L(0); PG8_BAR; PG8_MMA(0, 0, At, B0); PG8_MMA(0, 1, At, B1); PG8_BAR; PG8_SCHED;
            PG8_LDA(At, 0, 1); PG8_STAGE(PG8_SB(0, 0), b2, voffB); PG8_STAGE(PG8_SB(0, 1), b2 + hstep, voffB); PG8_STAGE(PG8_SA(0, 0), a2, voffA);
            PG8_WAIT_V(8); PG8_WAIT_L(0); PG8_BAR; PG8_MMA(1, 0, At, B0); PG8_MMA(1, 1, At, B1); PG8_BAR; PG8_SCHED;
            PG8_LDB(B0, 1, 0); PG8_LDB(B1, 1, 1); PG8_SCHED; PG8_LDA(At, 1, 0); PG8_STAGE(PG8_SA(0, 1), a2 + hstep, voffA);
            PG8_WAIT_V(8); PG8_WAIT_L(0); PG8_BAR; PG8_MMA(0, 0, At, B0); PG8_MMA(0, 1, At, B1); PG8_BAR; PG8_SCHED;
            PG8_LDA(At, 1, 1); PG8_STAGE(PG8_SB(1, 0), b3, voffB); PG8_STAGE(PG8_SB(1, 1), b3 + hstep, voffB); PG8_STAGE(PG8_SA(1, 0), a3, voffA);
            PG8_WAIT_V(8); PG8_WAIT_L(0); PG8_BAR; PG8_MMA(1, 0, At, B0); PG8_MMA(1, 1, At, B1); PG8_BAR; PG8_SCHED;
            } else {
            PG8_LDB(B0, 0, 0); PG8_SCHED; PG8_LDA(At, 0, 0); PG8_STAGE(PG8_SA(1, 1), a1 + hstep, voffA);
            PG8_WAIT_L(8); PG8_BAR; PG8_WAIT_L(0); PG8_MMA(0, 0, At, B0); PG8_BAR; PG8_SCHED;
            PG8_LDB(B1, 0, 1); PG8_STAGE(PG8_SB(0, 0), b2, voffB);
            PG8_BAR; PG8_WAIT_L(0); PG8_MMA(0, 1, At, B1); PG8_BAR;
            PG8_LDA(At, 0, 1); PG8_STAGE(PG8_SA(0, 0), a2, voffA);
            PG8_BAR; PG8_WAIT_L(0); PG8_MMA(1, 0, At, B0); PG8_BAR; PG8_SCHED;
            PG8_STAGE(PG8_SB(0, 1), b2 + hstep, voffB);
            PG8_WAIT_V(6); PG8_BAR; PG8_MMA(1, 1, At, B1); PG8_BAR;
            PG8_LDB(B0, 1, 0); PG8_SCHED; PG8_LDA(At, 1, 0); PG8_STAGE(PG8_SA(0, 1), a2 + hstep, voffA);
            PG8_WAIT_L(8); PG8_BAR; PG8_WAIT_L(0); PG8_MMA(0, 0, At, B0); PG8_BAR; PG8_SCHED;
            PG8_LDB(B1, 1, 1); PG8_STAGE(PG8_SB(1, 0), b3, voffB);
            PG8_BAR; PG8_WAIT_L(0); PG8_MMA(0, 1, At, B1); PG8_BAR;
            PG8_LDA(At, 1, 1); PG8_STAGE(PG8_SA(1, 0), a3, voffA);
            PG8_BAR; PG8_WAIT_L(0); PG8_MMA(1, 0, At, B0); PG8_BAR; PG8_SCHED;
            PG8_STAGE(PG8_SB(1, 1), b3 + hstep, voffB);
            PG8_WAIT_V(6); PG8_BAR; PG8_MMA(1, 1, At, B1); PG8_BAR;
            }
        }
        if constexpr (ALIGN_EPI) { if (wr == 0) PG8_BAR; }
        if constexpr (!Epi::AFTER_DRAIN) { E(acc, cur, wr, wc, fr, fq); S.done(cur); }
        if (!has_next) break;
#pragma unroll
        for (int a = 0; a < 2; ++a)
#pragma unroll
            for (int b = 0; b < 2; ++b)
#pragma unroll
                for (int m = 0; m < 4; ++m)
#pragma unroll
                    for (int n = 0; n < 2; ++n) acc[a][b][m][n] = (f32x4){0.f, 0.f, 0.f, 0.f};
        cur = nxt; cA = nA; cB = nB; ++ui;
        if constexpr (ALIGN_EPI) { if (wr == 1) PG8_BAR; }
    }
    PG8_WAIT_V(0);
    if constexpr (!ALIGN_EPI) { if (wr == 0) PG8_BAR; }
    PG8_BAR;
    if constexpr (Epi::AFTER_DRAIN) { E.fused(acc, cur, wr, wc, fr, fq, lds, wid, lane); S.done(cur); }
#undef PG8_SA
#undef PG8_SB
#undef PG8_STAGE
#undef PG8_LDA
#undef PG8_LDB
#undef PG8_MMA
#undef PG8_WAIT_V
#undef PG8_WAIT_L
#undef PG8_BAR
#undef PG8_SCHED
}
}

namespace pg8 {
struct EpiF32 {
  static constexpr bool PERM = false, AFTER_DRAIN = false;
  float* C; int ldc; int ncols; int split_cols; size_t split_stride; const float* r0; const float* r1; int nr0;
  __device__ __forceinline__ void operator()(const f32x4 (&acc)[2][2][4][2], const Unit& u, int wr, int wc, int fr0, int fq0) const {
    int fr = fr0, fq = fq0; asm volatile("" : "+v"(fr), "+v"(fq));
    const int row0 = u.pm * BM + wr * 64 + fr; int colt = u.pn * BM; float* base = C;
    if (split_cols) { const int t = colt / split_cols; base += (size_t)t * split_stride; colt -= t * split_cols; }
    const int col0 = colt + wc * 32 + 4 * fq;
#pragma unroll
    for (int ai = 0; ai < 2; ++ai)
#pragma unroll
      for (int m = 0; m < 4; ++m) {
        const int row = row0 + ai * HALF + m * 16;
        const float* rr = r0 ? (row < nr0 ? r0 + (size_t)row * ldc : r1 + (size_t)(row - nr0) * ldc) : nullptr;
#pragma unroll
        for (int bj = 0; bj < 2; ++bj)
#pragma unroll
          for (int n = 0; n < 2; ++n) {
            const int col = col0 + bj * HALF + n * 16;
            if (col < ncols) { f32x4 v = acc[ai][bj][m][n]; if (rr) v += *(const f32x4*)(rr + col); *(f32x4*)(base + (size_t)row * ldc + col) = v; }
          }
      }
  }
};
}

constexpr int DM = 1024, BATCH = 4, SEQ = 4096, DB = 128, DT = 8, PAST = 8192, PAGE = 128, NPG = 64, NMEM = 256;
constexpr int NP = BATCH * SEQ, NS = DB * DT, NT = NP + NS;
constexpr int INC = 2592;
constexpr int C_CQ = 0, C_CKV = 256, C_KR = 384, C_GMLA = 416, C_Z = 928, C_GRWKV = 1824, C_QX = 2080, C_GX = 2336;
constexpr float MLA_SCALE = 0.10206207261596575f;
constexpr float X_SCALE = 0.125f;
constexpr float RMS_EPS = 1e-6f, GN_EPS = 64e-5f;
constexpr size_t O_YP = 0, O_YS = 16777216, O_CKVP = 17825792, O_KPEP = 19922944, O_WKVP = 20447232, O_SHP = 20512768,
                 O_MKP = 20516352, O_MVP = 20778496, O_CKVS = 21040640, O_KPES = 21171712, O_WKVS = 21204480, O_SHS = 23301632;
constexpr size_t W_H = 0;
constexpr size_t W_HM = W_H + (size_t)NT * 1024;
constexpr size_t W_PROJ = W_HM + (size_t)1024 * 1024;
constexpr size_t W_CQN = W_PROJ + (size_t)NT * INC;
constexpr size_t W_Q = W_CQN + (size_t)NT * 256;
constexpr size_t W_KN = W_Q + (size_t)NT * 768;
constexpr size_t W_V = W_KN + (size_t)NP * 512;
constexpr size_t W_QLAT = W_V + (size_t)NP * 512;
constexpr size_t W_OLAT = W_QLAT + (size_t)NS * 1024;
constexpr size_t W_R = W_OLAT + (size_t)NS * 1024;
constexpr size_t W_W = W_R + (size_t)NT * 256;
constexpr size_t W_KF = W_W + (size_t)NT * 256;
constexpr size_t W_VV = W_KF + (size_t)NT * 256;
constexpr size_t W_KK = W_VV + (size_t)NT * 256;
constexpr size_t W_BB = W_KK + (size_t)NT * 256;
constexpr size_t W_MIX = W_BB + (size_t)NT * 256;
constexpr size_t W_PO = W_MIX + (size_t)NT * 1024;
constexpr size_t W_PML = W_PO + (size_t)256 * 64 * 128;
constexpr size_t W_Y = W_PML + (size_t)256 * 64 * 2;
constexpr size_t W_CTL = W_Y + (size_t)NP * 256;
constexpr size_t W_CS = W_CTL + 64;
constexpr size_t W_END = W_CS + (size_t)4104 * 32;
constexpr int INCP = 2816;
constexpr size_t B_H = 0;
constexpr size_t B_HM = B_H + (size_t)NT * 1024;
constexpr size_t B_WIN = B_HM + (size_t)1024 * 1024;
constexpr size_t B_WMEM = B_WIN + (size_t)INCP * 1024;
constexpr size_t B_WOUT = B_WMEM + (size_t)512 * 1024;
constexpr size_t B_MIX = B_WOUT + (size_t)1024 * 1024;
constexpr size_t B_QP = B_MIX + (size_t)NT * 1024;
constexpr size_t B_KP = B_QP + (size_t)NP * 768;
constexpr size_t B_VT = B_KP + (size_t)NP * 768;
constexpr size_t B_QS = B_VT + (size_t)512 * NP;
constexpr size_t B_QX = B_QS + (size_t)NS * 8 * 160;
constexpr size_t B_KM = B_QX + (size_t)NP * 256;
constexpr size_t B_VMT = B_KM + (size_t)4 * 256 * 256;
constexpr size_t B_CQN = B_VMT + (size_t)4 * 256 * 256;
constexpr size_t B_CKVN = B_CQN + (size_t)NT * 256;
constexpr size_t B_WUQ = B_CKVN + (size_t)NP * 128;
constexpr size_t B_WQL = B_WUQ + (size_t)768 * 256;
constexpr size_t B_WUK = B_WQL + (size_t)1024 * 256;
constexpr size_t B_WUV = B_WUK + (size_t)512 * 128;
constexpr size_t B_OLAT = B_WUV + (size_t)512 * 128;
constexpr size_t B_WUVBD = B_OLAT + (size_t)NS * 1024;
constexpr size_t B_END = B_WUVBD + (size_t)512 * 1024;
constexpr size_t WS_BYTES = W_END * 4 + B_END * 2;
constexpr int LDS_BYTES = 147456;

struct Params {
  const float* x_prompt; const float* x_sample; const float* mem_prompt; const float* cache_ckv; const float* cache_kpe;
  const int* page_table; const float* state_wkv; const float* state_shift; const float* cache_mem_k; const float* cache_mem_v;
  const float* ln_g; const float* w_in; const float* q_norm_g; const float* kv_norm_g; const float* w_uq; const float* w_uk;
  const float* w_uv; const float* shift_mu; const float* w0; const float* w_up; const float* a0; const float* a_up;
  const float* k_k; const float* k_a; const float* r_k; const float* lnx_g; const float* lnx_b; const float* mem_norm_g;
  const float* w_mem_kv; const float* w_out; const float* final_g;
  float* out; float* ws;
};

__device__ __forceinline__ unsigned f2bf(float f);
__device__ __forceinline__ unsigned pk2(float lo, float hi);
typedef unsigned short bf16;
__device__ __forceinline__ float wave_sum(float v) {
#pragma unroll
  for (int o = 1; o < 64; o <<= 1) v += __shfl_xor(v, o);
  return v;
}
__device__ __forceinline__ float wave_max(float v) {
#pragma unroll
  for (int o = 1; o < 64; o <<= 1) v = fmaxf(v, __shfl_xor(v, o));
  return v;
}
__device__ __forceinline__ float silu(float x) { return x / (1.f + expf(-x)); }
__device__ __forceinline__ const float* xrow(const Params& p, int row) {
  return row < NP ? p.x_prompt + (size_t)row * DM : p.x_sample + (size_t)(row - NP) * DM;
}
__device__ __forceinline__ float* ckv_out_row(const Params& p, int row) {
  return row < NP ? p.out + O_CKVP + (size_t)row * 128 : p.out + O_CKVS + (size_t)(row - NP) * 128;
}
__device__ __forceinline__ float* kpe_out_row(const Params& p, int row) {
  return row < NP ? p.out + O_KPEP + (size_t)row * 32 : p.out + O_KPES + (size_t)(row - NP) * 32;
}

template <bool BT>
__device__ __forceinline__ void gemm_f32(const float* __restrict__ A, int lda, const float* __restrict__ B, int ldb, float* __restrict__ C, int ldc,
                         int M, int N, int K, float* sm) {
  const int tid = threadIdx.x, tx = tid & 15, ty = tid >> 4;
  float(*As)[68] = (float(*)[68])sm;
  float(*Bs)[68] = (float(*)[68])(sm + 16 * 68);
  const int tm = M / 64, tn = (N + 63) / 64;
  for (int tile = blockIdx.x; tile < tm * tn; tile += gridDim.x) {
    const int m0 = (tile / tn) * 64, n0 = (tile % tn) * 64;
    float acc[2][4];
#pragma unroll
    for (int i = 0; i < 2; ++i)
#pragma unroll
      for (int j = 0; j < 4; ++j) acc[i][j] = 0.f;
    for (int k0 = 0; k0 < K; k0 += 16) {
      for (int i = tid; i < 1024; i += 512) { const int r = i >> 4, kk = i & 15; As[kk][r] = A[(size_t)(m0 + r) * lda + k0 + kk]; }
      if (BT) {
        for (int i = tid; i < 1024; i += 512) { const int c = i >> 4, kk = i & 15; Bs[kk][c] = (n0 + c < N) ? B[(size_t)(n0 + c) * ldb + k0 + kk] : 0.f; }
      } else {
        for (int i = tid; i < 1024; i += 512) { const int kk = i >> 6, c = i & 63; Bs[kk][c] = (n0 + c < N) ? B[(size_t)(k0 + kk) * ldb + n0 + c] : 0.f; }
      }
      __syncthreads();
#pragma unroll
      for (int kk = 0; kk < 16; ++kk) {
        const float a0 = As[kk][ty * 2], a1 = As[kk][ty * 2 + 1];
        const float b0 = Bs[kk][tx * 4], b1 = Bs[kk][tx * 4 + 1], b2 = Bs[kk][tx * 4 + 2], b3 = Bs[kk][tx * 4 + 3];
        acc[0][0] += a0 * b0; acc[0][1] += a0 * b1; acc[0][2] += a0 * b2; acc[0][3] += a0 * b3;
        acc[1][0] += a1 * b0; acc[1][1] += a1 * b1; acc[1][2] += a1 * b2; acc[1][3] += a1 * b3;
      }
      __syncthreads();
    }
#pragma unroll
    for (int i = 0; i < 2; ++i)
#pragma unroll
      for (int j = 0; j < 4; ++j) { const int col = n0 + tx * 4 + j; if (col < N) C[(size_t)(m0 + ty * 2 + i) * ldc + col] = acc[i][j]; }
  }
}

template <int D1, int D2, int DV>
__device__ __forceinline__ void attn_row_tile(const float* wsm, const float* k1, const float* k2, const float* v, bool valid, int lane,
                                              float& m, float& l, float& o0, float& o1) {
  float sc = 0.f;
#pragma unroll 4
  for (int c = 0; c < D1; c += 4) { const float4 kv = *(const float4*)(k1 + c); sc += wsm[c] * kv.x + wsm[c + 1] * kv.y + wsm[c + 2] * kv.z + wsm[c + 3] * kv.w; }
  if (D2 > 0)
#pragma unroll 4
  for (int c = 0; c < D2; c += 4) { const float4 kv = *(const float4*)(k2 + c); sc += wsm[D1 + c] * kv.x + wsm[D1 + c + 1] * kv.y + wsm[D1 + c + 2] * kv.z + wsm[D1 + c + 3] * kv.w; }
  sc = valid ? sc : -1e30f;
  const float tmax = wave_max(sc), mn = fmaxf(m, tmax), alpha = expf(m - mn), pj = valid ? expf(sc - mn) : 0.f;
  l = l * alpha + wave_sum(pj); o0 *= alpha; o1 *= alpha;
  const unsigned long long pa = (unsigned long long)(uintptr_t)v;
  const int plo = (int)(unsigned)(pa & 0xffffffffull), phi = (int)(unsigned)(pa >> 32);
#pragma unroll 2
  for (int j = 0; j < 64; ++j) {
    const float pjj = __shfl(pj, j);
    const unsigned lo = (unsigned)__shfl(plo, j), hi = (unsigned)__shfl(phi, j);
    const float* vj = (const float*)(uintptr_t)(((unsigned long long)hi << 32) | lo);
    o0 += pjj * vj[lane];
    if (DV > 64) o1 += pjj * vj[64 + lane];
  }
  m = mn;
}

__device__ __forceinline__ void prompt_attn_wave(const Params& p, int bh, int qb, int lane, float* wsm) {
  const int b = bh >> 3, h = bh & 7;
  const float* Q = p.ws + W_Q; const float* KN = p.ws + W_KN; const float* V = p.ws + W_V; const float* KPE = p.out + O_KPEP;
  for (int qi = 0; qi < 64; ++qi) {
    const int s = qb * 64 + qi, row = b * SEQ + s;
    wsm[lane] = Q[(size_t)row * 768 + h * 96 + lane] * MLA_SCALE;
    if (lane < 32) wsm[64 + lane] = Q[(size_t)row * 768 + h * 96 + 64 + lane] * MLA_SCALE;
    float m = -1e30f, l = 0.f, o0 = 0.f, o1 = 0.f;
    for (int tile = 0; tile <= qb; ++tile) {
      const int j = tile * 64 + lane;
      const size_t krow = (size_t)b * SEQ + j;
      attn_row_tile<64, 32, 64>(wsm, KN + krow * 512 + h * 64, KPE + krow * 32, V + krow * 512 + h * 64, j <= s, lane, m, l, o0, o1);
    }
    const float g = p.ws[W_PROJ + (size_t)row * INC + C_GMLA + h * 64 + lane];
    p.ws[W_MIX + (size_t)row * 1024 + h * 64 + lane] = o0 / l * silu(g);
  }
}

__device__ __forceinline__ void sample_attn_wave(const Params& p, int rowid  , int lane, float* wsm) {
  const int h = rowid & 7, t = (rowid >> 3) & 7, db = rowid >> 6;
  const int srow = db * 8 + t, row = NP + srow;
  const float* QLAT = p.ws + W_QLAT; const float* Q = p.ws + W_Q;
  wsm[lane] = QLAT[(size_t)srow * 1024 + h * 128 + lane] * MLA_SCALE;
  wsm[64 + lane] = QLAT[(size_t)srow * 1024 + h * 128 + 64 + lane] * MLA_SCALE;
  if (lane < 32) wsm[128 + lane] = Q[(size_t)row * 768 + h * 96 + 64 + lane] * MLA_SCALE;
  float m = -1e30f, l = 0.f, o0 = 0.f, o1 = 0.f;
  for (int tile = 0; tile <= 128; ++tile) {
    const float* ckv; const float* kpe; bool valid;
    if (tile < 128) {
      const int k = tile * 64 + lane;
      const int page = p.page_table[db * NPG + (k >> 7)];
      const size_t base = (size_t)page * PAGE + (k & 127);
      ckv = p.cache_ckv + base * 128; kpe = p.cache_kpe + base * 32; valid = true;
    } else {
      const int u = lane < 8 ? lane : 0;
      valid = (lane < 8) && (lane <= t);
      ckv = p.out + O_CKVS + (size_t)(db * 8 + u) * 128; kpe = p.out + O_KPES + (size_t)(db * 8 + u) * 32;
    }
    attn_row_tile<128, 32, 128>(wsm, ckv, kpe, ckv, valid, lane, m, l, o0, o1);
  }
  float* OLAT = p.ws + W_OLAT;
  OLAT[(size_t)srow * 1024 + h * 128 + lane] = o0 / l;
  OLAT[(size_t)srow * 1024 + h * 128 + 64 + lane] = o1 / l;
}

__device__ __forceinline__ void mem_attn_wave(const Params& p, int item, int lane, float* wsm) {
  const int h = item / (NS / 2), r0 = NP + (item - h * (NS / 2)) * 2;
  for (int ri = 0; ri < 2; ++ri) {
    const int row = r0 + ri;
    const int db = (row - NP) >> 3;
    const float* kbase = p.cache_mem_k + (size_t)db * 256 * 256 + h * 64; const float* vbase = p.cache_mem_v + (size_t)db * 256 * 256 + h * 64;
    wsm[lane] = p.ws[W_PROJ + (size_t)row * INC + C_QX + h * 64 + lane] * X_SCALE;
    float m = -1e30f, l = 0.f, o0 = 0.f, o1 = 0.f;
    for (int tile = 0; tile < 4; ++tile) {
      const int j = tile * 64 + lane;
      attn_row_tile<64, 0, 64>(wsm, kbase + (size_t)j * 256, nullptr, vbase + (size_t)j * 256, true, lane, m, l, o0, o1);
    }
    const float g = p.ws[W_PROJ + (size_t)row * INC + C_GX + h * 64 + lane];
    ((bf16*)(p.ws + W_END))[B_MIX + (size_t)row * 1024 + 768 + h * 64 + lane] = (bf16)f2bf(o0 / l * silu(g));
  }
}

#define CBAR() asm volatile("" ::: "memory")
__device__ __forceinline__ void rwkv_scan_wave(const Params& p, bool prompt, int bi, int h, int lane, float* wsm  ) {
  float S[64];
  const float* s0 = p.state_wkv + ((size_t)(bi * 4 + h) * 64 + lane) * 64;
#pragma unroll
  for (int k = 0; k < 64; ++k) S[k] = prompt ? 0.f : s0[k];
  const int T = prompt ? SEQ : DT, row0 = prompt ? bi * SEQ : NP + bi * DT;
  const float lg = p.lnx_g[h * 64 + lane], lb = p.lnx_b[h * 64 + lane], rk = p.r_k[h * 64 + lane];
#pragma unroll 1
  for (int t = 0; t < T; ++t) {
    const int row = row0 + t;
    const size_t off = (size_t)row * 256 + h * 64 + lane;
    const float r_l = p.ws[W_R + off], w_l = p.ws[W_W + off], kf_l = p.ws[W_KF + off], kk_l = p.ws[W_KK + off], bb_l = p.ws[W_BB + off];
    const float vv = p.ws[W_VV + off];
    wsm[lane] = kk_l; wsm[64 + lane] = w_l; wsm[128 + lane] = bb_l; wsm[192 + lane] = kf_l; wsm[256 + lane] = r_l;
    CBAR();
    float sa = 0.f;
#pragma unroll
    for (int c = 0; c < 4; ++c) {
#pragma unroll
      for (int k = 16 * c; k < 16 * c + 16; ++k) sa += S[k] * wsm[k];
      CBAR();
    }
    sa = -sa;
    float y = 0.f;
#pragma unroll
    for (int c = 0; c < 8; ++c) {
#pragma unroll
      for (int k = 8 * c; k < 8 * c + 8; ++k) { S[k] = S[k] * wsm[64 + k] + sa * wsm[128 + k] + vv * wsm[192 + k]; y += S[k] * wsm[256 + k]; }
      CBAR();
    }
    const float mean = wave_sum(y) * (1.f / 64.f), d = y - mean, var = wave_sum(d * d) * (1.f / 64.f);
    const float yn = d * rsqrtf(var + GN_EPS) * lg + lb;
    const float bsum = wave_sum(r_l * kf_l * rk);
    const float o = yn + bsum * vv;
    const float g = p.ws[W_PROJ + (size_t)row * INC + C_GRWKV + h * 64 + lane];
    ((bf16*)(p.ws + W_END))[B_MIX + (size_t)row * 1024 + 512 + h * 64 + lane] = (bf16)f2bf(o * silu(g));
    CBAR();
  }
  float* so = prompt ? p.out + O_WKVP + ((size_t)(bi * 4 + h) * 64 + lane) * 64 : p.out + O_WKVS + ((size_t)(bi * 4 + h) * 64 + lane) * 64;
#pragma unroll
  for (int k = 0; k < 64; ++k) so[k] = S[k];
}


namespace pg8 {
typedef unsigned u32x2 __attribute__((ext_vector_type(2)));
template <class F> struct EpiBf16F {
  static constexpr bool PERM = true, AFTER_DRAIN = false;
  F f; float scale;
  __device__ __forceinline__ void operator()(const f32x4 (&acc)[2][2][4][2], const Unit& u, int wr, int wc, int fr, int fq) const {
    int fr_ = fr, fq_ = fq; asm volatile("" : "+v"(fr_), "+v"(fq_));
    const int row0 = u.pm * BM + wr * 64 + fr_, col0 = u.pn * BM + wc * 32 + 8 * fq_;
#pragma unroll
    for (int ai = 0; ai < 2; ++ai)
#pragma unroll
      for (int m = 0; m < 4; ++m)
#pragma unroll
        for (int bj = 0; bj < 2; ++bj) {
          bf16_t* dst = f(row0 + ai * HALF + m * 16, col0 + bj * HALF);
          if (dst) { const f32x4 v0 = acc[ai][bj][m][0] * scale, v1 = acc[ai][bj][m][1] * scale;
            u32x4 w; w.x = cvt_pk_bf16(v0[0], v0[1]); w.y = cvt_pk_bf16(v0[2], v0[3]); w.z = cvt_pk_bf16(v1[0], v1[1]); w.w = cvt_pk_bf16(v1[2], v1[3]);
            *(u32x4*)dst = w; }
        }
  }
};
struct EpiQ {
  static constexpr bool PERM = false, AFTER_DRAIN = false;
  bf16_t* Qp; bf16_t* Qs; const float* CS; float scale; int np;
  __device__ __forceinline__ void operator()(const f32x4 (&acc)[2][2][4][2], const Unit& u, int wr, int wc, int fr0, int fq0) const {
    int fr = fr0, fq = fq0; asm volatile("" : "+v"(fr), "+v"(fq));
    const int row0 = u.pm * BM + wr * 64 + fr;
    if (u.pn < 2) {
      if (u.pm * BM >= np) return;
#pragma unroll
      for (int ai = 0; ai < 2; ++ai)
#pragma unroll
        for (int m = 0; m < 4; ++m) {
          const int row = row0 + ai * HALF + m * 16;
#pragma unroll
          for (int bj = 0; bj < 2; ++bj)
#pragma unroll
            for (int n = 0; n < 2; ++n) {
              const int col = u.pn * BM + bj * HALF + wc * 32 + 16 * n + 4 * fq, head = col >> 6, d = col & 63;
              const f32x4 v = acc[ai][bj][m][n] * scale;
              *(u32x2*)(Qp + (size_t)row * 768 + head * 96 + d) = (u32x2){cvt_pk_bf16(v[0], v[1]), cvt_pk_bf16(v[2], v[3])};
            }
        }
    } else {
#pragma unroll
      for (int ai = 0; ai < 2; ++ai)
#pragma unroll
        for (int m = 0; m < 4; ++m) {
          const int row = row0 + ai * HALF + m * 16;
          const bool pr = row < np;
          const int pi = pr ? (row & 4095) : 4096 + ((row - np) & 7);
#pragma unroll
          for (int n = 0; n < 2; ++n) {
            const int head = 2 * wc + n, j = 4 * fq;
            const f32x4 cs0 = *(const f32x4*)(CS + ((size_t)pi * 16 + j) * 2), cs1 = *(const f32x4*)(CS + ((size_t)pi * 16 + j) * 2 + 4);
            const f32x4 x1 = acc[ai][0][m][n], x2 = acc[ai][1][m][n];
            f32x4 y1, y2;
            y1[0] = x1[0] * cs0[0] - x2[0] * cs0[1]; y2[0] = x2[0] * cs0[0] + x1[0] * cs0[1];
            y1[1] = x1[1] * cs0[2] - x2[1] * cs0[3]; y2[1] = x2[1] * cs0[2] + x1[1] * cs0[3];
            y1[2] = x1[2] * cs1[0] - x2[2] * cs1[1]; y2[2] = x2[2] * cs1[0] + x1[2] * cs1[1];
            y1[3] = x1[3] * cs1[2] - x2[3] * cs1[3]; y2[3] = x2[3] * cs1[2] + x1[3] * cs1[3];
            y1 = y1 * scale; y2 = y2 * scale;
            bf16_t* dst = pr ? Qp + (size_t)row * 768 + head * 96 + 64 + j : Qs + ((size_t)(row - np) * 8 + head) * 160 + 128 + j;
            *(u32x2*)dst = (u32x2){cvt_pk_bf16(y1[0], y1[1]), cvt_pk_bf16(y1[2], y1[3])};
            *(u32x2*)(dst + 16) = (u32x2){cvt_pk_bf16(y2[0], y2[1]), cvt_pk_bf16(y2[2], y2[3])};
          }
        }
    }
  }
};
}

namespace pg8 {
struct EpiGateBf16 {
  static constexpr bool PERM = true, AFTER_DRAIN = false;
  bf16_t* O; int ldo; const float* G; int ldg;
  __device__ __forceinline__ float sl(float x) const { return x / (1.f + __expf(-x)); }
  __device__ __forceinline__ void operator()(const f32x4 (&acc)[2][2][4][2], const Unit& u, int wr, int wc, int fr0, int fq0) const {
    int fr = fr0, fq = fq0; asm volatile("" : "+v"(fr), "+v"(fq));
    const int row0 = u.pm * BM + wr * 64 + fr, col0 = u.pn * BM + wc * 32 + 8 * fq;
#pragma unroll
    for (int ai = 0; ai < 2; ++ai)
#pragma unroll
      for (int m = 0; m < 4; ++m)
#pragma unroll
        for (int bj = 0; bj < 2; ++bj) {
          const int row = row0 + ai * HALF + m * 16, col = col0 + bj * HALF;
          const f32x4 g0 = *(const f32x4*)(G + (size_t)row * ldg + col), g1 = *(const f32x4*)(G + (size_t)row * ldg + col + 4);
          const f32x4 v0 = acc[ai][bj][m][0], v1 = acc[ai][bj][m][1];
          u32x4 w; w.x = cvt_pk_bf16(v0[0] * sl(g0[0]), v0[1] * sl(g0[1])); w.y = cvt_pk_bf16(v0[2] * sl(g0[2]), v0[3] * sl(g0[3]));
          w.z = cvt_pk_bf16(v1[0] * sl(g1[0]), v1[1] * sl(g1[1])); w.w = cvt_pk_bf16(v1[2] * sl(g1[2]), v1[3] * sl(g1[3]));
          *(u32x4*)(O + (size_t)row * ldo + col) = w;
        }
  }
};
}
#define LAS __attribute__((address_space(3)))
namespace pa {
typedef short bf16x8 __attribute__((ext_vector_type(8)));
typedef short s16x4 __attribute__((ext_vector_type(4)));
typedef float f32x16 __attribute__((ext_vector_type(16)));
typedef unsigned u32x4 __attribute__((ext_vector_type(4)));
typedef unsigned u32x2 __attribute__((ext_vector_type(2)));
typedef float f32x2_t __attribute__((ext_vector_type(2)));
typedef __bf16 bf16x2_t __attribute__((ext_vector_type(2)));
constexpr int KSTR = 208, VSTR = 136, KBYTES = 64 * KSTR, VBYTES = 64 * VSTR, STG = KBYTES + VBYTES;
__device__ __forceinline__ unsigned cvtpk(float lo, float hi) { f32x2_t v = {lo, hi}; bf16x2_t b = __builtin_convertvector(v, bf16x2_t); return __builtin_bit_cast(unsigned, b); }
__device__ __forceinline__ int crow(int r, int hi) { return (r & 3) + 8 * (r >> 2) + 4 * hi; }
__device__ __forceinline__ float swap_max(float v) { auto rr = __builtin_amdgcn_permlane32_swap(__float_as_uint(v), __float_as_uint(v), false, false); return fmaxf(__uint_as_float(rr[0]), __uint_as_float(rr[1])); }
__device__ __forceinline__ float swap_sum(float v) { auto rr = __builtin_amdgcn_permlane32_swap(__float_as_uint(v), __float_as_uint(v), false, false); return __uint_as_float(rr[0]) + __uint_as_float(rr[1]); }

template <int DQK, bool CAUSAL, class Out>
__device__ __forceinline__ void attn_unit(unsigned char* lds, const bf16* Qb, int qs, const bf16* Kb, int ks, const bf16* Vb, int vs, int ntiles, int qpos0, const Out& out, int wid_s) {
  const int tid = mk_tid(wid_s), lane = tid & 63, wid = wid_s, r32 = lane & 31, hi = lane >> 5;
  constexpr int CPR = DQK / 8, NKC = 64 * CPR, KS = DQK / 16;
  bf16x8 qf[KS];
#pragma unroll
  for (int s = 0; s < KS; ++s) qf[s] = *(const bf16x8*)(Qb + (size_t)(wid * 32 + r32) * qs + 16 * s + 8 * hi);
  u32x4 kreg0, kreg1, vreg;
  const int kc0 = tid, kc1 = tid + 512;
  const int krow0 = kc0 / CPR, kcc0 = kc0 % CPR, krow1 = kc1 / CPR, kcc1 = kc1 % CPR;
  const int vdv = tid >> 3, vcc = tid & 7;
#define PA_GLOAD(t) do { kreg0 = *(const u32x4*)(Kb + (size_t)(64 * (t) + krow0) * ks + kcc0 * 8); \
    if (kc1 < NKC) kreg1 = *(const u32x4*)(Kb + (size_t)(64 * (t) + krow1) * ks + kcc1 * 8); \
    vreg = *(const u32x4*)(Vb + (size_t)vdv * vs + 64 * (t) + vcc * 8); } while (0)
#define PA_LSTORE(buf) do { unsigned char* b_ = lds + (buf) * STG; *(u32x4*)(b_ + krow0 * KSTR + kcc0 * 16) = kreg0; \
    if (kc1 < NKC) *(u32x4*)(b_ + krow1 * KSTR + kcc1 * 16) = kreg1; \
    *(u32x2*)(b_ + KBYTES + vdv * VSTR + vcc * 16) = (u32x2){vreg.x, vreg.y}; *(u32x2*)(b_ + KBYTES + vdv * VSTR + vcc * 16 + 8) = (u32x2){vreg.z, vreg.w}; } while (0)
  PA_GLOAD(0); PA_LSTORE(0); __syncthreads();
  f32x16 o0, o1;
#pragma unroll
  for (int r = 0; r < 16; ++r) { o0[r] = 0.f; o1[r] = 0.f; }
  float m = -1e30f, l = 0.f;
  const int qlo = qpos0 + 32 * wid;
  for (int t = 0; t < ntiles; ++t) {
    if (t + 1 < ntiles) PA_GLOAD(t + 1);
    const unsigned char* kb = lds + (t & 1) * STG; const unsigned char* vb = kb + KBYTES;
    const bool active = !CAUSAL || (64 * t <= qlo + 31);
    if (active) {
      f32x16 p0, p1;
#pragma unroll
      for (int r = 0; r < 16; ++r) { p0[r] = 0.f; p1[r] = 0.f; }
#pragma unroll
      for (int s = 0; s < KS; ++s) {
        const bf16x8 a0 = *(const bf16x8*)(kb + r32 * KSTR + (16 * s + 8 * hi) * 2);
        const bf16x8 a1 = *(const bf16x8*)(kb + (32 + r32) * KSTR + (16 * s + 8 * hi) * 2);
        p0 = __builtin_amdgcn_mfma_f32_32x32x16_bf16(a0, qf[s], p0, 0, 0, 0);
        p1 = __builtin_amdgcn_mfma_f32_32x32x16_bf16(a1, qf[s], p1, 0, 0, 0);
      }
      if (CAUSAL && (64 * t + 63 > qlo)) {
        const int q = qlo + r32;
#pragma unroll
        for (int r = 0; r < 16; ++r) { const int key = 64 * t + crow(r, hi); if (key > q) p0[r] = -1e30f; if (key + 32 > q) p1[r] = -1e30f; }
      }
      float mx = fmaxf(p0[0], p1[0]);
#pragma unroll
      for (int r = 1; r < 16; ++r) mx = fmaxf(mx, fmaxf(p0[r], p1[r]));
      mx = swap_max(mx);
      const float mn = fmaxf(m, mx), alpha = __builtin_amdgcn_exp2f(m - mn);
      m = mn;
      float ps = 0.f;
#pragma unroll
      for (int r = 0; r < 16; ++r) { p0[r] = __builtin_amdgcn_exp2f(p0[r] - mn); p1[r] = __builtin_amdgcn_exp2f(p1[r] - mn); ps += p0[r] + p1[r]; }
      l = l * alpha + ps;
#pragma unroll
      for (int r = 0; r < 16; ++r) { o0[r] *= alpha; o1[r] *= alpha; }
      bf16x8 pb[4];
#pragma unroll
      for (int k = 0; k < 4; ++k) {
        u32x4 w;
        if (k < 2) { w.x = cvtpk(p0[8 * k], p0[8 * k + 1]); w.y = cvtpk(p0[8 * k + 2], p0[8 * k + 3]); w.z = cvtpk(p0[8 * k + 4], p0[8 * k + 5]); w.w = cvtpk(p0[8 * k + 6], p0[8 * k + 7]); }
        else { const int kk = k - 2; w.x = cvtpk(p1[8 * kk], p1[8 * kk + 1]); w.y = cvtpk(p1[8 * kk + 2], p1[8 * kk + 3]); w.z = cvtpk(p1[8 * kk + 4], p1[8 * kk + 5]); w.w = cvtpk(p1[8 * kk + 6], p1[8 * kk + 7]); }
        pb[k] = __builtin_bit_cast(bf16x8, w);
      }
#pragma unroll
      for (int k = 0; k < 4; ++k) {
#pragma unroll
        for (int d = 0; d < 2; ++d) {
          const unsigned char* vp = vb + (32 * d + r32) * VSTR + (16 * k + 4 * hi) * 2;
          const u32x2 lo = *(const u32x2*)vp, hi2 = *(const u32x2*)(vp + 16);
          const u32x4 w = {lo.x, lo.y, hi2.x, hi2.y};
          const bf16x8 va = __builtin_bit_cast(bf16x8, w);
          if (d == 0) o0 = __builtin_amdgcn_mfma_f32_32x32x16_bf16(va, pb[k], o0, 0, 0, 0);
          else o1 = __builtin_amdgcn_mfma_f32_32x32x16_bf16(va, pb[k], o1, 0, 0, 0);
        }
      }
    }
    if (t + 1 < ntiles) PA_LSTORE((t + 1) & 1);
    __syncthreads();
  }
#undef PA_GLOAD
#undef PA_LSTORE
  const float inv = 1.f / swap_sum(l);
#pragma unroll
  for (int g = 0; g < 4; ++g) {
    out(32 * wid + r32, 8 * g + 4 * hi, make_float4(o0[4 * g] * inv, o0[4 * g + 1] * inv, o0[4 * g + 2] * inv, o0[4 * g + 3] * inv));
    out(32 * wid + r32, 32 + 8 * g + 4 * hi, make_float4(o1[4 * g] * inv, o1[4 * g + 1] * inv, o1[4 * g + 2] * inv, o1[4 * g + 3] * inv));
  }
}
}

namespace sa {
using pa::bf16x8; using pa::f32x16; using pa::u32x4; using pa::u32x2; using pa::cvtpk; using pa::crow; using pa::swap_max; using pa::swap_sum;
typedef float f32x4 __attribute__((ext_vector_type(4)));
typedef short v4i16_t __attribute__((ext_vector_type(4)));
constexpr int KVSTR = 336, TILE = 64 * KVSTR;
__device__ __forceinline__ void sample_attn_item(unsigned char* lds, const Params& p, const bf16* Qs, float* PO, float* PML, int item, int wid_s) {
  const int db = item >> 1, half = item & 1;
  const int tid = mk_tid(wid_s), lane = tid & 63, wid = wid_s, r32 = lane & 31, hi = lane >> 5;
  const int qt = wid >> 2, ct = wid & 3;
  bf16x8 qf[10];
#pragma unroll
  for (int s = 0; s < 10; ++s) qf[s] = *(const bf16x8*)(Qs + (size_t)(db * 64 + 32 * qt + r32) * 160 + 16 * s + 8 * hi);
  const int ntiles = 64 + half;
  f32x4 st0, st1, st2, st3, sp;
  const f32x4 zero4 = {0.f, 0.f, 0.f, 0.f};
#define SA_GLOAD(t) do { if ((t) < 64) { const int key0_ = 4096 * half + 64 * (t); const int page_ = p.page_table[db * NPG + (key0_ >> 7)]; \
      const size_t base_ = (size_t)page_ * PAGE + (key0_ & 127); const float* ck_ = p.cache_ckv + base_ * 128; const float* kp_ = p.cache_kpe + base_ * 32; \
      st0 = *(const f32x4*)(ck_ + (size_t)(tid) * 4); st1 = *(const f32x4*)(ck_ + (size_t)(tid + 512) * 4); st2 = *(const f32x4*)(ck_ + (size_t)(tid + 1024) * 4); st3 = *(const f32x4*)(ck_ + (size_t)(tid + 1536) * 4); \
      sp = *(const f32x4*)(kp_ + (size_t)tid * 4); \
    } else { const float* ck_ = p.out + O_CKVS + (size_t)db * 8 * 128; const float* kp_ = p.out + O_KPES + (size_t)db * 8 * 32; \
      st0 = (tid < 256) ? *(const f32x4*)(ck_ + (size_t)tid * 4) : zero4; st1 = zero4; st2 = zero4; st3 = zero4; \
      sp = (tid < 64) ? *(const f32x4*)(kp_ + (size_t)tid * 4) : zero4; } } while (0)
#define SA_ST1(buf, f_, v_) do { const int key_ = (f_) >> 5, c4_ = (f_) & 31; *(u32x2*)(lds + (buf) * TILE + key_ * KVSTR + c4_ * 8) = (u32x2){cvtpk((v_).x, (v_).y), cvtpk((v_).z, (v_).w)}; } while (0)
#define SA_LSTORE(buf) do { SA_ST1(buf, tid, st0); SA_ST1(buf, tid + 512, st1); SA_ST1(buf, tid + 1024, st2); SA_ST1(buf, tid + 1536, st3); \
    { const int key_ = tid >> 3, c4_ = tid & 7; *(u32x2*)(lds + (buf) * TILE + key_ * KVSTR + 256 + c4_ * 8) = (u32x2){cvtpk(sp.x, sp.y), cvtpk(sp.z, sp.w)}; } } while (0)
  SA_GLOAD(0); SA_LSTORE(0); __syncthreads();
  f32x16 o;
#pragma unroll
  for (int r = 0; r < 16; ++r) o[r] = 0.f;
  float m = -1e30f, l = 0.f;
  const int tq = (32 * qt + r32) >> 3;
  for (int t = 0; t < ntiles; ++t) {
    if (t + 1 < ntiles) SA_GLOAD(t + 1);
    const unsigned char* kb = lds + (t & 1) * TILE;
    f32x16 p0, p1;
#pragma unroll
    for (int r = 0; r < 16; ++r) { p0[r] = 0.f; p1[r] = 0.f; }
#pragma unroll
    for (int s = 0; s < 10; ++s) {
      const bf16x8 a0 = *(const bf16x8*)(kb + r32 * KVSTR + (16 * s + 8 * hi) * 2);
      const bf16x8 a1 = *(const bf16x8*)(kb + (32 + r32) * KVSTR + (16 * s + 8 * hi) * 2);
      p0 = __builtin_amdgcn_mfma_f32_32x32x16_bf16(a0, qf[s], p0, 0, 0, 0);
      p1 = __builtin_amdgcn_mfma_f32_32x32x16_bf16(a1, qf[s], p1, 0, 0, 0);
    }
    if (t == 64) {
#pragma unroll
      for (int r = 0; r < 16; ++r) { const int u = crow(r, hi); if (!(u < 8 && u <= tq)) p0[r] = -1e30f; p1[r] = -1e30f; }
    }
    float mx = fmaxf(p0[0], p1[0]);
#pragma unroll
    for (int r = 1; r < 16; ++r) mx = fmaxf(mx, fmaxf(p0[r], p1[r]));
    mx = swap_max(mx);
    const float mn = fmaxf(m, mx), alpha = __builtin_amdgcn_exp2f(m - mn);
    m = mn;
    float ps = 0.f;
#pragma unroll
    for (int r = 0; r < 16; ++r) { p0[r] = __builtin_amdgcn_exp2f(p0[r] - mn); p1[r] = __builtin_amdgcn_exp2f(p1[r] - mn); ps += p0[r] + p1[r]; }
    l = l * alpha + ps;
#pragma unroll
    for (int r = 0; r < 16; ++r) o[r] *= alpha;
    bf16x8 pb[4];
#pragma unroll
    for (int k = 0; k < 4; ++k) {
      u32x4 w;
      if (k < 2) { w.x = cvtpk(p0[8 * k], p0[8 * k + 1]); w.y = cvtpk(p0[8 * k + 2], p0[8 * k + 3]); w.z = cvtpk(p0[8 * k + 4], p0[8 * k + 5]); w.w = cvtpk(p0[8 * k + 6], p0[8 * k + 7]); }
      else { const int kk = k - 2; w.x = cvtpk(p1[8 * kk], p1[8 * kk + 1]); w.y = cvtpk(p1[8 * kk + 2], p1[8 * kk + 3]); w.z = cvtpk(p1[8 * kk + 4], p1[8 * kk + 5]); w.w = cvtpk(p1[8 * kk + 6], p1[8 * kk + 7]); }
      pb[k] = __builtin_bit_cast(bf16x8, w);
    }
    {
      const int g = lane >> 4, i = lane & 15;
      const LAS unsigned char* vbase = (const LAS unsigned char*)kb + (4 * (g >> 1) + (i >> 2)) * KVSTR + (32 * ct + 16 * (g & 1) + 4 * (i & 3)) * 2;
#pragma unroll
      for (int k = 0; k < 4; ++k) {
        const v4i16_t lo = __builtin_amdgcn_ds_read_tr16_b64_v4i16((LAS v4i16_t*)(vbase + (16 * k) * KVSTR));
        const v4i16_t hi4 = __builtin_amdgcn_ds_read_tr16_b64_v4i16((LAS v4i16_t*)(vbase + (16 * k + 8) * KVSTR));
        const bf16x8 va = {lo[0], lo[1], lo[2], lo[3], hi4[0], hi4[1], hi4[2], hi4[3]};
        o = __builtin_amdgcn_mfma_f32_32x32x16_bf16(va, pb[k], o, 0, 0, 0);
      }
    }
    if (t + 1 < ntiles) SA_LSTORE((t + 1) & 1);
    __syncthreads();
  }
#undef SA_GLOAD
#undef SA_ST1
#undef SA_LSTORE
  const float lt = swap_sum(l);
  const int q = 32 * qt + r32;
  if (ct == 0 && hi == 0) { PML[((size_t)item * 64 + q) * 2] = m; PML[((size_t)item * 64 + q) * 2 + 1] = lt; }
#pragma unroll
  for (int g4 = 0; g4 < 4; ++g4) {
    const int c0 = 32 * ct + 8 * g4 + 4 * hi;
    *(f32x4*)(PO + ((size_t)item * 64 + q) * 128 + c0) = (f32x4){o[4 * g4], o[4 * g4 + 1], o[4 * g4 + 2], o[4 * g4 + 3]};
  }
}
}

namespace rw {
typedef float f32x4 __attribute__((ext_vector_type(4)));
constexpr int CH = 32, STEPF = 384, CHF = CH * STEPF;
__device__ __forceinline__ float dpp_sum16(float v) {
  v += __int_as_float(__builtin_amdgcn_update_dpp(0, __float_as_int(v), 0xB1, 0xF, 0xF, true));
  v += __int_as_float(__builtin_amdgcn_update_dpp(0, __float_as_int(v), 0x4E, 0xF, 0xF, true));
  v += __int_as_float(__builtin_amdgcn_update_dpp(0, __float_as_int(v), 0x141, 0xF, 0xF, true));
  v += __int_as_float(__builtin_amdgcn_update_dpp(0, __float_as_int(v), 0x140, 0xF, 0xF, true));
  return v;
}
__device__ __forceinline__ void rwkv_prompt_item(unsigned char* lds, const Params& p, int item, int wid_s) {
  const int bh = item >> 1, half = item & 1, b = bh >> 2, h = bh & 3;
  const int tid = mk_tid(wid_s), sub = tid & 15, vl = tid >> 4, v = 32 * half + vl;
  float* L = (float*)lds; float* yb = L + 2 * CHF;
  const float* ws = p.ws;
  const size_t rowbase = (size_t)b * SEQ;
  const int ls = tid >> 4, lk4 = tid & 15;
  f32x4 g0, g1, g2, g3, g4, g5;
#define RW_GLOAD(c) do { const size_t off_ = (rowbase + (size_t)(c) * CH + ls) * 256 + h * 64 + lk4 * 4; \
    g0 = *(const f32x4*)(ws + W_KK + off_); g1 = *(const f32x4*)(ws + W_W + off_); g2 = *(const f32x4*)(ws + W_BB + off_); \
    g3 = *(const f32x4*)(ws + W_KF + off_); g4 = *(const f32x4*)(ws + W_R + off_); g5 = *(const f32x4*)(ws + W_VV + off_); } while (0)
#define RW_LSTORE(buf) do { float* b_ = L + (buf) * CHF + ls * STEPF + lk4 * 4; *(f32x4*)(b_) = g0; *(f32x4*)(b_ + 64) = g1; *(f32x4*)(b_ + 128) = -g2; \
    *(f32x4*)(b_ + 192) = g3; *(f32x4*)(b_ + 256) = g4; *(f32x4*)(b_ + 320) = g5; } while (0)
  f32x4 S = {0.f, 0.f, 0.f, 0.f};
  RW_GLOAD(0); RW_LSTORE(0); __syncthreads();
  constexpr int NCH = SEQ / CH;
  struct Ops { f32x4 kk, w, nb, kf, r; float vv; };
#define RW_LD(o, s) do { const float* sb_ = cb + (s) * STEPF; (o).kk = *(const f32x4*)(sb_ + 4 * sub); (o).w = *(const f32x4*)(sb_ + 64 + 4 * sub); \
    (o).nb = *(const f32x4*)(sb_ + 128 + 4 * sub); (o).kf = *(const f32x4*)(sb_ + 192 + 4 * sub); (o).r = *(const f32x4*)(sb_ + 256 + 4 * sub); (o).vv = sb_[320 + v]; } while (0)
#define RW_STEP(o, s) do { const f32x4 t_ = (o).kf * (o).vv; const f32x4 d4_ = S * (o).kk; \
    float dot_ = (d4_.x + d4_.y) + (d4_.z + d4_.w); dot_ = dpp_sum16(dot_); \
    S = S * (o).w + ((o).nb * dot_ + t_); \
    const f32x4 y4_ = S * (o).r; float y_ = (y4_.x + y4_.y) + (y4_.z + y4_.w); y_ = dpp_sum16(y_); \
    ykeep = (sub == ((s) & 15)) ? y_ : ykeep; \
    if (((s) & 15) == 15) ybc[vl * 33 + ((s) - 15) + sub] = ykeep; } while (0)
  for (int c = 0; c < NCH; ++c) {
    if (c + 1 < NCH) RW_GLOAD(c + 1);
    const float* cb = L + (c & 1) * CHF;
    float* ybc = yb + (c & 1) * (32 * 33);
    float ykeep = 0.f;
    Ops A, B;
    RW_LD(A, 0);
#pragma unroll
    for (int s = 0; s < CH; s += 2) {
      RW_LD(B, s + 1);
      RW_STEP(A, s);
      if (s + 2 < CH) RW_LD(A, s + 2);
      RW_STEP(B, s + 1);
    }
    if (c + 1 < NCH) RW_LSTORE((c + 1) & 1);
    __syncthreads();
#pragma unroll
    for (int i = 0; i < 2; ++i) { const int f = tid + 512 * i, s = f >> 5, vv_ = f & 31;
      p.ws[W_Y + (rowbase + (size_t)c * CH + s) * 256 + h * 64 + 32 * half + vv_] = ybc[vv_ * 33 + s]; }
  }
#undef RW_LD
#undef RW_STEP
#undef RW_GLOAD
#undef RW_LSTORE
  *(f32x4*)(p.out + O_WKVP + ((size_t)(b * 4 + h) * 64 + v) * 64 + 4 * sub) = S;
  __syncthreads();
}
}

typedef unsigned v4u __attribute__((ext_vector_type(4)));
__device__ __forceinline__ unsigned f2bf(float f) { unsigned u = __builtin_bit_cast(unsigned, f); return (u + 0x7fffu + ((u >> 16) & 1u)) >> 16; }
__device__ __forceinline__ unsigned pk2(float lo, float hi) { return f2bf(lo) | (f2bf(hi) << 16); }
__device__ __forceinline__ void p0_transpose_item(const float* W, int K, int N, bf16* WT, int row_off, LAS float* scr, int item, int lane) {
  const int nblk = N / 32, kb = item / nblk, nb = item % nblk, k0 = 64 * kb, n0 = 32 * nb;
#pragma unroll 8
  for (int i = 0; i < 32; ++i) { const int kk = 2 * i + (lane >> 5); scr[kk * 33 + (lane & 31)] = W[(size_t)(k0 + kk) * N + n0 + (lane & 31)]; }
  asm volatile("s_waitcnt lgkmcnt(0)" ::: "memory");
  const int c = lane & 7;
#pragma unroll
  for (int j = 0; j < 4; ++j) { const int n = (lane >> 3) + 8 * j; const LAS float* s = scr + (8 * c) * 33 + n;
    v4u o; o.x = pk2(s[0 * 33], s[1 * 33]); o.y = pk2(s[2 * 33], s[3 * 33]); o.z = pk2(s[4 * 33], s[5 * 33]); o.w = pk2(s[6 * 33], s[7 * 33]);
    *(v4u*)(WT + (size_t)(row_off + n0 + n) * K + k0 + 8 * c) = o; }
  asm volatile("s_waitcnt lgkmcnt(0)" ::: "memory");
}

__global__ void __launch_bounds__(512) fwd_megakernel(Params p) {
  cg::grid_group grid = cg::this_grid();
  extern __shared__ __attribute__((aligned(16))) unsigned char lds[];
  float* sm = (float*)lds;
  bf16* wb = (bf16*)(p.ws + W_END);
  float* ws = p.ws;
  const int wid_s = __builtin_amdgcn_readfirstlane((int)(threadIdx.x >> 6));
#define PH_IDS const int tid = mk_tid(wid_s); const int lane = tid & 63, wv = tid >> 6; const int gw = blockIdx.x * 8 + wv, NGW = gridDim.x * 8; \
  const int gtid = blockIdx.x * 512 + tid, NTH = gridDim.x * 512; (void)lane; (void)wv; (void)gw; (void)NGW; (void)gtid; (void)NTH;
  { PH_IDS

  {
    LAS float* scr = (LAS float*)((LAS unsigned char*)lds + wv * 16384);
    constexpr int I_IN = 16 * (INC / 32), I_MEM = 16 * (512 / 32), I_OUT = 16 * (1024 / 32);
    for (int it = gw; it < I_IN + I_MEM + I_OUT; it += NGW) {
      int r = it;
      if (r < I_IN) { p0_transpose_item(p.w_in, 1024, INC, wb + B_WIN, 0, scr, r, lane); continue; } r -= I_IN;
      if (r < I_MEM) { p0_transpose_item(p.w_mem_kv, 1024, 512, wb + B_WMEM, 0, scr, r, lane); continue; } r -= I_MEM;
      p0_transpose_item(p.w_out, 1024, 1024, wb + B_WOUT, 0, scr, r, lane);
    }
    if (gtid < 64) ((unsigned*)(p.ws + W_CTL))[gtid] = 0u;
    for (int it = gw; it < 64; it += NGW) {
      if (it < 32) p0_transpose_item(p.w_uk, 128, 512, wb + B_WUK, 0, scr, it, lane);
      else p0_transpose_item(p.w_uv, 128, 512, wb + B_WUV, 0, scr, it - 32, lane);
    }
    for (int i = gtid; i < 768 * 256; i += NTH) {
      const int n = i >> 8, k = i & 255;
      const int orig = n < 512 ? (n >> 6) * 96 + (n & 63) : (n < 640 ? ((n - 512) >> 4) * 96 + 64 + ((n - 512) & 15) : ((n - 640) >> 4) * 96 + 80 + ((n - 640) & 15));
      wb[B_WUQ + i] = (bf16)f2bf(p.w_uq[(size_t)k * 768 + orig]);
    }
    for (int i = gtid; i < 1024 * 256; i += NTH) {
      const int n = i >> 8, k = i & 255, h = n >> 7, c = n & 127;
      const float* a = p.w_uq + (size_t)k * 768 + h * 96; const float* b = p.w_uk + (size_t)c * 512 + h * 64;
      float acc = 0.f;
#pragma unroll 8
      for (int d = 0; d < 64; ++d) acc += a[d] * b[d];
      wb[B_WQL + i] = (bf16)f2bf(acc);
    }
    for (int i = gtid; i < 512 * 1024; i += NTH) {
      const int n = i >> 10, k = i & 1023, h = n >> 6, hk = k >> 7, c = k & 127;
      wb[B_WUVBD + i] = hk == h ? (bf16)f2bf(p.w_uv[(size_t)c * 512 + n]) : (bf16)0;
    }
    for (int i = gtid; i < 4104 * 16; i += NTH) {
      const int pi = i >> 4, j = i & 15; const int pos = pi < 4096 ? pi : PAST + (pi - 4096);
      const float inv = 1.0f / powf(10000.0f, (float)j * (2.0f / 32.0f));
      const float ang = (float)pos * inv;
      p.ws[W_CS + (size_t)i * 2] = cosf(ang); p.ws[W_CS + (size_t)i * 2 + 1] = sinf(ang);
    }
    for (int i = gtid; i < (INCP - INC) * 1024 / 8; i += NTH) ((v4u*)(wb + B_WIN + (size_t)INC * 1024))[i] = (v4u){0u, 0u, 0u, 0u};
  }
  for (int r = gw; r < NT + 1024; r += NGW) {
    const float* src; const float* g; bf16* dst;
    if (r < NT) { src = xrow(p, r); g = p.ln_g; dst = wb + B_H + (size_t)r * 1024; }
    else { src = p.mem_prompt + (size_t)(r - NT) * 1024; g = p.mem_norm_g; dst = wb + B_HM + (size_t)(r - NT) * 1024; }
    float4 v[4]; float ss = 0.f;
#pragma unroll
    for (int i = 0; i < 4; ++i) { v[i] = *(const float4*)(src + 4 * lane + 256 * i); ss += v[i].x * v[i].x + v[i].y * v[i].y + v[i].z * v[i].z + v[i].w * v[i].w; }
    const float rs = rsqrtf(wave_sum(ss) * (1.f / 1024.f) + RMS_EPS);
#pragma unroll
    for (int i = 0; i < 4; ++i) {
      const float4 gg = *(const float4*)(g + 4 * lane + 256 * i);
      uint2 o; o.x = pk2(v[i].x * rs * gg.x, v[i].y * rs * gg.y); o.y = pk2(v[i].z * rs * gg.z, v[i].w * rs * gg.w);
      *(uint2*)(dst + 4 * lane + 256 * i) = o;
    }
  }
  }
  grid.sync();
  { PH_IDS

  {
    pg8::Gemm g{wb + B_H, wb + B_WIN, NT, INCP, 1024}; pg8::StaticOrder S; S.init(NT, INCP, (int)gridDim.x, (int)blockIdx.x);
    pg8::EpiF32 E{ws + W_PROJ, INC, INC, 0, 0, nullptr, nullptr, 0};
    pg8::gemm_phase<pg8::EpiF32, pg8::StaticOrder, true, true>((PG8_LAS unsigned char*)lds, g, S, E, wid_s);
  }
  {
    pg8::Gemm g{wb + B_HM, wb + B_WMEM, 1024, 512, 1024}; pg8::StaticOrder S; S.init(1024, 512, (int)gridDim.x, (int)((blockIdx.x + 20) % gridDim.x));
    pg8::EpiF32 E{p.out + O_MKP, 256, 256, 256, O_MVP - O_MKP, nullptr, nullptr, 0};
    pg8::gemm_phase<pg8::EpiF32, pg8::StaticOrder, true, true>((PG8_LAS unsigned char*)lds, g, S, E, wid_s);
  }
  }
  grid.sync();
  { PH_IDS

  for (size_t i = gtid; i < (size_t)4 * 256 * 256; i += NTH) {
    wb[B_KM + i] = (bf16)f2bf(p.out[O_MKP + i]);
    const size_t b_ = i >> 16, c = (i >> 8) & 255, m_ = i & 255;
    wb[B_VMT + i] = (bf16)f2bf(p.out[O_MVP + (b_ * 256 + m_) * 256 + c]);
  }
  {
    float* wl = sm; float* al = sm + 16384;
    float* tds = sm + 32768 + wv * 128;
    for (int i = tid; i < 4096; i += 512) { ((float4*)wl)[i] = ((const float4*)p.w_up)[i]; ((float4*)al)[i] = ((const float4*)p.a_up)[i]; }
    __syncthreads();
    for (int row = gw; row < NT; row += NGW) {
      const float* pr = ws + W_PROJ + (size_t)row * INC;
      {
        float v[4]; float ss = 0.f;
#pragma unroll
        for (int i = 0; i < 4; ++i) { v[i] = pr[C_CQ + lane + 64 * i]; ss += v[i] * v[i]; }
        const float rs = rsqrtf(wave_sum(ss) * (1.f / 256.f) + RMS_EPS);
#pragma unroll
        for (int i = 0; i < 4; ++i) wb[B_CQN + (size_t)row * 256 + lane + 64 * i] = (bf16)f2bf(v[i] * rs * p.q_norm_g[lane + 64 * i]);
      }
      {
        const float v0 = pr[C_CKV + lane], v1 = pr[C_CKV + 64 + lane];
        const float rs = rsqrtf(wave_sum(v0 * v0 + v1 * v1) * (1.f / 128.f) + RMS_EPS);
        float* o = ckv_out_row(p, row);
        const float c0 = v0 * rs * p.kv_norm_g[lane], c1 = v1 * rs * p.kv_norm_g[64 + lane];
        o[lane] = c0; o[64 + lane] = c1;
        if (row < NP) { wb[B_CKVN + (size_t)row * 128 + lane] = (bf16)f2bf(c0); wb[B_CKVN + (size_t)row * 128 + 64 + lane] = (bf16)f2bf(c1); }
      }
      const int pos = row < NP ? (row % SEQ) : PAST + ((row - NP) & 7);
      if (lane < 16) {
        const float inv = 1.0f / powf(10000.0f, (float)lane * (2.0f / 32.0f));
        const float ang = (float)pos * inv; const float c = cosf(ang), s = sinf(ang);
        const float x1 = pr[C_KR + lane], x2 = pr[C_KR + 16 + lane];
        float* o = kpe_out_row(p, row);
        const float y1 = x1 * c - x2 * s, y2 = x2 * c + x1 * s;
        o[lane] = y1; o[16 + lane] = y2;
        if (row < NP) {
          const bf16 b1 = (bf16)f2bf(y1), b2 = (bf16)f2bf(y2);
#pragma unroll
          for (int hh = 0; hh < 8; ++hh) { wb[B_KP + (size_t)row * 768 + hh * 96 + 64 + lane] = b1; wb[B_KP + (size_t)row * 768 + hh * 96 + 80 + lane] = b2; }
        }
      }
      if (row < NP) {
        const float XSC = X_SCALE * 1.4426950408889634f;
        const float4 v = *(const float4*)(pr + C_QX + lane * 4);
        *(uint2*)(wb + B_QX + (size_t)row * 256 + lane * 4) = make_uint2(pk2(v.x * XSC, v.y * XSC), pk2(v.z * XSC, v.w * XSC));
      }
      if (row < NP) { if ((row % SEQ) == SEQ - 1) { const int b = row / SEQ; for (int i = lane; i < 896; i += 64) p.out[O_SHP + (size_t)b * 896 + i] = pr[C_Z + i]; } }
      else { if (((row - NP) & 7) == 7) { const int db = (row - NP) >> 3; for (int i = lane; i < 896; i += 64) p.out[O_SHS + (size_t)db * 896 + i] = pr[C_Z + i]; } }
      {
        const bool first = row < NP ? ((row % SEQ) == 0) : (((row - NP) & 7) == 0);
        const float* prev = first ? (row < NP ? nullptr : p.state_shift + (size_t)((row - NP) >> 3) * 896 - C_Z) : pr - INC;
        auto zmix = [&](int i) -> float { const float z = pr[C_Z + i]; const float pv = prev ? prev[C_Z + i] : 0.f; return z + (pv - z) * p.shift_mu[i]; };
        tds[lane] = tanhf(zmix(768 + lane)); tds[64 + lane] = zmix(832 + lane);
        __builtin_amdgcn_fence(__ATOMIC_RELEASE, "wavefront"); __builtin_amdgcn_wave_barrier();
        float uu[4], aa[4];
#pragma unroll
        for (int hh = 0; hh < 4; ++hh) { uu[hh] = p.w0[hh * 64 + lane]; aa[hh] = p.a0[hh * 64 + lane]; }
#pragma unroll 8
        for (int j = 0; j < 64; ++j) {
          const float t_ = tds[j], a_ = tds[64 + j];
#pragma unroll
          for (int hh = 0; hh < 4; ++hh) { uu[hh] += t_ * wl[j * 256 + hh * 64 + lane]; aa[hh] += a_ * al[j * 256 + hh * 64 + lane]; }
        }
#pragma unroll
        for (int hh = 0; hh < 4; ++hh) {
          const int c = hh * 64 + lane;
          const float u = uu[hh], au = aa[hh];
          const float nu = -u;
          const float sp = fmaxf(nu, 0.f) + log1pf(expf(-fabsf(nu)));
          const float wlog = -sp - 0.5f;
          const float decay = expf(-expf(wlog));
          const float a = 1.f / (1.f + expf(-au));
          const float k = zmix(256 + c), r = zmix(c), v = zmix(512 + c);
          float kk = k * p.k_k[c];
          const float nrm = fmaxf(sqrtf(wave_sum(kk * kk)), 1e-12f);
          kk = kk / nrm;
          const float kf = k * (1.f + (a - 1.f) * p.k_a[c]);
          const size_t o = (size_t)row * 256 + c;
          ws[W_R + o] = r; ws[W_W + o] = decay; ws[W_KF + o] = kf; ws[W_VV + o] = v; ws[W_KK + o] = kk; ws[W_BB + o] = kk * a;
        }
        __builtin_amdgcn_fence(__ATOMIC_RELEASE, "wavefront"); __builtin_amdgcn_wave_barrier();
      }
    }
  }
  }
  grid.sync();
  { PH_IDS

  {
    const float QSC = MLA_SCALE * 1.4426950408889634f;
    const int G = (int)gridDim.x, bx = (int)blockIdx.x;
    {
      pg8::Gemm g{wb + B_CQN, wb + B_WUQ, NT, 768, 256}; pg8::StaticOrder S; S.init(NT, 768, G, bx);
      pg8::EpiQ E{wb + B_QP, wb + B_QS, ws + W_CS, QSC, NP};
      pg8::gemm_phase<pg8::EpiQ, pg8::StaticOrder, true, true>((PG8_LAS unsigned char*)lds, g, S, E, wid_s);
    }
    {
      bf16* Qs = wb + B_QS;
      auto f = [=](int row, int col) -> bf16* { return Qs + ((size_t)row * 8 + (col >> 7)) * 160 + (col & 127); };
      pg8::Gemm g{wb + B_CQN + (size_t)NP * 256, wb + B_WQL, NS, 1024, 256}; pg8::StaticOrder S; S.init(NS, 1024, G, (bx + G - 204 % G) % G);
      pg8::EpiBf16F<decltype(f)> E{f, QSC};
      pg8::gemm_phase<pg8::EpiBf16F<decltype(f)>, pg8::StaticOrder, true, true>((PG8_LAS unsigned char*)lds, g, S, E, wid_s);
    }
    {
      bf16* Kp = wb + B_KP;
      auto f = [=](int row, int col) -> bf16* { return Kp + (size_t)row * 768 + (col >> 6) * 96 + (col & 63); };
      pg8::Gemm g{wb + B_CKVN, wb + B_WUK, NP, 512, 128}; pg8::StaticOrder S; S.init(NP, 512, G, (bx + G - 220 % G) % G);
      pg8::EpiBf16F<decltype(f)> E{f, 1.f};
      pg8::gemm_phase<pg8::EpiBf16F<decltype(f)>, pg8::StaticOrder, true, true>((PG8_LAS unsigned char*)lds, g, S, E, wid_s);
    }
    {
      bf16* Vt = wb + B_VT;
      auto f = [=](int row, int col) -> bf16* { return Vt + (size_t)row * NP + col; };
      pg8::Gemm g{wb + B_WUV, wb + B_CKVN, 512, NP, 128}; pg8::StaticOrder S; S.init(512, NP, G, (bx + G - 92 % G) % G);
      pg8::EpiBf16F<decltype(f)> E{f, 1.f};
      pg8::gemm_phase<pg8::EpiBf16F<decltype(f)>, pg8::StaticOrder, true, true>((PG8_LAS unsigned char*)lds, g, S, E, wid_s);
    }
  }
  }
  grid.sync();
  { PH_IDS

  {
    unsigned* qctr = (unsigned*)(p.ws + W_CTL);
    volatile unsigned* qslot = (volatile unsigned*)(lds + LDS_BYTES - 16);
    constexpr int Q_RW = 32, Q_PA = 512, Q_SA = 256, Q_MA = 256, Q_TOT = Q_RW + Q_PA + Q_SA + Q_MA;
    for (;;) {
      if (tid == 0) *qslot = atomicAdd(qctr, 1u);
      __syncthreads();
      int item = (int)*qslot;
      __syncthreads();
      item = __builtin_amdgcn_readfirstlane(item);
      if (item >= Q_TOT) break;
      if (item < Q_RW) { rw::rwkv_prompt_item(lds, p, item, wid_s); continue; }
      item -= Q_RW;
      if (item < Q_PA) {
        const int bh = item & 31, qb = 15 - (item >> 5);
        const int b = bh >> 3, h = bh & 7;
        const size_t row0 = (size_t)b * SEQ + 256 * qb;
        auto out = [&](int ql, int dv0, float4 v) {
          const size_t row = row0 + ql;
          const float4 g = *(const float4*)(ws + W_PROJ + row * INC + C_GMLA + h * 64 + dv0);
          *(uint2*)(wb + B_MIX + row * 1024 + h * 64 + dv0) = make_uint2(pk2(v.x * silu(g.x), v.y * silu(g.y)), pk2(v.z * silu(g.z), v.w * silu(g.w)));
        };
        pa::attn_unit<96, true>(lds, wb + B_QP + row0 * 768 + h * 96, 768, wb + B_KP + (size_t)b * SEQ * 768 + h * 96, 768,
                                wb + B_VT + (size_t)(h * 64) * NP + (size_t)b * SEQ, NP, 4 * qb + 4, 256 * qb, out, wid_s);
        continue;
      }
      item -= Q_PA;
      if (item < Q_SA) { sa::sample_attn_item(lds, p, wb + B_QS, ws + W_PO, ws + W_PML, item, wid_s); continue; }
      item -= Q_SA;
      {
        const int qb = item & 15, h = (item >> 4) & 3, b = item >> 6;
        const size_t row0 = (size_t)b * SEQ + 256 * qb;
        auto out = [&](int ql, int dv0, float4 v) {
          const size_t row = row0 + ql;
          const float4 g = *(const float4*)(ws + W_PROJ + row * INC + C_GX + h * 64 + dv0);
          *(uint2*)(wb + B_MIX + row * 1024 + 768 + h * 64 + dv0) = make_uint2(pk2(v.x * silu(g.x), v.y * silu(g.y)), pk2(v.z * silu(g.z), v.w * silu(g.w)));
        };
        pa::attn_unit<64, false>(lds, wb + B_QX + row0 * 256 + h * 64, 256, wb + B_KM + (size_t)b * 65536 + h * 64, 256,
                                 wb + B_VMT + (size_t)b * 65536 + (size_t)(h * 64) * 256, 256, 4, 0, out, wid_s);
      }
    }
    __syncthreads();
  }
  {
    constexpr int N_RS = 512, N_MA = 4 * (NS / 2);
    constexpr int TOT = N_RS + N_MA;
    float* wsm = sm + wv * 320;
    for (int it = gw; it < TOT; it += NGW) {
      int i = __builtin_amdgcn_readfirstlane(it);
      if (i < N_RS) { rwkv_scan_wave(p, false, i >> 2, i & 3, lane, wsm); continue; }
      i -= N_RS;
      mem_attn_wave(p, i, lane, wsm);
    }
  }
  }
  grid.sync();
  { PH_IDS

  for (int i = gtid; i < NS * 8 * 32; i += NTH) {
    const int c4 = i & 31, h = (i >> 5) & 7, srow = i >> 8;
    const int db_ = srow >> 3, qi = (srow & 7) * 8 + h;
    const float* ml0 = ws + W_PML + ((size_t)(2 * db_) * 64 + qi) * 2; const float* ml1 = ml0 + 128;
    const float M_ = fmaxf(ml0[0], ml1[0]), w0_ = exp2f(ml0[0] - M_), w1_ = exp2f(ml1[0] - M_);
    const float invL = 1.f / (ml0[1] * w0_ + ml1[1] * w1_);
    const float4 a = *(const float4*)(ws + W_PO + ((size_t)(2 * db_) * 64 + qi) * 128 + c4 * 4), b2 = *(const float4*)(ws + W_PO + ((size_t)(2 * db_ + 1) * 64 + qi) * 128 + c4 * 4);
    *(uint2*)(wb + B_OLAT + (size_t)srow * 1024 + h * 128 + c4 * 4) = make_uint2(pk2((a.x * w0_ + b2.x * w1_) * invL, (a.y * w0_ + b2.y * w1_) * invL), pk2((a.z * w0_ + b2.z * w1_) * invL, (a.w * w0_ + b2.w * w1_) * invL));
  }
  for (int it = gw; it < NP * 4; it += NGW) {
    const int row = it >> 2, h = it & 3;
    const size_t off = (size_t)row * 256 + h * 64 + lane;
    const float y = ws[W_Y + off];
    const float mean = wave_sum(y) * (1.f / 64.f), d = y - mean, var = wave_sum(d * d) * (1.f / 64.f);
    const float yn = d * rsqrtf(var + GN_EPS) * p.lnx_g[h * 64 + lane] + p.lnx_b[h * 64 + lane];
    const float bsum = wave_sum(ws[W_R + off] * ws[W_KF + off] * p.r_k[h * 64 + lane]);
    const float o = yn + bsum * ws[W_VV + off];
    const float g = ws[W_PROJ + (size_t)row * INC + C_GRWKV + h * 64 + lane];
    wb[B_MIX + (size_t)row * 1024 + 512 + h * 64 + lane] = (bf16)f2bf(o * silu(g));
  }
  grid.sync();
  {
    pg8::Gemm g{wb + B_OLAT, wb + B_WUVBD, NS, 512, 1024}; pg8::StaticOrder S; S.init(NS, 512, (int)gridDim.x, (int)blockIdx.x);
    pg8::EpiGateBf16 E{wb + B_MIX + (size_t)NP * 1024, 1024, ws + W_PROJ + (size_t)NP * INC + C_GMLA, INC};
    pg8::gemm_phase<pg8::EpiGateBf16, pg8::StaticOrder, true, true>((PG8_LAS unsigned char*)lds, g, S, E, wid_s);
  }
  grid.sync();

  {
    pg8::Gemm g{wb + B_MIX, wb + B_WOUT, NT, 1024, 1024}; pg8::StaticOrder S; S.init(NT, 1024, (int)gridDim.x, (int)blockIdx.x);
    pg8::EpiF32 E{p.out, 1024, 1024, 0, 0, p.x_prompt, p.x_sample, NP};
    pg8::gemm_phase<pg8::EpiF32, pg8::StaticOrder, true, true>((PG8_LAS unsigned char*)lds, g, S, E, wid_s);
  }
  }
  grid.sync();
  { PH_IDS

  for (int r = gw; r < NT; r += NGW) {
    float* y = p.out + (size_t)r * 1024;
    float v[16]; float ss = 0.f;
#pragma unroll
    for (int i = 0; i < 16; ++i) { v[i] = y[lane + 64 * i]; ss += v[i] * v[i]; }
    const float rs = rsqrtf(wave_sum(ss) * (1.f / 1024.f) + RMS_EPS);
#pragma unroll
    for (int i = 0; i < 16; ++i) y[lane + 64 * i] = v[i] * rs * p.final_g[lane + 64 * i];
  }
  }
#undef PH_IDS
}

extern "C" void kernel_launch(void* const* d_in, const int* in_sizes, int n_in, void* d_out,
                              int out_size, void* d_ws, size_t ws_size, hipStream_t stream) {
  static int grid_blocks = 0;
  if (!grid_blocks) {
    int dev = 0, cus = 0, per_cu = 0;
    (void)hipGetDevice(&dev);
    (void)hipDeviceGetAttribute(&cus, hipDeviceAttributeMultiprocessorCount, dev);
    (void)hipFuncSetAttribute((const void*)fwd_megakernel, hipFuncAttributeMaxDynamicSharedMemorySize, LDS_BYTES);
    (void)hipOccupancyMaxActiveBlocksPerMultiprocessor(&per_cu, fwd_megakernel, 512, LDS_BYTES);
    if (per_cu < 1) per_cu = 1;
    grid_blocks = cus;
    if (ws_size < WS_BYTES) fprintf(stderr, "workspace too small: %zu < %zu\n", ws_size, (size_t)WS_BYTES);
  }
  Params p{};
  const float** pf = (const float**)&p;
  (void)pf;
  p.x_prompt = (const float*)d_in[0]; p.x_sample = (const float*)d_in[1]; p.mem_prompt = (const float*)d_in[2];
  p.cache_ckv = (const float*)d_in[3]; p.cache_kpe = (const float*)d_in[4]; p.page_table = (const int*)d_in[5];
  p.state_wkv = (const float*)d_in[6]; p.state_shift = (const float*)d_in[7]; p.cache_mem_k = (const float*)d_in[8];
  p.cache_mem_v = (const float*)d_in[9]; p.ln_g = (const float*)d_in[10]; p.w_in = (const float*)d_in[11];
  p.q_norm_g = (const float*)d_in[12]; p.kv_norm_g = (const float*)d_in[13]; p.w_uq = (const float*)d_in[14];
  p.w_uk = (const float*)d_in[15]; p.w_uv = (const float*)d_in[16]; p.shift_mu = (const float*)d_in[17];
  p.w0 = (const float*)d_in[18]; p.w_up = (const float*)d_in[19]; p.a0 = (const float*)d_in[20]; p.a_up = (const float*)d_in[21];
  p.k_k = (const float*)d_in[22]; p.k_a = (const float*)d_in[23]; p.r_k = (const float*)d_in[24]; p.lnx_g = (const float*)d_in[25];
  p.lnx_b = (const float*)d_in[26]; p.mem_norm_g = (const float*)d_in[27]; p.w_mem_kv = (const float*)d_in[28];
  p.w_out = (const float*)d_in[29]; p.final_g = (const float*)d_in[30];
  p.out = (float*)d_out; p.ws = (float*)d_ws;
  void* args[] = {&p};
  hipError_t e = hipLaunchCooperativeKernel((void*)fwd_megakernel, dim3(grid_blocks), dim3(512), args, LDS_BYTES, stream);
  if (e != hipSuccess) fprintf(stderr, "cooperative launch failed: %s (grid %d)\n", hipGetErrorString(e), grid_blocks);
}
```

```cpp
#include <hip/hip_runtime.h>
#ifndef PROF_SEL
#define PROF_SEL -1
#endif
#include <hip/hip_cooperative_groups.h>
#include <cstdio>
#include <cstdint>
namespace cg = cooperative_groups;

__device__ __forceinline__ int mk_tid(int wid_s) { int z; asm volatile("s_mov_b32 %0, 0" : "=s"(z)); return wid_s * 64 + (int)__builtin_amdgcn_mbcnt_hi(~0u, __builtin_amdgcn_mbcnt_lo(~0u, (unsigned)z)); }
namespace pg8 {
#define PG8_LAS __attribute__((address_space(3)))
typedef unsigned short bf16_t;
typedef short bf16x8 __attribute__((ext_vector_type(8)));
typedef float f32x4 __attribute__((ext_vector_type(4)));
typedef unsigned u32x4 __attribute__((ext_vector_type(4)));
constexpr int BM = 256, BK = 64, HALF = 128, HTB = HALF * BK * 2  , STAGE_BYTES = 8 * HTB, NXCD = 8, WGM = 8;

__host__ __device__ __forceinline__ int lds_byte(int r, int c) { const int st = (r >> 4) * 2 + (c >> 5), rr = r & 15, cc = c & 31, ob = rr * 64 + cc * 2; return st * 1024 + (ob ^ (((ob >> 9) & 1) << 5)); }
__host__ __device__ __forceinline__ void stage_rc(int b, int& R, int& C) { const int st = b / 1024, sb = b % 1024, swz = sb ^ (((sb >> 9) & 1) << 5); R = (st >> 1) * 16 + swz / 64; C = (st & 1) * 32 + (swz % 64) / 2; }
__host__ __device__ __forceinline__ int perm32(int rho) { const int n = rho >> 4, i = rho & 15; return 8 * (i >> 2) + 4 * n + (i & 3); }

struct Unit { int pm, pn; };
struct Gemm { const bf16_t* A; const bf16_t* Bt; int M, N, K; };

struct StaticOrder {
    int nM, nN, nwg, G, c;
    __host__ __device__ void init(int M, int N, int G_, int c_) { nM = M / BM; nN = N / BM; nwg = nM * nN; G = G_; c = c_; }
    __host__ __device__ bool next(int i, Unit& u) const {
        const long L = (long)i * G + c; if (L >= nwg) return false;
        int wgid = (int)L; { const int q = nwg / NXCD, r = nwg % NXCD, xcd = wgid % NXCD, off = wgid / NXCD; wgid = (xcd < r ? xcd * (q + 1) : r * (q + 1) + (xcd - r) * q) + off; }
        const int nig = WGM * nN, gid = wgid / nig, fm = gid * WGM, gsz = (nM - fm) < WGM ? (nM - fm) : WGM;
        u.pm = fm + ((wgid % nig) % gsz); u.pn = (wgid % nig) / gsz; return true;
    }
    __device__ __forceinline__ void a_ready(const Unit&) const {}
    __device__ __forceinline__ void done(const Unit&) const {}
};
__device__ __forceinline__ unsigned cvt_pk_bf16(float lo, float hi) { unsigned r; asm volatile("v_cvt_pk_bf16_f32 %0, %1, %2" : "=v"(r) : "v"(lo), "v"(hi)); return r; }
typedef float f32x2 __attribute__((ext_vector_type(2)));
template <class Epi, class Sched, bool ALIGN_EPI = false, bool SP2 = false>
__device__ __forceinline__ void gemm_phase(PG8_LAS unsigned char* lds, const Gemm g, const Sched& S, const Epi& E, int wid_s) {
    const int tid = mk_tid(wid_s), wid = wid_s, lane = tid & 63, wr = wid >> 2, wc = wid & 3, fr = lane & 15, fq = lane >> 4;
    const int K = g.K, nt = K / BK;
    unsigned voffA[2], voffB[2];
#pragma unroll
    for (int i = 0; i < 2; ++i) { int R, C; stage_rc(tid * 16 + i * 8192, R, C); const int Rb = Epi::PERM ? ((R & ~31) + perm32(R & 31)) : R;
        voffA[i] = (unsigned)(R * K + C) * 2u; voffB[i] = (unsigned)(Rb * K + C) * 2u; }
    const size_t kstep = (size_t)(BK * 2);
    const size_t hstep = (size_t)HALF * K * 2;
    const size_t tstep = 2 * hstep;
    const unsigned ldsw = (unsigned)wid * 1024u;
    const int aoff = lds_byte(wr * 64 + fr, fq * 8), boff = lds_byte(wc * 32 + fr, fq * 8);
#define PG8_SA(b, h) (((b) * 2 + (h)) * HTB)
#define PG8_SB(b, h) ((4 + (b) * 2 + (h)) * HTB)
#define PG8_STAGE(bufoff, gbase, voff) do { _Pragma("unroll") for (int _i = 0; _i < 2; ++_i) \
        __builtin_amdgcn_global_load_lds((const unsigned*)((const char*)(gbase) + (voff)[_i]), (PG8_LAS unsigned*)(lds + (bufoff) + ldsw + _i * 8192), 16, 0, 0); } while (0)
#define PG8_LDA(dst, b, h) do { _Pragma("unroll") for (int m = 0; m < 4; ++m) _Pragma("unroll") for (int k = 0; k < 2; ++k) dst[m][k] = *(const PG8_LAS bf16x8*)(lds + PG8_SA(b, h) + aoff + m * 2048 + k * 1024); } while (0)
#define PG8_LDB(dst, b, h) do { _Pragma("unroll") for (int n = 0; n < 2; ++n) _Pragma("unroll") for (int k = 0; k < 2; ++k) dst[n][k] = *(const PG8_LAS bf16x8*)(lds + PG8_SB(b, h) + boff + n * 2048 + k * 1024); } while (0)
#define PG8_MMA(ai, bj, At, Bt) do { __builtin_amdgcn_s_setprio(1); _Pragma("unroll") for (int m = 0; m < 4; ++m) _Pragma("unroll") for (int n = 0; n < 2; ++n) _Pragma("unroll") for (int k = 0; k < 2; ++k) \
        acc[ai][bj][m][n] = __builtin_amdgcn_mfma_f32_16x16x32_bf16(Bt[n][k], At[m][k], acc[ai][bj][m][n], 0, 0, 0); __builtin_amdgcn_s_setprio(0); } while (0)
#define PG8_WAIT_V(n) asm volatile("s_waitcnt vmcnt(" #n ")" ::: "memory")
#define PG8_WAIT_L(n) asm volatile("s_waitcnt lgkmcnt(" #n ")" ::: "memory")
#define PG8_BAR __builtin_amdgcn_s_barrier()
#define PG8_SCHED __builtin_amdgcn_sched_barrier(0)
    Unit cur, nxt; int ui = 0;
    if (!S.next(0, cur)) return;
    f32x4 acc[2][2][4][2];
#pragma unroll
    for (int a = 0; a < 2; ++a)
#pragma unroll
        for (int b = 0; b < 2; ++b)
#pragma unroll
            for (int m = 0; m < 4; ++m)
#pragma unroll
                for (int n = 0; n < 2; ++n) acc[a][b][m][n] = (f32x4){0.f, 0.f, 0.f, 0.f};
    bf16x8 At[4][2], B0[2][2], B1[2][2];
    const char* cA = (const char*)g.A + (size_t)cur.pm * tstep; const char* cB = (const char*)g.Bt + (size_t)cur.pn * tstep;
    S.a_ready(cur);
    if constexpr (SP2) {
        PG8_STAGE(PG8_SB(0, 0), cB, voffB); PG8_STAGE(PG8_SB(0, 1), cB + hstep, voffB); PG8_STAGE(PG8_SA(0, 0), cA, voffA); PG8_STAGE(PG8_SA(0, 1), cA + hstep, voffA);
        if (wr == 1) PG8_BAR;
        PG8_WAIT_V(2); PG8_BAR;
        PG8_STAGE(PG8_SB(1, 0), cB + kstep, voffB); PG8_STAGE(PG8_SA(1, 0), cA + kstep, voffA); PG8_STAGE(PG8_SB(1, 1), cB + hstep + kstep, voffB);
        PG8_WAIT_V(6); PG8_BAR;
    } else {
        PG8_STAGE(PG8_SB(0, 0), cB, voffB); PG8_STAGE(PG8_SA(0, 0), cA, voffA); PG8_STAGE(PG8_SB(0, 1), cB + hstep, voffB); PG8_STAGE(PG8_SA(0, 1), cA + hstep, voffA);
        if (wr == 1) PG8_BAR;
        PG8_WAIT_V(4); PG8_BAR;
        PG8_STAGE(PG8_SB(1, 0), cB + kstep, voffB); PG8_STAGE(PG8_SA(1, 0), cA + kstep, voffA); PG8_STAGE(PG8_SB(1, 1), cB + hstep + kstep, voffB);
        PG8_WAIT_V(6); PG8_BAR;
    }
    for (;;) {
        const bool has_next = S.next(ui + 1, nxt);
        const char* nA = has_next ? (const char*)g.A + (size_t)nxt.pm * tstep : cA; const char* nB = has_next ? (const char*)g.Bt + (size_t)nxt.pn * tstep : cB;
        for (int t = 0; t < nt; t += 2) {
            const bool last = (t == nt - 2);
            const char* a1 = cA + (size_t)(t + 1) * kstep;
            const char* a2 = last ? nA : cA + (size_t)(t + 2) * kstep; const char* b2 = last ? nB : cB + (size_t)(t + 2) * kstep;
            const char* a3 = a2 + kstep; const char* b3 = b2 + kstep;
            if (last && has_next) S.a_ready(nxt);
            if constexpr (SP2) {
            PG8_LDB(B0, 0, 0); PG8_LDB(B1, 0, 1); PG8_SCHED; PG8_LDA(At, 0, 0); PG8_STAGE(PG8_SA(1, 1), a1 + hstep, voffA);
            PG8_WAIT_V(8); PG8_WAIT_L(0); PG8_BAR; PG8_MMA(0, 0, At, B0); PG8_MMA(0, 1, At, B1); PG8_BAR; PG8_SCHED;
            PG8_LDA(At, 0, 1); PG8_STAGE(PG8_SB(0, 0), b2, voffB); PG8_STAGE(PG8_SB(0, 1), b2 + hstep, voffB); PG8_STAGE(PG8_SA(0, 0), a2, voffA);
            PG8_WAIT_V(8); PG8_WAIT_L(0); PG8_BAR; PG8_MMA(1, 0, At, B0); PG8_MMA(1, 1, At, B1); PG8_BAR; PG8_SCHED;
            PG8_LDB(B0, 1, 0); PG8_LDB(B1, 1, 1); PG8_SCHED; PG8_LDA(At, 1, 0); PG8_STAGE(PG8_SA(0, 1), a2 + hstep, voffA);
            PG8_WAIT_V(8); PG8_WAIT_L(0); PG8_BAR; PG8_MMA(0, 0, At, B0); PG8_MMA(0, 1, At, B1); PG8_BAR; PG8_SCHED;
            PG8_LDA(At, 1, 1); PG8_STAGE(PG8_SB(1, 0), b3, voffB); PG8_STAGE(PG8_SB(1, 1), b3 + hstep, voffB); PG8_STAGE(PG8_SA(1, 0), a3, voffA);
            PG8_WAIT_V(8); PG8_WAIT_L(0); PG8_BAR; PG8_MMA(1, 0, At, B0); PG8_MMA(1, 1, At, B1); PG8_BAR; PG8_SCHED;
            } else {
            PG8_LDB(B0, 0, 0); PG8_SCHED; PG8_LDA(At, 0, 0); PG8_STAGE(PG8_SA(1, 1), a1 + hstep, voffA);
            PG8_WAIT_L(8); PG8_BAR; PG8_WAIT_L(0); PG8_MMA(0, 0, At, B0); PG8_BAR; PG8_SCHED;
            PG8_LDB(B1, 0, 1); PG8_STAGE(PG8_SB(0, 0), b2, voffB);
            PG8_BAR; PG8_WAIT_L(0); PG8_MMA(0, 1, At, B1); PG8_BAR;
            PG8_LDA(At, 0, 1); PG8_STAGE(PG8_SA(0, 0), a2, voffA);
            PG8_BAR; PG8_WAIT_L(0); PG8_MMA(1, 0, At, B0); PG8_BAR; PG8_SCHED;
            PG8_STAGE(PG8_SB(0, 1), b2 + hstep, voffB);
            PG8_WAIT_V(6); PG8_BAR; PG8_MMA(1, 1, At, B1); PG8_BAR;
            PG8_LDB(B0, 1, 0); PG8_SCHED; PG8_LDA(At, 1, 0); PG8_STAGE(PG8_SA(0, 1), a2 + hstep, voffA);
            PG8_WAIT_L(8); PG8_BAR; PG8_WAIT_L(0); PG8_MMA(0, 0, At, B0); PG8_BAR; PG8_SCHED;
            PG8_LDB(B1, 1, 1); PG8_STAGE(PG8_SB(1, 0), b3, voffB);
            PG8_BAR; PG8_WAIT_L(0); PG8_MMA(0, 1, At, B1); PG8_BAR;
            PG8_LDA(At, 1, 1); PG8_STAGE(PG8_SA(1, 0), a3, voffA);
            PG8_BAR; PG8_WAIT_L(0); PG8_MMA(1, 0, At, B0); PG8_BAR; PG8_SCHED;
            PG8_STAGE(PG8_SB(1, 1), b3 + hstep, voffB);
            PG8_WAIT_V(6); PG8_BAR; PG8_MMA(1, 1, At, B1); PG8_BAR;
            }
        }
        if constexpr (ALIGN_EPI) { if (wr == 0) PG8_BAR; }
        if constexpr (!Epi::AFTER_DRAIN) { E(acc, cur, wr, wc, fr, fq); S.done(cur); }
        if (!has_next) break;
#pragma unroll
        for (int a = 0; a < 2; ++a)
#pragma unroll
            for (int b = 0; b < 2; ++b)
#pragma unroll
                for (int m = 0; m < 4; ++m)
#pragma unroll
                    for (int n = 0; n < 2; ++n) acc[a][b][m][n] = (f32x4){0.f, 0.f, 0.f, 0.f};
        cur = nxt; cA = nA; cB = nB; ++ui;
        if constexpr (ALIGN_EPI) { if (wr == 1) PG8_BAR; }
    }
    PG8_WAIT_V(0);
    if constexpr (!ALIGN_EPI) { if (wr == 0) PG8_BAR; }
    PG8_BAR;
    if constexpr (Epi::AFTER_DRAIN) { E.fused(acc, cur, wr, wc, fr, fq, lds, wid, lane); S.done(cur); }
#undef PG8_SA
#undef PG8_SB
#undef PG8_STAGE
#undef PG8_LDA
#undef PG8_LDB
#undef PG8_MMA
#undef PG8_WAIT_V
#undef PG8_WAIT_L
#undef PG8_BAR
#undef PG8_SCHED
}
}

namespace pg8 {
struct EpiF32 {
  static constexpr bool PERM = false, AFTER_DRAIN = false;
  float* C; int ldc; int ncols; int split_cols; size_t split_stride; const float* r0; const float* r1; int nr0;
  __device__ __forceinline__ void operator()(const f32x4 (&acc)[2][2][4][2], const Unit& u, int wr, int wc, int fr0, int fq0) const {
    int fr = fr0, fq = fq0; asm volatile("" : "+v"(fr), "+v"(fq));
    const int row0 = u.pm * BM + wr * 64 + fr; int colt = u.pn * BM; float* base = C;
    if (split_cols) { const int t = colt / split_cols; base += (size_t)t * split_stride; colt -= t * split_cols; }
    const int col0 = colt + wc * 32 + 4 * fq;
#pragma unroll
    for (int ai = 0; ai < 2; ++ai)
#pragma unroll
      for (int m = 0; m < 4; ++m) {
        const int row = row0 + ai * HALF + m * 16;
        const float* rr = r0 ? (row < nr0 ? r0 + (size_t)row * ldc : r1 + (size_t)(row - nr0) * ldc) : nullptr;
#pragma unroll
        for (int bj = 0; bj < 2; ++bj)
#pragma unroll
          for (int n = 0; n < 2; ++n) {
            const int col = col0 + bj * HALF + n * 16;
            if (col < ncols) { f32x4 v = acc[ai][bj][m][n]; if (rr) v += *(const f32x4*)(rr + col); *(f32x4*)(base + (size_t)row * ldc + col) = v; }
          }
        asm volatile("" ::: "memory");
      }
  }
};
}

constexpr int DM = 1024, BATCH = 4, SEQ = 4096, DB = 128, DT = 8, PAST = 8192, PAGE = 128, NPG = 64, NMEM = 256;
constexpr int NP = BATCH * SEQ, NS = DB * DT, NT = NP + NS;
constexpr int INC = 2592;
constexpr int C_CQ = 0, C_CKV = 256, C_KR = 384, C_GMLA = 416, C_Z = 928, C_GRWKV = 1824, C_QX = 2080, C_GX = 2336;
constexpr float MLA_SCALE = 0.10206207261596575f;
constexpr float X_SCALE = 0.125f;
constexpr float RMS_EPS = 1e-6f, GN_EPS = 64e-5f;
constexpr size_t O_YP = 0, O_YS = 16777216, O_CKVP = 17825792, O_KPEP = 19922944, O_WKVP = 20447232, O_SHP = 20512768,
                 O_MKP = 20516352, O_MVP = 20778496, O_CKVS = 21040640, O_KPES = 21171712, O_WKVS = 21204480, O_SHS = 23301632;
constexpr size_t W_H = 0;
constexpr size_t W_HM = W_H + (size_t)NT * 1024;
constexpr size_t W_PROJ = W_HM + (size_t)1024 * 1024;
constexpr size_t W_CQN = W_PROJ + (size_t)NT * INC;
constexpr size_t W_Q = W_CQN + (size_t)NT * 256;
constexpr size_t W_KN = W_Q + (size_t)NT * 768;
constexpr size_t W_V = W_KN + (size_t)NP * 512;
constexpr size_t W_QLAT = W_V + (size_t)NP * 512;
constexpr size_t W_OLAT = W_QLAT + (size_t)NS * 1024;
constexpr size_t W_R = W_OLAT + (size_t)NS * 1024;
constexpr size_t W_W = W_R + (size_t)NT * 256;
constexpr size_t W_KF = W_W + (size_t)NT * 256;
constexpr size_t W_VV = W_KF + (size_t)NT * 256;
constexpr size_t W_KK = W_VV + (size_t)NT * 256;
constexpr size_t W_BB = W_KK + (size_t)NT * 256;
constexpr size_t W_MIX = W_BB + (size_t)NT * 256;
constexpr size_t W_PO = W_MIX + (size_t)NT * 1024;
constexpr size_t W_PML = W_PO + (size_t)256 * 64 * 128;
constexpr size_t W_Y = W_PML + (size_t)256 * 64 * 2;
constexpr size_t W_CTL = W_Y + (size_t)NT * 256;
constexpr size_t W_CS = W_CTL + 256;
constexpr size_t W_XB = W_CS + (size_t)4104 * 32;
constexpr size_t W_TS = W_XB + (size_t)NP * 4;
constexpr size_t W_END = W_TS + 64;
constexpr int INCP = 2816;
constexpr size_t B_H = 0;
constexpr size_t B_HM = B_H + (size_t)NT * 1024;
constexpr size_t B_WIN = B_HM + (size_t)1024 * 1024;
constexpr size_t B_WMEM = B_WIN + (size_t)INCP * 1024;
constexpr size_t B_WOUT = B_WMEM + (size_t)512 * 1024;
constexpr size_t B_MIX = B_WOUT + (size_t)1024 * 1024;
constexpr size_t B_QP = B_MIX + (size_t)NT * 1024;
constexpr size_t B_KP = B_QP + (size_t)NP * 768;
constexpr size_t B_VT = B_KP + (size_t)NP * 768;
constexpr size_t B_QS = B_VT + (size_t)512 * NP;
constexpr size_t B_QX = B_QS + (size_t)NS * 8 * 160;
constexpr size_t B_KM = B_QX + (size_t)NP * 256;
constexpr size_t B_VMT = B_KM + (size_t)4 * 256 * 256;
constexpr size_t B_CQN = B_VMT + (size_t)4 * 256 * 256;
constexpr size_t B_CKVN = B_CQN + (size_t)NT * 256;
constexpr size_t B_WUQ = B_CKVN + (size_t)NP * 128;
constexpr size_t B_WQL = B_WUQ + (size_t)768 * 256;
constexpr size_t B_WUK = B_WQL + (size_t)1024 * 256;
constexpr size_t B_WUV = B_WUK + (size_t)512 * 128;
constexpr size_t B_OLAT = B_WUV + (size_t)512 * 128;
constexpr size_t B_WUVBD = B_OLAT + (size_t)NS * 1024;
constexpr size_t B_PROJ = B_WUVBD + (size_t)512 * 1024;
constexpr size_t B_END = B_PROJ + (size_t)NT * INC;
constexpr size_t WS_BYTES = W_END * 4 + B_END * 2;
constexpr int LDS_BYTES = 147456;
constexpr int NSCAN = 32;

struct Params {
  const float* x_prompt; const float* x_sample; const float* mem_prompt; const float* cache_ckv; const float* cache_kpe;
  const int* page_table; const float* state_wkv; const float* state_shift; const float* cache_mem_k; const float* cache_mem_v;
  const float* ln_g; const float* w_in; const float* q_norm_g; const float* kv_norm_g; const float* w_uq; const float* w_uk;
  const float* w_uv; const float* shift_mu; const float* w0; const float* w_up; const float* a0; const float* a_up;
  const float* k_k; const float* k_a; const float* r_k; const float* lnx_g; const float* lnx_b; const float* mem_norm_g;
  const float* w_mem_kv; const float* w_out; const float* final_g;
  float* out; float* ws;
};

__device__ __forceinline__ unsigned f2bf(float f);
__device__ __forceinline__ unsigned pk2(float lo, float hi);
typedef unsigned short bf16;

__device__ __forceinline__ float bf2f(unsigned short b) { return __uint_as_float((unsigned)b << 16); }
__device__ __forceinline__ float pj(const unsigned short* P, size_t row, int col) { return bf2f(P[row * INC + col]); }
__device__ __forceinline__ float4 pj4(const unsigned short* P, size_t row, int col) {
  const uint2 w = *(const uint2*)(P + row * INC + col);
  return make_float4(__uint_as_float(w.x << 16), __uint_as_float(w.x & 0xffff0000u), __uint_as_float(w.y << 16), __uint_as_float(w.y & 0xffff0000u));
}
__device__ __forceinline__ float wave_sum(float v) {
#pragma unroll
  for (int o = 1; o < 64; o <<= 1) v += __shfl_xor(v, o);
  return v;
}

__device__ __forceinline__ float wave_sum_fast(float v) {
  v += __int_as_float(__builtin_amdgcn_update_dpp(0, __float_as_int(v), 0xB1, 0xF, 0xF, true));
  v += __int_as_float(__builtin_amdgcn_update_dpp(0, __float_as_int(v), 0x4E, 0xF, 0xF, true));
  v += __int_as_float(__builtin_amdgcn_update_dpp(0, __float_as_int(v), 0x141, 0xF, 0xF, true));
  v += __int_as_float(__builtin_amdgcn_update_dpp(0, __float_as_int(v), 0x140, 0xF, 0xF, true));
  v += __int_as_float(__builtin_amdgcn_update_dpp(0, __float_as_int(v), 0x142, 0xA, 0xF, false));
  v += __int_as_float(__builtin_amdgcn_update_dpp(0, __float_as_int(v), 0x143, 0xC, 0xF, false));
  return __int_as_float(__builtin_amdgcn_readlane(__float_as_int(v), 63));
}
__device__ __forceinline__ float wave_max(float v) {
#pragma unroll
  for (int o = 1; o < 64; o <<= 1) v = fmaxf(v, __shfl_xor(v, o));
  return v;
}
__device__ __forceinline__ float silu(float x) { return x / (1.f + expf(-x)); }
__device__ __forceinline__ const float* xrow(const Params& p, int row) {
  return row < NP ? p.x_prompt + (size_t)row * DM : p.x_sample + (size_t)(row - NP) * DM;
}
__device__ __forceinline__ float* ckv_out_row(const Params& p, int row) {
  return row < NP ? p.out + O_CKVP + (size_t)row * 128 : p.out + O_CKVS + (size_t)(row - NP) * 128;
}
__device__ __forceinline__ float* kpe_out_row(const Params& p, int row) {
  return row < NP ? p.out + O_KPEP + (size_t)row * 32 : p.out + O_KPES + (size_t)(row - NP) * 32;
}


namespace pg8 {
typedef unsigned u32x2 __attribute__((ext_vector_type(2)));
template <class F> struct EpiBf16F {
  static constexpr bool PERM = true, AFTER_DRAIN = false;
  F f; float scale;
  __device__ __forceinline__ void operator()(const f32x4 (&acc)[2][2][4][2], const Unit& u, int wr, int wc, int fr, int fq) const {
    int fr_ = fr, fq_ = fq; asm volatile("" : "+v"(fr_), "+v"(fq_));
    const int row0 = u.pm * BM + wr * 64 + fr_, col0 = u.pn * BM + wc * 32 + 8 * fq_;
#pragma unroll
    for (int ai = 0; ai < 2; ++ai)
#pragma unroll
      for (int m = 0; m < 4; ++m)
#pragma unroll
        for (int bj = 0; bj < 2; ++bj) {
          bf16_t* dst = f(row0 + ai * HALF + m * 16, col0 + bj * HALF);
          if (dst) { const f32x4 v0 = acc[ai][bj][m][0] * scale, v1 = acc[ai][bj][m][1] * scale;
            u32x4 w; w.x = cvt_pk_bf16(v0[0], v0[1]); w.y = cvt_pk_bf16(v0[2], v0[3]); w.z = cvt_pk_bf16(v1[0], v1[1]); w.w = cvt_pk_bf16(v1[2], v1[3]);
            *(u32x4*)dst = w; }
        }
  }
};
struct EpiQ {
  static constexpr bool PERM = false, AFTER_DRAIN = false;
  bf16_t* Qp; bf16_t* Qs; const float* CS; float scale; int np;
  __device__ __forceinline__ void operator()(const f32x4 (&acc)[2][2][4][2], const Unit& u, int wr, int wc, int fr0, int fq0) const {
    int fr = fr0, fq = fq0; asm volatile("" : "+v"(fr), "+v"(fq));
    const int row0 = u.pm * BM + wr * 64 + fr;
    if (u.pn < 2) {
      if (u.pm * BM >= np) return;
#pragma unroll
      for (int ai = 0; ai < 2; ++ai)
#pragma unroll
        for (int m = 0; m < 4; ++m) {
          const int row = row0 + ai * HALF + m * 16;
#pragma unroll
          for (int bj = 0; bj < 2; ++bj)
#pragma unroll
            for (int n = 0; n < 2; ++n) {
              const int col = u.pn * BM + bj * HALF + wc * 32 + 16 * n + 4 * fq, head = col >> 6, d = col & 63;
              const f32x4 v = acc[ai][bj][m][n] * scale;
              *(u32x2*)(Qp + (size_t)row * 768 + head * 96 + d) = (u32x2){cvt_pk_bf16(v[0], v[1]), cvt_pk_bf16(v[2], v[3])};
            }
        }
    } else {
#pragma unroll
      for (int ai = 0; ai < 2; ++ai)
#pragma unroll
        for (int m = 0; m < 4; ++m) {
          const int row = row0 + ai * HALF + m * 16;
          const bool pr = row < np;
          const int pi = pr ? (row & 4095) : 4096 + ((row - np) & 7);
#pragma unroll
          for (int n = 0; n < 2; ++n) {
            const int head = 2 * wc + n, j = 4 * fq;
            const f32x4 cs0 = *(const f32x4*)(CS + ((size_t)pi * 16 + j) * 2), cs1 = *(const f32x4*)(CS + ((size_t)pi * 16 + j) * 2 + 4);
            const f32x4 x1 = acc[ai][0][m][n], x2 = acc[ai][1][m][n];
            f32x4 y1, y2;
            y1[0] = x1[0] * cs0[0] - x2[0] * cs0[1]; y2[0] = x2[0] * cs0[0] + x1[0] * cs0[1];
            y1[1] = x1[1] * cs0[2] - x2[1] * cs0[3]; y2[1] = x2[1] * cs0[2] + x1[1] * cs0[3];
            y1[2] = x1[2] * cs1[0] - x2[2] * cs1[1]; y2[2] = x2[2] * cs1[0] + x1[2] * cs1[1];
            y1[3] = x1[3] * cs1[2] - x2[3] * cs1[3]; y2[3] = x2[3] * cs1[2] + x1[3] * cs1[3];
            y1 = y1 * scale; y2 = y2 * scale;
            bf16_t* dst = pr ? Qp + (size_t)row * 768 + head * 96 + 64 + j : Qs + ((size_t)(row - np) * 8 + head) * 160 + 128 + j;
            *(u32x2*)dst = (u32x2){cvt_pk_bf16(y1[0], y1[1]), cvt_pk_bf16(y1[2], y1[3])};
            *(u32x2*)(dst + 16) = (u32x2){cvt_pk_bf16(y2[0], y2[1]), cvt_pk_bf16(y2[2], y2[3])};
          }
          asm volatile("" ::: "memory");
        }
    }
  }
};
}

namespace pg8 {
struct EpiGateBf16 {
  static constexpr bool PERM = true, AFTER_DRAIN = false;
  bf16_t* O; int ldo; const float* G; int ldg;
  __device__ __forceinline__ float sl(float x) const { return x / (1.f + __expf(-x)); }
  __device__ __forceinline__ void operator()(const f32x4 (&acc)[2][2][4][2], const Unit& u, int wr, int wc, int fr0, int fq0) const {
    int fr = fr0, fq = fq0; asm volatile("" : "+v"(fr), "+v"(fq));
    const int row0 = u.pm * BM + wr * 64 + fr, col0 = u.pn * BM + wc * 32 + 8 * fq;
#pragma unroll
    for (int ai = 0; ai < 2; ++ai)
#pragma unroll
      for (int m = 0; m < 4; ++m)
#pragma unroll
        for (int bj = 0; bj < 2; ++bj) {
          const int row = row0 + ai * HALF + m * 16, col = col0 + bj * HALF;
          const f32x4 g0 = *(const f32x4*)(G + (size_t)row * ldg + col), g1 = *(const f32x4*)(G + (size_t)row * ldg + col + 4);
          const f32x4 v0 = acc[ai][bj][m][0], v1 = acc[ai][bj][m][1];
          u32x4 w; w.x = cvt_pk_bf16(v0[0] * sl(g0[0]), v0[1] * sl(g0[1])); w.y = cvt_pk_bf16(v0[2] * sl(g0[2]), v0[3] * sl(g0[3]));
          w.z = cvt_pk_bf16(v1[0] * sl(g1[0]), v1[1] * sl(g1[1])); w.w = cvt_pk_bf16(v1[2] * sl(g1[2]), v1[3] * sl(g1[3]));
          *(u32x4*)(O + (size_t)row * ldo + col) = w;
          asm volatile("" ::: "memory");
        }
  }
};
}

namespace pg8 {
struct EpiRmsOut {
  static constexpr bool PERM = false, AFTER_DRAIN = true;
  const float* x; float* out; const float* gain; float* xbuf; unsigned* cnt; float eps;
  __device__ __forceinline__ void fused(f32x4 (&acc)[2][2][4][2], const Unit& u, int wr, int wc, int fr0, int fq0, PG8_LAS unsigned char* lds, int wid, int lane) const {
    int fr = fr0, fq = fq0; asm volatile("" : "+v"(fr), "+v"(fq));
    PG8_LAS float* P = (PG8_LAS float*)lds;
    PG8_LAS float* S = (PG8_LAS float*)(lds + 4096);
    const int col0 = u.pn * BM + wc * 32 + 4 * fq;
#pragma unroll
    for (int ai = 0; ai < 2; ++ai)
#pragma unroll
      for (int m = 0; m < 4; ++m) {
        const int rl = ai * HALF + wr * 64 + m * 16 + fr;
        const float* xr = x + (size_t)(u.pm * BM + rl) * 1024;
        float s = 0.f;
#pragma unroll
        for (int bj = 0; bj < 2; ++bj)
#pragma unroll
          for (int n = 0; n < 2; ++n) {
            const f32x4 v = acc[ai][bj][m][n] + *(const f32x4*)(xr + col0 + bj * HALF + n * 16);
            acc[ai][bj][m][n] = v; s += (v[0] * v[0] + v[1] * v[1]) + (v[2] * v[2] + v[3] * v[3]);
          }
        s += __shfl_xor(s, 16); s += __shfl_xor(s, 32);
        if (fq == 0) P[rl * 4 + wc] = s;
        asm volatile("" ::: "memory");
      }
    asm volatile("s_waitcnt lgkmcnt(0)" ::: "memory"); __builtin_amdgcn_s_barrier(); asm volatile("" ::: "memory");
    const int tid = wid * 64 + lane;
    if (tid < 256) {
      const float tot = (P[tid * 4] + P[tid * 4 + 1]) + (P[tid * 4 + 2] + P[tid * 4 + 3]);
      __hip_atomic_store((unsigned*)xbuf + ((size_t)(u.pm * BM + tid)) * 4 + u.pn, __float_as_uint(tot), __ATOMIC_RELAXED, __HIP_MEMORY_SCOPE_AGENT);
    }
    asm volatile("s_waitcnt vmcnt(0)" ::: "memory");
    if (tid < 256 && lane == 0) __hip_atomic_fetch_add(cnt + u.pm, 1u, __ATOMIC_RELAXED, __HIP_MEMORY_SCOPE_AGENT);
    if (wid == 0) {
      for (;;) {
        const unsigned c_ = (unsigned)__builtin_amdgcn_readfirstlane((int)__hip_atomic_load(cnt + u.pm, __ATOMIC_RELAXED, __HIP_MEMORY_SCOPE_AGENT));
        if (c_ >= 16u) break;
        __builtin_amdgcn_s_sleep(2);
      }
      __builtin_amdgcn_fence(__ATOMIC_ACQUIRE, "agent");
    }
    asm volatile("s_waitcnt vmcnt(0) lgkmcnt(0)" ::: "memory"); __builtin_amdgcn_s_barrier(); asm volatile("" ::: "memory");
    if (tid < 256) {
      unsigned* xb = (unsigned*)xbuf + ((size_t)(u.pm * BM + tid)) * 4;
      const float ssq = (__uint_as_float(__hip_atomic_load(xb, __ATOMIC_RELAXED, __HIP_MEMORY_SCOPE_AGENT)) + __uint_as_float(__hip_atomic_load(xb + 1, __ATOMIC_RELAXED, __HIP_MEMORY_SCOPE_AGENT))) +
                        (__uint_as_float(__hip_atomic_load(xb + 2, __ATOMIC_RELAXED, __HIP_MEMORY_SCOPE_AGENT)) + __uint_as_float(__hip_atomic_load(xb + 3, __ATOMIC_RELAXED, __HIP_MEMORY_SCOPE_AGENT)));
      S[tid] = 1.0f / sqrtf(ssq * (1.f / 1024.f) + eps);
    }
    asm volatile("s_waitcnt lgkmcnt(0)" ::: "memory"); __builtin_amdgcn_s_barrier(); asm volatile("" ::: "memory");
#pragma unroll
    for (int ai = 0; ai < 2; ++ai)
#pragma unroll
      for (int m = 0; m < 4; ++m) {
        const int rl = ai * HALF + wr * 64 + m * 16 + fr;
        const float rs = S[rl];
        float* orow = out + (size_t)(u.pm * BM + rl) * 1024;
#pragma unroll
        for (int bj = 0; bj < 2; ++bj)
#pragma unroll
          for (int n = 0; n < 2; ++n) {
            const int col = col0 + bj * HALF + n * 16;
            *(f32x4*)(orow + col) = acc[ai][bj][m][n] * rs * *(const f32x4*)(gain + col);
          }
        asm volatile("" ::: "memory");
      }
  }
};
}
#define LAS __attribute__((address_space(3)))
namespace pa {
typedef short bf16x8 __attribute__((ext_vector_type(8)));
typedef short s16x4 __attribute__((ext_vector_type(4)));
typedef float f32x16 __attribute__((ext_vector_type(16)));
typedef unsigned u32x4 __attribute__((ext_vector_type(4)));
typedef unsigned u32x2 __attribute__((ext_vector_type(2)));
typedef float f32x2_t __attribute__((ext_vector_type(2)));
typedef __bf16 bf16x2_t __attribute__((ext_vector_type(2)));
constexpr int KSTR = 208, VSTR = 136, KBYTES = 64 * KSTR, VBYTES = 64 * VSTR, STG = KBYTES + VBYTES;
__device__ __forceinline__ unsigned cvtpk(float lo, float hi) { f32x2_t v = {lo, hi}; bf16x2_t b = __builtin_convertvector(v, bf16x2_t); return __builtin_bit_cast(unsigned, b); }
__device__ __forceinline__ int crow(int r, int hi) { return (r & 3) + 8 * (r >> 2) + 4 * hi; }
__device__ __forceinline__ float swap_max(float v) { auto rr = __builtin_amdgcn_permlane32_swap(__float_as_uint(v), __float_as_uint(v), false, false); return fmaxf(__uint_as_float(rr[0]), __uint_as_float(rr[1])); }
__device__ __forceinline__ float swap_sum(float v) { auto rr = __builtin_amdgcn_permlane32_swap(__float_as_uint(v), __float_as_uint(v), false, false); return __uint_as_float(rr[0]) + __uint_as_float(rr[1]); }

template <int DQK, bool CAUSAL, class Out>
__device__ __forceinline__ void attn_unit(unsigned char* lds, const bf16* Qb, int qs, const bf16* Kb, int ks, const bf16* Vb, int vs, int ntiles, int qpos0, const Out& out, int wid_s) {
  const int tid = mk_tid(wid_s), lane = tid & 63, wid = wid_s, r32 = lane & 31, hi = lane >> 5;
  constexpr int CPR = DQK / 8, NKC = 64 * CPR, KS = DQK / 16;
  bf16x8 qf[KS];
#pragma unroll
  for (int s = 0; s < KS; ++s) qf[s] = *(const bf16x8*)(Qb + (size_t)(wid * 32 + r32) * qs + 16 * s + 8 * hi);
  struct Stg { u32x4 k0, k1, v; } sA, sB;
  const int kc0 = tid, kc1 = tid + 512;
  const int krow0 = kc0 / CPR, kcc0 = kc0 % CPR, krow1 = kc1 / CPR, kcc1 = kc1 % CPR;
  const int vdv = tid >> 3, vcc = tid & 7;
#define PA_GLOAD(S, t) do { (S).k0 = *(const u32x4*)(Kb + (size_t)(64 * (t) + krow0) * ks + kcc0 * 8); \
    if (kc1 < NKC) (S).k1 = *(const u32x4*)(Kb + (size_t)(64 * (t) + krow1) * ks + kcc1 * 8); \
    (S).v = *(const u32x4*)(Vb + (size_t)vdv * vs + 64 * (t) + vcc * 8); } while (0)
#define PA_LSTORE(S, buf) do { unsigned char* b_ = lds + (buf) * STG; *(u32x4*)(b_ + krow0 * KSTR + kcc0 * 16) = (S).k0; \
    if (kc1 < NKC) *(u32x4*)(b_ + krow1 * KSTR + kcc1 * 16) = (S).k1; \
    *(u32x2*)(b_ + KBYTES + vdv * VSTR + vcc * 16) = (u32x2){(S).v.x, (S).v.y}; *(u32x2*)(b_ + KBYTES + vdv * VSTR + vcc * 16 + 8) = (u32x2){(S).v.z, (S).v.w}; } while (0)
  PA_GLOAD(sA, 0); PA_LSTORE(sA, 0); if (ntiles > 1) PA_GLOAD(sB, 1); __syncthreads();
  f32x16 o0, o1;
#pragma unroll
  for (int r = 0; r < 16; ++r) { o0[r] = 0.f; o1[r] = 0.f; }
  float m = -1e30f, l = 0.f;
  const int qlo = qpos0 + 32 * wid;
  auto compute_tile = [&](int t) {
    const unsigned char* kb = lds + (t & 1) * STG; const unsigned char* vb = kb + KBYTES;
    const bool active = !CAUSAL || (64 * t <= qlo + 31);
    if (active) {
      f32x16 p0, p1;
#pragma unroll
      for (int r = 0; r < 16; ++r) { p0[r] = 0.f; p1[r] = 0.f; }
#pragma unroll
      for (int s = 0; s < KS; ++s) {
        const bf16x8 a0 = *(const bf16x8*)(kb + r32 * KSTR + (16 * s + 8 * hi) * 2);
        const bf16x8 a1 = *(const bf16x8*)(kb + (32 + r32) * KSTR + (16 * s + 8 * hi) * 2);
        p0 = __builtin_amdgcn_mfma_f32_32x32x16_bf16(a0, qf[s], p0, 0, 0, 0);
        p1 = __builtin_amdgcn_mfma_f32_32x32x16_bf16(a1, qf[s], p1, 0, 0, 0);
      }
      if (CAUSAL && (64 * t + 63 > qlo)) {
        const int q = qlo + r32;
#pragma unroll
        for (int r = 0; r < 16; ++r) { const int key = 64 * t + crow(r, hi); if (key > q) p0[r] = -1e30f; if (key + 32 > q) p1[r] = -1e30f; }
      }
      float mx = fmaxf(p0[0], p1[0]);
#pragma unroll
      for (int r = 1; r < 16; ++r) mx = fmaxf(mx, fmaxf(p0[r], p1[r]));
      mx = swap_max(mx);
      const float mn = fmaxf(m, mx), alpha = __builtin_amdgcn_exp2f(m - mn);
      m = mn;
      float ps = 0.f;
#pragma unroll
      for (int r = 0; r < 16; ++r) { p0[r] = __builtin_amdgcn_exp2f(p0[r] - mn); p1[r] = __builtin_amdgcn_exp2f(p1[r] - mn); ps += p0[r] + p1[r]; }
      l = l * alpha + ps;
#pragma unroll
      for (int r = 0; r < 16; ++r) { o0[r] *= alpha; o1[r] *= alpha; }
      bf16x8 pb[4];
#pragma unroll
      for (int k = 0; k < 4; ++k) {
        u32x4 w;
        if (k < 2) { w.x = cvtpk(p0[8 * k], p0[8 * k + 1]); w.y = cvtpk(p0[8 * k + 2], p0[8 * k + 3]); w.z = cvtpk(p0[8 * k + 4], p0[8 * k + 5]); w.w = cvtpk(p0[8 * k + 6], p0[8 * k + 7]); }
        else { const int kk = k - 2; w.x = cvtpk(p1[8 * kk], p1[8 * kk + 1]); w.y = cvtpk(p1[8 * kk + 2], p1[8 * kk + 3]); w.z = cvtpk(p1[8 * kk + 4], p1[8 * kk + 5]); w.w = cvtpk(p1[8 * kk + 6], p1[8 * kk + 7]); }
        pb[k] = __builtin_bit_cast(bf16x8, w);
      }
#pragma unroll
      for (int k = 0; k < 4; ++k) {
#pragma unroll
        for (int d = 0; d < 2; ++d) {
          const unsigned char* vp = vb + (32 * d + r32) * VSTR + (16 * k + 4 * hi) * 2;
          const u32x2 lo = *(const u32x2*)vp, hi2 = *(const u32x2*)(vp + 16);
          const u32x4 w = {lo.x, lo.y, hi2.x, hi2.y};
          const bf16x8 va = __builtin_bit_cast(bf16x8, w);
          if (d == 0) o0 = __builtin_amdgcn_mfma_f32_32x32x16_bf16(va, pb[k], o0, 0, 0, 0);
          else o1 = __builtin_amdgcn_mfma_f32_32x32x16_bf16(va, pb[k], o1, 0, 0, 0);
        }
      }
    }
  };
  for (int t = 0; t < ntiles; t += 2) {
    if (t + 2 < ntiles) PA_GLOAD(sA, t + 2);
    compute_tile(t);
    if (t + 1 < ntiles) PA_LSTORE(sB, (t + 1) & 1);
    __syncthreads();
    if (t + 1 < ntiles) {
      if (t + 3 < ntiles) PA_GLOAD(sB, t + 3);
      compute_tile(t + 1);
      if (t + 2 < ntiles) PA_LSTORE(sA, t & 1);
      __syncthreads();
    }
  }
#undef PA_GLOAD
#undef PA_LSTORE
  const float inv = 1.f / swap_sum(l);
#pragma unroll
  for (int g = 0; g < 4; ++g) {
    out(32 * wid + r32, 8 * g + 4 * hi, make_float4(o0[4 * g] * inv, o0[4 * g + 1] * inv, o0[4 * g + 2] * inv, o0[4 * g + 3] * inv));
    out(32 * wid + r32, 32 + 8 * g + 4 * hi, make_float4(o1[4 * g] * inv, o1[4 * g + 1] * inv, o1[4 * g + 2] * inv, o1[4 * g + 3] * inv));
  }
}
}

namespace sa {
using pa::bf16x8; using pa::f32x16; using pa::u32x4; using pa::u32x2; using pa::cvtpk; using pa::crow; using pa::swap_max; using pa::swap_sum;
typedef float f32x4 __attribute__((ext_vector_type(4)));
typedef short v4i16_t __attribute__((ext_vector_type(4)));
constexpr int KVSTR = 336, TK = 128, TILE = TK * KVSTR;
__device__ __forceinline__ void sample_attn_item(unsigned char* lds, const Params& p, const bf16* Qs, float* PO, float* PML, int item, int wid_s) {
  const int db = item >> 1, half = item & 1;
  const int tid = mk_tid(wid_s), lane = tid & 63, wid = wid_s, r32 = lane & 31, hi = lane >> 5;
  const int qt = wid >> 2, ks = wid & 3;
  bf16x8 qf[10];
#pragma unroll
  for (int s = 0; s < 10; ++s) qf[s] = *(const bf16x8*)(Qs + (size_t)(db * 64 + 32 * qt + r32) * 160 + 16 * s + 8 * hi);
  const int ntiles = 32 + half;
  f32x4 stA[8], spA[2], stB[8], spB[2];
  const f32x4 zero4 = {0.f, 0.f, 0.f, 0.f};
#define SA_GLOAD(st, sp, t) do { if ((t) < 32) { const int page_ = p.page_table[db * NPG + 32 * half + (t)]; \
      const f32x4* ck_ = (const f32x4*)(p.cache_ckv + (size_t)page_ * PAGE * 128); const f32x4* kp_ = (const f32x4*)(p.cache_kpe + (size_t)page_ * PAGE * 32); \
      _Pragma("unroll") for (int i_ = 0; i_ < 8; ++i_) st[i_] = __builtin_nontemporal_load(ck_ + tid + 512 * i_); \
      sp[0] = __builtin_nontemporal_load(kp_ + tid); sp[1] = __builtin_nontemporal_load(kp_ + tid + 512); \
    } else { const float* ck_ = p.out + O_CKVS + (size_t)db * 8 * 128; const float* kp_ = p.out + O_KPES + (size_t)db * 8 * 32; \
      st[0] = (tid < 256) ? *(const f32x4*)(ck_ + (size_t)tid * 4) : zero4; \
      _Pragma("unroll") for (int i_ = 1; i_ < 8; ++i_) st[i_] = zero4; \
      sp[0] = (tid < 64) ? *(const f32x4*)(kp_ + (size_t)tid * 4) : zero4; sp[1] = zero4; } } while (0)
#define SA_LSTORE(st, sp, buf) do { _Pragma("unroll") for (int i_ = 0; i_ < 8; ++i_) { const int f_ = tid + 512 * i_, key_ = f_ >> 5, c4_ = f_ & 31; \
      *(u32x2*)(lds + (buf) * TILE + key_ * KVSTR + c4_ * 8) = (u32x2){cvtpk(st[i_].x, st[i_].y), cvtpk(st[i_].z, st[i_].w)}; } \
    _Pragma("unroll") for (int i_ = 0; i_ < 2; ++i_) { const int f_ = tid + 512 * i_, key_ = f_ >> 3, c4_ = f_ & 7; \
      *(u32x2*)(lds + (buf) * TILE + key_ * KVSTR + 256 + c4_ * 8) = (u32x2){cvtpk(sp[i_].x, sp[i_].y), cvtpk(sp[i_].z, sp[i_].w)}; } } while (0)
#if PROF_SEL == 120 || PROF_SEL == 121 || PROF_SEL == 122
  if (item == 0 && tid == 0 && PROF_SEL != 121) ((unsigned long long*)(p.ws + W_TS))[0] = __builtin_amdgcn_s_memrealtime();
#endif
  SA_GLOAD(stA, spA, 0); SA_LSTORE(stA, spA, 0); SA_GLOAD(stB, spB, 1); __syncthreads();
  f32x16 o[4];
#pragma unroll
  for (int c = 0; c < 4; ++c)
#pragma unroll
    for (int r = 0; r < 16; ++r) o[c][r] = 0.f;
  float m = -1e30f, l = 0.f;
  const int tq = (32 * qt + r32) >> 3;
  auto compute_tile = [&](int t) {
    const unsigned char* kb = lds + (t & 1) * TILE + (32 * ks) * KVSTR;
    if (t < 32 || ks == 0) {
      f32x16 p0;
#pragma unroll
      for (int r = 0; r < 16; ++r) p0[r] = 0.f;
#pragma unroll
      for (int s = 0; s < 10; ++s) {
        const bf16x8 a0 = *(const bf16x8*)(kb + r32 * KVSTR + (16 * s + 8 * hi) * 2);
        p0 = __builtin_amdgcn_mfma_f32_32x32x16_bf16(a0, qf[s], p0, 0, 0, 0);
      }
      if (t == 32) {
#pragma unroll
        for (int r = 0; r < 16; ++r) { const int u = crow(r, hi); if (!(u < 8 && u <= tq)) p0[r] = -1e30f; }
      }
      float mx = p0[0];
#pragma unroll
      for (int r = 1; r < 16; ++r) mx = fmaxf(mx, p0[r]);
      mx = swap_max(mx);
      const float mn = fmaxf(m, mx), alpha = __builtin_amdgcn_exp2f(m - mn);
      m = mn;
      float ps = 0.f;
#pragma unroll
      for (int r = 0; r < 16; ++r) { p0[r] = __builtin_amdgcn_exp2f(p0[r] - mn); ps += p0[r]; }
      l = l * alpha + ps;
#pragma unroll
      for (int c = 0; c < 4; ++c)
#pragma unroll
        for (int r = 0; r < 16; ++r) o[c][r] *= alpha;
      bf16x8 pb[2];
#pragma unroll
      for (int k = 0; k < 2; ++k) {
        u32x4 w; w.x = cvtpk(p0[8 * k], p0[8 * k + 1]); w.y = cvtpk(p0[8 * k + 2], p0[8 * k + 3]); w.z = cvtpk(p0[8 * k + 4], p0[8 * k + 5]); w.w = cvtpk(p0[8 * k + 6], p0[8 * k + 7]);
        pb[k] = __builtin_bit_cast(bf16x8, w);
      }
      const int g = lane >> 4, i = lane & 15;
      const LAS unsigned char* vbase = (const LAS unsigned char*)kb + (4 * (g >> 1) + (i >> 2)) * KVSTR + (16 * (g & 1) + 4 * (i & 3)) * 2;
#pragma unroll
      for (int k = 0; k < 2; ++k) {
#pragma unroll
        for (int c = 0; c < 4; ++c) {
          const v4i16_t lo = __builtin_amdgcn_ds_read_tr16_b64_v4i16((LAS v4i16_t*)(vbase + (16 * k) * KVSTR + 64 * c));
          const v4i16_t hi4 = __builtin_amdgcn_ds_read_tr16_b64_v4i16((LAS v4i16_t*)(vbase + (16 * k + 8) * KVSTR + 64 * c));
          const bf16x8 va = {lo[0], lo[1], lo[2], lo[3], hi4[0], hi4[1], hi4[2], hi4[3]};
          o[c] = __builtin_amdgcn_mfma_f32_32x32x16_bf16(va, pb[k], o[c], 0, 0, 0);
        }
      }
    }
  };
  for (int t = 0; t < ntiles; t += 2) {
    if (t + 2 < ntiles) SA_GLOAD(stA, spA, t + 2);
    compute_tile(t);
    if (t + 1 < ntiles) SA_LSTORE(stB, spB, (t + 1) & 1);
    __syncthreads();
    if (t + 1 < ntiles) {
      if (t + 3 < ntiles) SA_GLOAD(stB, spB, t + 3);
      compute_tile(t + 1);
      if (t + 2 < ntiles) SA_LSTORE(stA, spA, t & 1);
      __syncthreads();
    }
  }
#undef SA_GLOAD
#undef SA_LSTORE
#if PROF_SEL == 120 || PROF_SEL == 121
  if (item == 0 && tid == 0) ((unsigned long long*)(p.ws + W_TS))[PROF_SEL == 120 ? 1 : 0] = __builtin_amdgcn_s_memrealtime();
#endif
  {
    float* X = (float*)lds;
#pragma unroll
    for (int round = 0; round < 2; ++round) {
      const bool writer = round == 0 ? (ks >= 2) : (ks == 1);
      const bool reader = round == 0 ? (ks < 2) : (ks == 0);
      const int slot = round == 0 ? (qt * 2 + (ks & 1)) : qt;
      float* xs = X + (size_t)slot * (66 * 64);
      if (writer) {
        xs[lane] = m; xs[64 + lane] = l;
#pragma unroll
        for (int c = 0; c < 4; ++c)
#pragma unroll
          for (int r = 0; r < 16; ++r) xs[(2 + c * 16 + r) * 64 + lane] = o[c][r];
      }
      __syncthreads();
      if (reader) {
        const float m2 = xs[lane], l2 = xs[64 + lane];
        const float mn = fmaxf(m, m2), s1 = __builtin_amdgcn_exp2f(m - mn), s2 = __builtin_amdgcn_exp2f(m2 - mn);
        m = mn; l = l * s1 + l2 * s2;
#pragma unroll
        for (int c = 0; c < 4; ++c)
#pragma unroll
          for (int r = 0; r < 16; ++r) o[c][r] = o[c][r] * s1 + xs[(2 + c * 16 + r) * 64 + lane] * s2;
      }
      __syncthreads();
    }
  }
  const int q = 32 * qt + r32;
  if (ks == 0) {
    const float lt = swap_sum(l);
    if (hi == 0) __hip_atomic_store((unsigned long long*)(PML + ((size_t)item * 64 + q) * 2), ((unsigned long long)__float_as_uint(lt) << 32) | __float_as_uint(m), __ATOMIC_RELAXED, __HIP_MEMORY_SCOPE_AGENT);
#pragma unroll
    for (int c = 0; c < 4; ++c)
#pragma unroll
      for (int g4 = 0; g4 < 4; ++g4) {
        const int c0 = 32 * c + 8 * g4 + 4 * hi;
        unsigned long long* dst_ = (unsigned long long*)(PO + ((size_t)item * 64 + q) * 128 + c0);
        __hip_atomic_store(dst_, ((unsigned long long)__float_as_uint(o[c][4 * g4 + 1]) << 32) | __float_as_uint(o[c][4 * g4]), __ATOMIC_RELAXED, __HIP_MEMORY_SCOPE_AGENT);
        __hip_atomic_store(dst_ + 1, ((unsigned long long)__float_as_uint(o[c][4 * g4 + 3]) << 32) | __float_as_uint(o[c][4 * g4 + 2]), __ATOMIC_RELAXED, __HIP_MEMORY_SCOPE_AGENT);
      }
  }
  asm volatile("s_waitcnt vmcnt(0)" ::: "memory");
  __syncthreads();
  volatile unsigned* flag = (volatile unsigned*)(lds + 2 * TILE);
  if (tid == 0) *flag = atomicAdd((unsigned*)(p.ws + W_CTL) + 64 + db, 1u);
  __syncthreads();
  const unsigned arrived = *flag;
  __syncthreads();
  if (arrived == 1u) {
    __builtin_amdgcn_fence(__ATOMIC_ACQUIRE, "agent");
    typedef float f32x4_t __attribute__((ext_vector_type(4)));
    const int h = wid, r16 = lane & 15, kq = lane >> 4;
    const bool rv = r16 < 8;
    const int qq = (rv ? r16 : 0) * 8 + h;
    const float* ml0 = PML + ((size_t)(2 * db) * 64 + qq) * 2; const float* ml1 = ml0 + 128;
    const float m0 = ml0[0], m1 = ml1[0], M_ = fmaxf(m0, m1), w0_ = __builtin_amdgcn_exp2f(m0 - M_), w1_ = __builtin_amdgcn_exp2f(m1 - M_);
    const float invL = 1.f / (ml0[1] * w0_ + ml1[1] * w1_);
    const float s0 = rv ? w0_ * invL : 0.f, s1 = rv ? w1_ * invL : 0.f;
    const float* po0 = PO + ((size_t)(2 * db) * 64 + qq) * 128; const float* po1 = po0 + 64 * 128;
    const bf16* wuv = (const bf16*)(p.ws + W_END) + B_WUV;
    f32x4_t acc[4];
#pragma unroll
    for (int nt = 0; nt < 4; ++nt) acc[nt] = (f32x4_t){0.f, 0.f, 0.f, 0.f};
#pragma unroll
    for (int ks = 0; ks < 4; ++ks) {
      const int c0 = 32 * ks + 8 * kq;
      const f32x4_t a0 = *(const f32x4_t*)(po0 + c0), a1 = *(const f32x4_t*)(po0 + c0 + 4), b0 = *(const f32x4_t*)(po1 + c0), b1 = *(const f32x4_t*)(po1 + c0 + 4);
      const f32x4_t x0 = a0 * s0 + b0 * s1, x1 = a1 * s0 + b1 * s1;
      u32x4 aw; aw.x = cvtpk(x0.x, x0.y); aw.y = cvtpk(x0.z, x0.w); aw.z = cvtpk(x1.x, x1.y); aw.w = cvtpk(x1.z, x1.w);
      const bf16x8 af = __builtin_bit_cast(bf16x8, aw);
#pragma unroll
      for (int nt = 0; nt < 4; ++nt) {
        const bf16x8 bfr = *(const bf16x8*)(wuv + (size_t)(h * 64 + 16 * nt + r16) * 128 + c0);
        acc[nt] = __builtin_amdgcn_mfma_f32_16x16x32_bf16(af, bfr, acc[nt], 0, 0, 0);
      }
    }
    if (kq < 2) {
      bf16* mix = (bf16*)(p.ws + W_END) + B_MIX;
#pragma unroll
      for (int nt = 0; nt < 4; ++nt)
#pragma unroll
        for (int rg = 0; rg < 4; ++rg) {
          const int t = 4 * kq + rg, col = h * 64 + 16 * nt + r16;
          const size_t row = (size_t)NP + db * 8 + t;
          const float g = pj((const bf16*)(p.ws + W_END) + B_PROJ, row, C_GMLA + col);
          mix[row * 1024 + col] = (bf16)f2bf(acc[nt][rg] * (g / (1.f + __expf(-g))));
        }
    }
  }
#if PROF_SEL == 121 || PROF_SEL == 122
  if (item == 0 && tid == 0) ((unsigned long long*)(p.ws + W_TS))[1] = __builtin_amdgcn_s_memrealtime();
#endif
}
}

namespace rw {
typedef float f32x4 __attribute__((ext_vector_type(4)));
constexpr int CH = 32, STEPF = 384, CHF = CH * STEPF;
__device__ __forceinline__ float dpp_sum16(float v) {
  v += __int_as_float(__builtin_amdgcn_update_dpp(0, __float_as_int(v), 0xB1, 0xF, 0xF, true));
  v += __int_as_float(__builtin_amdgcn_update_dpp(0, __float_as_int(v), 0x4E, 0xF, 0xF, true));
  v += __int_as_float(__builtin_amdgcn_update_dpp(0, __float_as_int(v), 0x141, 0xF, 0xF, true));
  v += __int_as_float(__builtin_amdgcn_update_dpp(0, __float_as_int(v), 0x140, 0xF, 0xF, true));
  return v;
}
__device__ __forceinline__ float dpp_sum8(float v) {
  v += __int_as_float(__builtin_amdgcn_update_dpp(0, __float_as_int(v), 0xB1, 0xF, 0xF, true));
  v += __int_as_float(__builtin_amdgcn_update_dpp(0, __float_as_int(v), 0x4E, 0xF, 0xF, true));
  v += __int_as_float(__builtin_amdgcn_update_dpp(0, __float_as_int(v), 0x141, 0xF, 0xF, true));
  return v;
}
__device__ __forceinline__ void rwkv_prompt_item(unsigned char* lds, const Params& p, int item, int wid_s) {
  const int bh = item >> 1, half = item & 1, b = bh >> 2, h = bh & 3;
  const int tid = mk_tid(wid_s);
  float* L = (float*)lds; float* yb = L + 2 * CHF;
  const float* ws = p.ws;
  const size_t rowbase = (size_t)b * SEQ;
  constexpr int NCH = SEQ / CH;
  if (wid_s >= 4) {
    const int ht = tid - 256;
    f32x4 g[12];
#define RW_GLOAD(c) do { _Pragma("unroll") for (int i_ = 0; i_ < 12; ++i_) { const int f_ = ht + 256 * i_, arr_ = f_ >> 9, s_ = (f_ >> 4) & 31, k4_ = f_ & 15; \
      const size_t off_ = (rowbase + (size_t)(c) * CH + s_) * 256 + h * 64 + k4_ * 4; \
      const size_t base_ = arr_ == 0 ? W_KK : arr_ == 1 ? W_W : arr_ == 2 ? W_BB : arr_ == 3 ? W_KF : arr_ == 4 ? W_R : W_VV; \
      g[i_] = *(const f32x4*)(ws + base_ + off_); } } while (0)
#define RW_LSTORE(buf) do { _Pragma("unroll") for (int i_ = 0; i_ < 12; ++i_) { const int f_ = ht + 256 * i_, arr_ = f_ >> 9, s_ = (f_ >> 4) & 31, k4_ = f_ & 15; \
      *(f32x4*)(L + (buf) * CHF + s_ * STEPF + arr_ * 64 + k4_ * 4) = (arr_ == 2) ? -g[i_] : g[i_]; } } while (0)
#define RW_FLUSH(c) do { const float* ybc_ = yb + ((c) & 1) * (32 * 33); _Pragma("unroll") for (int i_ = 0; i_ < 4; ++i_) { const int f_ = ht + 256 * i_, s_ = f_ >> 5, vv_ = f_ & 31; \
      p.ws[W_Y + (rowbase + (size_t)(c) * CH + s_) * 256 + h * 64 + 32 * half + vv_] = ybc_[vv_ * 33 + s_]; } } while (0)
    RW_GLOAD(0); RW_LSTORE(0);
    __syncthreads();
    for (int c = 0; c < NCH; ++c) {
      if (c + 1 < NCH) { RW_GLOAD(c + 1); RW_LSTORE((c + 1) & 1); }
      if (c > 0) RW_FLUSH(c - 1);
      __syncthreads();
    }
    RW_FLUSH(NCH - 1);
#undef RW_GLOAD
#undef RW_LSTORE
#undef RW_FLUSH
  } else {
    const int sub = tid & 7, vl = tid >> 3, v = 32 * half + vl;
    f32x4 Sa = {0.f, 0.f, 0.f, 0.f}, Sb = {0.f, 0.f, 0.f, 0.f};
    struct Ops { f32x4 kk0, kk1, w0, w1, nb0, nb1, kf0, kf1, r0, r1; float vv; };
#define RW_LD(o, s) do { const float* sb_ = cb + (s) * STEPF + 8 * sub; (o).kk0 = *(const f32x4*)(sb_); (o).kk1 = *(const f32x4*)(sb_ + 4); \
      (o).w0 = *(const f32x4*)(sb_ + 64); (o).w1 = *(const f32x4*)(sb_ + 68); (o).nb0 = *(const f32x4*)(sb_ + 128); (o).nb1 = *(const f32x4*)(sb_ + 132); \
      (o).kf0 = *(const f32x4*)(sb_ + 192); (o).kf1 = *(const f32x4*)(sb_ + 196); (o).r0 = *(const f32x4*)(sb_ + 256); (o).r1 = *(const f32x4*)(sb_ + 260); \
      (o).vv = cb[(s) * STEPF + 320 + v]; } while (0)
#define RW_STEP(o, s) do { const f32x4 ta_ = (o).kf0 * (o).vv, tb_ = (o).kf1 * (o).vv; const f32x4 d4_ = Sa * (o).kk0 + Sb * (o).kk1; \
      float dot_ = (d4_.x + d4_.y) + (d4_.z + d4_.w); dot_ = dpp_sum8(dot_); \
      Sa = Sa * (o).w0 + ((o).nb0 * dot_ + ta_); Sb = Sb * (o).w1 + ((o).nb1 * dot_ + tb_); \
      const f32x4 y4_ = Sa * (o).r0 + Sb * (o).r1; float y_ = (y4_.x + y4_.y) + (y4_.z + y4_.w); y_ = dpp_sum8(y_); \
      ykeep = (sub == ((s) & 7)) ? y_ : ykeep; \
      if (((s) & 7) == 7) ybc[vl * 33 + ((s) - 7) + sub] = ykeep; } while (0)
    __syncthreads();
    for (int c = 0; c < NCH; ++c) {
      const float* cb = L + (c & 1) * CHF;
      float* ybc = yb + (c & 1) * (32 * 33);
      float ykeep = 0.f;
      Ops A, B;
      RW_LD(A, 0);
#pragma unroll
      for (int s = 0; s < CH; s += 2) {
        RW_LD(B, s + 1);
        RW_STEP(A, s);
        if (s + 2 < CH) RW_LD(A, s + 2);
        RW_STEP(B, s + 1);
      }
      __syncthreads();
    }
#undef RW_LD
#undef RW_STEP
    float* so = p.out + O_WKVP + ((size_t)(b * 4 + h) * 64 + v) * 64 + 8 * sub;
    *(f32x4*)so = Sa; *(f32x4*)(so + 4) = Sb;
  }
  __syncthreads();
}
}

namespace rw {
__device__ __forceinline__ void rwkv_sample_item(unsigned char* lds, const Params& p, int item, int wid_s) {
  float* YL = (float*)lds;
  const int db = item >> 2, h = item & 3;
  const int tid = mk_tid(wid_s), sub = tid & 7, v = tid >> 3;
  const float* ws = p.ws;
  const float* s0 = p.state_wkv + ((size_t)(db * 4 + h) * 64 + v) * 64 + 8 * sub;
  f32x4 Sa = *(const f32x4*)s0, Sb = *(const f32x4*)(s0 + 4);
  const size_t row0 = (size_t)NP + db * DT;
  struct Ops { f32x4 kk0, kk1, w0, w1, b0, b1, kf0, kf1, r0, r1; float vv; };
#define RS_LD(o, t) do { const size_t off_ = (row0 + (t)) * 256 + h * 64; const float* q_ = ws + off_ + 8 * sub; \
    (o).kk0 = *(const f32x4*)(q_ + W_KK); (o).kk1 = *(const f32x4*)(q_ + W_KK + 4); (o).w0 = *(const f32x4*)(q_ + W_W); (o).w1 = *(const f32x4*)(q_ + W_W + 4); \
    (o).b0 = *(const f32x4*)(q_ + W_BB); (o).b1 = *(const f32x4*)(q_ + W_BB + 4); (o).kf0 = *(const f32x4*)(q_ + W_KF); (o).kf1 = *(const f32x4*)(q_ + W_KF + 4); \
    (o).r0 = *(const f32x4*)(q_ + W_R); (o).r1 = *(const f32x4*)(q_ + W_R + 4); (o).vv = ws[W_VV + off_ + v]; } while (0)
#define RS_STEP(o, t) do { const f32x4 d4_ = Sa * (o).kk0 + Sb * (o).kk1; float dot_ = (d4_.x + d4_.y) + (d4_.z + d4_.w); dot_ = dpp_sum8(dot_); \
    const float sa_ = -dot_; \
    Sa = Sa * (o).w0 + ((o).b0 * sa_ + (o).kf0 * (o).vv); Sb = Sb * (o).w1 + ((o).b1 * sa_ + (o).kf1 * (o).vv); \
    const f32x4 y4_ = Sa * (o).r0 + Sb * (o).r1; float y_ = (y4_.x + y4_.y) + (y4_.z + y4_.w); y_ = dpp_sum8(y_); \
    if (sub == 0) YL[(t) * 64 + v] = y_; } while (0)
  Ops A, B;
  RS_LD(A, 0);
#pragma unroll
  for (int t = 0; t < DT; t += 2) {
    RS_LD(B, t + 1);
    RS_STEP(A, t);
    if (t + 2 < DT) RS_LD(A, t + 2);
    RS_STEP(B, t + 1);
  }
#undef RS_LD
#undef RS_STEP
  float* so = p.out + O_WKVS + ((size_t)(db * 4 + h) * 64 + v) * 64 + 8 * sub;
  *(f32x4*)so = Sa; *(f32x4*)(so + 4) = Sb;
  __syncthreads();
  {
    const int t = wid_s, lane = tid & 63;
    const size_t row = row0 + t, off = row * 256 + h * 64 + lane;
    const float y = YL[t * 64 + lane];
    const float mean = wave_sum_fast(y) * (1.f / 64.f), d = y - mean, var = wave_sum_fast(d * d) * (1.f / 64.f);
    const float yn = d * rsqrtf(var + GN_EPS) * p.lnx_g[h * 64 + lane] + p.lnx_b[h * 64 + lane];
    const float bsum = wave_sum_fast(ws[W_R + off] * ws[W_KF + off] * p.r_k[h * 64 + lane]);
    const float o = yn + bsum * ws[W_VV + off];
    const float g = pj((const bf16*)(p.ws + W_END) + B_PROJ, row, C_GRWKV + h * 64 + lane);
    ((bf16*)(p.ws + W_END))[B_MIX + row * 1024 + 512 + h * 64 + lane] = (bf16)f2bf(o * (g / (1.f + __expf(-g))));
  }
  __syncthreads();
}
}

namespace ma {
typedef float f32x4 __attribute__((ext_vector_type(4)));
__device__ __forceinline__ void mem_sample_item(unsigned char* lds, const Params& p, int db, int wid_s) {
  const int tid = mk_tid(wid_s), lane = tid & 63, t = wid_s;
  constexpr int KST = 65;
  float* Kl = (float*)lds;
  float* Vl = Kl + 256 * KST;
  float* ps = Vl + 256 * 64 + t * 256;
  const float* ws = p.ws;
  const float* kg = p.cache_mem_k + (size_t)db * 65536; const float* vg = p.cache_mem_v + (size_t)db * 65536;
  const size_t row = (size_t)NP + db * 8 + t;
  f32x4 kr[8], vr[8];
#define MS_GLOAD(h) do { _Pragma("unroll") for (int i_ = 0; i_ < 8; ++i_) { const int f_ = tid + 512 * i_, m_ = f_ >> 4, c4_ = f_ & 15; \
    kr[i_] = *(const f32x4*)(kg + (size_t)m_ * 256 + (h) * 64 + c4_ * 4); vr[i_] = *(const f32x4*)(vg + (size_t)m_ * 256 + (h) * 64 + c4_ * 4); } } while (0)
#define MS_LSTORE() do { _Pragma("unroll") for (int i_ = 0; i_ < 8; ++i_) { const int f_ = tid + 512 * i_, m_ = f_ >> 4, c4_ = f_ & 15; \
    float* kd_ = Kl + m_ * KST + c4_ * 4; kd_[0] = kr[i_].x; kd_[1] = kr[i_].y; kd_[2] = kr[i_].z; kd_[3] = kr[i_].w; \
    *(f32x4*)(Vl + m_ * 64 + c4_ * 4) = vr[i_]; } } while (0)
  MS_GLOAD(0);
  bf16* mix = (bf16*)(p.ws + W_END) + B_MIX;
  for (int h = 0; h < 4; ++h) {
    __syncthreads();
    MS_LSTORE();
    if (h + 1 < 4) MS_GLOAD(h + 1);
    float q[64];
    { const bf16* PJ = (const bf16*)(p.ws + W_END) + B_PROJ;
#pragma unroll
      for (int d4 = 0; d4 < 16; ++d4) { const float4 v = pj4(PJ, row, C_QX + h * 64 + d4 * 4); q[4 * d4] = v.x * X_SCALE; q[4 * d4 + 1] = v.y * X_SCALE; q[4 * d4 + 2] = v.z * X_SCALE; q[4 * d4 + 3] = v.w * X_SCALE; } }
    __syncthreads();
    float s[4] = {0.f, 0.f, 0.f, 0.f};
#pragma unroll
    for (int d = 0; d < 64; ++d) {
#pragma unroll
      for (int j = 0; j < 4; ++j) s[j] += Kl[(lane + 64 * j) * KST + d] * q[d];
    }
    float mx = wave_max(fmaxf(fmaxf(s[0], s[1]), fmaxf(s[2], s[3])));
    float sum = 0.f;
#pragma unroll
    for (int j = 0; j < 4; ++j) { s[j] = __expf(s[j] - mx); sum += s[j]; }
    const float inv = 1.f / wave_sum_fast(sum);
#pragma unroll
    for (int j = 0; j < 4; ++j) ps[lane + 64 * j] = s[j] * inv;
    float o0 = 0.f, o1 = 0.f, o2 = 0.f, o3 = 0.f;
#pragma unroll 4
    for (int m = 0; m < 256; m += 4) {
      const f32x4 pm = *(const f32x4*)(ps + m);
      o0 += pm.x * Vl[(m) * 64 + lane]; o1 += pm.y * Vl[(m + 1) * 64 + lane]; o2 += pm.z * Vl[(m + 2) * 64 + lane]; o3 += pm.w * Vl[(m + 3) * 64 + lane];
    }
    const float o = (o0 + o1) + (o2 + o3);
    const float g = pj((const bf16*)(p.ws + W_END) + B_PROJ, row, C_GX + h * 64 + lane);
    mix[row * 1024 + 768 + h * 64 + lane] = (bf16)f2bf(o * (g / (1.f + __expf(-g))));
  }
#undef MS_GLOAD
#undef MS_LSTORE
  __syncthreads();
}
}

typedef unsigned v4u __attribute__((ext_vector_type(4)));
__device__ __forceinline__ unsigned f2bf(float f) { unsigned u = __builtin_bit_cast(unsigned, f); return (u + 0x7fffu + ((u >> 16) & 1u)) >> 16; }
__device__ __forceinline__ unsigned pk2(float lo, float hi) { return f2bf(lo) | (f2bf(hi) << 16); }
__device__ __forceinline__ void p0_transpose_item(const float* W, int K, int N, bf16* WT, int row_off, LAS float* scr, int item, int lane) {
  const int nblk = N / 32, kb = item / nblk, nb = item % nblk, k0 = 64 * kb, n0 = 32 * nb;
#pragma unroll 8
  for (int i = 0; i < 32; ++i) { const int kk = 2 * i + (lane >> 5); scr[kk * 33 + (lane & 31)] = W[(size_t)(k0 + kk) * N + n0 + (lane & 31)]; }
  asm volatile("s_waitcnt lgkmcnt(0)" ::: "memory");
  const int c = lane & 7;
#pragma unroll
  for (int j = 0; j < 4; ++j) { const int n = (lane >> 3) + 8 * j; const LAS float* s = scr + (8 * c) * 33 + n;
    v4u o; o.x = pk2(s[0 * 33], s[1 * 33]); o.y = pk2(s[2 * 33], s[3 * 33]); o.z = pk2(s[4 * 33], s[5 * 33]); o.w = pk2(s[6 * 33], s[7 * 33]);
    *(v4u*)(WT + (size_t)(row_off + n0 + n) * K + k0 + 8 * c) = o; }
  asm volatile("s_waitcnt lgkmcnt(0)" ::: "memory");
}


#if PROF_SEL >= 0
#define PROF_STAMP(i) do { if ((i) == PROF_SEL || (i) == PROF_SEL + 1 || ((i) == 0 && PROF_SEL >= 130 && PROF_SEL <= 136)) { if (blockIdx.x == 0 && mk_tid(wid_s) == 0) ((unsigned long long*)(p.ws + W_TS))[(i) == 0 ? 0 : (i) - PROF_SEL] = __builtin_amdgcn_s_memrealtime(); } } while (0)
#else
#define PROF_STAMP(i) do { } while (0)
#endif
__global__ void __launch_bounds__(512) fwd_megakernel(Params p) {
  cg::grid_group grid = cg::this_grid();
  extern __shared__ __attribute__((aligned(16))) unsigned char lds[];
  float* sm = (float*)lds;
  bf16* wb = (bf16*)(p.ws + W_END);
  float* ws = p.ws;
  const int wid_s = __builtin_amdgcn_readfirstlane((int)(threadIdx.x >> 6));
  PROF_STAMP(0);
#define PH_IDS const int tid = mk_tid(wid_s); const int lane = tid & 63, wv = tid >> 6; const int gw = blockIdx.x * 8 + wv, NGW = gridDim.x * 8; \
  const int gtid = blockIdx.x * 512 + tid, NTH = gridDim.x * 512; (void)lane; (void)wv; (void)gw; (void)NGW; (void)gtid; (void)NTH;
  { PH_IDS

  {
    LAS float* scr = (LAS float*)((LAS unsigned char*)lds + wv * 16384);
    constexpr int I_IN = 16 * (INC / 32), I_MEM = 16 * (512 / 32), I_OUT = 16 * (1024 / 32);
    for (int it = gw; it < I_IN + I_MEM + I_OUT; it += NGW) {
      int r = it;
      if (r < I_IN) { p0_transpose_item(p.w_in, 1024, INC, wb + B_WIN, 0, scr, r, lane); continue; } r -= I_IN;
      if (r < I_MEM) { p0_transpose_item(p.w_mem_kv, 1024, 512, wb + B_WMEM, 0, scr, r, lane); continue; } r -= I_MEM;
      p0_transpose_item(p.w_out, 1024, 1024, wb + B_WOUT, 0, scr, r, lane);
    }
    if (gtid < 256) ((unsigned*)(p.ws + W_CTL))[gtid] = 0u;

#if PROF_SEL == 130
    if (blockIdx.x == 0 && tid == 0) { asm volatile("s_waitcnt vmcnt(0)" ::: "memory"); ((unsigned long long*)(p.ws + W_TS))[1] = __builtin_amdgcn_s_memrealtime(); }
#endif
    for (int it = gw; it < 64; it += NGW) {
      if (it < 32) p0_transpose_item(p.w_uk, 128, 512, wb + B_WUK, 0, scr, it, lane);
      else p0_transpose_item(p.w_uv, 128, 512, wb + B_WUV, 0, scr, it - 32, lane);
    }

#if PROF_SEL == 131
    if (blockIdx.x == 0 && tid == 0) { asm volatile("s_waitcnt vmcnt(0)" ::: "memory"); ((unsigned long long*)(p.ws + W_TS))[1] = __builtin_amdgcn_s_memrealtime(); }
#endif
    for (int i = gtid; i < 768 * 256; i += NTH) {
      const int n = i >> 8, k = i & 255;
      const int orig = n < 512 ? (n >> 6) * 96 + (n & 63) : (n < 640 ? ((n - 512) >> 4) * 96 + 64 + ((n - 512) & 15) : ((n - 640) >> 4) * 96 + 80 + ((n - 640) & 15));
      wb[B_WUQ + i] = (bf16)f2bf(p.w_uq[(size_t)k * 768 + orig]);
    }

#if PROF_SEL == 132
    if (blockIdx.x == 0 && tid == 0) { asm volatile("s_waitcnt vmcnt(0)" ::: "memory"); ((unsigned long long*)(p.ws + W_TS))[1] = __builtin_amdgcn_s_memrealtime(); }
#endif
    for (int it0 = gw; it0 < 1024; it0 += NGW) {
      const int it = __builtin_amdgcn_readfirstlane(it0);
      const int h = it >> 7, k = ((it >> 5) & 3) * 64 + lane, cg = it & 31;
      float ar[64];
#pragma unroll
      for (int d4 = 0; d4 < 16; ++d4) { const float4 v = *(const float4*)(p.w_uq + (size_t)k * 768 + h * 96 + d4 * 4); ar[4 * d4] = v.x; ar[4 * d4 + 1] = v.y; ar[4 * d4 + 2] = v.z; ar[4 * d4 + 3] = v.w; }
#pragma unroll 4
      for (int c = cg * 4; c < cg * 4 + 4; ++c) {
        const float* br = p.w_uk + (size_t)c * 512 + h * 64;
        float acc = 0.f;
#pragma unroll
        for (int d4 = 0; d4 < 16; ++d4) { const float4 v = *(const float4*)(br + d4 * 4); acc += (ar[4 * d4] * v.x + ar[4 * d4 + 1] * v.y) + (ar[4 * d4 + 2] * v.z + ar[4 * d4 + 3] * v.w); }
        wb[B_WQL + (size_t)(h * 128 + c) * 256 + k] = (bf16)f2bf(acc);
      }
    }

#if PROF_SEL == 133
    if (blockIdx.x == 0 && tid == 0) { asm volatile("s_waitcnt vmcnt(0)" ::: "memory"); ((unsigned long long*)(p.ws + W_TS))[1] = __builtin_amdgcn_s_memrealtime(); }
#endif
    for (int i = gtid; i < 512 * 1024; i += NTH) {
      const int n = i >> 10, k = i & 1023, h = n >> 6, hk = k >> 7, c = k & 127;
      wb[B_WUVBD + i] = hk == h ? (bf16)f2bf(p.w_uv[(size_t)c * 512 + n]) : (bf16)0;
    }

#if PROF_SEL == 134
    if (blockIdx.x == 0 && tid == 0) { asm volatile("s_waitcnt vmcnt(0)" ::: "memory"); ((unsigned long long*)(p.ws + W_TS))[1] = __builtin_amdgcn_s_memrealtime(); }
#endif
    for (int i = gtid; i < 4104 * 16; i += NTH) {
      const int pi = i >> 4, j = i & 15; const int pos = pi < 4096 ? pi : PAST + (pi - 4096);
      const float inv = 1.0f / powf(10000.0f, (float)j * (2.0f / 32.0f));
      const float ang = (float)pos * inv;
      p.ws[W_CS + (size_t)i * 2] = cosf(ang); p.ws[W_CS + (size_t)i * 2 + 1] = sinf(ang);
    }
    for (int i = gtid; i < (INCP - INC) * 1024 / 8; i += NTH) ((v4u*)(wb + B_WIN + (size_t)INC * 1024))[i] = (v4u){0u, 0u, 0u, 0u};
  }

#if PROF_SEL == 135
    if (blockIdx.x == 0 && tid == 0) { asm volatile("s_waitcnt vmcnt(0)" ::: "memory"); ((unsigned long long*)(p.ws + W_TS))[1] = __builtin_amdgcn_s_memrealtime(); }
#endif
  for (int r = gw; r < NT + 1024; r += NGW) {
    const float* src; const float* g; bf16* dst;
    if (r < NT) { src = xrow(p, r); g = p.ln_g; dst = wb + B_H + (size_t)r * 1024; }
    else { src = p.mem_prompt + (size_t)(r - NT) * 1024; g = p.mem_norm_g; dst = wb + B_HM + (size_t)(r - NT) * 1024; }
    float4 v[4]; float ss = 0.f;
#pragma unroll
    for (int i = 0; i < 4; ++i) { v[i] = *(const float4*)(src + 4 * lane + 256 * i); ss += v[i].x * v[i].x + v[i].y * v[i].y + v[i].z * v[i].z + v[i].w * v[i].w; }
    const float rs = rsqrtf(wave_sum_fast(ss) * (1.f / 1024.f) + RMS_EPS);
#pragma unroll
    for (int i = 0; i < 4; ++i) {
      const float4 gg = *(const float4*)(g + 4 * lane + 256 * i);
      uint2 o; o.x = pk2(v[i].x * rs * gg.x, v[i].y * rs * gg.y); o.y = pk2(v[i].z * rs * gg.z, v[i].w * rs * gg.w);
      *(uint2*)(dst + 4 * lane + 256 * i) = o;
    }
  }
  }
  grid.sync();
  PROF_STAMP(1);
  { PH_IDS

  {
    pg8::Gemm g{wb + B_H, wb + B_WIN, NT, INCP, 1024}; pg8::StaticOrder S; S.init(NT, INCP, (int)gridDim.x, (int)blockIdx.x);
    bf16* PJ = wb + B_PROJ;
    auto f = [=](int row, int col) -> bf16* { return col < INC ? PJ + (size_t)row * INC + col : nullptr; };
    pg8::EpiBf16F<decltype(f)> E{f, 1.f};
    pg8::gemm_phase<pg8::EpiBf16F<decltype(f)>, pg8::StaticOrder, true, true>((PG8_LAS unsigned char*)lds, g, S, E, wid_s);
  }
  {
    pg8::Gemm g{wb + B_HM, wb + B_WMEM, 1024, 512, 1024}; pg8::StaticOrder S; S.init(1024, 512, (int)gridDim.x, (int)((blockIdx.x + 20) % gridDim.x));
    pg8::EpiF32 E{p.out + O_MKP, 256, 256, 256, O_MVP - O_MKP, nullptr, nullptr, 0};
    pg8::gemm_phase<pg8::EpiF32, pg8::StaticOrder, true, true>((PG8_LAS unsigned char*)lds, g, S, E, wid_s);
  }
  }
  grid.sync();
  PROF_STAMP(2);
  { PH_IDS

  for (size_t i = gtid; i < (size_t)4 * 256 * 256; i += NTH) {
    wb[B_KM + i] = (bf16)f2bf(p.out[O_MKP + i]);
    const size_t b_ = i >> 16, c = (i >> 8) & 255, m_ = i & 255;
    wb[B_VMT + i] = (bf16)f2bf(p.out[O_MVP + (b_ * 256 + m_) * 256 + c]);
  }
  {
    constexpr int WST = 72, TST = 136;
    bf16* wl = (bf16*)lds; bf16* al = wl + 256 * WST;
    bf16* td = al + 256 * WST + wv * (16 * TST);
    for (int i = tid; i < 64 * 256; i += 512) { const int k = i >> 8, n = i & 255; wl[n * WST + k] = (bf16)f2bf(p.w_up[i]); al[n * WST + k] = (bf16)f2bf(p.a_up[i]); }
    __syncthreads();
    float mu[14];
#pragma unroll
    for (int i = 0; i < 14; ++i) mu[i] = p.shift_mu[lane + 64 * i];
    float qg[4], kg[2];
#pragma unroll
    for (int i = 0; i < 4; ++i) qg[i] = p.q_norm_g[lane + 64 * i];
    kg[0] = p.kv_norm_g[lane]; kg[1] = p.kv_norm_g[64 + lane];
    constexpr int GT = 8;
    struct TokIn { float cq[4], ck0, ck1, kr1, kr2, z[14], zp[14]; float2 csv; float4 qx4; };
    auto tok_load = [&](int row, TokIn& T) {
      const bf16* pr = wb + B_PROJ + (size_t)row * INC;
      const bool isp = row < NP; const int srow = row - NP;
      const bool first = isp ? ((row & (SEQ - 1)) == 0) : ((srow & 7) == 0);
      const float* sst = p.state_shift + (size_t)((first && !isp) ? (srow >> 3) : 0) * 896;
#pragma unroll
      for (int i = 0; i < 4; ++i) T.cq[i] = bf2f(pr[C_CQ + lane + 64 * i]);
      T.ck0 = bf2f(pr[C_CKV + lane]); T.ck1 = bf2f(pr[C_CKV + 64 + lane]);
      T.kr1 = bf2f(pr[C_KR + (lane & 15)]); T.kr2 = bf2f(pr[C_KR + 16 + (lane & 15)]);
#pragma unroll
      for (int i = 0; i < 14; ++i) { T.z[i] = bf2f(pr[C_Z + lane + 64 * i]); T.zp[i] = first ? (isp ? 0.f : sst[lane + 64 * i]) : bf2f(pr[C_Z - INC + lane + 64 * i]); }
      const int pi = isp ? (row & (SEQ - 1)) : 4096 + (srow & 7);
      T.csv = *(const float2*)(ws + W_CS + ((size_t)pi * 16 + (lane & 15)) * 2);
      T.qx4 = make_float4(0.f, 0.f, 0.f, 0.f);
      if (isp) T.qx4 = pj4(wb + B_PROJ, (size_t)row, C_QX + lane * 4);
    };
    for (int grp = gw; grp < NT / GT; grp += NGW) {
      TokIn cur; tok_load(grp * GT, cur);
      for (int ti = 0; ti < GT; ++ti) {
        const int row = grp * GT + ti;
        TokIn nxt; tok_load(ti + 1 < GT ? row + 1 : row, nxt);
        const bool isp = row < NP;
        const int srow = row - NP;
        const float* z = cur.z;
        float zm[14];
#pragma unroll
        for (int i = 0; i < 14; ++i) zm[i] = cur.z[i] + (cur.zp[i] - cur.z[i]) * mu[i];
        { const float e2 = __expf(2.f * zm[12]); td[ti * TST + lane] = (bf16)f2bf(1.f - 2.f / (e2 + 1.f)); } td[ti * TST + 64 + lane] = (bf16)f2bf(zm[13]);
#pragma unroll
        for (int hh = 0; hh < 4; ++hh) { const size_t o = (size_t)row * 256 + hh * 64 + lane; ws[W_R + o] = zm[hh]; ws[W_KF + o] = zm[4 + hh]; ws[W_VV + o] = zm[8 + hh]; }
        {
          const float rs = rsqrtf(wave_sum_fast((cur.cq[0] * cur.cq[0] + cur.cq[1] * cur.cq[1]) + (cur.cq[2] * cur.cq[2] + cur.cq[3] * cur.cq[3])) * (1.f / 256.f) + RMS_EPS);
#pragma unroll
          for (int i = 0; i < 4; ++i) wb[B_CQN + (size_t)row * 256 + lane + 64 * i] = (bf16)f2bf(cur.cq[i] * rs * qg[i]);
          const float rs2 = rsqrtf(wave_sum_fast(cur.ck0 * cur.ck0 + cur.ck1 * cur.ck1) * (1.f / 128.f) + RMS_EPS);
          const float c0 = cur.ck0 * rs2 * kg[0], c1 = cur.ck1 * rs2 * kg[1];
          float* o = ckv_out_row(p, row);
          o[lane] = c0; o[64 + lane] = c1;
          if (isp) { wb[B_CKVN + (size_t)row * 128 + lane] = (bf16)f2bf(c0); wb[B_CKVN + (size_t)row * 128 + 64 + lane] = (bf16)f2bf(c1); }
        }
        {
          const float y1 = cur.kr1 * cur.csv.x - cur.kr2 * cur.csv.y, y2 = cur.kr2 * cur.csv.x + cur.kr1 * cur.csv.y;
          if (lane < 16) { float* o = kpe_out_row(p, row); o[lane] = y1; o[16 + lane] = y2; }
          if (isp) {
            const bf16 b1 = (bf16)f2bf(y1), b2 = (bf16)f2bf(y2);
            const int j = lane & 15, hq = lane >> 4;
            wb[B_KP + (size_t)row * 768 + (2 * hq) * 96 + 64 + j] = b1; wb[B_KP + (size_t)row * 768 + (2 * hq) * 96 + 80 + j] = b2;
            wb[B_KP + (size_t)row * 768 + (2 * hq + 1) * 96 + 64 + j] = b1; wb[B_KP + (size_t)row * 768 + (2 * hq + 1) * 96 + 80 + j] = b2;
            const float XSC = X_SCALE * 1.4426950408889634f;
            *(uint2*)(wb + B_QX + (size_t)row * 256 + lane * 4) = make_uint2(pk2(cur.qx4.x * XSC, cur.qx4.y * XSC), pk2(cur.qx4.z * XSC, cur.qx4.w * XSC));
          }
        }
        if (isp) { if ((row & (SEQ - 1)) == SEQ - 1) { const int b = row / SEQ;
#pragma unroll
            for (int i = 0; i < 14; ++i) p.out[O_SHP + (size_t)b * 896 + lane + 64 * i] = z[i]; } }
        else { if ((srow & 7) == 7) { const int db = srow >> 3;
#pragma unroll
            for (int i = 0; i < 14; ++i) p.out[O_SHS + (size_t)db * 896 + lane + 64 * i] = z[i]; } }
        cur = nxt;
      }
      {
        typedef short bf16x8_t __attribute__((ext_vector_type(8)));
        typedef float f32x4_t __attribute__((ext_vector_type(4)));
        const int r16 = lane & 15, kq = lane >> 4;
        bf16x8_t at[2], aa_[2];
#pragma unroll
        for (int ks = 0; ks < 2; ++ks) { at[ks] = *(const bf16x8_t*)(td + r16 * TST + 32 * ks + 8 * kq); aa_[ks] = *(const bf16x8_t*)(td + r16 * TST + 64 + 32 * ks + 8 * kq); }
#pragma unroll 1
        for (int hh = 0; hh < 4; ++hh) {
          f32x4_t au[4], aA[4];
#pragma unroll
          for (int nt = 0; nt < 4; ++nt) {
            const int n = hh * 64 + nt * 16 + r16;
            au[nt] = (f32x4_t){0.f, 0.f, 0.f, 0.f}; aA[nt] = (f32x4_t){0.f, 0.f, 0.f, 0.f};
#pragma unroll
            for (int ks = 0; ks < 2; ++ks) {
              const bf16x8_t bw = *(const bf16x8_t*)(wl + n * WST + 32 * ks + 8 * kq), ba = *(const bf16x8_t*)(al + n * WST + 32 * ks + 8 * kq);
              au[nt] = __builtin_amdgcn_mfma_f32_16x16x32_bf16(at[ks], bw, au[nt], 0, 0, 0);
              aA[nt] = __builtin_amdgcn_mfma_f32_16x16x32_bf16(aa_[ks], ba, aA[nt], 0, 0, 0);
            }
          }
          float kkv[4][4], av[4][4], kraw[4][4], ssq[4] = {0.f, 0.f, 0.f, 0.f};
#pragma unroll
          for (int nt = 0; nt < 4; ++nt) {
            const int c = hh * 64 + nt * 16 + r16;
            const float w0c = p.w0[c], a0c = p.a0[c], kkc = p.k_k[c];
#pragma unroll
            for (int r = 0; r < 4; ++r) {
              const size_t o = (size_t)(grp * GT + (kq < 2 ? 4 * kq + r : 0)) * 256 + c;
              const float nu = -(w0c + au[nt][r]);
              const float sp = fmaxf(nu, 0.f) + __logf(1.f + __expf(-fabsf(nu)));
              if (kq < 2) ws[W_W + o] = __expf(-__expf(-sp - 0.5f));
              av[nt][r] = 1.f / (1.f + __expf(-(a0c + aA[nt][r])));
              kraw[nt][r] = ws[W_KF + o];
              kkv[nt][r] = kraw[nt][r] * kkc;
              ssq[r] += kkv[nt][r] * kkv[nt][r];
            }
          }
#pragma unroll
          for (int r = 0; r < 4; ++r) ssq[r] = 1.f / fmaxf(sqrtf(rw::dpp_sum16(ssq[r])), 1e-12f);
#pragma unroll
          for (int nt = 0; nt < 4; ++nt) {
            const int c = hh * 64 + nt * 16 + r16;
            const float kac = p.k_a[c];
#pragma unroll
            for (int r = 0; r < 4; ++r) {
              const size_t o = (size_t)(grp * GT + 4 * kq + r) * 256 + c;
              const float kk = kkv[nt][r] * ssq[r];
              if (kq < 2) { ws[W_KK + o] = kk; ws[W_BB + o] = kk * av[nt][r];
                ws[W_KF + o] = kraw[nt][r] * (1.f + (av[nt][r] - 1.f) * kac); }
            }
          }
        }
      }
    }
  }
  }
  grid.sync();
  PROF_STAMP(3);
  { PH_IDS

  {
    unsigned* dctr = (unsigned*)(p.ws + W_CTL) + 2;
    const unsigned nd = gridDim.x - NSCAN;
    if ((int)blockIdx.x >= NSCAN) {
      const float QSC = MLA_SCALE * 1.4426950408889634f;
      const int G = (int)gridDim.x - NSCAN, bx = (int)blockIdx.x - NSCAN;
      {
        pg8::Gemm g{wb + B_CQN, wb + B_WUQ, NT, 768, 256}; pg8::StaticOrder S; S.init(NT, 768, G, bx);
        pg8::EpiQ E{wb + B_QP, wb + B_QS, ws + W_CS, QSC, NP};
        pg8::gemm_phase<pg8::EpiQ, pg8::StaticOrder, true, true>((PG8_LAS unsigned char*)lds, g, S, E, wid_s);
      }
      {
        bf16* Qs = wb + B_QS;
        auto f = [=](int row, int col) -> bf16* { return Qs + ((size_t)row * 8 + (col >> 7)) * 160 + (col & 127); };
        pg8::Gemm g{wb + B_CQN + (size_t)NP * 256, wb + B_WQL, NS, 1024, 256}; pg8::StaticOrder S; S.init(NS, 1024, G, (bx + G - 204 % G) % G);
        pg8::EpiBf16F<decltype(f)> E{f, QSC};
        pg8::gemm_phase<pg8::EpiBf16F<decltype(f)>, pg8::StaticOrder, true, true>((PG8_LAS unsigned char*)lds, g, S, E, wid_s);
      }
      {
        bf16* Kp = wb + B_KP;
        auto f = [=](int row, int col) -> bf16* { return Kp + (size_t)row * 768 + (col >> 6) * 96 + (col & 63); };
        pg8::Gemm g{wb + B_CKVN, wb + B_WUK, NP, 512, 128}; pg8::StaticOrder S; S.init(NP, 512, G, (bx + G - 220 % G) % G);
        pg8::EpiBf16F<decltype(f)> E{f, 1.f};
        pg8::gemm_phase<pg8::EpiBf16F<decltype(f)>, pg8::StaticOrder, true, true>((PG8_LAS unsigned char*)lds, g, S, E, wid_s);
      }
      {
        bf16* Vt = wb + B_VT;
        auto f = [=](int row, int col) -> bf16* { return Vt + (size_t)row * NP + col; };
        pg8::Gemm g{wb + B_WUV, wb + B_CKVN, 512, NP, 128}; pg8::StaticOrder S; S.init(512, NP, G, (bx + G - 124 % G) % G);
        pg8::EpiBf16F<decltype(f)> E{f, 1.f};
        pg8::gemm_phase<pg8::EpiBf16F<decltype(f)>, pg8::StaticOrder, true, true>((PG8_LAS unsigned char*)lds, g, S, E, wid_s);
      }
      asm volatile("s_waitcnt vmcnt(0)" ::: "memory");
      __syncthreads();
      if (mk_tid(wid_s) == 0) { __builtin_amdgcn_fence(__ATOMIC_RELEASE, "agent"); asm volatile("s_waitcnt vmcnt(0)" ::: "memory"); __hip_atomic_fetch_add(dctr, 1u, __ATOMIC_RELAXED, __HIP_MEMORY_SCOPE_AGENT); }
    }
  }
  }
  { PH_IDS

  {
    unsigned* qctr = (unsigned*)(p.ws + W_CTL);
    volatile unsigned* qslot = (volatile unsigned*)(lds + LDS_BYTES - 16);
    constexpr int Q_RW = 32, Q_SA = 256, Q_PA = 512, Q_MA = 256, Q_RS = 512, Q_MS = 128, Q_TOT = Q_RW + Q_SA + Q_PA + Q_MA + Q_RS + Q_MS;
#if PROF_SEL >= 100 && PROF_SEL < 110
    int prof_prev_ = -1;
#endif
#if PROF_SEL >= 110 && PROF_SEL <= 116
    if (blockIdx.x == 0 && tid == 0) ((unsigned long long*)(p.ws + W_TS))[0] = __builtin_amdgcn_s_memrealtime();
#endif
    bool d_ready = false;
    for (;;) {
      if (tid == 0) *qslot = atomicAdd(qctr, 1u);
      __syncthreads();
      int item = (int)*qslot;
      __syncthreads();
      item = __builtin_amdgcn_readfirstlane(item);
#if PROF_SEL >= 100 && PROF_SEL < 110
      { constexpr int probe_items[8] = {0, 32, 34, 32 + 767, 32 + 765, 800, 1056, 1056 + 512};
        static unsigned long long* const dummy_ = nullptr; (void)dummy_;
        unsigned long long* ts_ = (unsigned long long*)(p.ws + W_TS);
        if (tid == 0 && item == probe_items[PROF_SEL - 100] + 1 + 100000) ts_[1] = 0;
        if (tid == 0) { if (prof_prev_ == probe_items[PROF_SEL - 100]) ts_[1] = __builtin_amdgcn_s_memrealtime(); if (item == probe_items[PROF_SEL - 100]) ts_[0] = __builtin_amdgcn_s_memrealtime(); }
        prof_prev_ = item; }
#endif
#if PROF_SEL >= 112 && PROF_SEL <= 116
      { constexpr int marks[5] = {Q_RW + Q_SA, Q_RW + Q_SA + 256, Q_RW + Q_SA + Q_PA, Q_RW + Q_SA + Q_PA + Q_MA, Q_RW + Q_SA + Q_PA + Q_MA + 64};
        if (tid == 0 && item == marks[PROF_SEL - 112]) ((unsigned long long*)(p.ws + W_TS))[1] = __builtin_amdgcn_s_memrealtime(); }
#endif
#if PROF_SEL == 110
      if (item >= Q_TOT && blockIdx.x == 0 && tid == 0) ((unsigned long long*)(p.ws + W_TS))[1] = __builtin_amdgcn_s_memrealtime();
#endif
#if PROF_SEL == 111
      if (item >= Q_TOT && tid == 0) { ((unsigned long long*)(p.ws + W_TS))[1] = __builtin_amdgcn_s_memrealtime(); }
#endif
      if (item >= Q_TOT) break;
      if (item < Q_RW) { rw::rwkv_prompt_item(lds, p, item, wid_s); continue; }
      if (!d_ready) {
        unsigned* dctr = (unsigned*)(p.ws + W_CTL) + 2; const unsigned nd = gridDim.x - NSCAN;
        if (tid == 0) { while (__hip_atomic_load(dctr, __ATOMIC_RELAXED, __HIP_MEMORY_SCOPE_AGENT) < nd) __builtin_amdgcn_s_sleep(8); }
        __syncthreads();
        __builtin_amdgcn_fence(__ATOMIC_ACQUIRE, "agent");
        d_ready = true;
      }
      item -= Q_RW;
      if (item < Q_SA + Q_PA) {
        const int grp = item / 3, sub3 = item - grp * 3;
        if (sub3 == 2) { sa::sample_attn_item(lds, p, wb + B_QS, ws + W_PO, ws + W_PML, grp, wid_s); continue; }
        item = grp * 2 + sub3;
        const int bh = item & 31, qb = 15 - (item >> 5);
        const int b = bh >> 3, h = bh & 7;
        const size_t row0 = (size_t)b * SEQ + 256 * qb;
        auto out = [&](int ql, int dv0, float4 v) {
          const size_t row = row0 + ql;
          const float4 g = pj4(wb + B_PROJ, row, C_GMLA + h * 64 + dv0);
          *(uint2*)(wb + B_MIX + row * 1024 + h * 64 + dv0) = make_uint2(pk2(v.x * silu(g.x), v.y * silu(g.y)), pk2(v.z * silu(g.z), v.w * silu(g.w)));
        };
        pa::attn_unit<96, true>(lds, wb + B_QP + row0 * 768 + h * 96, 768, wb + B_KP + (size_t)b * SEQ * 768 + h * 96, 768,
                                wb + B_VT + (size_t)(h * 64) * NP + (size_t)b * SEQ, NP, 4 * qb + 4, 256 * qb, out, wid_s);
        continue;
      }
      item -= Q_SA + Q_PA;
      if (item >= Q_MA) {
        item -= Q_MA;
        if (item < Q_RS) rw::rwkv_sample_item(lds, p, item, wid_s);
        else { ma::mem_sample_item(lds, p, item - Q_RS, wid_s); }
        continue;
      }
      {
        const int qb = item & 15, h = (item >> 4) & 3, b = item >> 6;
        const size_t row0 = (size_t)b * SEQ + 256 * qb;
        auto out = [&](int ql, int dv0, float4 v) {
          const size_t row = row0 + ql;
          const float4 g = pj4(wb + B_PROJ, row, C_GX + h * 64 + dv0);
          *(uint2*)(wb + B_MIX + row * 1024 + 768 + h * 64 + dv0) = make_uint2(pk2(v.x * silu(g.x), v.y * silu(g.y)), pk2(v.z * silu(g.z), v.w * silu(g.w)));
        };
        pa::attn_unit<64, false>(lds, wb + B_QX + row0 * 256 + h * 64, 256, wb + B_KM + (size_t)b * 65536 + h * 64, 256,
                                 wb + B_VMT + (size_t)b * 65536 + (size_t)(h * 64) * 256, 256, 4, 0, out, wid_s);
      }
    }
    __syncthreads();
  }
  }
  grid.sync();
  PROF_STAMP(4);
  { PH_IDS

  constexpr int NGB = 16;
  for (int it0 = (int)blockIdx.x >= NGB ? gw - NGB * 8 : NP * 2; it0 < NP * 2; it0 += NGW - NGB * 8) {
    float y[2], rr[2], kf_[2], vv_[2], g_[2]; size_t off[2]; int hh_[2]; size_t rowi[2];
#pragma unroll
    for (int u = 0; u < 2; ++u) {
      const int it = it0 * 2 + u; const int row = it >> 2, h = it & 3;
      rowi[u] = row; hh_[u] = h; off[u] = (size_t)row * 256 + h * 64 + lane;
      y[u] = ws[W_Y + off[u]]; rr[u] = ws[W_R + off[u]]; kf_[u] = ws[W_KF + off[u]]; vv_[u] = ws[W_VV + off[u]];
      g_[u] = pj(wb + B_PROJ, (size_t)row, C_GRWKV + h * 64 + lane);
    }
#pragma unroll
    for (int u = 0; u < 2; ++u) {
      const int h = hh_[u];
      const float mean = wave_sum_fast(y[u]) * (1.f / 64.f), d = y[u] - mean, var = wave_sum_fast(d * d) * (1.f / 64.f);
      const float yn = d * rsqrtf(var + GN_EPS) * p.lnx_g[h * 64 + lane] + p.lnx_b[h * 64 + lane];
      const float bsum = wave_sum_fast(rr[u] * kf_[u] * p.r_k[h * 64 + lane]);
      const float o = yn + bsum * vv_[u];
      wb[B_MIX + rowi[u] * 1024 + 512 + h * 64 + lane] = (bf16)f2bf(o * silu(g_[u]));
    }
  }
  {
    pg8::Gemm g{wb + B_MIX + (size_t)NP * 1024, wb + B_WOUT, NS, 1024, 1024}; pg8::StaticOrder S; S.init(NS, 1024, (int)gridDim.x, (int)blockIdx.x);
    pg8::EpiF32 E{p.out + O_YS, 1024, 1024, 0, 0, p.x_sample, p.x_sample, NS};
    pg8::gemm_phase<pg8::EpiF32, pg8::StaticOrder, true, true>((PG8_LAS unsigned char*)lds, g, S, E, wid_s);
  }
  }
  grid.sync();
  PROF_STAMP(5);
  { PH_IDS
  for (int r = NP + gw; r < NT; r += NGW) {
    float* y = p.out + (size_t)r * 1024;
    float v[16]; float ss = 0.f;
#pragma unroll
    for (int i = 0; i < 16; ++i) { v[i] = y[lane + 64 * i]; ss += v[i] * v[i]; }
    const float rs = rsqrtf(wave_sum_fast(ss) * (1.f / 1024.f) + RMS_EPS);
#pragma unroll
    for (int i = 0; i < 16; ++i) y[lane + 64 * i] = v[i] * rs * p.final_g[lane + 64 * i];
  }
  {
    pg8::Gemm g{wb + B_MIX, wb + B_WOUT, NP, 1024, 1024}; pg8::StaticOrder S; S.init(NP, 1024, (int)gridDim.x, (int)blockIdx.x);
    pg8::EpiRmsOut E{p.x_prompt, p.out, p.final_g, ws + W_XB, (unsigned*)(ws + W_CTL) + 192, RMS_EPS};
    pg8::gemm_phase<pg8::EpiRmsOut, pg8::StaticOrder, false, true>((PG8_LAS unsigned char*)lds, g, S, E, wid_s);
  }
#if PROF_SEL >= 0
  grid.sync();
  PROF_STAMP(6);
#endif
#if PROF_SEL >= 0
    if (blockIdx.x == 0 && tid == 0) {
      unsigned long long* ts_ = (unsigned long long*)(p.ws + W_TS);
      asm volatile("s_waitcnt vmcnt(0) lgkmcnt(0)" ::: "memory");
      __builtin_amdgcn_fence(__ATOMIC_ACQUIRE, "agent");
      const float us_ = (float)(ts_[1] - ts_[0]) * 0.01f;
      p.out[0] += us_ * 0.01f;
    }
#endif
  }
#undef PH_IDS
}

extern "C" void kernel_launch(void* const* d_in, const int* in_sizes, int n_in, void* d_out,
                              int out_size, void* d_ws, size_t ws_size, hipStream_t stream) {
  static int grid_blocks = 0;
  if (!grid_blocks) {
    int dev = 0, cus = 0, per_cu = 0;
    (void)hipGetDevice(&dev);
    (void)hipDeviceGetAttribute(&cus, hipDeviceAttributeMultiprocessorCount, dev);
    (void)hipFuncSetAttribute((const void*)fwd_megakernel, hipFuncAttributeMaxDynamicSharedMemorySize, LDS_BYTES);
    (void)hipOccupancyMaxActiveBlocksPerMultiprocessor(&per_cu, fwd_megakernel, 512, LDS_BYTES);
    if (per_cu < 1) per_cu = 1;
    grid_blocks = cus;
    if (ws_size < WS_BYTES) fprintf(stderr, "workspace too small: %zu < %zu\n", ws_size, (size_t)WS_BYTES);
  }
  Params p{};
  const float** pf = (const float**)&p;
  (void)pf;
  p.x_prompt = (const float*)d_in[0]; p.x_sample = (const float*)d_in[1]; p.mem_prompt = (const float*)d_in[2];
  p.cache_ckv = (const float*)d_in[3]; p.cache_kpe = (const float*)d_in[4]; p.page_table = (const int*)d_in[5];
  p.state_wkv = (const float*)d_in[6]; p.state_shift = (const float*)d_in[7]; p.cache_mem_k = (const float*)d_in[8];
  p.cache_mem_v = (const float*)d_in[9]; p.ln_g = (const float*)d_in[10]; p.w_in = (const float*)d_in[11];
  p.q_norm_g = (const float*)d_in[12]; p.kv_norm_g = (const float*)d_in[13]; p.w_uq = (const float*)d_in[14];
  p.w_uk = (const float*)d_in[15]; p.w_uv = (const float*)d_in[16]; p.shift_mu = (const float*)d_in[17];
  p.w0 = (const float*)d_in[18]; p.w_up = (const float*)d_in[19]; p.a0 = (const float*)d_in[20]; p.a_up = (const float*)d_in[21];
  p.k_k = (const float*)d_in[22]; p.k_a = (const float*)d_in[23]; p.r_k = (const float*)d_in[24]; p.lnx_g = (const float*)d_in[25];
  p.lnx_b = (const float*)d_in[26]; p.mem_norm_g = (const float*)d_in[27]; p.w_mem_kv = (const float*)d_in[28];
  p.w_out = (const float*)d_in[29]; p.final_g = (const float*)d_in[30];
  p.out = (float*)d_out; p.ws = (float*)d_ws;
  void* args[] = {&p};
  hipError_t e = hipLaunchCooperativeKernel((void*)fwd_megakernel, dim3(grid_blocks), dim3(512), args, LDS_BYTES, stream);
  if (e != hipSuccess) fprintf(stderr, "cooperative launch failed: %s (grid %d)\n", hipGetErrorString(e), grid_blocks);
}
```

```cpp
#include <hip/hip_runtime.h>
#ifndef PROF_SEL
#define PROF_SEL -1
#endif
#include <hip/hip_cooperative_groups.h>
#include <cstdio>
#include <cstdint>
namespace cg = cooperative_groups;

__device__ __forceinline__ int mk_tid(int wid_s) { int z; asm volatile("s_mov_b32 %0, 0" : "=s"(z)); return wid_s * 64 + (int)__builtin_amdgcn_mbcnt_hi(~0u, __builtin_amdgcn_mbcnt_lo(~0u, (unsigned)z)); }
namespace pg8 {
#define PG8_LAS __attribute__((address_space(3)))
typedef unsigned short bf16_t;
typedef short bf16x8 __attribute__((ext_vector_type(8)));
typedef float f32x4 __attribute__((ext_vector_type(4)));
typedef unsigned u32x4 __attribute__((ext_vector_type(4)));
constexpr int BM = 256, BK = 64, HALF = 128, HTB = HALF * BK * 2  , STAGE_BYTES = 8 * HTB, NXCD = 8, WGM = 8;

__host__ __device__ __forceinline__ int lds_byte(int r, int c) { const int st = (r >> 4) * 2 + (c >> 5), rr = r & 15, cc = c & 31, ob = rr * 64 + cc * 2; return st * 1024 + (ob ^ (((ob >> 9) & 1) << 5)); }
__host__ __device__ __forceinline__ void stage_rc(int b, int& R, int& C) { const int st = b / 1024, sb = b % 1024, swz = sb ^ (((sb >> 9) & 1) << 5); R = (st >> 1) * 16 + swz / 64; C = (st & 1) * 32 + (swz % 64) / 2; }
__host__ __device__ __forceinline__ int perm32(int rho) { const int n = rho >> 4, i = rho & 15; return 8 * (i >> 2) + 4 * n + (i & 3); }

struct Unit { int pm, pn; };
struct Gemm { const bf16_t* A; const bf16_t* Bt; int M, N, K; };

struct StaticOrder {
    int nM, nN, nwg, G, c;
    __host__ __device__ void init(int M, int N, int G_, int c_) { nM = M / BM; nN = N / BM; nwg = nM * nN; G = G_; c = c_; }
    __host__ __device__ bool next(int i, Unit& u) const {
        const long L = (long)i * G + c; if (L >= nwg) return false;
        int wgid = (int)L; { const int q = nwg / NXCD, r = nwg % NXCD, xcd = wgid % NXCD, off = wgid / NXCD; wgid = (xcd < r ? xcd * (q + 1) : r * (q + 1) + (xcd - r) * q) + off; }
        const int nig = WGM * nN, gid = wgid / nig, fm = gid * WGM, gsz = (nM - fm) < WGM ? (nM - fm) : WGM;
        u.pm = fm + ((wgid % nig) % gsz); u.pn = (wgid % nig) / gsz; return true;
    }
    __device__ __forceinline__ void a_ready(const Unit&) const {}
    __device__ __forceinline__ void done(const Unit&) const {}
};
__device__ __forceinline__ unsigned cvt_pk_bf16(float lo, float hi) { unsigned r; asm volatile("v_cvt_pk_bf16_f32 %0, %1, %2" : "=v"(r) : "v"(lo), "v"(hi)); return r; }
typedef float f32x2 __attribute__((ext_vector_type(2)));
template <class Epi, class Sched, bool ALIGN_EPI = false, bool SP2 = false>
__device__ __forceinline__ void gemm_phase(PG8_LAS unsigned char* lds, const Gemm g, const Sched& S, const Epi& E, int wid_s) {
    const int tid = mk_tid(wid_s), wid = wid_s, lane = tid & 63, wr = wid >> 2, wc = wid & 3, fr = lane & 15, fq = lane >> 4;
    const int K = g.K, nt = K / BK;
    unsigned voffA[2], voffB[2];
#pragma unroll
    for (int i = 0; i < 2; ++i) { int R, C; stage_rc(tid * 16 + i * 8192, R, C); const int Rb = Epi::PERM ? ((R & ~31) + perm32(R & 31)) : R;
        voffA[i] = (unsigned)(R * K + C) * 2u; voffB[i] = (unsigned)(Rb * K + C) * 2u; }
    const size_t kstep = (size_t)(BK * 2);
    const size_t hstep = (size_t)HALF * K * 2;
    const size_t tstep = 2 * hstep;
    const unsigned ldsw = (unsigned)wid * 1024u;
    const int aoff = lds_byte(wr * 64 + fr, fq * 8), boff = lds_byte(wc * 32 + fr, fq * 8);
#define PG8_SA(b, h) (((b) * 2 + (h)) * HTB)
#define PG8_SB(b, h) ((4 + (b) * 2 + (h)) * HTB)
#define PG8_STAGE(bufoff, gbase, voff) do { _Pragma("unroll") for (int _i = 0; _i < 2; ++_i) \
        __builtin_amdgcn_global_load_lds((const unsigned*)((const char*)(gbase) + (voff)[_i]), (PG8_LAS unsigned*)(lds + (bufoff) + ldsw + _i * 8192), 16, 0, 0); } while (0)
#define PG8_LDA(dst, b, h) do { _Pragma("unroll") for (int m = 0; m < 4; ++m) _Pragma("unroll") for (int k = 0; k < 2; ++k) dst[m][k] = *(const PG8_LAS bf16x8*)(lds + PG8_SA(b, h) + aoff + m * 2048 + k * 1024); } while (0)
#define PG8_LDB(dst, b, h) do { _Pragma("unroll") for (int n = 0; n < 2; ++n) _Pragma("unroll") for (int k = 0; k < 2; ++k) dst[n][k] = *(const PG8_LAS bf16x8*)(lds + PG8_SB(b, h) + boff + n * 2048 + k * 1024); } while (0)
#define PG8_MMA(ai, bj, At, Bt) do { __builtin_amdgcn_s_setprio(1); _Pragma("unroll") for (int m = 0; m < 4; ++m) _Pragma("unroll") for (int n = 0; n < 2; ++n) _Pragma("unroll") for (int k = 0; k < 2; ++k) \
        acc[ai][bj][m][n] = __builtin_amdgcn_mfma_f32_16x16x32_bf16(Bt[n][k], At[m][k], acc[ai][bj][m][n], 0, 0, 0); __builtin_amdgcn_s_setprio(0); } while (0)
#define PG8_WAIT_V(n) asm volatile("s_waitcnt vmcnt(" #n ")" ::: "memory")
#define PG8_WAIT_L(n) asm volatile("s_waitcnt lgkmcnt(" #n ")" ::: "memory")
#define PG8_BAR __builtin_amdgcn_s_barrier()
#define PG8_SCHED __builtin_amdgcn_sched_barrier(0)
    Unit cur, nxt; int ui = 0;
    if (!S.next(0, cur)) return;
    f32x4 acc[2][2][4][2];
#pragma unroll
    for (int a = 0; a < 2; ++a)
#pragma unroll
        for (int b = 0; b < 2; ++b)
#pragma unroll
            for (int m = 0; m < 4; ++m)
#pragma unroll
                for (int n = 0; n < 2; ++n) acc[a][b][m][n] = (f32x4){0.f, 0.f, 0.f, 0.f};
    bf16x8 At[4][2], B0[2][2], B1[2][2];
    const char* cA = (const char*)g.A + (size_t)cur.pm * tstep; const char* cB = (const char*)g.Bt + (size_t)cur.pn * tstep;
    S.a_ready(cur);
    if constexpr (SP2) {
        PG8_STAGE(PG8_SB(0, 0), cB, voffB); PG8_STAGE(PG8_SB(0, 1), cB + hstep, voffB); PG8_STAGE(PG8_SA(0, 0), cA, voffA); PG8_STAGE(PG8_SA(0, 1), cA + hstep, voffA);
        if (wr == 1) PG8_BAR;
        PG8_WAIT_V(2); PG8_BAR;
        PG8_STAGE(PG8_SB(1, 0), cB + kstep, voffB); PG8_STAGE(PG8_SA(1, 0), cA + kstep, voffA); PG8_STAGE(PG8_SB(1, 1), cB + hstep + kstep, voffB);
        PG8_WAIT_V(6); PG8_BAR;
    } else {
        PG8_STAGE(PG8_SB(0, 0), cB, voffB); PG8_STAGE(PG8_SA(0, 0), cA, voffA); PG8_STAGE(PG8_SB(0, 1), cB + hstep, voffB); PG8_STAGE(PG8_SA(0, 1), cA + hstep, voffA);
        if (wr == 1) PG8_BAR;
        PG8_WAIT_V(4); PG8_BAR;
        PG8_STAGE(PG8_SB(1, 0), cB + kstep, voffB); PG8_STAGE(PG8_SA(1, 0), cA + kstep, voffA); PG8_STAGE(PG8_SB(1, 1), cB + hstep + kstep, voffB);
        PG8_WAIT_V(6); PG8_BAR;
    }
    for (;;) {
        const bool has_next = S.next(ui + 1, nxt);
        const char* nA = has_next ? (const char*)g.A + (size_t)nxt.pm * tstep : cA; const char* nB = has_next ? (const char*)g.Bt + (size_t)nxt.pn * tstep : cB;
        for (int t = 0; t < nt; t += 2) {
            const bool last = (t == nt - 2);
            const char* a1 = cA + (size_t)(t + 1) * kstep;
            const char* a2 = last ? nA : cA + (size_t)(t + 2) * kstep; const char* b2 = last ? nB : cB + (size_t)(t + 2) * kstep;
            const char* a3 = a2 + kstep; const char* b3 = b2 + kstep;
            if (last && has_next) S.a_ready(nxt);
            if constexpr (SP2) {
            PG8_LDB(B0, 0, 0); PG8_LDB(B1, 0, 1); PG8_SCHED; PG8_LDA(At, 0, 0); PG8_STAGE(PG8_SA(1, 1), a1 + hstep, voffA);
            PG8_WAIT_V(8); PG8_WAIT_L(0); PG8_BAR; PG8_MMA(0, 0, At, B0); PG8_MMA(0, 1, At, B1); PG8_BAR; PG8_SCHED;
            PG8_LDA(At, 0, 1); PG8_STAGE(PG8_SB(0, 0), b2, voffB); PG8_STAGE(PG8_SB(0, 1), b2 + hstep, voffB); PG8_STAGE(PG8_SA(0, 0), a2, voffA);
            PG8_WAIT_V(8); PG8_WAIT_L(0); PG8_BAR; PG8_MMA(1, 0, At, B0); PG8_MMA(1, 1, At, B1); PG8_BAR; PG8_SCHED;
            PG8_LDB(B0, 1, 0); PG8_LDB(B1, 1, 1); PG8_SCHED; PG8_LDA(At, 1, 0); PG8_STAGE(PG8_SA(0, 1), a2 + hstep, voffA);
            PG8_WAIT_V(8); PG8_WAIT_L(0); PG8_BAR; PG8_MMA(0, 0, At, B0); PG8_MMA(0, 1, At, B1); PG8_BAR; PG8_SCHED;
            PG8_LDA(At, 1, 1); PG8_STAGE(PG8_SB(1, 0), b3, voffB); PG8_STAGE(PG8_SB(1, 1), b3 + hstep, voffB); PG8_STAGE(PG8_SA(1, 0), a3, voffA);
            PG8_WAIT_V(8); PG8_WAIT_L(0); PG8_BAR; PG8_MMA(1, 0, At, B0); PG8_MMA(1, 1, At, B1); PG8_BAR; PG8_SCHED;
            } else {
            PG8_LDB(B0, 0, 0); PG8_SCHED; PG8_LDA(At, 0, 0); PG8_STAGE(PG8_SA(1, 1), a1 + hstep, voffA);
            PG8_WAIT_L(8); PG8_BAR; PG8_WAIT_L(0); PG8_MMA(0, 0, At, B0); PG8_BAR; PG8_SCHED;
            PG8_LDB(B1, 0, 1); PG8_STAGE(PG8_SB(0, 0), b2, voffB);
            PG8_BAR; PG8_WAIT_L(0); PG8_MMA(0, 1, At, B1); PG8_BAR;
            PG8_LDA(At, 0, 1); PG8_STAGE(PG8_SA(0, 0), a2, voffA);
            PG8_BAR; PG8_WAIT_L(0); PG8_MMA(1, 0, At, B0); PG8_BAR; PG8_SCHED;
            PG8_STAGE(PG8_SB(0, 1), b2 + hstep, voffB);
            PG8_WAIT_V(6); PG8_BAR; PG8_MMA(1, 1, At, B1); PG8_BAR;
            PG8_LDB(B0, 1, 0); PG8_SCHED; PG8_LDA(At, 1, 0); PG8_STAGE(PG8_SA(0, 1), a2 + hstep, voffA);
            PG8_WAIT_L(8); PG8_BAR; PG8_WAIT_L(0); PG8_MMA(0, 0, At, B0); PG8_BAR; PG8_SCHED;
            PG8_LDB(B1, 1, 1); PG8_STAGE(PG8_SB(1, 0), b3, voffB);
            PG8_BAR; PG8_WAIT_L(0); PG8_MMA(0, 1, At, B1); PG8_BAR;
            PG8_LDA(At, 1, 1); PG8_STAGE(PG8_SA(1, 0), a3, voffA);
            PG8_BAR; PG8_WAIT_L(0); PG8_MMA(1, 0, At, B0); PG8_BAR; PG8_SCHED;
            PG8_STAGE(PG8_SB(1, 1), b3 + hstep, voffB);
            PG8_WAIT_V(6); PG8_BAR; PG8_MMA(1, 1, At, B1); PG8_BAR;
            }
        }
        if constexpr (ALIGN_EPI) { if (wr == 0) PG8_BAR; }
        if constexpr (!Epi::AFTER_DRAIN) { E(acc, cur, wr, wc, fr, fq); S.done(cur); }
        if (!has_next) break;
#pragma unroll
        for (int a = 0; a < 2; ++a)
#pragma unroll
            for (int b = 0; b < 2; ++b)
#pragma unroll
                for (int m = 0; m < 4; ++m)
#pragma unroll
                    for (int n = 0; n < 2; ++n) acc[a][b][m][n] = (f32x4){0.f, 0.f, 0.f, 0.f};
        cur = nxt; cA = nA; cB = nB; ++ui;
        if constexpr (ALIGN_EPI) { if (wr == 1) PG8_BAR; }
    }
    PG8_WAIT_V(0);
    if constexpr (!ALIGN_EPI) { if (wr == 0) PG8_BAR; }
    PG8_BAR;
    if constexpr (Epi::AFTER_DRAIN) { E.fused(acc, cur, wr, wc, fr, fq, lds, wid, lane); S.done(cur); }
#undef PG8_SA
#undef PG8_SB
#undef PG8_STAGE
#undef PG8_LDA
#undef PG8_LDB
#undef PG8_MMA
#undef PG8_WAIT_V
#undef PG8_WAIT_L
#undef PG8_BAR
#undef PG8_SCHED
}
}

namespace pg8 {
struct EpiF32 {
  static constexpr bool PERM = false, AFTER_DRAIN = false;
  float* C; int ldc; int ncols; int split_cols; size_t split_stride; const float* r0; const float* r1; int nr0;
  __device__ __forceinline__ void operator()(const f32x4 (&acc)[2][2][4][2], const Unit& u, int wr, int wc, int fr0, int fq0) const {
    int fr = fr0, fq = fq0; asm volatile("" : "+v"(fr), "+v"(fq));
    const int row0 = u.pm * BM + wr * 64 + fr; int colt = u.pn * BM; float* base = C;
    if (split_cols) { const int t = colt / split_cols; base += (size_t)t * split_stride; colt -= t * split_cols; }
    const int col0 = colt + wc * 32 + 4 * fq;
#pragma unroll
    for (int ai = 0; ai < 2; ++ai)
#pragma unroll
      for (int m = 0; m < 4; ++m) {
        const int row = row0 + ai * HALF + m * 16;
        const float* rr = r0 ? (row < nr0 ? r0 + (size_t)row * ldc : r1 + (size_t)(row - nr0) * ldc) : nullptr;
#pragma unroll
        for (int bj = 0; bj < 2; ++bj)
#pragma unroll
          for (int n = 0; n < 2; ++n) {
            const int col = col0 + bj * HALF + n * 16;
            if (col < ncols) { f32x4 v = acc[ai][bj][m][n]; if (rr) v += *(const f32x4*)(rr + col); *(f32x4*)(base + (size_t)row * ldc + col) = v; }
          }
        asm volatile("" ::: "memory");
      }
  }
};
}

constexpr int DM = 1024, BATCH = 4, SEQ = 4096, DB = 128, DT = 8, PAST = 8192, PAGE = 128, NPG = 64, NMEM = 256;
constexpr int NP = BATCH * SEQ, NS = DB * DT, NT = NP + NS;
constexpr int INC = 2592;
constexpr int C_CQ = 0, C_CKV = 256, C_KR = 384, C_GMLA = 416, C_Z = 928, C_GRWKV = 1824, C_QX = 2080, C_GX = 2336;
constexpr float MLA_SCALE = 0.10206207261596575f;
constexpr float X_SCALE = 0.125f;
constexpr float RMS_EPS = 1e-6f, GN_EPS = 64e-5f;
constexpr size_t O_YP = 0, O_YS = 16777216, O_CKVP = 17825792, O_KPEP = 19922944, O_WKVP = 20447232, O_SHP = 20512768,
                 O_MKP = 20516352, O_MVP = 20778496, O_CKVS = 21040640, O_KPES = 21171712, O_WKVS = 21204480, O_SHS = 23301632;
constexpr size_t W_H = 0;
constexpr size_t W_HM = W_H + (size_t)NT * 1024;
constexpr size_t W_PROJ = W_HM + (size_t)1024 * 1024;
constexpr size_t W_CQN = W_PROJ + (size_t)NT * INC;
constexpr size_t W_Q = W_CQN + (size_t)NT * 256;
constexpr size_t W_KN = W_Q + (size_t)NT * 768;
constexpr size_t W_V = W_KN + (size_t)NP * 512;
constexpr size_t W_QLAT = W_V + (size_t)NP * 512;
constexpr size_t W_OLAT = W_QLAT + (size_t)NS * 1024;
constexpr size_t W_R = W_OLAT + (size_t)NS * 1024;
constexpr size_t W_W = W_R + (size_t)NT * 256;
constexpr size_t W_KF = W_W + (size_t)NT * 256;
constexpr size_t W_VV = W_KF + (size_t)NT * 256;
constexpr size_t W_KK = W_VV + (size_t)NT * 256;
constexpr size_t W_BB = W_KK + (size_t)NT * 256;
constexpr size_t W_MIX = W_BB + (size_t)NT * 256;
constexpr size_t W_PO = W_MIX + (size_t)NT * 1024;
constexpr size_t W_PML = W_PO + (size_t)256 * 64 * 128;
constexpr size_t W_Y = W_PML + (size_t)256 * 64 * 2;
constexpr size_t W_CTL = W_Y + (size_t)NT * 256;
constexpr size_t W_CS = W_CTL + 256;
constexpr size_t W_XB = W_CS + (size_t)4104 * 32;
constexpr size_t W_TS = W_XB + (size_t)NP * 4;
constexpr size_t W_END = W_TS + 64;
constexpr int INCP = 2816;
constexpr size_t B_H = 0;
constexpr size_t B_HM = B_H + (size_t)NT * 1024;
constexpr size_t B_WIN = B_HM + (size_t)1024 * 1024;
constexpr size_t B_WMEM = B_WIN + (size_t)INCP * 1024;
constexpr size_t B_WOUT = B_WMEM + (size_t)512 * 1024;
constexpr size_t B_MIX = B_WOUT + (size_t)1024 * 1024;
constexpr size_t B_QP = B_MIX + (size_t)NT * 1024;
constexpr size_t B_KP = B_QP + (size_t)NP * 768;
constexpr size_t B_VT = B_KP + (size_t)NP * 768;
constexpr size_t B_QS = B_VT + (size_t)512 * NP;
constexpr size_t B_QX = B_QS + (size_t)NS * 8 * 160;
constexpr size_t B_KM = B_QX + (size_t)NP * 256;
constexpr size_t B_VMT = B_KM + (size_t)4 * 256 * 256;
constexpr size_t B_CQN = B_VMT + (size_t)4 * 256 * 256;
constexpr size_t B_CKVN = B_CQN + (size_t)NT * 256;
constexpr size_t B_WUQ = B_CKVN + (size_t)NP * 128;
constexpr size_t B_WQL = B_WUQ + (size_t)768 * 256;
constexpr size_t B_WUK = B_WQL + (size_t)1024 * 256;
constexpr size_t B_WUV = B_WUK + (size_t)512 * 128;
constexpr size_t B_OLAT = B_WUV + (size_t)512 * 128;
constexpr size_t B_WUVBD = B_OLAT + (size_t)NS * 1024;
constexpr size_t B_PROJ = B_WUVBD + (size_t)512 * 1024;
constexpr size_t B_END = B_PROJ + (size_t)NT * INC;
constexpr size_t WS_BYTES = W_END * 4 + B_END * 2;
constexpr int LDS_BYTES = 147456;
constexpr int NSCAN = 32;

struct Params {
  const float* x_prompt; const float* x_sample; const float* mem_prompt; const float* cache_ckv; const float* cache_kpe;
  const int* page_table; const float* state_wkv; const float* state_shift; const float* cache_mem_k; const float* cache_mem_v;
  const float* ln_g; const float* w_in; const float* q_norm_g; const float* kv_norm_g; const float* w_uq; const float* w_uk;
  const float* w_uv; const float* shift_mu; const float* w0; const float* w_up; const float* a0; const float* a_up;
  const float* k_k; const float* k_a; const float* r_k; const float* lnx_g; const float* lnx_b; const float* mem_norm_g;
  const float* w_mem_kv; const float* w_out; const float* final_g;
  float* out; float* ws;
};

__device__ __forceinline__ unsigned f2bf(float f);
__device__ __forceinline__ unsigned pk2(float lo, float hi);
typedef unsigned short bf16;

__device__ __forceinline__ float bf2f(unsigned short b) { return __uint_as_float((unsigned)b << 16); }
__device__ __forceinline__ float pj(const unsigned short* P, size_t row, int col) { return bf2f(P[row * INC + col]); }
__device__ __forceinline__ float4 pj4(const unsigned short* P, size_t row, int col) {
  const uint2 w = *(const uint2*)(P + row * INC + col);
  return make_float4(__uint_as_float(w.x << 16), __uint_as_float(w.x & 0xffff0000u), __uint_as_float(w.y << 16), __uint_as_float(w.y & 0xffff0000u));
}
__device__ __forceinline__ float wave_sum(float v) {
#pragma unroll
  for (int o = 1; o < 64; o <<= 1) v += __shfl_xor(v, o);
  return v;
}

__device__ __forceinline__ float wave_sum_fast(float v) {
  v += __int_as_float(__builtin_amdgcn_update_dpp(0, __float_as_int(v), 0xB1, 0xF, 0xF, true));
  v += __int_as_float(__builtin_amdgcn_update_dpp(0, __float_as_int(v), 0x4E, 0xF, 0xF, true));
  v += __int_as_float(__builtin_amdgcn_update_dpp(0, __float_as_int(v), 0x141, 0xF, 0xF, true));
  v += __int_as_float(__builtin_amdgcn_update_dpp(0, __float_as_int(v), 0x140, 0xF, 0xF, true));
  v += __int_as_float(__builtin_amdgcn_update_dpp(0, __float_as_int(v), 0x142, 0xA, 0xF, false));
  v += __int_as_float(__builtin_amdgcn_update_dpp(0, __float_as_int(v), 0x143, 0xC, 0xF, false));
  return __int_as_float(__builtin_amdgcn_readlane(__float_as_int(v), 63));
}
__device__ __forceinline__ float wave_max(float v) {
#pragma unroll
  for (int o = 1; o < 64; o <<= 1) v = fmaxf(v, __shfl_xor(v, o));
  return v;
}
__device__ __forceinline__ float silu(float x) { return x / (1.f + expf(-x)); }
__device__ __forceinline__ const float* xrow(const Params& p, int row) {
  return row < NP ? p.x_prompt + (size_t)row * DM : p.x_sample + (size_t)(row - NP) * DM;
}
__device__ __forceinline__ float* ckv_out_row(const Params& p, int row) {
  return row < NP ? p.out + O_CKVP + (size_t)row * 128 : p.out + O_CKVS + (size_t)(row - NP) * 128;
}
__device__ __forceinline__ float* kpe_out_row(const Params& p, int row) {
  return row < NP ? p.out + O_KPEP + (size_t)row * 32 : p.out + O_KPES + (size_t)(row - NP) * 32;
}


namespace pg8 {
typedef unsigned u32x2 __attribute__((ext_vector_type(2)));
template <class F> struct EpiBf16F {
  static constexpr bool PERM = true, AFTER_DRAIN = false;
  F f; float scale;
  __device__ __forceinline__ void operator()(const f32x4 (&acc)[2][2][4][2], const Unit& u, int wr, int wc, int fr, int fq) const {
    int fr_ = fr, fq_ = fq; asm volatile("" : "+v"(fr_), "+v"(fq_));
    const int row0 = u.pm * BM + wr * 64 + fr_, col0 = u.pn * BM + wc * 32 + 8 * fq_;
#pragma unroll
    for (int ai = 0; ai < 2; ++ai)
#pragma unroll
      for (int m = 0; m < 4; ++m)
#pragma unroll
        for (int bj = 0; bj < 2; ++bj) {
          bf16_t* dst = f(row0 + ai * HALF + m * 16, col0 + bj * HALF);
          if (dst) { const f32x4 v0 = acc[ai][bj][m][0] * scale, v1 = acc[ai][bj][m][1] * scale;
            u32x4 w; w.x = cvt_pk_bf16(v0[0], v0[1]); w.y = cvt_pk_bf16(v0[2], v0[3]); w.z = cvt_pk_bf16(v1[0], v1[1]); w.w = cvt_pk_bf16(v1[2], v1[3]);
            *(u32x4*)dst = w; }
        }
  }
};
struct EpiQ {
  static constexpr bool PERM = false, AFTER_DRAIN = false;
  bf16_t* Qp; bf16_t* Qs; const float* CS; float scale; int np;
  __device__ __forceinline__ void operator()(const f32x4 (&acc)[2][2][4][2], const Unit& u, int wr, int wc, int fr0, int fq0) const {
    int fr = fr0, fq = fq0; asm volatile("" : "+v"(fr), "+v"(fq));
    const int row0 = u.pm * BM + wr * 64 + fr;
    if (u.pn < 2) {
      if (u.pm * BM >= np) return;
#pragma unroll
      for (int ai = 0; ai < 2; ++ai)
#pragma unroll
        for (int m = 0; m < 4; ++m) {
          const int row = row0 + ai * HALF + m * 16;
#pragma unroll
          for (int bj = 0; bj < 2; ++bj)
#pragma unroll
            for (int n = 0; n < 2; ++n) {
              const int col = u.pn * BM + bj * HALF + wc * 32 + 16 * n + 4 * fq, head = col >> 6, d = col & 63;
              const f32x4 v = acc[ai][bj][m][n] * scale;
              *(u32x2*)(Qp + (size_t)row * 768 + head * 96 + d) = (u32x2){cvt_pk_bf16(v[0], v[1]), cvt_pk_bf16(v[2], v[3])};
            }
        }
    } else {
#pragma unroll
      for (int ai = 0; ai < 2; ++ai)
#pragma unroll
        for (int m = 0; m < 4; ++m) {
          const int row = row0 + ai * HALF + m * 16;
          const bool pr = row < np;
          const int pi = pr ? (row & 4095) : 4096 + ((row - np) & 7);
#pragma unroll
          for (int n = 0; n < 2; ++n) {
            const int head = 2 * wc + n, j = 4 * fq;
            const f32x4 cs0 = *(const f32x4*)(CS + ((size_t)pi * 16 + j) * 2), cs1 = *(const f32x4*)(CS + ((size_t)pi * 16 + j) * 2 + 4);
            const f32x4 x1 = acc[ai][0][m][n], x2 = acc[ai][1][m][n];
            f32x4 y1, y2;
            y1[0] = x1[0] * cs0[0] - x2[0] * cs0[1]; y2[0] = x2[0] * cs0[0] + x1[0] * cs0[1];
            y1[1] = x1[1] * cs0[2] - x2[1] * cs0[3]; y2[1] = x2[1] * cs0[2] + x1[1] * cs0[3];
            y1[2] = x1[2] * cs1[0] - x2[2] * cs1[1]; y2[2] = x2[2] * cs1[0] + x1[2] * cs1[1];
            y1[3] = x1[3] * cs1[2] - x2[3] * cs1[3]; y2[3] = x2[3] * cs1[2] + x1[3] * cs1[3];
            y1 = y1 * scale; y2 = y2 * scale;
            bf16_t* dst = pr ? Qp + (size_t)row * 768 + head * 96 + 64 + j : Qs + ((size_t)(row - np) * 8 + head) * 160 + 128 + j;
            *(u32x2*)dst = (u32x2){cvt_pk_bf16(y1[0], y1[1]), cvt_pk_bf16(y1[2], y1[3])};
            *(u32x2*)(dst + 16) = (u32x2){cvt_pk_bf16(y2[0], y2[1]), cvt_pk_bf16(y2[2], y2[3])};
          }
          asm volatile("" ::: "memory");
        }
    }
  }
};
}

namespace pg8 {
struct EpiGateBf16 {
  static constexpr bool PERM = true, AFTER_DRAIN = false;
  bf16_t* O; int ldo; const float* G; int ldg;
  __device__ __forceinline__ float sl(float x) const { return x / (1.f + __expf(-x)); }
  __device__ __forceinline__ void operator()(const f32x4 (&acc)[2][2][4][2], const Unit& u, int wr, int wc, int fr0, int fq0) const {
    int fr = fr0, fq = fq0; asm volatile("" : "+v"(fr), "+v"(fq));
    const int row0 = u.pm * BM + wr * 64 + fr, col0 = u.pn * BM + wc * 32 + 8 * fq;
#pragma unroll
    for (int ai = 0; ai < 2; ++ai)
#pragma unroll
      for (int m = 0; m < 4; ++m)
#pragma unroll
        for (int bj = 0; bj < 2; ++bj) {
          const int row = row0 + ai * HALF + m * 16, col = col0 + bj * HALF;
          const f32x4 g0 = *(const f32x4*)(G + (size_t)row * ldg + col), g1 = *(const f32x4*)(G + (size_t)row * ldg + col + 4);
          const f32x4 v0 = acc[ai][bj][m][0], v1 = acc[ai][bj][m][1];
          u32x4 w; w.x = cvt_pk_bf16(v0[0] * sl(g0[0]), v0[1] * sl(g0[1])); w.y = cvt_pk_bf16(v0[2] * sl(g0[2]), v0[3] * sl(g0[3]));
          w.z = cvt_pk_bf16(v1[0] * sl(g1[0]), v1[1] * sl(g1[1])); w.w = cvt_pk_bf16(v1[2] * sl(g1[2]), v1[3] * sl(g1[3]));
          *(u32x4*)(O + (size_t)row * ldo + col) = w;
          asm volatile("" ::: "memory");
        }
  }
};
}

namespace pg8 {
struct EpiRmsOut {
  static constexpr bool PERM = false, AFTER_DRAIN = true;
  const float* x; float* out; const float* gain; float* xbuf; unsigned* cnt; float eps;
  __device__ __forceinline__ void fused(f32x4 (&acc)[2][2][4][2], const Unit& u, int wr, int wc, int fr0, int fq0, PG8_LAS unsigned char* lds, int wid, int lane) const {
    int fr = fr0, fq = fq0; asm volatile("" : "+v"(fr), "+v"(fq));
    PG8_LAS float* P = (PG8_LAS float*)lds;
    PG8_LAS float* S = (PG8_LAS float*)(lds + 4096);
    const int col0 = u.pn * BM + wc * 32 + 4 * fq;
#pragma unroll
    for (int ai = 0; ai < 2; ++ai)
#pragma unroll
      for (int m = 0; m < 4; ++m) {
        const int rl = ai * HALF + wr * 64 + m * 16 + fr;
        const float* xr = x + (size_t)(u.pm * BM + rl) * 1024;
        float s = 0.f;
#pragma unroll
        for (int bj = 0; bj < 2; ++bj)
#pragma unroll
          for (int n = 0; n < 2; ++n) {
            const f32x4 v = acc[ai][bj][m][n] + *(const f32x4*)(xr + col0 + bj * HALF + n * 16);
            acc[ai][bj][m][n] = v; s += (v[0] * v[0] + v[1] * v[1]) + (v[2] * v[2] + v[3] * v[3]);
          }
        s += __shfl_xor(s, 16); s += __shfl_xor(s, 32);
        if (fq == 0) P[rl * 4 + wc] = s;
        asm volatile("" ::: "memory");
      }
    asm volatile("s_waitcnt lgkmcnt(0)" ::: "memory"); __builtin_amdgcn_s_barrier(); asm volatile("" ::: "memory");
    const int tid = wid * 64 + lane;
    if (tid < 256) {
      const float tot = (P[tid * 4] + P[tid * 4 + 1]) + (P[tid * 4 + 2] + P[tid * 4 + 3]);
      __hip_atomic_store((unsigned*)xbuf + ((size_t)(u.pm * BM + tid)) * 4 + u.pn, __float_as_uint(tot), __ATOMIC_RELAXED, __HIP_MEMORY_SCOPE_AGENT);
    }
    asm volatile("s_waitcnt vmcnt(0)" ::: "memory");
    if (tid < 256 && lane == 0) __hip_atomic_fetch_add(cnt + u.pm, 1u, __ATOMIC_RELAXED, __HIP_MEMORY_SCOPE_AGENT);
    if (wid == 0) {
      for (;;) {
        const unsigned c_ = (unsigned)__builtin_amdgcn_readfirstlane((int)__hip_atomic_load(cnt + u.pm, __ATOMIC_RELAXED, __HIP_MEMORY_SCOPE_AGENT));
        if (c_ >= 16u) break;
        __builtin_amdgcn_s_sleep(2);
      }
      __builtin_amdgcn_fence(__ATOMIC_ACQUIRE, "agent");
    }
    asm volatile("s_waitcnt vmcnt(0) lgkmcnt(0)" ::: "memory"); __builtin_amdgcn_s_barrier(); asm volatile("" ::: "memory");
    if (tid < 256) {
      unsigned* xb = (unsigned*)xbuf + ((size_t)(u.pm * BM + tid)) * 4;
      const float ssq = (__uint_as_float(__hip_atomic_load(xb, __ATOMIC_RELAXED, __HIP_MEMORY_SCOPE_AGENT)) + __uint_as_float(__hip_atomic_load(xb + 1, __ATOMIC_RELAXED, __HIP_MEMORY_SCOPE_AGENT))) +
                        (__uint_as_float(__hip_atomic_load(xb + 2, __ATOMIC_RELAXED, __HIP_MEMORY_SCOPE_AGENT)) + __uint_as_float(__hip_atomic_load(xb + 3, __ATOMIC_RELAXED, __HIP_MEMORY_SCOPE_AGENT)));
      S[tid] = 1.0f / sqrtf(ssq * (1.f / 1024.f) + eps);
    }
    asm volatile("s_waitcnt lgkmcnt(0)" ::: "memory"); __builtin_amdgcn_s_barrier(); asm volatile("" ::: "memory");
#pragma unroll
    for (int ai = 0; ai < 2; ++ai)
#pragma unroll
      for (int m = 0; m < 4; ++m) {
        const int rl = ai * HALF + wr * 64 + m * 16 + fr;
        const float rs = S[rl];
        float* orow = out + (size_t)(u.pm * BM + rl) * 1024;
#pragma unroll
        for (int bj = 0; bj < 2; ++bj)
#pragma unroll
          for (int n = 0; n < 2; ++n) {
            const int col = col0 + bj * HALF + n * 16;
            *(f32x4*)(orow + col) = acc[ai][bj][m][n] * rs * *(const f32x4*)(gain + col);
          }
        asm volatile("" ::: "memory");
      }
  }
};
}
#define LAS __attribute__((address_space(3)))
namespace pa {
typedef short bf16x8 __attribute__((ext_vector_type(8)));
typedef short s16x4 __attribute__((ext_vector_type(4)));
typedef float f32x16 __attribute__((ext_vector_type(16)));
typedef unsigned u32x4 __attribute__((ext_vector_type(4)));
typedef unsigned u32x2 __attribute__((ext_vector_type(2)));
typedef float f32x2_t __attribute__((ext_vector_type(2)));
typedef __bf16 bf16x2_t __attribute__((ext_vector_type(2)));
constexpr int KSTR = 208, VSTR = 136, KBYTES = 64 * KSTR, VBYTES = 64 * VSTR, STG = KBYTES + VBYTES;
__device__ __forceinline__ unsigned cvtpk(float lo, float hi) { f32x2_t v = {lo, hi}; bf16x2_t b = __builtin_convertvector(v, bf16x2_t); return __builtin_bit_cast(unsigned, b); }
__device__ __forceinline__ int crow(int r, int hi) { return (r & 3) + 8 * (r >> 2) + 4 * hi; }
__device__ __forceinline__ float swap_max(float v) { auto rr = __builtin_amdgcn_permlane32_swap(__float_as_uint(v), __float_as_uint(v), false, false); return fmaxf(__uint_as_float(rr[0]), __uint_as_float(rr[1])); }
__device__ __forceinline__ float swap_sum(float v) { auto rr = __builtin_amdgcn_permlane32_swap(__float_as_uint(v), __float_as_uint(v), false, false); return __uint_as_float(rr[0]) + __uint_as_float(rr[1]); }

template <int DQK, bool CAUSAL, class Out>
__device__ __forceinline__ void attn_unit(unsigned char* lds, const bf16* Qb, int qs, const bf16* Kb, int ks, const bf16* Vb, int vs, int ntiles, int qpos0, const Out& out, int wid_s) {
  const int tid = mk_tid(wid_s), lane = tid & 63, wid = wid_s, r32 = lane & 31, hi = lane >> 5;
  constexpr int CPR = DQK / 8, NKC = 64 * CPR, KS = DQK / 16;
  bf16x8 qf[KS];
#pragma unroll
  for (int s = 0; s < KS; ++s) qf[s] = *(const bf16x8*)(Qb + (size_t)(wid * 32 + r32) * qs + 16 * s + 8 * hi);
  struct Stg { u32x4 k0, k1, v; } sA, sB;
  const int kc0 = tid, kc1 = tid + 512;
  const int krow0 = kc0 / CPR, kcc0 = kc0 % CPR, krow1 = kc1 / CPR, kcc1 = kc1 % CPR;
  const int vdv = tid >> 3, vcc = tid & 7;
#define PA_GLOAD(S, t) do { (S).k0 = *(const u32x4*)(Kb + (size_t)(64 * (t) + krow0) * ks + kcc0 * 8); \
    if (kc1 < NKC) (S).k1 = *(const u32x4*)(Kb + (size_t)(64 * (t) + krow1) * ks + kcc1 * 8); \
    (S).v = *(const u32x4*)(Vb + (size_t)vdv * vs + 64 * (t) + vcc * 8); } while (0)
#define PA_LSTORE(S, buf) do { unsigned char* b_ = lds + (buf) * STG; *(u32x4*)(b_ + krow0 * KSTR + kcc0 * 16) = (S).k0; \
    if (kc1 < NKC) *(u32x4*)(b_ + krow1 * KSTR + kcc1 * 16) = (S).k1; \
    *(u32x2*)(b_ + KBYTES + vdv * VSTR + vcc * 16) = (u32x2){(S).v.x, (S).v.y}; *(u32x2*)(b_ + KBYTES + vdv * VSTR + vcc * 16 + 8) = (u32x2){(S).v.z, (S).v.w}; } while (0)
  PA_GLOAD(sA, 0); PA_LSTORE(sA, 0); if (ntiles > 1) PA_GLOAD(sB, 1); __syncthreads();
  f32x16 o0, o1;
#pragma unroll
  for (int r = 0; r < 16; ++r) { o0[r] = 0.f; o1[r] = 0.f; }
  float m = -1e30f, l = 0.f;
  const int qlo = qpos0 + 32 * wid;
  auto compute_tile = [&](int t) {
    const unsigned char* kb = lds + (t & 1) * STG; const unsigned char* vb = kb + KBYTES;
    const bool active = !CAUSAL || (64 * t <= qlo + 31);
    if (active) {
      f32x16 p0, p1;
#pragma unroll
      for (int r = 0; r < 16; ++r) { p0[r] = 0.f; p1[r] = 0.f; }
#pragma unroll
      for (int s = 0; s < KS; ++s) {
        const bf16x8 a0 = *(const bf16x8*)(kb + r32 * KSTR + (16 * s + 8 * hi) * 2);
        const bf16x8 a1 = *(const bf16x8*)(kb + (32 + r32) * KSTR + (16 * s + 8 * hi) * 2);
        p0 = __builtin_amdgcn_mfma_f32_32x32x16_bf16(a0, qf[s], p0, 0, 0, 0);
        p1 = __builtin_amdgcn_mfma_f32_32x32x16_bf16(a1, qf[s], p1, 0, 0, 0);
      }
      if (CAUSAL && (64 * t + 63 > qlo)) {
        const int q = qlo + r32;
#pragma unroll
        for (int r = 0; r < 16; ++r) { const int key = 64 * t + crow(r, hi); if (key > q) p0[r] = -1e30f; if (key + 32 > q) p1[r] = -1e30f; }
      }
      float mx = fmaxf(p0[0], p1[0]);
#pragma unroll
      for (int r = 1; r < 16; ++r) mx = fmaxf(mx, fmaxf(p0[r], p1[r]));
      mx = swap_max(mx);
      const float mn = fmaxf(m, mx), alpha = __builtin_amdgcn_exp2f(m - mn);
      m = mn;
      float ps = 0.f;
#pragma unroll
      for (int r = 0; r < 16; ++r) { p0[r] = __builtin_amdgcn_exp2f(p0[r] - mn); p1[r] = __builtin_amdgcn_exp2f(p1[r] - mn); ps += p0[r] + p1[r]; }
      l = l * alpha + ps;
#pragma unroll
      for (int r = 0; r < 16; ++r) { o0[r] *= alpha; o1[r] *= alpha; }
      bf16x8 pb[4];
#pragma unroll
      for (int k = 0; k < 4; ++k) {
        u32x4 w;
        if (k < 2) { w.x = cvtpk(p0[8 * k], p0[8 * k + 1]); w.y = cvtpk(p0[8 * k + 2], p0[8 * k + 3]); w.z = cvtpk(p0[8 * k + 4], p0[8 * k + 5]); w.w = cvtpk(p0[8 * k + 6], p0[8 * k + 7]); }
        else { const int kk = k - 2; w.x = cvtpk(p1[8 * kk], p1[8 * kk + 1]); w.y = cvtpk(p1[8 * kk + 2], p1[8 * kk + 3]); w.z = cvtpk(p1[8 * kk + 4], p1[8 * kk + 5]); w.w = cvtpk(p1[8 * kk + 6], p1[8 * kk + 7]); }
        pb[k] = __builtin_bit_cast(bf16x8, w);
      }
#pragma unroll
      for (int k = 0; k < 4; ++k) {
#pragma unroll
        for (int d = 0; d < 2; ++d) {
          const unsigned char* vp = vb + (32 * d + r32) * VSTR + (16 * k + 4 * hi) * 2;
          const u32x2 lo = *(const u32x2*)vp, hi2 = *(const u32x2*)(vp + 16);
          const u32x4 w = {lo.x, lo.y, hi2.x, hi2.y};
          const bf16x8 va = __builtin_bit_cast(bf16x8, w);
          if (d == 0) o0 = __builtin_amdgcn_mfma_f32_32x32x16_bf16(va, pb[k], o0, 0, 0, 0);
          else o1 = __builtin_amdgcn_mfma_f32_32x32x16_bf16(va, pb[k], o1, 0, 0, 0);
        }
      }
    }
  };
  for (int t = 0; t < ntiles; t += 2) {
    if (t + 2 < ntiles) PA_GLOAD(sA, t + 2);
    compute_tile(t);
    if (t + 1 < ntiles) PA_LSTORE(sB, (t + 1) & 1);
    __syncthreads();
    if (t + 1 < ntiles) {
      if (t + 3 < ntiles) PA_GLOAD(sB, t + 3);
      compute_tile(t + 1);
      if (t + 2 < ntiles) PA_LSTORE(sA, t & 1);
      __syncthreads();
    }
  }
#undef PA_GLOAD
#undef PA_LSTORE
  const float inv = 1.f / swap_sum(l);
#pragma unroll
  for (int g = 0; g < 4; ++g) {
    out(32 * wid + r32, 8 * g + 4 * hi, make_float4(o0[4 * g] * inv, o0[4 * g + 1] * inv, o0[4 * g + 2] * inv, o0[4 * g + 3] * inv));
    out(32 * wid + r32, 32 + 8 * g + 4 * hi, make_float4(o1[4 * g] * inv, o1[4 * g + 1] * inv, o1[4 * g + 2] * inv, o1[4 * g + 3] * inv));
  }
}
}

namespace sa {
using pa::bf16x8; using pa::f32x16; using pa::u32x4; using pa::u32x2; using pa::cvtpk; using pa::crow; using pa::swap_max; using pa::swap_sum;
typedef float f32x4 __attribute__((ext_vector_type(4)));
typedef short v4i16_t __attribute__((ext_vector_type(4)));
constexpr int KVSTR = 336, TK = 128, TILE = TK * KVSTR;
__device__ __forceinline__ void sample_attn_item(unsigned char* lds, const Params& p, const bf16* Qs, float* PO, float* PML, int item, int wid_s) {
  const int db = item >> 1, half = item & 1;
  const int tid = mk_tid(wid_s), lane = tid & 63, wid = wid_s, r32 = lane & 31, hi = lane >> 5;
  const int qt = wid >> 2, ks = wid & 3;
  bf16x8 qf[10];
#pragma unroll
  for (int s = 0; s < 10; ++s) qf[s] = *(const bf16x8*)(Qs + (size_t)(db * 64 + 32 * qt + r32) * 160 + 16 * s + 8 * hi);
  const int ntiles = 32 + half;
  f32x4 stA[8], spA[2], stB[8], spB[2];
  const f32x4 zero4 = {0.f, 0.f, 0.f, 0.f};
#define SA_GLOAD(st, sp, t) do { if ((t) < 32) { const int page_ = p.page_table[db * NPG + 32 * half + (t)]; \
      const f32x4* ck_ = (const f32x4*)(p.cache_ckv + (size_t)page_ * PAGE * 128); const f32x4* kp_ = (const f32x4*)(p.cache_kpe + (size_t)page_ * PAGE * 32); \
      _Pragma("unroll") for (int i_ = 0; i_ < 8; ++i_) st[i_] = __builtin_nontemporal_load(ck_ + tid + 512 * i_); \
      sp[0] = __builtin_nontemporal_load(kp_ + tid); sp[1] = __builtin_nontemporal_load(kp_ + tid + 512); \
    } else { const float* ck_ = p.out + O_CKVS + (size_t)db * 8 * 128; const float* kp_ = p.out + O_KPES + (size_t)db * 8 * 32; \
      st[0] = (tid < 256) ? *(const f32x4*)(ck_ + (size_t)tid * 4) : zero4; \
      _Pragma("unroll") for (int i_ = 1; i_ < 8; ++i_) st[i_] = zero4; \
      sp[0] = (tid < 64) ? *(const f32x4*)(kp_ + (size_t)tid * 4) : zero4; sp[1] = zero4; } } while (0)
#define SA_LSTORE(st, sp, buf) do { _Pragma("unroll") for (int i_ = 0; i_ < 8; ++i_) { const int f_ = tid + 512 * i_, key_ = f_ >> 5, c4_ = f_ & 31; \
      *(u32x2*)(lds + (buf) * TILE + key_ * KVSTR + c4_ * 8) = (u32x2){cvtpk(st[i_].x, st[i_].y), cvtpk(st[i_].z, st[i_].w)}; } \
    _Pragma("unroll") for (int i_ = 0; i_ < 2; ++i_) { const int f_ = tid + 512 * i_, key_ = f_ >> 3, c4_ = f_ & 7; \
      *(u32x2*)(lds + (buf) * TILE + key_ * KVSTR + 256 + c4_ * 8) = (u32x2){cvtpk(sp[i_].x, sp[i_].y), cvtpk(sp[i_].z, sp[i_].w)}; } } while (0)
#if PROF_SEL == 120 || PROF_SEL == 121 || PROF_SEL == 122
  if (item == 0 && tid == 0 && PROF_SEL != 121) ((unsigned long long*)(p.ws + W_TS))[0] = __builtin_amdgcn_s_memrealtime();
#endif
  SA_GLOAD(stA, spA, 0); SA_LSTORE(stA, spA, 0); SA_GLOAD(stB, spB, 1); __syncthreads();
  f32x16 o[4];
#pragma unroll
  for (int c = 0; c < 4; ++c)
#pragma unroll
    for (int r = 0; r < 16; ++r) o[c][r] = 0.f;
  float m = -1e30f, l = 0.f;
  const int tq = (32 * qt + r32) >> 3;
  auto compute_tile = [&](int t) {
    const unsigned char* kb = lds + (t & 1) * TILE + (32 * ks) * KVSTR;
    if (t < 32 || ks == 0) {
      f32x16 p0;
#pragma unroll
      for (int r = 0; r < 16; ++r) p0[r] = 0.f;
#pragma unroll
      for (int s = 0; s < 10; ++s) {
        const bf16x8 a0 = *(const bf16x8*)(kb + r32 * KVSTR + (16 * s + 8 * hi) * 2);
        p0 = __builtin_amdgcn_mfma_f32_32x32x16_bf16(a0, qf[s], p0, 0, 0, 0);
      }
      if (t == 32) {
#pragma unroll
        for (int r = 0; r < 16; ++r) { const int u = crow(r, hi); if (!(u < 8 && u <= tq)) p0[r] = -1e30f; }
      }
      float mx = p0[0];
#pragma unroll
      for (int r = 1; r < 16; ++r) mx = fmaxf(mx, p0[r]);
      mx = swap_max(mx);
      const float mn = fmaxf(m, mx), alpha = __builtin_amdgcn_exp2f(m - mn);
      m = mn;
      float ps = 0.f;
#pragma unroll
      for (int r = 0; r < 16; ++r) { p0[r] = __builtin_amdgcn_exp2f(p0[r] - mn); ps += p0[r]; }
      l = l * alpha + ps;
#pragma unroll
      for (int c = 0; c < 4; ++c)
#pragma unroll
        for (int r = 0; r < 16; ++r) o[c][r] *= alpha;
      bf16x8 pb[2];
#pragma unroll
      for (int k = 0; k < 2; ++k) {
        u32x4 w; w.x = cvtpk(p0[8 * k], p0[8 * k + 1]); w.y = cvtpk(p0[8 * k + 2], p0[8 * k + 3]); w.z = cvtpk(p0[8 * k + 4], p0[8 * k + 5]); w.w = cvtpk(p0[8 * k + 6], p0[8 * k + 7]);
        pb[k] = __builtin_bit_cast(bf16x8, w);
      }
      const int g = lane >> 4, i = lane & 15;
      const LAS unsigned char* vbase = (const LAS unsigned char*)kb + (4 * (g >> 1) + (i >> 2)) * KVSTR + (16 * (g & 1) + 4 * (i & 3)) * 2;
#pragma unroll
      for (int k = 0; k < 2; ++k) {
#pragma unroll
        for (int c = 0; c < 4; ++c) {
          const v4i16_t lo = __builtin_amdgcn_ds_read_tr16_b64_v4i16((LAS v4i16_t*)(vbase + (16 * k) * KVSTR + 64 * c));
          const v4i16_t hi4 = __builtin_amdgcn_ds_read_tr16_b64_v4i16((LAS v4i16_t*)(vbase + (16 * k + 8) * KVSTR + 64 * c));
          const bf16x8 va = {lo[0], lo[1], lo[2], lo[3], hi4[0], hi4[1], hi4[2], hi4[3]};
          o[c] = __builtin_amdgcn_mfma_f32_32x32x16_bf16(va, pb[k], o[c], 0, 0, 0);
        }
      }
    }
  };
  for (int t = 0; t < ntiles; t += 2) {
    if (t + 2 < ntiles) SA_GLOAD(stA, spA, t + 2);
    compute_tile(t);
    if (t + 1 < ntiles) SA_LSTORE(stB, spB, (t + 1) & 1);
    __syncthreads();
    if (t + 1 < ntiles) {
      if (t + 3 < ntiles) SA_GLOAD(stB, spB, t + 3);
      compute_tile(t + 1);
      if (t + 2 < ntiles) SA_LSTORE(stA, spA, t & 1);
      __syncthreads();
    }
  }
#undef SA_GLOAD
#undef SA_LSTORE
#if PROF_SEL == 120 || PROF_SEL == 121
  if (item == 0 && tid == 0) ((unsigned long long*)(p.ws + W_TS))[PROF_SEL == 120 ? 1 : 0] = __builtin_amdgcn_s_memrealtime();
#endif
  {
    float* X = (float*)lds;
#pragma unroll
    for (int round = 0; round < 2; ++round) {
      const bool writer = round == 0 ? (ks >= 2) : (ks == 1);
      const bool reader = round == 0 ? (ks < 2) : (ks == 0);
      const int slot = round == 0 ? (qt * 2 + (ks & 1)) : qt;
      float* xs = X + (size_t)slot * (66 * 64);
      if (writer) {
        xs[lane] = m; xs[64 + lane] = l;
#pragma unroll
        for (int c = 0; c < 4; ++c)
#pragma unroll
          for (int r = 0; r < 16; ++r) xs[(2 + c * 16 + r) * 64 + lane] = o[c][r];
      }
      __syncthreads();
      if (reader) {
        const float m2 = xs[lane], l2 = xs[64 + lane];
        const float mn = fmaxf(m, m2), s1 = __builtin_amdgcn_exp2f(m - mn), s2 = __builtin_amdgcn_exp2f(m2 - mn);
        m = mn; l = l * s1 + l2 * s2;
#pragma unroll
        for (int c = 0; c < 4; ++c)
#pragma unroll
          for (int r = 0; r < 16; ++r) o[c][r] = o[c][r] * s1 + xs[(2 + c * 16 + r) * 64 + lane] * s2;
      }
      __syncthreads();
    }
  }
  const int q = 32 * qt + r32;
  if (ks == 0) {
    const float lt = swap_sum(l);
    if (hi == 0) __hip_atomic_store((unsigned long long*)(PML + ((size_t)item * 64 + q) * 2), ((unsigned long long)__float_as_uint(lt) << 32) | __float_as_uint(m), __ATOMIC_RELAXED, __HIP_MEMORY_SCOPE_AGENT);
#pragma unroll
    for (int c = 0; c < 4; ++c)
#pragma unroll
      for (int g4 = 0; g4 < 4; ++g4) {
        const int c0 = 32 * c + 8 * g4 + 4 * hi;
        unsigned long long* dst_ = (unsigned long long*)(PO + ((size_t)item * 64 + q) * 128 + c0);
        __hip_atomic_store(dst_, ((unsigned long long)__float_as_uint(o[c][4 * g4 + 1]) << 32) | __float_as_uint(o[c][4 * g4]), __ATOMIC_RELAXED, __HIP_MEMORY_SCOPE_AGENT);
        __hip_atomic_store(dst_ + 1, ((unsigned long long)__float_as_uint(o[c][4 * g4 + 3]) << 32) | __float_as_uint(o[c][4 * g4 + 2]), __ATOMIC_RELAXED, __HIP_MEMORY_SCOPE_AGENT);
      }
  }
  asm volatile("s_waitcnt vmcnt(0)" ::: "memory");
  __syncthreads();
  volatile unsigned* flag = (volatile unsigned*)(lds + 2 * TILE);
  if (tid == 0) *flag = atomicAdd((unsigned*)(p.ws + W_CTL) + 64 + db, 1u);
  __syncthreads();
  const unsigned arrived = *flag;
  __syncthreads();
  if (arrived == 1u) {
    __builtin_amdgcn_fence(__ATOMIC_ACQUIRE, "agent");
    typedef float f32x4_t __attribute__((ext_vector_type(4)));
    const int h = wid, r16 = lane & 15, kq = lane >> 4;
    const bool rv = r16 < 8;
    const int qq = (rv ? r16 : 0) * 8 + h;
    const float* ml0 = PML + ((size_t)(2 * db) * 64 + qq) * 2; const float* ml1 = ml0 + 128;
    const float m0 = ml0[0], m1 = ml1[0], M_ = fmaxf(m0, m1), w0_ = __builtin_amdgcn_exp2f(m0 - M_), w1_ = __builtin_amdgcn_exp2f(m1 - M_);
    const float invL = 1.f / (ml0[1] * w0_ + ml1[1] * w1_);
    const float s0 = rv ? w0_ * invL : 0.f, s1 = rv ? w1_ * invL : 0.f;
    const float* po0 = PO + ((size_t)(2 * db) * 64 + qq) * 128; const float* po1 = po0 + 64 * 128;
    const bf16* wuv = (const bf16*)(p.ws + W_END) + B_WUV;
    f32x4_t acc[4];
#pragma unroll
    for (int nt = 0; nt < 4; ++nt) acc[nt] = (f32x4_t){0.f, 0.f, 0.f, 0.f};
#pragma unroll
    for (int ks = 0; ks < 4; ++ks) {
      const int c0 = 32 * ks + 8 * kq;
      const f32x4_t a0 = *(const f32x4_t*)(po0 + c0), a1 = *(const f32x4_t*)(po0 + c0 + 4), b0 = *(const f32x4_t*)(po1 + c0), b1 = *(const f32x4_t*)(po1 + c0 + 4);
      const f32x4_t x0 = a0 * s0 + b0 * s1, x1 = a1 * s0 + b1 * s1;
      u32x4 aw; aw.x = cvtpk(x0.x, x0.y); aw.y = cvtpk(x0.z, x0.w); aw.z = cvtpk(x1.x, x1.y); aw.w = cvtpk(x1.z, x1.w);
      const bf16x8 af = __builtin_bit_cast(bf16x8, aw);
#pragma unroll
      for (int nt = 0; nt < 4; ++nt) {
        const bf16x8 bfr = *(const bf16x8*)(wuv + (size_t)(h * 64 + 16 * nt + r16) * 128 + c0);
        acc[nt] = __builtin_amdgcn_mfma_f32_16x16x32_bf16(af, bfr, acc[nt], 0, 0, 0);
      }
    }
    if (kq < 2) {
      bf16* mix = (bf16*)(p.ws + W_END) + B_MIX;
#pragma unroll
      for (int nt = 0; nt < 4; ++nt)
#pragma unroll
        for (int rg = 0; rg < 4; ++rg) {
          const int t = 4 * kq + rg, col = h * 64 + 16 * nt + r16;
          const size_t row = (size_t)NP + db * 8 + t;
          const float g = pj((const bf16*)(p.ws + W_END) + B_PROJ, row, C_GMLA + col);
          mix[row * 1024 + col] = (bf16)f2bf(acc[nt][rg] * (g / (1.f + __expf(-g))));
        }
    }
  }
#if PROF_SEL == 121 || PROF_SEL == 122
  if (item == 0 && tid == 0) ((unsigned long long*)(p.ws + W_TS))[1] = __builtin_amdgcn_s_memrealtime();
#endif
}
}

namespace rw {
typedef float f32x4 __attribute__((ext_vector_type(4)));
constexpr int CH = 32, STEPF = 384, CHF = CH * STEPF;
__device__ __forceinline__ float dpp_sum16(float v) {
  v += __int_as_float(__builtin_amdgcn_update_dpp(0, __float_as_int(v), 0xB1, 0xF, 0xF, true));
  v += __int_as_float(__builtin_amdgcn_update_dpp(0, __float_as_int(v), 0x4E, 0xF, 0xF, true));
  v += __int_as_float(__builtin_amdgcn_update_dpp(0, __float_as_int(v), 0x141, 0xF, 0xF, true));
  v += __int_as_float(__builtin_amdgcn_update_dpp(0, __float_as_int(v), 0x140, 0xF, 0xF, true));
  return v;
}
__device__ __forceinline__ float dpp_sum8(float v) {
  v += __int_as_float(__builtin_amdgcn_update_dpp(0, __float_as_int(v), 0xB1, 0xF, 0xF, true));
  v += __int_as_float(__builtin_amdgcn_update_dpp(0, __float_as_int(v), 0x4E, 0xF, 0xF, true));
  v += __int_as_float(__builtin_amdgcn_update_dpp(0, __float_as_int(v), 0x141, 0xF, 0xF, true));
  return v;
}
__device__ __forceinline__ void rwkv_prompt_item(unsigned char* lds, const Params& p, int item, int wid_s) {
  const int bh = item >> 1, half = item & 1, b = bh >> 2, h = bh & 3;
  const int tid = mk_tid(wid_s);
  float* L = (float*)lds; float* yb = L + 2 * CHF;
  const float* ws = p.ws;
  const size_t rowbase = (size_t)b * SEQ;
  constexpr int NCH = SEQ / CH;
  if (wid_s >= 4) {
    const int ht = tid - 256;
    f32x4 g[12];
#define RW_GLOAD(c) do { _Pragma("unroll") for (int i_ = 0; i_ < 12; ++i_) { const int f_ = ht + 256 * i_, arr_ = f_ >> 9, s_ = (f_ >> 4) & 31, k4_ = f_ & 15; \
      const size_t off_ = (rowbase + (size_t)(c) * CH + s_) * 256 + h * 64 + k4_ * 4; \
      const size_t base_ = arr_ == 0 ? W_KK : arr_ == 1 ? W_W : arr_ == 2 ? W_BB : arr_ == 3 ? W_KF : arr_ == 4 ? W_R : W_VV; \
      g[i_] = *(const f32x4*)(ws + base_ + off_); } } while (0)
#define RW_LSTORE(buf) do { _Pragma("unroll") for (int i_ = 0; i_ < 12; ++i_) { const int f_ = ht + 256 * i_, arr_ = f_ >> 9, s_ = (f_ >> 4) & 31, k4_ = f_ & 15; \
      *(f32x4*)(L + (buf) * CHF + s_ * STEPF + arr_ * 64 + k4_ * 4) = (arr_ == 2) ? -g[i_] : g[i_]; } } while (0)
#define RW_FLUSH(c) do { const float* ybc_ = yb + ((c) & 1) * (32 * 33); _Pragma("unroll") for (int i_ = 0; i_ < 4; ++i_) { const int f_ = ht + 256 * i_, s_ = f_ >> 5, vv_ = f_ & 31; \
      p.ws[W_Y + (rowbase + (size_t)(c) * CH + s_) * 256 + h * 64 + 32 * half + vv_] = ybc_[vv_ * 33 + s_]; } } while (0)
    RW_GLOAD(0); RW_LSTORE(0);
    __syncthreads();
    for (int c = 0; c < NCH; ++c) {
      if (c + 1 < NCH) { RW_GLOAD(c + 1); RW_LSTORE((c + 1) & 1); }
      if (c > 0) RW_FLUSH(c - 1);
      __syncthreads();
    }
    RW_FLUSH(NCH - 1);
#undef RW_GLOAD
#undef RW_LSTORE
#undef RW_FLUSH
  } else {
    const int sub = tid & 7, vl = tid >> 3, v = 32 * half + vl;
    f32x4 Sa = {0.f, 0.f, 0.f, 0.f}, Sb = {0.f, 0.f, 0.f, 0.f};
    struct Ops { f32x4 kk0, kk1, w0, w1, nb0, nb1, kf0, kf1, r0, r1; float vv; };
#define RW_LD(o, s) do { const float* sb_ = cb + (s) * STEPF + 8 * sub; (o).kk0 = *(const f32x4*)(sb_); (o).kk1 = *(const f32x4*)(sb_ + 4); \
      (o).w0 = *(const f32x4*)(sb_ + 64); (o).w1 = *(const f32x4*)(sb_ + 68); (o).nb0 = *(const f32x4*)(sb_ + 128); (o).nb1 = *(const f32x4*)(sb_ + 132); \
      (o).kf0 = *(const f32x4*)(sb_ + 192); (o).kf1 = *(const f32x4*)(sb_ + 196); (o).r0 = *(const f32x4*)(sb_ + 256); (o).r1 = *(const f32x4*)(sb_ + 260); \
      (o).vv = cb[(s) * STEPF + 320 + v]; } while (0)
#define RW_STEP(o, s) do { const f32x4 ta_ = (o).kf0 * (o).vv, tb_ = (o).kf1 * (o).vv; const f32x4 d4_ = Sa * (o).kk0 + Sb * (o).kk1; \
      float dot_ = (d4_.x + d4_.y) + (d4_.z + d4_.w); dot_ = dpp_sum8(dot_); \
      Sa = Sa * (o).w0 + ((o).nb0 * dot_ + ta_); Sb = Sb * (o).w1 + ((o).nb1 * dot_ + tb_); \
      const f32x4 y4_ = Sa * (o).r0 + Sb * (o).r1; float y_ = (y4_.x + y4_.y) + (y4_.z + y4_.w); y_ = dpp_sum8(y_); \
      ykeep = (sub == ((s) & 7)) ? y_ : ykeep; \
      if (((s) & 7) == 7) ybc[vl * 33 + ((s) - 7) + sub] = ykeep; } while (0)
    __syncthreads();
    for (int c = 0; c < NCH; ++c) {
      const float* cb = L + (c & 1) * CHF;
      float* ybc = yb + (c & 1) * (32 * 33);
      float ykeep = 0.f;
      Ops A, B;
      RW_LD(A, 0);
#pragma unroll
      for (int s = 0; s < CH; s += 2) {
        RW_LD(B, s + 1);
        RW_STEP(A, s);
        if (s + 2 < CH) RW_LD(A, s + 2);
        RW_STEP(B, s + 1);
      }
      __syncthreads();
    }
#undef RW_LD
#undef RW_STEP
    float* so = p.out + O_WKVP + ((size_t)(b * 4 + h) * 64 + v) * 64 + 8 * sub;
    *(f32x4*)so = Sa; *(f32x4*)(so + 4) = Sb;
  }
  __syncthreads();
}
}

namespace rw {
__device__ __forceinline__ void rwkv_sample_item(unsigned char* lds, const Params& p, int item, int wid_s) {
  float* YL = (float*)lds;
  const int db = item >> 2, h = item & 3;
  const int tid = mk_tid(wid_s), sub = tid & 7, v = tid >> 3;
  const float* ws = p.ws;
  const float* s0 = p.state_wkv + ((size_t)(db * 4 + h) * 64 + v) * 64 + 8 * sub;
  f32x4 Sa = *(const f32x4*)s0, Sb = *(const f32x4*)(s0 + 4);
  const size_t row0 = (size_t)NP + db * DT;
  struct Ops { f32x4 kk0, kk1, w0, w1, b0, b1, kf0, kf1, r0, r1; float vv; };
#define RS_LD(o, t) do { const size_t off_ = (row0 + (t)) * 256 + h * 64; const float* q_ = ws + off_ + 8 * sub; \
    (o).kk0 = *(const f32x4*)(q_ + W_KK); (o).kk1 = *(const f32x4*)(q_ + W_KK + 4); (o).w0 = *(const f32x4*)(q_ + W_W); (o).w1 = *(const f32x4*)(q_ + W_W + 4); \
    (o).b0 = *(const f32x4*)(q_ + W_BB); (o).b1 = *(const f32x4*)(q_ + W_BB + 4); (o).kf0 = *(const f32x4*)(q_ + W_KF); (o).kf1 = *(const f32x4*)(q_ + W_KF + 4); \
    (o).r0 = *(const f32x4*)(q_ + W_R); (o).r1 = *(const f32x4*)(q_ + W_R + 4); (o).vv = ws[W_VV + off_ + v]; } while (0)
#define RS_STEP(o, t) do { const f32x4 d4_ = Sa * (o).kk0 + Sb * (o).kk1; float dot_ = (d4_.x + d4_.y) + (d4_.z + d4_.w); dot_ = dpp_sum8(dot_); \
    const float sa_ = -dot_; \
    Sa = Sa * (o).w0 + ((o).b0 * sa_ + (o).kf0 * (o).vv); Sb = Sb * (o).w1 + ((o).b1 * sa_ + (o).kf1 * (o).vv); \
    const f32x4 y4_ = Sa * (o).r0 + Sb * (o).r1; float y_ = (y4_.x + y4_.y) + (y4_.z + y4_.w); y_ = dpp_sum8(y_); \
    if (sub == 0) YL[(t) * 64 + v] = y_; } while (0)
  Ops A, B;
  RS_LD(A, 0);
#pragma unroll
  for (int t = 0; t < DT; t += 2) {
    RS_LD(B, t + 1);
    RS_STEP(A, t);
    if (t + 2 < DT) RS_LD(A, t + 2);
    RS_STEP(B, t + 1);
  }
#undef RS_LD
#undef RS_STEP
  float* so = p.out + O_WKVS + ((size_t)(db * 4 + h) * 64 + v) * 64 + 8 * sub;
  *(f32x4*)so = Sa; *(f32x4*)(so + 4) = Sb;
  __syncthreads();
  {
    const int t = wid_s, lane = tid & 63;
    const size_t row = row0 + t, off = row * 256 + h * 64 + lane;
    const float y = YL[t * 64 + lane];
    const float mean = wave_sum_fast(y) * (1.f / 64.f), d = y - mean, var = wave_sum_fast(d * d) * (1.f / 64.f);
    const float yn = d * rsqrtf(var + GN_EPS) * p.lnx_g[h * 64 + lane] + p.lnx_b[h * 64 + lane];
    const float bsum = wave_sum_fast(ws[W_R + off] * ws[W_KF + off] * p.r_k[h * 64 + lane]);
    const float o = yn + bsum * ws[W_VV + off];
    const float g = pj((const bf16*)(p.ws + W_END) + B_PROJ, row, C_GRWKV + h * 64 + lane);
    ((bf16*)(p.ws + W_END))[B_MIX + row * 1024 + 512 + h * 64 + lane] = (bf16)f2bf(o * (g / (1.f + __expf(-g))));
  }
  __syncthreads();
}
}

namespace ma {
typedef float f32x4 __attribute__((ext_vector_type(4)));
__device__ __forceinline__ void mem_sample_item(unsigned char* lds, const Params& p, int db, int wid_s) {
  const int tid = mk_tid(wid_s), lane = tid & 63, t = wid_s;
  constexpr int KST = 65;
  float* Kl = (float*)lds;
  float* Vl = Kl + 256 * KST;
  float* ps = Vl + 256 * 64 + t * 256;
  const float* ws = p.ws;
  const float* kg = p.cache_mem_k + (size_t)db * 65536; const float* vg = p.cache_mem_v + (size_t)db * 65536;
  const size_t row = (size_t)NP + db * 8 + t;
  f32x4 kr[8], vr[8];
#define MS_GLOAD(h) do { _Pragma("unroll") for (int i_ = 0; i_ < 8; ++i_) { const int f_ = tid + 512 * i_, m_ = f_ >> 4, c4_ = f_ & 15; \
    kr[i_] = *(const f32x4*)(kg + (size_t)m_ * 256 + (h) * 64 + c4_ * 4); vr[i_] = *(const f32x4*)(vg + (size_t)m_ * 256 + (h) * 64 + c4_ * 4); } } while (0)
#define MS_LSTORE() do { _Pragma("unroll") for (int i_ = 0; i_ < 8; ++i_) { const int f_ = tid + 512 * i_, m_ = f_ >> 4, c4_ = f_ & 15; \
    float* kd_ = Kl + m_ * KST + c4_ * 4; kd_[0] = kr[i_].x; kd_[1] = kr[i_].y; kd_[2] = kr[i_].z; kd_[3] = kr[i_].w; \
    *(f32x4*)(Vl + m_ * 64 + c4_ * 4) = vr[i_]; } } while (0)
  MS_GLOAD(0);
  bf16* mix = (bf16*)(p.ws + W_END) + B_MIX;
  for (int h = 0; h < 4; ++h) {
    __syncthreads();
    MS_LSTORE();
    if (h + 1 < 4) MS_GLOAD(h + 1);
    float q[64];
    { const bf16* PJ = (const bf16*)(p.ws + W_END) + B_PROJ;
#pragma unroll
      for (int d4 = 0; d4 < 16; ++d4) { const float4 v = pj4(PJ, row, C_QX + h * 64 + d4 * 4); q[4 * d4] = v.x * X_SCALE; q[4 * d4 + 1] = v.y * X_SCALE; q[4 * d4 + 2] = v.z * X_SCALE; q[4 * d4 + 3] = v.w * X_SCALE; } }
    __syncthreads();
    float s[4] = {0.f, 0.f, 0.f, 0.f};
#pragma unroll
    for (int d = 0; d < 64; ++d) {
#pragma unroll
      for (int j = 0; j < 4; ++j) s[j] += Kl[(lane + 64 * j) * KST + d] * q[d];
    }
    float mx = wave_max(fmaxf(fmaxf(s[0], s[1]), fmaxf(s[2], s[3])));
    float sum = 0.f;
#pragma unroll
    for (int j = 0; j < 4; ++j) { s[j] = __expf(s[j] - mx); sum += s[j]; }
    const float inv = 1.f / wave_sum_fast(sum);
#pragma unroll
    for (int j = 0; j < 4; ++j) ps[lane + 64 * j] = s[j] * inv;
    float o0 = 0.f, o1 = 0.f, o2 = 0.f, o3 = 0.f;
#pragma unroll 4
    for (int m = 0; m < 256; m += 4) {
      const f32x4 pm = *(const f32x4*)(ps + m);
      o0 += pm.x * Vl[(m) * 64 + lane]; o1 += pm.y * Vl[(m + 1) * 64 + lane]; o2 += pm.z * Vl[(m + 2) * 64 + lane]; o3 += pm.w * Vl[(m + 3) * 64 + lane];
    }
    const float o = (o0 + o1) + (o2 + o3);
    const float g = pj((const bf16*)(p.ws + W_END) + B_PROJ, row, C_GX + h * 64 + lane);
    mix[row * 1024 + 768 + h * 64 + lane] = (bf16)f2bf(o * (g / (1.f + __expf(-g))));
  }
#undef MS_GLOAD
#undef MS_LSTORE
  __syncthreads();
}
}

typedef unsigned v4u __attribute__((ext_vector_type(4)));
__device__ __forceinline__ unsigned f2bf(float f) { unsigned u = __builtin_bit_cast(unsigned, f); return (u + 0x7fffu + ((u >> 16) & 1u)) >> 16; }
__device__ __forceinline__ unsigned pk2(float lo, float hi) { return f2bf(lo) | (f2bf(hi) << 16); }
__device__ __forceinline__ void p0_transpose_item(const float* W, int K, int N, bf16* WT, int row_off, LAS float* scr, int item, int lane) {
  const int nblk = N / 32, kb = item / nblk, nb = item % nblk, k0 = 64 * kb, n0 = 32 * nb;
#pragma unroll 8
  for (int i = 0; i < 32; ++i) { const int kk = 2 * i + (lane >> 5); scr[kk * 33 + (lane & 31)] = W[(size_t)(k0 + kk) * N + n0 + (lane & 31)]; }
  asm volatile("s_waitcnt lgkmcnt(0)" ::: "memory");
  const int c = lane & 7;
#pragma unroll
  for (int j = 0; j < 4; ++j) { const int n = (lane >> 3) + 8 * j; const LAS float* s = scr + (8 * c) * 33 + n;
    v4u o; o.x = pk2(s[0 * 33], s[1 * 33]); o.y = pk2(s[2 * 33], s[3 * 33]); o.z = pk2(s[4 * 33], s[5 * 33]); o.w = pk2(s[6 * 33], s[7 * 33]);
    *(v4u*)(WT + (size_t)(row_off + n0 + n) * K + k0 + 8 * c) = o; }
  asm volatile("s_waitcnt lgkmcnt(0)" ::: "memory");
}


#if PROF_SEL >= 0
#define PROF_STAMP(i) do { if ((i) == PROF_SEL || (i) == PROF_SEL + 1 || ((i) == 0 && PROF_SEL >= 130 && PROF_SEL <= 136)) { if (blockIdx.x == 0 && mk_tid(wid_s) == 0) ((unsigned long long*)(p.ws + W_TS))[(i) == 0 ? 0 : (i) - PROF_SEL] = __builtin_amdgcn_s_memrealtime(); } } while (0)
#else
#define PROF_STAMP(i) do { } while (0)
#endif
__global__ void __launch_bounds__(512) fwd_megakernel(Params p) {
  cg::grid_group grid = cg::this_grid();
  extern __shared__ __attribute__((aligned(16))) unsigned char lds[];
  float* sm = (float*)lds;
  bf16* wb = (bf16*)(p.ws + W_END);
  float* ws = p.ws;
  const int wid_s = __builtin_amdgcn_readfirstlane((int)(threadIdx.x >> 6));
  PROF_STAMP(0);
#define PH_IDS const int tid = mk_tid(wid_s); const int lane = tid & 63, wv = tid >> 6; const int gw = blockIdx.x * 8 + wv, NGW = gridDim.x * 8; \
  const int gtid = blockIdx.x * 512 + tid, NTH = gridDim.x * 512; (void)lane; (void)wv; (void)gw; (void)NGW; (void)gtid; (void)NTH;
  { PH_IDS

  {
    LAS float* scr = (LAS float*)((LAS unsigned char*)lds + wv * 16384);
    constexpr int I_IN = 16 * (INC / 32), I_MEM = 16 * (512 / 32), I_OUT = 16 * (1024 / 32);
    for (int it = gw; it < I_IN + I_MEM + I_OUT; it += NGW) {
      int r = it;
      if (r < I_IN) { p0_transpose_item(p.w_in, 1024, INC, wb + B_WIN, 0, scr, r, lane); continue; } r -= I_IN;
      if (r < I_MEM) { p0_transpose_item(p.w_mem_kv, 1024, 512, wb + B_WMEM, 0, scr, r, lane); continue; } r -= I_MEM;
      p0_transpose_item(p.w_out, 1024, 1024, wb + B_WOUT, 0, scr, r, lane);
    }
    if (gtid < 256) ((unsigned*)(p.ws + W_CTL))[gtid] = 0u;

#if PROF_SEL == 130
    if (blockIdx.x == 0 && tid == 0) { asm volatile("s_waitcnt vmcnt(0)" ::: "memory"); ((unsigned long long*)(p.ws + W_TS))[1] = __builtin_amdgcn_s_memrealtime(); }
#endif
    for (int it = gw; it < 64; it += NGW) {
      if (it < 32) p0_transpose_item(p.w_uk, 128, 512, wb + B_WUK, 0, scr, it, lane);
      else p0_transpose_item(p.w_uv, 128, 512, wb + B_WUV, 0, scr, it - 32, lane);
    }

#if PROF_SEL == 131
    if (blockIdx.x == 0 && tid == 0) { asm volatile("s_waitcnt vmcnt(0)" ::: "memory"); ((unsigned long long*)(p.ws + W_TS))[1] = __builtin_amdgcn_s_memrealtime(); }
#endif
    for (int i = gtid; i < 768 * 256; i += NTH) {
      const int n = i >> 8, k = i & 255;
      const int orig = n < 512 ? (n >> 6) * 96 + (n & 63) : (n < 640 ? ((n - 512) >> 4) * 96 + 64 + ((n - 512) & 15) : ((n - 640) >> 4) * 96 + 80 + ((n - 640) & 15));
      wb[B_WUQ + i] = (bf16)f2bf(p.w_uq[(size_t)k * 768 + orig]);
    }

#if PROF_SEL == 132
    if (blockIdx.x == 0 && tid == 0) { asm volatile("s_waitcnt vmcnt(0)" ::: "memory"); ((unsigned long long*)(p.ws + W_TS))[1] = __builtin_amdgcn_s_memrealtime(); }
#endif
    for (int it0 = gw; it0 < 1024; it0 += NGW) {
      const int it = __builtin_amdgcn_readfirstlane(it0);
      const int h = it >> 7, k = ((it >> 5) & 3) * 64 + lane, cg = it & 31;
      float ar[64];
#pragma unroll
      for (int d4 = 0; d4 < 16; ++d4) { const float4 v = *(const float4*)(p.w_uq + (size_t)k * 768 + h * 96 + d4 * 4); ar[4 * d4] = v.x; ar[4 * d4 + 1] = v.y; ar[4 * d4 + 2] = v.z; ar[4 * d4 + 3] = v.w; }
#pragma unroll 4
      for (int c = cg * 4; c < cg * 4 + 4; ++c) {
        const float* br = p.w_uk + (size_t)c * 512 + h * 64;
        float acc = 0.f;
#pragma unroll
        for (int d4 = 0; d4 < 16; ++d4) { const float4 v = *(const float4*)(br + d4 * 4); acc += (ar[4 * d4] * v.x + ar[4 * d4 + 1] * v.y) + (ar[4 * d4 + 2] * v.z + ar[4 * d4 + 3] * v.w); }
        wb[B_WQL + (size_t)(h * 128 + c) * 256 + k] = (bf16)f2bf(acc);
      }
    }

#if PROF_SEL == 133
    if (blockIdx.x == 0 && tid == 0) { asm volatile("s_waitcnt vmcnt(0)" ::: "memory"); ((unsigned long long*)(p.ws + W_TS))[1] = __builtin_amdgcn_s_memrealtime(); }
#endif
    for (int i = gtid; i < 512 * 1024; i += NTH) {
      const int n = i >> 10, k = i & 1023, h = n >> 6, hk = k >> 7, c = k & 127;
      wb[B_WUVBD + i] = hk == h ? (bf16)f2bf(p.w_uv[(size_t)c * 512 + n]) : (bf16)0;
    }

#if PROF_SEL == 134
    if (blockIdx.x == 0 && tid == 0) { asm volatile("s_waitcnt vmcnt(0)" ::: "memory"); ((unsigned long long*)(p.ws + W_TS))[1] = __builtin_amdgcn_s_memrealtime(); }
#endif
    for (int i = gtid; i < 4104 * 16; i += NTH) {
      const int pi = i >> 4, j = i & 15; const int pos = pi < 4096 ? pi : PAST + (pi - 4096);
      const float inv = 1.0f / powf(10000.0f, (float)j * (2.0f / 32.0f));
      const float ang = (float)pos * inv;
      p.ws[W_CS + (size_t)i * 2] = cosf(ang); p.ws[W_CS + (size_t)i * 2 + 1] = sinf(ang);
    }
    for (int i = gtid; i < (INCP - INC) * 1024 / 8; i += NTH) ((v4u*)(wb + B_WIN + (size_t)INC * 1024))[i] = (v4u){0u, 0u, 0u, 0u};
  }

#if PROF_SEL == 135
    if (blockIdx.x == 0 && tid == 0) { asm volatile("s_waitcnt vmcnt(0)" ::: "memory"); ((unsigned long long*)(p.ws + W_TS))[1] = __builtin_amdgcn_s_memrealtime(); }
#endif
  for (int r = gw; r < NT + 1024; r += NGW) {
    const float* src; const float* g; bf16* dst;
    if (r < NT) { src = xrow(p, r); g = p.ln_g; dst = wb + B_H + (size_t)r * 1024; }
    else { src = p.mem_prompt + (size_t)(r - NT) * 1024; g = p.mem_norm_g; dst = wb + B_HM + (size_t)(r - NT) * 1024; }
    float4 v[4]; float ss = 0.f;
#pragma unroll
    for (int i = 0; i < 4; ++i) { v[i] = *(const float4*)(src + 4 * lane + 256 * i); ss += v[i].x * v[i].x + v[i].y * v[i].y + v[i].z * v[i].z + v[i].w * v[i].w; }
    const float rs = rsqrtf(wave_sum_fast(ss) * (1.f / 1024.f) + RMS_EPS);
#pragma unroll
    for (int i = 0; i < 4; ++i) {
      const float4 gg = *(const float4*)(g + 4 * lane + 256 * i);
      uint2 o; o.x = pk2(v[i].x * rs * gg.x, v[i].y * rs * gg.y); o.y = pk2(v[i].z * rs * gg.z, v[i].w * rs * gg.w);
      *(uint2*)(dst + 4 * lane + 256 * i) = o;
    }
  }
  }
  grid.sync();
  PROF_STAMP(1);
  { PH_IDS

  {
    pg8::Gemm g{wb + B_H, wb + B_WIN, NT, INCP, 1024}; pg8::StaticOrder S; S.init(NT, INCP, (int)gridDim.x, (int)blockIdx.x);
    bf16* PJ = wb + B_PROJ;
    auto f = [=](int row, int col) -> bf16* { return col < INC ? PJ + (size_t)row * INC + col : nullptr; };
    pg8::EpiBf16F<decltype(f)> E{f, 1.f};
    pg8::gemm_phase<pg8::EpiBf16F<decltype(f)>, pg8::StaticOrder, true, true>((PG8_LAS unsigned char*)lds, g, S, E, wid_s);
  }
  {
    pg8::Gemm g{wb + B_HM, wb + B_WMEM, 1024, 512, 1024}; pg8::StaticOrder S; S.init(1024, 512, (int)gridDim.x, (int)((blockIdx.x + 20) % gridDim.x));
    pg8::EpiF32 E{p.out + O_MKP, 256, 256, 256, O_MVP - O_MKP, nullptr, nullptr, 0};
    pg8::gemm_phase<pg8::EpiF32, pg8::StaticOrder, true, true>((PG8_LAS unsigned char*)lds, g, S, E, wid_s);
  }
  }
  grid.sync();
  PROF_STAMP(2);
  { PH_IDS

  for (size_t i = gtid; i < (size_t)4 * 256 * 256; i += NTH) {
    wb[B_KM + i] = (bf16)f2bf(p.out[O_MKP + i]);
    const size_t b_ = i >> 16, c = (i >> 8) & 255, m_ = i & 255;
    wb[B_VMT + i] = (bf16)f2bf(p.out[O_MVP + (b_ * 256 + m_) * 256 + c]);
  }
  {
    constexpr int WST = 72, TST = 136;
    bf16* wl = (bf16*)lds; bf16* al = wl + 256 * WST;
    bf16* td = al + 256 * WST + wv * (16 * TST);
    for (int i = tid; i < 64 * 256; i += 512) { const int k = i >> 8, n = i & 255; wl[n * WST + k] = (bf16)f2bf(p.w_up[i]); al[n * WST + k] = (bf16)f2bf(p.a_up[i]); }
    __syncthreads();
    float mu[14];
#pragma unroll
    for (int i = 0; i < 14; ++i) mu[i] = p.shift_mu[lane + 64 * i];
    float qg[4], kg[2];
#pragma unroll
    for (int i = 0; i < 4; ++i) qg[i] = p.q_norm_g[lane + 64 * i];
    kg[0] = p.kv_norm_g[lane]; kg[1] = p.kv_norm_g[64 + lane];
    constexpr int GT = 8;
    struct TokIn { float cq[4], ck0, ck1, kr1, kr2, z[14], zp[14]; float2 csv; float4 qx4; };
    auto tok_load = [&](int row, TokIn& T) {
      const bf16* pr = wb + B_PROJ + (size_t)row * INC;
      const bool isp = row < NP; const int srow = row - NP;
      const bool first = isp ? ((row & (SEQ - 1)) == 0) : ((srow & 7) == 0);
      const bf16* pp = first ? pr : pr - INC;
#pragma unroll
      for (int i = 0; i < 4; ++i) T.cq[i] = bf2f(pr[C_CQ + lane + 64 * i]);
      T.ck0 = bf2f(pr[C_CKV + lane]); T.ck1 = bf2f(pr[C_CKV + 64 + lane]);
      T.kr1 = bf2f(pr[C_KR + (lane & 15)]); T.kr2 = bf2f(pr[C_KR + 16 + (lane & 15)]);
#pragma unroll
      for (int i = 0; i < 14; ++i) { T.z[i] = bf2f(pr[C_Z + lane + 64 * i]); T.zp[i] = bf2f(pp[C_Z + lane + 64 * i]); }
      if (first) {
        const float* sst = p.state_shift + (size_t)(isp ? 0 : (srow >> 3)) * 896;
#pragma unroll
        for (int i = 0; i < 14; ++i) T.zp[i] = isp ? 0.f : sst[lane + 64 * i];
      }
      const int pi = isp ? (row & (SEQ - 1)) : 4096 + (srow & 7);
      T.csv = *(const float2*)(ws + W_CS + ((size_t)pi * 16 + (lane & 15)) * 2);
      T.qx4 = make_float4(0.f, 0.f, 0.f, 0.f);
      if (isp) T.qx4 = pj4(wb + B_PROJ, (size_t)row, C_QX + lane * 4);
    };
    for (int grp = gw; grp < NT / GT; grp += NGW) {
      TokIn cur; tok_load(grp * GT, cur);
      for (int ti = 0; ti < GT; ++ti) {
        const int row = grp * GT + ti;
        TokIn nxt; tok_load(ti + 1 < GT ? row + 1 : row, nxt);
        const bool isp = row < NP;
        const int srow = row - NP;
        const float* z = cur.z;
        float zm[14];
#pragma unroll
        for (int i = 0; i < 14; ++i) zm[i] = cur.z[i] + (cur.zp[i] - cur.z[i]) * mu[i];
        { const float e2 = __expf(2.f * zm[12]); td[ti * TST + lane] = (bf16)f2bf(1.f - 2.f / (e2 + 1.f)); } td[ti * TST + 64 + lane] = (bf16)f2bf(zm[13]);
#pragma unroll
        for (int hh = 0; hh < 4; ++hh) { const size_t o = (size_t)row * 256 + hh * 64 + lane; ws[W_R + o] = zm[hh]; ws[W_KF + o] = zm[4 + hh]; ws[W_VV + o] = zm[8 + hh]; }
        {
          const float rs = rsqrtf(wave_sum_fast((cur.cq[0] * cur.cq[0] + cur.cq[1] * cur.cq[1]) + (cur.cq[2] * cur.cq[2] + cur.cq[3] * cur.cq[3])) * (1.f / 256.f) + RMS_EPS);
#pragma unroll
          for (int i = 0; i < 4; ++i) wb[B_CQN + (size_t)row * 256 + lane + 64 * i] = (bf16)f2bf(cur.cq[i] * rs * qg[i]);
          const float rs2 = rsqrtf(wave_sum_fast(cur.ck0 * cur.ck0 + cur.ck1 * cur.ck1) * (1.f / 128.f) + RMS_EPS);
          const float c0 = cur.ck0 * rs2 * kg[0], c1 = cur.ck1 * rs2 * kg[1];
          float* o = ckv_out_row(p, row);
          o[lane] = c0; o[64 + lane] = c1;
          if (isp) { wb[B_CKVN + (size_t)row * 128 + lane] = (bf16)f2bf(c0); wb[B_CKVN + (size_t)row * 128 + 64 + lane] = (bf16)f2bf(c1); }
        }
        {
          const float y1 = cur.kr1 * cur.csv.x - cur.kr2 * cur.csv.y, y2 = cur.kr2 * cur.csv.x + cur.kr1 * cur.csv.y;
          if (lane < 16) { float* o = kpe_out_row(p, row); o[lane] = y1; o[16 + lane] = y2; }
          if (isp) {
            const bf16 b1 = (bf16)f2bf(y1), b2 = (bf16)f2bf(y2);
            const int j = lane & 15, hq = lane >> 4;
            wb[B_KP + (size_t)row * 768 + (2 * hq) * 96 + 64 + j] = b1; wb[B_KP + (size_t)row * 768 + (2 * hq) * 96 + 80 + j] = b2;
            wb[B_KP + (size_t)row * 768 + (2 * hq + 1) * 96 + 64 + j] = b1; wb[B_KP + (size_t)row * 768 + (2 * hq + 1) * 96 + 80 + j] = b2;
            const float XSC = X_SCALE * 1.4426950408889634f;
            *(uint2*)(wb + B_QX + (size_t)row * 256 + lane * 4) = make_uint2(pk2(cur.qx4.x * XSC, cur.qx4.y * XSC), pk2(cur.qx4.z * XSC, cur.qx4.w * XSC));
          }
        }
        if (isp) { if ((row & (SEQ - 1)) == SEQ - 1) { const int b = row / SEQ;
#pragma unroll
            for (int i = 0; i < 14; ++i) p.out[O_SHP + (size_t)b * 896 + lane + 64 * i] = z[i]; } }
        else { if ((srow & 7) == 7) { const int db = srow >> 3;
#pragma unroll
            for (int i = 0; i < 14; ++i) p.out[O_SHS + (size_t)db * 896 + lane + 64 * i] = z[i]; } }
        cur = nxt;
      }
      {
        typedef short bf16x8_t __attribute__((ext_vector_type(8)));
        typedef float f32x4_t __attribute__((ext_vector_type(4)));
        const int r16 = lane & 15, kq = lane >> 4;
        bf16x8_t at[2], aa_[2];
#pragma unroll
        for (int ks = 0; ks < 2; ++ks) { at[ks] = *(const bf16x8_t*)(td + r16 * TST + 32 * ks + 8 * kq); aa_[ks] = *(const bf16x8_t*)(td + r16 * TST + 64 + 32 * ks + 8 * kq); }
#pragma unroll 1
        for (int hh = 0; hh < 4; ++hh) {
          f32x4_t au[4], aA[4];
#pragma unroll
          for (int nt = 0; nt < 4; ++nt) {
            const int n = hh * 64 + nt * 16 + r16;
            au[nt] = (f32x4_t){0.f, 0.f, 0.f, 0.f}; aA[nt] = (f32x4_t){0.f, 0.f, 0.f, 0.f};
#pragma unroll
            for (int ks = 0; ks < 2; ++ks) {
              const bf16x8_t bw = *(const bf16x8_t*)(wl + n * WST + 32 * ks + 8 * kq), ba = *(const bf16x8_t*)(al + n * WST + 32 * ks + 8 * kq);
              au[nt] = __builtin_amdgcn_mfma_f32_16x16x32_bf16(at[ks], bw, au[nt], 0, 0, 0);
              aA[nt] = __builtin_amdgcn_mfma_f32_16x16x32_bf16(aa_[ks], ba, aA[nt], 0, 0, 0);
            }
          }
          float kkv[4][4], av[4][4], kraw[4][4], ssq[4] = {0.f, 0.f, 0.f, 0.f};
#pragma unroll
          for (int nt = 0; nt < 4; ++nt) {
            const int c = hh * 64 + nt * 16 + r16;
            const float w0c = p.w0[c], a0c = p.a0[c], kkc = p.k_k[c];
#pragma unroll
            for (int r = 0; r < 4; ++r) {
              const size_t o = (size_t)(grp * GT + (kq < 2 ? 4 * kq + r : 0)) * 256 + c;
              const float nu = -(w0c + au[nt][r]);
              const float sp = fmaxf(nu, 0.f) + __logf(1.f + __expf(-fabsf(nu)));
              if (kq < 2) ws[W_W + o] = __expf(-__expf(-sp - 0.5f));
              av[nt][r] = 1.f / (1.f + __expf(-(a0c + aA[nt][r])));
              kraw[nt][r] = ws[W_KF + o];
              kkv[nt][r] = kraw[nt][r] * kkc;
              ssq[r] += kkv[nt][r] * kkv[nt][r];
            }
          }
#pragma unroll
          for (int r = 0; r < 4; ++r) ssq[r] = 1.f / fmaxf(sqrtf(rw::dpp_sum16(ssq[r])), 1e-12f);
#pragma unroll
          for (int nt = 0; nt < 4; ++nt) {
            const int c = hh * 64 + nt * 16 + r16;
            const float kac = p.k_a[c];
#pragma unroll
            for (int r = 0; r < 4; ++r) {
              const size_t o = (size_t)(grp * GT + 4 * kq + r) * 256 + c;
              const float kk = kkv[nt][r] * ssq[r];
              if (kq < 2) { ws[W_KK + o] = kk; ws[W_BB + o] = kk * av[nt][r];
                ws[W_KF + o] = kraw[nt][r] * (1.f + (av[nt][r] - 1.f) * kac); }
            }
          }
        }
      }
    }
  }
  }
  grid.sync();
  PROF_STAMP(3);
  { PH_IDS

  {
    unsigned* dctr = (unsigned*)(p.ws + W_CTL) + 2;
    const unsigned nd = gridDim.x - NSCAN;
    if ((int)blockIdx.x >= NSCAN) {
      const float QSC = MLA_SCALE * 1.4426950408889634f;
      const int G = (int)gridDim.x - NSCAN, bx = (int)blockIdx.x - NSCAN;
      {
        pg8::Gemm g{wb + B_CQN, wb + B_WUQ, NT, 768, 256}; pg8::StaticOrder S; S.init(NT, 768, G, bx);
        pg8::EpiQ E{wb + B_QP, wb + B_QS, ws + W_CS, QSC, NP};
        pg8::gemm_phase<pg8::EpiQ, pg8::StaticOrder, true, true>((PG8_LAS unsigned char*)lds, g, S, E, wid_s);
      }
      {
        bf16* Qs = wb + B_QS;
        auto f = [=](int row, int col) -> bf16* { return Qs + ((size_t)row * 8 + (col >> 7)) * 160 + (col & 127); };
        pg8::Gemm g{wb + B_CQN + (size_t)NP * 256, wb + B_WQL, NS, 1024, 256}; pg8::StaticOrder S; S.init(NS, 1024, G, (bx + G - 204 % G) % G);
        pg8::EpiBf16F<decltype(f)> E{f, QSC};
        pg8::gemm_phase<pg8::EpiBf16F<decltype(f)>, pg8::StaticOrder, true, true>((PG8_LAS unsigned char*)lds, g, S, E, wid_s);
      }
      {
        bf16* Kp = wb + B_KP;
        auto f = [=](int row, int col) -> bf16* { return Kp + (size_t)row * 768 + (col >> 6) * 96 + (col & 63); };
        pg8::Gemm g{wb + B_CKVN, wb + B_WUK, NP, 512, 128}; pg8::StaticOrder S; S.init(NP, 512, G, (bx + G - 220 % G) % G);
        pg8::EpiBf16F<decltype(f)> E{f, 1.f};
        pg8::gemm_phase<pg8::EpiBf16F<decltype(f)>, pg8::StaticOrder, true, true>((PG8_LAS unsigned char*)lds, g, S, E, wid_s);
      }
      {
        bf16* Vt = wb + B_VT;
        auto f = [=](int row, int col) -> bf16* { return Vt + (size_t)row * NP + col; };
        pg8::Gemm g{wb + B_WUV, wb + B_CKVN, 512, NP, 128}; pg8::StaticOrder S; S.init(512, NP, G, (bx + G - 124 % G) % G);
        pg8::EpiBf16F<decltype(f)> E{f, 1.f};
        pg8::gemm_phase<pg8::EpiBf16F<decltype(f)>, pg8::StaticOrder, true, true>((PG8_LAS unsigned char*)lds, g, S, E, wid_s);
      }
      asm volatile("s_waitcnt vmcnt(0)" ::: "memory");
      __syncthreads();
      if (mk_tid(wid_s) == 0) { __builtin_amdgcn_fence(__ATOMIC_RELEASE, "agent"); asm volatile("s_waitcnt vmcnt(0)" ::: "memory"); __hip_atomic_fetch_add(dctr, 1u, __ATOMIC_RELAXED, __HIP_MEMORY_SCOPE_AGENT); }
    }
  }
  }
  { PH_IDS

  {
    unsigned* qctr = (unsigned*)(p.ws + W_CTL);
    volatile unsigned* qslot = (volatile unsigned*)(lds + LDS_BYTES - 16);
    constexpr int Q_RW = 32, Q_SA = 256, Q_PA = 512, Q_MA = 256, Q_RS = 512, Q_MS = 128, Q_TOT = Q_RW + Q_SA + Q_PA + Q_MA + Q_RS + Q_MS;
#if PROF_SEL >= 100 && PROF_SEL < 110
    int prof_prev_ = -1;
#endif
#if PROF_SEL >= 110 && PROF_SEL <= 116
    if (blockIdx.x == 0 && tid == 0) ((unsigned long long*)(p.ws + W_TS))[0] = __builtin_amdgcn_s_memrealtime();
#endif
    bool d_ready = false;
    for (;;) {
      if (tid == 0) *qslot = atomicAdd(qctr, 1u);
      __syncthreads();
      int item = (int)*qslot;
      __syncthreads();
      item = __builtin_amdgcn_readfirstlane(item);
#if PROF_SEL >= 100 && PROF_SEL < 110
      { constexpr int probe_items[8] = {0, 32, 34, 32 + 767, 32 + 765, 800, 1056, 1056 + 512};
        static unsigned long long* const dummy_ = nullptr; (void)dummy_;
        unsigned long long* ts_ = (unsigned long long*)(p.ws + W_TS);
        if (tid == 0 && item == probe_items[PROF_SEL - 100] + 1 + 100000) ts_[1] = 0;
        if (tid == 0) { if (prof_prev_ == probe_items[PROF_SEL - 100]) ts_[1] = __builtin_amdgcn_s_memrealtime(); if (item == probe_items[PROF_SEL - 100]) ts_[0] = __builtin_amdgcn_s_memrealtime(); }
        prof_prev_ = item; }
#endif
#if PROF_SEL >= 112 && PROF_SEL <= 116
      { constexpr int marks[5] = {Q_RW + Q_SA, Q_RW + Q_SA + 256, Q_RW + Q_SA + Q_PA, Q_RW + Q_SA + Q_PA + Q_MA, Q_RW + Q_SA + Q_PA + Q_MA + 64};
        if (tid == 0 && item == marks[PROF_SEL - 112]) ((unsigned long long*)(p.ws + W_TS))[1] = __builtin_amdgcn_s_memrealtime(); }
#endif
#if PROF_SEL == 110
      if (item >= Q_TOT && blockIdx.x == 0 && tid == 0) ((unsigned long long*)(p.ws + W_TS))[1] = __builtin_amdgcn_s_memrealtime();
#endif
#if PROF_SEL == 111
      if (item >= Q_TOT && tid == 0) { ((unsigned long long*)(p.ws + W_TS))[1] = __builtin_amdgcn_s_memrealtime(); }
#endif
      if (item >= Q_TOT) break;
      if (item < Q_RW) { rw::rwkv_prompt_item(lds, p, item, wid_s); continue; }
      if (!d_ready) {
        unsigned* dctr = (unsigned*)(p.ws + W_CTL) + 2; const unsigned nd = gridDim.x - NSCAN;
        if (tid == 0) { while (__hip_atomic_load(dctr, __ATOMIC_RELAXED, __HIP_MEMORY_SCOPE_AGENT) < nd) __builtin_amdgcn_s_sleep(8); }
        __syncthreads();
        __builtin_amdgcn_fence(__ATOMIC_ACQUIRE, "agent");
        d_ready = true;
      }
      item -= Q_RW;
      if (item < Q_SA + Q_PA) {
        const int grp = item / 3, sub3 = item - grp * 3;
        if (sub3 == 2) { sa::sample_attn_item(lds, p, wb + B_QS, ws + W_PO, ws + W_PML, grp, wid_s); continue; }
        item = grp * 2 + sub3;
        const int bh = item & 31, qb = 15 - (item >> 5);
        const int b = bh >> 3, h = bh & 7;
        const size_t row0 = (size_t)b * SEQ + 256 * qb;
        auto out = [&](int ql, int dv0, float4 v) {
          const size_t row = row0 + ql;
          const float4 g = pj4(wb + B_PROJ, row, C_GMLA + h * 64 + dv0);
          *(uint2*)(wb + B_MIX + row * 1024 + h * 64 + dv0) = make_uint2(pk2(v.x * silu(g.x), v.y * silu(g.y)), pk2(v.z * silu(g.z), v.w * silu(g.w)));
        };
        pa::attn_unit<96, true>(lds, wb + B_QP + row0 * 768 + h * 96, 768, wb + B_KP + (size_t)b * SEQ * 768 + h * 96, 768,
                                wb + B_VT + (size_t)(h * 64) * NP + (size_t)b * SEQ, NP, 4 * qb + 4, 256 * qb, out, wid_s);
        continue;
      }
      item -= Q_SA + Q_PA;
      if (item >= Q_MA) {
        item -= Q_MA;
        if (item < Q_RS) rw::rwkv_sample_item(lds, p, item, wid_s);
        else { ma::mem_sample_item(lds, p, item - Q_RS, wid_s); }
        continue;
      }
      {
        const int qb = item & 15, h = (item >> 4) & 3, b = item >> 6;
        const size_t row0 = (size_t)b * SEQ + 256 * qb;
        auto out = [&](int ql, int dv0, float4 v) {
          const size_t row = row0 + ql;
          const float4 g = pj4(wb + B_PROJ, row, C_GX + h * 64 + dv0);
          *(uint2*)(wb + B_MIX + row * 1024 + 768 + h * 64 + dv0) = make_uint2(pk2(v.x * silu(g.x), v.y * silu(g.y)), pk2(v.z * silu(g.z), v.w * silu(g.w)));
        };
        pa::attn_unit<64, false>(lds, wb + B_QX + row0 * 256 + h * 64, 256, wb + B_KM + (size_t)b * 65536 + h * 64, 256,
                                 wb + B_VMT + (size_t)b * 65536 + (size_t)(h * 64) * 256, 256, 4, 0, out, wid_s);
      }
    }
    __syncthreads();
  }
  }
  grid.sync();
  PROF_STAMP(4);
  { PH_IDS

  constexpr int NGB = 16;
  for (int it0 = (int)blockIdx.x >= NGB ? gw - NGB * 8 : NP * 2; it0 < NP * 2; it0 += NGW - NGB * 8) {
    float y[2], rr[2], kf_[2], vv_[2], g_[2]; size_t off[2]; int hh_[2]; size_t rowi[2];
#pragma unroll
    for (int u = 0; u < 2; ++u) {
      const int it = it0 * 2 + u; const int row = it >> 2, h = it & 3;
      rowi[u] = row; hh_[u] = h; off[u] = (size_t)row * 256 + h * 64 + lane;
      y[u] = ws[W_Y + off[u]]; rr[u] = ws[W_R + off[u]]; kf_[u] = ws[W_KF + off[u]]; vv_[u] = ws[W_VV + off[u]];
      g_[u] = pj(wb + B_PROJ, (size_t)row, C_GRWKV + h * 64 + lane);
    }
#pragma unroll
    for (int u = 0; u < 2; ++u) {
      const int h = hh_[u];
      const float mean = wave_sum_fast(y[u]) * (1.f / 64.f), d = y[u] - mean, var = wave_sum_fast(d * d) * (1.f / 64.f);
      const float yn = d * rsqrtf(var + GN_EPS) * p.lnx_g[h * 64 + lane] + p.lnx_b[h * 64 + lane];
      const float bsum = wave_sum_fast(rr[u] * kf_[u] * p.r_k[h * 64 + lane]);
      const float o = yn + bsum * vv_[u];
      wb[B_MIX + rowi[u] * 1024 + 512 + h * 64 + lane] = (bf16)f2bf(o * silu(g_[u]));
    }
  }
  {
    pg8::Gemm g{wb + B_MIX + (size_t)NP * 1024, wb + B_WOUT, NS, 1024, 1024}; pg8::StaticOrder S; S.init(NS, 1024, (int)gridDim.x, (int)blockIdx.x);
    pg8::EpiF32 E{p.out + O_YS, 1024, 1024, 0, 0, p.x_sample, p.x_sample, NS};
    pg8::gemm_phase<pg8::EpiF32, pg8::StaticOrder, true, true>((PG8_LAS unsigned char*)lds, g, S, E, wid_s);
  }
  }
  grid.sync();
  PROF_STAMP(5);
  { PH_IDS
  for (int r = NP + gw; r < NT; r += NGW) {
    float* y = p.out + (size_t)r * 1024;
    float v[16]; float ss = 0.f;
#pragma unroll
    for (int i = 0; i < 16; ++i) { v[i] = y[lane + 64 * i]; ss += v[i] * v[i]; }
    const float rs = rsqrtf(wave_sum_fast(ss) * (1.f / 1024.f) + RMS_EPS);
#pragma unroll
    for (int i = 0; i < 16; ++i) y[lane + 64 * i] = v[i] * rs * p.final_g[lane + 64 * i];
  }
  {
    pg8::Gemm g{wb + B_MIX, wb + B_WOUT, NP, 1024, 1024}; pg8::StaticOrder S; S.init(NP, 1024, (int)gridDim.x, (int)blockIdx.x);
    pg8::EpiRmsOut E{p.x_prompt, p.out, p.final_g, ws + W_XB, (unsigned*)(ws + W_CTL) + 192, RMS_EPS};
    pg8::gemm_phase<pg8::EpiRmsOut, pg8::StaticOrder, false, true>((PG8_LAS unsigned char*)lds, g, S, E, wid_s);
  }
#if PROF_SEL >= 0
  grid.sync();
  PROF_STAMP(6);
#endif
#if PROF_SEL >= 0
    if (blockIdx.x == 0 && tid == 0) {
      unsigned long long* ts_ = (unsigned long long*)(p.ws + W_TS);
      asm volatile("s_waitcnt vmcnt(0) lgkmcnt(0)" ::: "memory");
      __builtin_amdgcn_fence(__ATOMIC_ACQUIRE, "agent");
      const float us_ = (float)(ts_[1] - ts_[0]) * 0.01f;
      p.out[0] += us_ * 0.01f;
    }
#endif
  }
#undef PH_IDS
}

extern "C" void kernel_launch(void* const* d_in, const int* in_sizes, int n_in, void* d_out,
                              int out_size, void* d_ws, size_t ws_size, hipStream_t stream) {
  static int grid_blocks = 0;
  if (!grid_blocks) {
    int dev = 0, cus = 0, per_cu = 0;
    (void)hipGetDevice(&dev);
    (void)hipDeviceGetAttribute(&cus, hipDeviceAttributeMultiprocessorCount, dev);
    (void)hipFuncSetAttribute((const void*)fwd_megakernel, hipFuncAttributeMaxDynamicSharedMemorySize, LDS_BYTES);
    (void)hipOccupancyMaxActiveBlocksPerMultiprocessor(&per_cu, fwd_megakernel, 512, LDS_BYTES);
    if (per_cu < 1) per_cu = 1;
    grid_blocks = cus;
    if (ws_size < WS_BYTES) fprintf(stderr, "workspace too small: %zu < %zu\n", ws_size, (size_t)WS_BYTES);
  }
  Params p{};
  const float** pf = (const float**)&p;
  (void)pf;
  p.x_prompt = (const float*)d_in[0]; p.x_sample = (const float*)d_in[1]; p.mem_prompt = (const float*)d_in[2];
  p.cache_ckv = (const float*)d_in[3]; p.cache_kpe = (const float*)d_in[4]; p.page_table = (const int*)d_in[5];
  p.state_wkv = (const float*)d_in[6]; p.state_shift = (const float*)d_in[7]; p.cache_mem_k = (const float*)d_in[8];
  p.cache_mem_v = (const float*)d_in[9]; p.ln_g = (const float*)d_in[10]; p.w_in = (const float*)d_in[11];
  p.q_norm_g = (const float*)d_in[12]; p.kv_norm_g = (const float*)d_in[13]; p.w_uq = (const float*)d_in[14];
  p.w_uk = (const float*)d_in[15]; p.w_uv = (const float*)d_in[16]; p.shift_mu = (const float*)d_in[17];
  p.w0 = (const float*)d_in[18]; p.w_up = (const float*)d_in[19]; p.a0 = (const float*)d_in[20]; p.a_up = (const float*)d_in[21];
  p.k_k = (const float*)d_in[22]; p.k_a = (const float*)d_in[23]; p.r_k = (const float*)d_in[24]; p.lnx_g = (const float*)d_in[25];
  p.lnx_b = (const float*)d_in[26]; p.mem_norm_g = (const float*)d_in[27]; p.w_mem_kv = (const float*)d_in[28];
  p.w_out = (const float*)d_in[29]; p.final_g = (const float*)d_in[30];
  p.out = (float*)d_out; p.ws = (float*)d_ws;
  void* args[] = {&p};
  hipError_t e = hipLaunchCooperativeKernel((void*)fwd_megakernel, dim3(grid_blocks), dim3(512), args, LDS_BYTES, stream);
  if (e != hipSuccess) fprintf(stderr, "cooperative launch failed: %s (grid %d)\n", hipGetErrorString(e), grid_blocks);
}
```

```cpp
#include <hip/hip_runtime.h>
#ifndef PROF_SEL
#define PROF_SEL -1
#endif
#include <hip/hip_cooperative_groups.h>
#include <cstdio>
#include <cstdint>
namespace cg = cooperative_groups;

__device__ __forceinline__ int mk_tid(int wid_s) { int z; asm volatile("s_mov_b32 %0, 0" : "=s"(z)); return wid_s * 64 + (int)__builtin_amdgcn_mbcnt_hi(~0u, __builtin_amdgcn_mbcnt_lo(~0u, (unsigned)z)); }
namespace pg8 {
#define PG8_LAS __attribute__((address_space(3)))
typedef unsigned short bf16_t;
typedef short bf16x8 __attribute__((ext_vector_type(8)));
typedef float f32x4 __attribute__((ext_vector_type(4)));
typedef unsigned u32x4 __attribute__((ext_vector_type(4)));
constexpr int BM = 256, BK = 64, HALF = 128, HTB = HALF * BK * 2  , STAGE_BYTES = 8 * HTB, NXCD = 8, WGM = 8;

__host__ __device__ __forceinline__ int lds_byte(int r, int c) { const int st = (r >> 4) * 2 + (c >> 5), rr = r & 15, cc = c & 31, ob = rr * 64 + cc * 2; return st * 1024 + (ob ^ (((ob >> 9) & 1) << 5)); }
__host__ __device__ __forceinline__ void stage_rc(int b, int& R, int& C) { const int st = b / 1024, sb = b % 1024, swz = sb ^ (((sb >> 9) & 1) << 5); R = (st >> 1) * 16 + swz / 64; C = (st & 1) * 32 + (swz % 64) / 2; }
__host__ __device__ __forceinline__ int perm32(int rho) { const int n = rho >> 4, i = rho & 15; return 8 * (i >> 2) + 4 * n + (i & 3); }

struct Unit { int pm, pn; };
struct Gemm { const bf16_t* A; const bf16_t* Bt; int M, N, K; };

struct StaticOrder {
    int nM, nN, nwg, G, c;
    __host__ __device__ void init(int M, int N, int G_, int c_) { nM = M / BM; nN = N / BM; nwg = nM * nN; G = G_; c = c_; }
    __host__ __device__ bool next(int i, Unit& u) const {
        const long L = (long)i * G + c; if (L >= nwg) return false;
        int wgid = (int)L; { const int q = nwg / NXCD, r = nwg % NXCD, xcd = wgid % NXCD, off = wgid / NXCD; wgid = (xcd < r ? xcd * (q + 1) : r * (q + 1) + (xcd - r) * q) + off; }
        const int nig = WGM * nN, gid = wgid / nig, fm = gid * WGM, gsz = (nM - fm) < WGM ? (nM - fm) : WGM;
        u.pm = fm + ((wgid % nig) % gsz); u.pn = (wgid % nig) / gsz; return true;
    }
    __device__ __forceinline__ void a_ready(const Unit&) const {}
    __device__ __forceinline__ void done(const Unit&) const {}
};
__device__ __forceinline__ unsigned cvt_pk_bf16(float lo, float hi) { unsigned r; asm volatile("v_cvt_pk_bf16_f32 %0, %1, %2" : "=v"(r) : "v"(lo), "v"(hi)); return r; }
typedef float f32x2 __attribute__((ext_vector_type(2)));
template <class Epi, class Sched, bool ALIGN_EPI = false, bool SP2 = false>
__device__ __forceinline__ void gemm_phase(PG8_LAS unsigned char* lds, const Gemm g, const Sched& S, const Epi& E, int wid_s) {
    const int tid = mk_tid(wid_s), wid = wid_s, lane = tid & 63, wr = wid >> 2, wc = wid & 3, fr = lane & 15, fq = lane >> 4;
    const int K = g.K, nt = K / BK;
    unsigned voffA[2], voffB[2];
#pragma unroll
    for (int i = 0; i < 2; ++i) { int R, C; stage_rc(tid * 16 + i * 8192, R, C); const int Rb = Epi::PERM ? ((R & ~31) + perm32(R & 31)) : R;
        voffA[i] = (unsigned)(R * K + C) * 2u; voffB[i] = (unsigned)(Rb * K + C) * 2u; }
    const size_t kstep = (size_t)(BK * 2);
    const size_t hstep = (size_t)HALF * K * 2;
    const size_t tstep = 2 * hstep;
    const unsigned ldsw = (unsigned)wid * 1024u;
    const int aoff = lds_byte(wr * 64 + fr, fq * 8), boff = lds_byte(wc * 32 + fr, fq * 8);
#define PG8_SA(b, h) (((b) * 2 + (h)) * HTB)
#define PG8_SB(b, h) ((4 + (b) * 2 + (h)) * HTB)
#define PG8_STAGE(bufoff, gbase, voff) do { _Pragma("unroll") for (int _i = 0; _i < 2; ++_i) \
        __builtin_amdgcn_global_load_lds((const unsigned*)((const char*)(gbase) + (voff)[_i]), (PG8_LAS unsigned*)(lds + (bufoff) + ldsw + _i * 8192), 16, 0, 0); } while (0)
#define PG8_LDA(dst, b, h) do { _Pragma("unroll") for (int m = 0; m < 4; ++m) _Pragma("unroll") for (int k = 0; k < 2; ++k) dst[m][k] = *(const PG8_LAS bf16x8*)(lds + PG8_SA(b, h) + aoff + m * 2048 + k * 1024); } while (0)
#define PG8_LDB(dst, b, h) do { _Pragma("unroll") for (int n = 0; n < 2; ++n) _Pragma("unroll") for (int k = 0; k < 2; ++k) dst[n][k] = *(const PG8_LAS bf16x8*)(lds + PG8_SB(b, h) + boff + n * 2048 + k * 1024); } while (0)
#define PG8_MMA(ai, bj, At, Bt) do { __builtin_amdgcn_s_setprio(1); _Pragma("unroll") for (int m = 0; m < 4; ++m) _Pragma("unroll") for (int n = 0; n < 2; ++n) _Pragma("unroll") for (int k = 0; k < 2; ++k) \
        acc[ai][bj][m][n] = __builtin_amdgcn_mfma_f32_16x16x32_bf16(Bt[n][k], At[m][k], acc[ai][bj][m][n], 0, 0, 0); __builtin_amdgcn_s_setprio(0); } while (0)
#define PG8_WAIT_V(n) asm volatile("s_waitcnt vmcnt(" #n ")" ::: "memory")
#define PG8_WAIT_L(n) asm volatile("s_waitcnt lgkmcnt(" #n ")" ::: "memory")
#define PG8_BAR __builtin_amdgcn_s_barrier()
#define PG8_SCHED __builtin_amdgcn_sched_barrier(0)
    Unit cur, nxt; int ui = 0;
    if (!S.next(0, cur)) return;
    f32x4 acc[2][2][4][2];
#pragma unroll
    for (int a = 0; a < 2; ++a)
#pragma unroll
        for (int b = 0; b < 2; ++b)
#pragma unroll
            for (int m = 0; m < 4; ++m)
#pragma unroll
                for (int n = 0; n < 2; ++n) acc[a][b][m][n] = (f32x4){0.f, 0.f, 0.f, 0.f};
    bf16x8 At[4][2], B0[2][2], B1[2][2];
    const char* cA = (const char*)g.A + (size_t)cur.pm * tstep; const char* cB = (const char*)g.Bt + (size_t)cur.pn * tstep;
    S.a_ready(cur);
    if constexpr (SP2) {
        PG8_STAGE(PG8_SB(0, 0), cB, voffB); PG8_STAGE(PG8_SB(0, 1), cB + hstep, voffB); PG8_STAGE(PG8_SA(0, 0), cA, voffA); PG8_STAGE(PG8_SA(0, 1), cA + hstep, voffA);
        if (wr == 1) PG8_BAR;
        PG8_WAIT_V(2); PG8_BAR;
        PG8_STAGE(PG8_SB(1, 0), cB + kstep, voffB); PG8_STAGE(PG8_SA(1, 0), cA + kstep, voffA); PG8_STAGE(PG8_SB(1, 1), cB + hstep + kstep, voffB);
        PG8_WAIT_V(6); PG8_BAR;
    } else {
        PG8_STAGE(PG8_SB(0, 0), cB, voffB); PG8_STAGE(PG8_SA(0, 0), cA, voffA); PG8_STAGE(PG8_SB(0, 1), cB + hstep, voffB); PG8_STAGE(PG8_SA(0, 1), cA + hstep, voffA);
        if (wr == 1) PG8_BAR;
        PG8_WAIT_V(4); PG8_BAR;
        PG8_STAGE(PG8_SB(1, 0), cB + kstep, voffB); PG8_STAGE(PG8_SA(1, 0), cA + kstep, voffA); PG8_STAGE(PG8_SB(1, 1), cB + hstep + kstep, voffB);
        PG8_WAIT_V(6); PG8_BAR;
    }
    for (;;) {
        const bool has_next = S.next(ui + 1, nxt);
        const char* nA = has_next ? (const char*)g.A + (size_t)nxt.pm * tstep : cA; const char* nB = has_next ? (const char*)g.Bt + (size_t)nxt.pn * tstep : cB;
        for (int t = 0; t < nt; t += 2) {
            const bool last = (t == nt - 2);
            const char* a1 = cA + (size_t)(t + 1) * kstep;
            const char* a2 = last ? nA : cA + (size_t)(t + 2) * kstep; const char* b2 = last ? nB : cB + (size_t)(t + 2) * kstep;
            const char* a3 = a2 + kstep; const char* b3 = b2 + kstep;
            if (last && has_next) S.a_ready(nxt);
            if constexpr (SP2) {
            PG8_LDB(B0, 0, 0); PG8_LDB(B1, 0, 1); PG8_SCHED; PG8_LDA(At, 0, 0); PG8_STAGE(PG8_SA(1, 1), a1 + hstep, voffA);
            PG8_WAIT_V(8); PG8_WAIT_L(0); PG8_BAR; PG8_MMA(0, 0, At, B0); PG8_MMA(0, 1, At, B1); PG8_BAR; PG8_SCHED;
            PG8_LDA(At, 0, 1); PG8_STAGE(PG8_SB(0, 0), b2, voffB); PG8_STAGE(PG8_SB(0, 1), b2 + hstep, voffB); PG8_STAGE(PG8_SA(0, 0), a2, voffA);
            PG8_WAIT_V(8); PG8_WAIT_L(0); PG8_BAR; PG8_MMA(1, 0, At, B0); PG8_MMA(1, 1, At, B1); PG8_BAR; PG8_SCHED;
            PG8_LDB(B0, 1, 0); PG8_LDB(B1, 1, 1); PG8_SCHED; PG8_LDA(At, 1, 0); PG8_STAGE(PG8_SA(0, 1), a2 + hstep, voffA);
            PG8_WAIT_V(8); PG8_WAIT_L(0); PG8_BAR; PG8_MMA(0, 0, At, B0); PG8_MMA(0, 1, At, B1); PG8_BAR; PG8_SCHED;
            PG8_LDA(At, 1, 1); PG8_STAGE(PG8_SB(1, 0), b3, voffB); PG8_STAGE(PG8_SB(1, 1), b3 + hstep, voffB); PG8_STAGE(PG8_SA(1, 0), a3, voffA);
            PG8_WAIT_V(8); PG8_WAIT_L(0); PG8_BAR; PG8_MMA(1, 0, At, B0); PG8_MMA(1, 1, At, B1); PG8_BAR; PG8_SCHED;
            } else {
            PG8_LDB(B0, 0, 0); PG8_SCHED; PG8_LDA(At, 0, 0); PG8_STAGE(PG8_SA(1, 1), a1 + hstep, voffA);
            PG8_WAIT_L(8); PG8_BAR; PG8_WAIT_L(0); PG8_MMA(0, 0, At, B0); PG8_BAR; PG8_SCHED;
            PG8_LDB(B1, 0, 1); PG8_STAGE(PG8_SB(0, 0), b2, voffB);
            PG8_BAR; PG8_WAIT_L(0); PG8_MMA(0, 1, At, B1); PG8_BAR;
            PG8_LDA(At, 0, 1); PG8_STAGE(PG8_SA(0, 0), a2, voffA);
            PG8_BAR; PG8_WAIT_L(0); PG8_MMA(1, 0, At, B0); PG8_BAR; PG8_SCHED;
            PG8_STAGE(PG8_SB(0, 1), b2 + hstep, voffB);
            PG8_WAIT_V(6); PG8_BAR; PG8_MMA(1, 1, At, B1); PG8_BAR;
            PG8_LDB(B0, 1, 0); PG8_SCHED; PG8_LDA(At, 1, 0); PG8_STAGE(PG8_SA(0, 1), a2 + hstep, voffA);
            PG8_WAIT_L(8); PG8_BAR; PG8_WAIT_L(0); PG8_MMA(0, 0, At, B0); PG8_BAR; PG8_SCHED;
            PG8_LDB(B1, 1, 1); PG8_STAGE(PG8_SB(1, 0), b3, voffB);
            PG8_BAR; PG8_WAIT_L(0); PG8_MMA(0, 1, At, B1); PG8_BAR;
            PG8_LDA(At, 1, 1); PG8_STAGE(PG8_SA(1, 0), a3, voffA);
            PG8_BAR; PG8_WAIT_L(0); PG8_MMA(1, 0, At, B0); PG8_BAR; PG8_SCHED;
            PG8_STAGE(PG8_SB(1, 1), b3 + hstep, voffB);
            PG8_WAIT_V(6); PG8_BAR; PG8_MMA(1, 1, At, B1); PG8_BAR;
            }
        }
        if constexpr (ALIGN_EPI) { if (wr == 0) PG8_BAR; }
        if constexpr (!Epi::AFTER_DRAIN) { E(acc, cur, wr, wc, fr, fq); S.done(cur); }
        if (!has_next) break;
#pragma unroll
        for (int a = 0; a < 2; ++a)
#pragma unroll
            for (int b = 0; b < 2; ++b)
#pragma unroll
                for (int m = 0; m < 4; ++m)
#pragma unroll
                    for (int n = 0; n < 2; ++n) acc[a][b][m][n] = (f32x4){0.f, 0.f, 0.f, 0.f};
        cur = nxt; cA = nA; cB = nB; ++ui;
        if constexpr (ALIGN_EPI) { if (wr == 1) PG8_BAR; }
    }
    PG8_WAIT_V(0);
    if constexpr (!ALIGN_EPI) { if (wr == 0) PG8_BAR; }
    PG8_BAR;
    if constexpr (Epi::AFTER_DRAIN) { E.fused(acc, cur, wr, wc, fr, fq, lds, wid, lane); S.done(cur); }
#undef PG8_SA
#undef PG8_SB
#undef PG8_STAGE
#undef PG8_LDA
#undef PG8_LDB
#undef PG8_MMA
#undef PG8_WAIT_V
#undef PG8_WAIT_L
#undef PG8_BAR
#undef PG8_SCHED
}
}

namespace pg8 {
struct EpiF32 {
  static constexpr bool PERM = false, AFTER_DRAIN = false;
  float* C; int ldc; int ncols; int split_cols; size_t split_stride; const float* r0; const float* r1; int nr0;
  __device__ __forceinline__ void operator()(const f32x4 (&acc)[2][2][4][2], const Unit& u, int wr, int wc, int fr0, int fq0) const {
    int fr = fr0, fq = fq0; asm volatile("" : "+v"(fr), "+v"(fq));
    const int row0 = u.pm * BM + wr * 64 + fr; int colt = u.pn * BM; float* base = C;
    if (split_cols) { const int t = colt / split_cols; base += (size_t)t * split_stride; colt -= t * split_cols; }
    const int col0 = colt + wc * 32 + 4 * fq;
#pragma unroll
    for (int ai = 0; ai < 2; ++ai)
#pragma unroll
      for (int m = 0; m < 4; ++m) {
        const int row = row0 + ai * HALF + m * 16;
        const float* rr = r0 ? (row < nr0 ? r0 + (size_t)row * ldc : r1 + (size_t)(row - nr0) * ldc) : nullptr;
#pragma unroll
        for (int bj = 0; bj < 2; ++bj)
#pragma unroll
          for (int n = 0; n < 2; ++n) {
            const int col = col0 + bj * HALF + n * 16;
            if (col < ncols) { f32x4 v = acc[ai][bj][m][n]; if (rr) v += *(const f32x4*)(rr + col); *(f32x4*)(base + (size_t)row * ldc + col) = v; }
          }
        asm volatile("" ::: "memory");
      }
  }
};
}

constexpr int DM = 1024, BATCH = 4, SEQ = 4096, DB = 128, DT = 8, PAST = 8192, PAGE = 128, NPG = 64, NMEM = 256;
constexpr int NP = BATCH * SEQ, NS = DB * DT, NT = NP + NS;
constexpr int INC = 2592;
constexpr int C_CQ = 0, C_CKV = 256, C_KR = 384, C_GMLA = 416, C_Z = 928, C_GRWKV = 1824, C_QX = 2080, C_GX = 2336;
constexpr float MLA_SCALE = 0.10206207261596575f;
constexpr float X_SCALE = 0.125f;
constexpr float RMS_EPS = 1e-6f, GN_EPS = 64e-5f;
constexpr size_t O_YP = 0, O_YS = 16777216, O_CKVP = 17825792, O_KPEP = 19922944, O_WKVP = 20447232, O_SHP = 20512768,
                 O_MKP = 20516352, O_MVP = 20778496, O_CKVS = 21040640, O_KPES = 21171712, O_WKVS = 21204480, O_SHS = 23301632;
constexpr size_t W_H = 0;
constexpr size_t W_HM = W_H + (size_t)NT * 1024;
constexpr size_t W_PROJ = W_HM + (size_t)1024 * 1024;
constexpr size_t W_CQN = W_PROJ + (size_t)NT * INC;
constexpr size_t W_Q = W_CQN + (size_t)NT * 256;
constexpr size_t W_KN = W_Q + (size_t)NT * 768;
constexpr size_t W_V = W_KN + (size_t)NP * 512;
constexpr size_t W_QLAT = W_V + (size_t)NP * 512;
constexpr size_t W_OLAT = W_QLAT + (size_t)NS * 1024;
constexpr size_t W_R = W_OLAT + (size_t)NS * 1024;
constexpr size_t W_W = W_R + (size_t)NT * 256;
constexpr size_t W_KF = W_W + (size_t)NT * 256;
constexpr size_t W_VV = W_KF + (size_t)NT * 256;
constexpr size_t W_KK = W_VV + (size_t)NT * 256;
constexpr size_t W_BB = W_KK + (size_t)NT * 256;
constexpr size_t W_MIX = W_BB + (size_t)NT * 256;
constexpr size_t W_PO = W_MIX + (size_t)NT * 1024;
constexpr size_t W_PML = W_PO + (size_t)256 * 64 * 128;
constexpr size_t W_Y = W_PML + (size_t)256 * 64 * 2;
constexpr size_t W_CTL = W_Y + (size_t)NT * 256;
constexpr size_t W_CS = W_CTL + 256;
constexpr size_t W_XB = W_CS + (size_t)4104 * 32;
constexpr size_t W_TS = W_XB + (size_t)NP * 4;
constexpr size_t W_END = W_TS + 64;
constexpr int INCP = 2816;
constexpr size_t B_H = 0;
constexpr size_t B_HM = B_H + (size_t)NT * 1024;
constexpr size_t B_WIN = B_HM + (size_t)1024 * 1024;
constexpr size_t B_WMEM = B_WIN + (size_t)INCP * 1024;
constexpr size_t B_WOUT = B_WMEM + (size_t)512 * 1024;
constexpr size_t B_MIX = B_WOUT + (size_t)1024 * 1024;
constexpr size_t B_QP = B_MIX + (size_t)NT * 1024;
constexpr size_t B_KP = B_QP + (size_t)NP * 768;
constexpr size_t B_VT = B_KP + (size_t)NP * 768;
constexpr size_t B_QS = B_VT + (size_t)512 * NP;
constexpr size_t B_QX = B_QS + (size_t)NS * 8 * 160;
constexpr size_t B_KM = B_QX + (size_t)NP * 256;
constexpr size_t B_VMT = B_KM + (size_t)4 * 256 * 256;
constexpr size_t B_CQN = B_VMT + (size_t)4 * 256 * 256;
constexpr size_t B_CKVN = B_CQN + (size_t)NT * 256;
constexpr size_t B_WUQ = B_CKVN + (size_t)NP * 128;
constexpr size_t B_WQL = B_WUQ + (size_t)768 * 256;
constexpr size_t B_WUK = B_WQL + (size_t)1024 * 256;
constexpr size_t B_WUV = B_WUK + (size_t)512 * 128;
constexpr size_t B_OLAT = B_WUV + (size_t)512 * 128;
constexpr size_t B_WUVBD = B_OLAT + (size_t)NS * 1024;
constexpr size_t B_PROJ = B_WUVBD + (size_t)512 * 1024;
constexpr size_t B_END = B_PROJ + (size_t)NT * INC;
constexpr size_t WS_BYTES = W_END * 4 + B_END * 2;
constexpr int LDS_BYTES = 147456;
constexpr int NSCAN = 32;

struct Params {
  const float* x_prompt; const float* x_sample; const float* mem_prompt; const float* cache_ckv; const float* cache_kpe;
  const int* page_table; const float* state_wkv; const float* state_shift; const float* cache_mem_k; const float* cache_mem_v;
  const float* ln_g; const float* w_in; const float* q_norm_g; const float* kv_norm_g; const float* w_uq; const float* w_uk;
  const float* w_uv; const float* shift_mu; const float* w0; const float* w_up; const float* a0; const float* a_up;
  const float* k_k; const float* k_a; const float* r_k; const float* lnx_g; const float* lnx_b; const float* mem_norm_g;
  const float* w_mem_kv; const float* w_out; const float* final_g;
  float* out; float* ws;
};

__device__ __forceinline__ unsigned f2bf(float f);
__device__ __forceinline__ unsigned pk2(float lo, float hi);
typedef unsigned short bf16;

__device__ __forceinline__ float bf2f(unsigned short b) { return __uint_as_float((unsigned)b << 16); }
__device__ __forceinline__ float pj(const unsigned short* P, size_t row, int col) { return bf2f(P[row * INC + col]); }
__device__ __forceinline__ float4 pj4(const unsigned short* P, size_t row, int col) {
  const uint2 w = *(const uint2*)(P + row * INC + col);
  return make_float4(__uint_as_float(w.x << 16), __uint_as_float(w.x & 0xffff0000u), __uint_as_float(w.y << 16), __uint_as_float(w.y & 0xffff0000u));
}
__device__ __forceinline__ float wave_sum(float v) {
#pragma unroll
  for (int o = 1; o < 64; o <<= 1) v += __shfl_xor(v, o);
  return v;
}

__device__ __forceinline__ float wave_sum_fast(float v) {
  v += __int_as_float(__builtin_amdgcn_update_dpp(0, __float_as_int(v), 0xB1, 0xF, 0xF, true));
  v += __int_as_float(__builtin_amdgcn_update_dpp(0, __float_as_int(v), 0x4E, 0xF, 0xF, true));
  v += __int_as_float(__builtin_amdgcn_update_dpp(0, __float_as_int(v), 0x141, 0xF, 0xF, true));
  v += __int_as_float(__builtin_amdgcn_update_dpp(0, __float_as_int(v), 0x140, 0xF, 0xF, true));
  v += __int_as_float(__builtin_amdgcn_update_dpp(0, __float_as_int(v), 0x142, 0xA, 0xF, false));
  v += __int_as_float(__builtin_amdgcn_update_dpp(0, __float_as_int(v), 0x143, 0xC, 0xF, false));
  return __int_as_float(__builtin_amdgcn_readlane(__float_as_int(v), 63));
}
__device__ __forceinline__ float wave_max(float v) {
#pragma unroll
  for (int o = 1; o < 64; o <<= 1) v = fmaxf(v, __shfl_xor(v, o));
  return v;
}
__device__ __forceinline__ float silu(float x) { return x / (1.f + expf(-x)); }
__device__ __forceinline__ const float* xrow(const Params& p, int row) {
  return row < NP ? p.x_prompt + (size_t)row * DM : p.x_sample + (size_t)(row - NP) * DM;
}
__device__ __forceinline__ float* ckv_out_row(const Params& p, int row) {
  return row < NP ? p.out + O_CKVP + (size_t)row * 128 : p.out + O_CKVS + (size_t)(row - NP) * 128;
}
__device__ __forceinline__ float* kpe_out_row(const Params& p, int row) {
  return row < NP ? p.out + O_KPEP + (size_t)row * 32 : p.out + O_KPES + (size_t)(row - NP) * 32;
}


namespace pg8 {
typedef unsigned u32x2 __attribute__((ext_vector_type(2)));
template <class F> struct EpiBf16F {
  static constexpr bool PERM = true, AFTER_DRAIN = false;
  F f; float scale;
  __device__ __forceinline__ void operator()(const f32x4 (&acc)[2][2][4][2], const Unit& u, int wr, int wc, int fr, int fq) const {
    int fr_ = fr, fq_ = fq; asm volatile("" : "+v"(fr_), "+v"(fq_));
    const int row0 = u.pm * BM + wr * 64 + fr_, col0 = u.pn * BM + wc * 32 + 8 * fq_;
#pragma unroll
    for (int ai = 0; ai < 2; ++ai)
#pragma unroll
      for (int m = 0; m < 4; ++m)
#pragma unroll
        for (int bj = 0; bj < 2; ++bj) {
          bf16_t* dst = f(row0 + ai * HALF + m * 16, col0 + bj * HALF);
          if (dst) { const f32x4 v0 = acc[ai][bj][m][0] * scale, v1 = acc[ai][bj][m][1] * scale;
            u32x4 w; w.x = cvt_pk_bf16(v0[0], v0[1]); w.y = cvt_pk_bf16(v0[2], v0[3]); w.z = cvt_pk_bf16(v1[0], v1[1]); w.w = cvt_pk_bf16(v1[2], v1[3]);
            *(u32x4*)dst = w; }
        }
  }
};
struct EpiQ {
  static constexpr bool PERM = false, AFTER_DRAIN = false;
  bf16_t* Qp; bf16_t* Qs; const float* CS; float scale; int np;
  __device__ __forceinline__ void operator()(const f32x4 (&acc)[2][2][4][2], const Unit& u, int wr, int wc, int fr0, int fq0) const {
    int fr = fr0, fq = fq0; asm volatile("" : "+v"(fr), "+v"(fq));
    const int row0 = u.pm * BM + wr * 64 + fr;
    if (u.pn < 2) {
      if (u.pm * BM >= np) return;
#pragma unroll
      for (int ai = 0; ai < 2; ++ai)
#pragma unroll
        for (int m = 0; m < 4; ++m) {
          const int row = row0 + ai * HALF + m * 16;
#pragma unroll
          for (int bj = 0; bj < 2; ++bj)
#pragma unroll
            for (int n = 0; n < 2; ++n) {
              const int col = u.pn * BM + bj * HALF + wc * 32 + 16 * n + 4 * fq, head = col >> 6, d = col & 63;
              const f32x4 v = acc[ai][bj][m][n] * scale;
              *(u32x2*)(Qp + (size_t)row * 768 + head * 96 + d) = (u32x2){cvt_pk_bf16(v[0], v[1]), cvt_pk_bf16(v[2], v[3])};
            }
        }
    } else {
#pragma unroll
      for (int ai = 0; ai < 2; ++ai)
#pragma unroll
        for (int m = 0; m < 4; ++m) {
          const int row = row0 + ai * HALF + m * 16;
          const bool pr = row < np;
          const int pi = pr ? (row & 4095) : 4096 + ((row - np) & 7);
#pragma unroll
          for (int n = 0; n < 2; ++n) {
            const int head = 2 * wc + n, j = 4 * fq;
            const f32x4 cs0 = *(const f32x4*)(CS + ((size_t)pi * 16 + j) * 2), cs1 = *(const f32x4*)(CS + ((size_t)pi * 16 + j) * 2 + 4);
            const f32x4 x1 = acc[ai][0][m][n], x2 = acc[ai][1][m][n];
            f32x4 y1, y2;
            y1[0] = x1[0] * cs0[0] - x2[0] * cs0[1]; y2[0] = x2[0] * cs0[0] + x1[0] * cs0[1];
            y1[1] = x1[1] * cs0[2] - x2[1] * cs0[3]; y2[1] = x2[1] * cs0[2] + x1[1] * cs0[3];
            y1[2] = x1[2] * cs1[0] - x2[2] * cs1[1]; y2[2] = x2[2] * cs1[0] + x1[2] * cs1[1];
            y1[3] = x1[3] * cs1[2] - x2[3] * cs1[3]; y2[3] = x2[3] * cs1[2] + x1[3] * cs1[3];
            y1 = y1 * scale; y2 = y2 * scale;
            bf16_t* dst = pr ? Qp + (size_t)row * 768 + head * 96 + 64 + j : Qs + ((size_t)(row - np) * 8 + head) * 160 + 128 + j;
            *(u32x2*)dst = (u32x2){cvt_pk_bf16(y1[0], y1[1]), cvt_pk_bf16(y1[2], y1[3])};
            *(u32x2*)(dst + 16) = (u32x2){cvt_pk_bf16(y2[0], y2[1]), cvt_pk_bf16(y2[2], y2[3])};
          }
          asm volatile("" ::: "memory");
        }
    }
  }
};
}

namespace pg8 {
struct EpiGateBf16 {
  static constexpr bool PERM = true, AFTER_DRAIN = false;
  bf16_t* O; int ldo; const float* G; int ldg;
  __device__ __forceinline__ float sl(float x) const { return x / (1.f + __expf(-x)); }
  __device__ __forceinline__ void operator()(const f32x4 (&acc)[2][2][4][2], const Unit& u, int wr, int wc, int fr0, int fq0) const {
    int fr = fr0, fq = fq0; asm volatile("" : "+v"(fr), "+v"(fq));
    const int row0 = u.pm * BM + wr * 64 + fr, col0 = u.pn * BM + wc * 32 + 8 * fq;
#pragma unroll
    for (int ai = 0; ai < 2; ++ai)
#pragma unroll
      for (int m = 0; m < 4; ++m)
#pragma unroll
        for (int bj = 0; bj < 2; ++bj) {
          const int row = row0 + ai * HALF + m * 16, col = col0 + bj * HALF;
          const f32x4 g0 = *(const f32x4*)(G + (size_t)row * ldg + col), g1 = *(const f32x4*)(G + (size_t)row * ldg + col + 4);
          const f32x4 v0 = acc[ai][bj][m][0], v1 = acc[ai][bj][m][1];
          u32x4 w; w.x = cvt_pk_bf16(v0[0] * sl(g0[0]), v0[1] * sl(g0[1])); w.y = cvt_pk_bf16(v0[2] * sl(g0[2]), v0[3] * sl(g0[3]));
          w.z = cvt_pk_bf16(v1[0] * sl(g1[0]), v1[1] * sl(g1[1])); w.w = cvt_pk_bf16(v1[2] * sl(g1[2]), v1[3] * sl(g1[3]));
          *(u32x4*)(O + (size_t)row * ldo + col) = w;
          asm volatile("" ::: "memory");
        }
  }
};
}

namespace pg8 {
struct EpiRmsOut {
  static constexpr bool PERM = false, AFTER_DRAIN = true;
  const float* x; float* out; const float* gain; float* xbuf; unsigned* cnt; float eps;
  __device__ __forceinline__ void fused(f32x4 (&acc)[2][2][4][2], const Unit& u, int wr, int wc, int fr0, int fq0, PG8_LAS unsigned char* lds, int wid, int lane) const {
    int fr = fr0, fq = fq0; asm volatile("" : "+v"(fr), "+v"(fq));
    PG8_LAS float* P = (PG8_LAS float*)lds;
    PG8_LAS float* S = (PG8_LAS float*)(lds + 4096);
    const int col0 = u.pn * BM + wc * 32 + 4 * fq;
#pragma unroll
    for (int ai = 0; ai < 2; ++ai)
#pragma unroll
      for (int m = 0; m < 4; ++m) {
        const int rl = ai * HALF + wr * 64 + m * 16 + fr;
        const float* xr = x + (size_t)(u.pm * BM + rl) * 1024;
        float s = 0.f;
#pragma unroll
        for (int bj = 0; bj < 2; ++bj)
#pragma unroll
          for (int n = 0; n < 2; ++n) {
            const f32x4 v = acc[ai][bj][m][n] + *(const f32x4*)(xr + col0 + bj * HALF + n * 16);
            acc[ai][bj][m][n] = v; s += (v[0] * v[0] + v[1] * v[1]) + (v[2] * v[2] + v[3] * v[3]);
          }
        s += __shfl_xor(s, 16); s += __shfl_xor(s, 32);
        if (fq == 0) P[rl * 4 + wc] = s;
        asm volatile("" ::: "memory");
      }
    asm volatile("s_waitcnt lgkmcnt(0)" ::: "memory"); __builtin_amdgcn_s_barrier(); asm volatile("" ::: "memory");
    const int tid = wid * 64 + lane;
    if (tid < 256) {
      const float tot = (P[tid * 4] + P[tid * 4 + 1]) + (P[tid * 4 + 2] + P[tid * 4 + 3]);
      __hip_atomic_store((unsigned*)xbuf + ((size_t)(u.pm * BM + tid)) * 4 + u.pn, __float_as_uint(tot), __ATOMIC_RELAXED, __HIP_MEMORY_SCOPE_AGENT);
    }
    asm volatile("s_waitcnt vmcnt(0)" ::: "memory");
    if (tid < 256 && lane == 0) __hip_atomic_fetch_add(cnt + u.pm, 1u, __ATOMIC_RELAXED, __HIP_MEMORY_SCOPE_AGENT);
    if (wid == 0) {
      for (;;) {
        const unsigned c_ = (unsigned)__builtin_amdgcn_readfirstlane((int)__hip_atomic_load(cnt + u.pm, __ATOMIC_RELAXED, __HIP_MEMORY_SCOPE_AGENT));
        if (c_ >= 16u) break;
        __builtin_amdgcn_s_sleep(2);
      }
      __builtin_amdgcn_fence(__ATOMIC_ACQUIRE, "agent");
    }
    asm volatile("s_waitcnt vmcnt(0) lgkmcnt(0)" ::: "memory"); __builtin_amdgcn_s_barrier(); asm volatile("" ::: "memory");
    if (tid < 256) {
      unsigned* xb = (unsigned*)xbuf + ((size_t)(u.pm * BM + tid)) * 4;
      const float ssq = (__uint_as_float(__hip_atomic_load(xb, __ATOMIC_RELAXED, __HIP_MEMORY_SCOPE_AGENT)) + __uint_as_float(__hip_atomic_load(xb + 1, __ATOMIC_RELAXED, __HIP_MEMORY_SCOPE_AGENT))) +
                        (__uint_as_float(__hip_atomic_load(xb + 2, __ATOMIC_RELAXED, __HIP_MEMORY_SCOPE_AGENT)) + __uint_as_float(__hip_atomic_load(xb + 3, __ATOMIC_RELAXED, __HIP_MEMORY_SCOPE_AGENT)));
      S[tid] = 1.0f / sqrtf(ssq * (1.f / 1024.f) + eps);
    }
    asm volatile("s_waitcnt lgkmcnt(0)" ::: "memory"); __builtin_amdgcn_s_barrier(); asm volatile("" ::: "memory");
#pragma unroll
    for (int ai = 0; ai < 2; ++ai)
#pragma unroll
      for (int m = 0; m < 4; ++m) {
        const int rl = ai * HALF + wr * 64 + m * 16 + fr;
        const float rs = S[rl];
        float* orow = out + (size_t)(u.pm * BM + rl) * 1024;
#pragma unroll
        for (int bj = 0; bj < 2; ++bj)
#pragma unroll
          for (int n = 0; n < 2; ++n) {
            const int col = col0 + bj * HALF + n * 16;
            *(f32x4*)(orow + col) = acc[ai][bj][m][n] * rs * *(const f32x4*)(gain + col);
          }
        asm volatile("" ::: "memory");
      }
  }
};
}
#define LAS __attribute__((address_space(3)))
namespace pa {
typedef short bf16x8 __attribute__((ext_vector_type(8)));
typedef short s16x4 __attribute__((ext_vector_type(4)));
typedef float f32x16 __attribute__((ext_vector_type(16)));
typedef unsigned u32x4 __attribute__((ext_vector_type(4)));
typedef unsigned u32x2 __attribute__((ext_vector_type(2)));
typedef float f32x2_t __attribute__((ext_vector_type(2)));
typedef __bf16 bf16x2_t __attribute__((ext_vector_type(2)));
constexpr int KSTR = 208, VSTR = 136, KBYTES = 64 * KSTR, VBYTES = 64 * VSTR, STG = KBYTES + VBYTES;
__device__ __forceinline__ unsigned cvtpk(float lo, float hi) { f32x2_t v = {lo, hi}; bf16x2_t b = __builtin_convertvector(v, bf16x2_t); return __builtin_bit_cast(unsigned, b); }
__device__ __forceinline__ int crow(int r, int hi) { return (r & 3) + 8 * (r >> 2) + 4 * hi; }
__device__ __forceinline__ float swap_max(float v) { auto rr = __builtin_amdgcn_permlane32_swap(__float_as_uint(v), __float_as_uint(v), false, false); return fmaxf(__uint_as_float(rr[0]), __uint_as_float(rr[1])); }
__device__ __forceinline__ float swap_sum(float v) { auto rr = __builtin_amdgcn_permlane32_swap(__float_as_uint(v), __float_as_uint(v), false, false); return __uint_as_float(rr[0]) + __uint_as_float(rr[1]); }

template <int DQK, bool CAUSAL, class Out>
__device__ __forceinline__ void attn_unit(unsigned char* lds, const bf16* Qb, int qs, const bf16* Kb, int ks, const bf16* Vb, int vs, int ntiles, int qpos0, const Out& out, int wid_s) {
  const int tid = mk_tid(wid_s), lane = tid & 63, wid = wid_s, r32 = lane & 31, hi = lane >> 5;
  constexpr int CPR = DQK / 8, NKC = 64 * CPR, KS = DQK / 16;
  bf16x8 qf[KS];
#pragma unroll
  for (int s = 0; s < KS; ++s) qf[s] = *(const bf16x8*)(Qb + (size_t)(wid * 32 + r32) * qs + 16 * s + 8 * hi);
  struct Stg { u32x4 k0, k1, v; } sA, sB;
  const int kc0 = tid, kc1 = tid + 512;
  const int krow0 = kc0 / CPR, kcc0 = kc0 % CPR, krow1 = kc1 / CPR, kcc1 = kc1 % CPR;
  const int vdv = tid >> 3, vcc = tid & 7;
#define PA_GLOAD(S, t) do { (S).k0 = *(const u32x4*)(Kb + (size_t)(64 * (t) + krow0) * ks + kcc0 * 8); \
    if (kc1 < NKC) (S).k1 = *(const u32x4*)(Kb + (size_t)(64 * (t) + krow1) * ks + kcc1 * 8); \
    (S).v = *(const u32x4*)(Vb + (size_t)vdv * vs + 64 * (t) + vcc * 8); } while (0)
#define PA_LSTORE(S, buf) do { unsigned char* b_ = lds + (buf) * STG; *(u32x4*)(b_ + krow0 * KSTR + kcc0 * 16) = (S).k0; \
    if (kc1 < NKC) *(u32x4*)(b_ + krow1 * KSTR + kcc1 * 16) = (S).k1; \
    *(u32x2*)(b_ + KBYTES + vdv * VSTR + vcc * 16) = (u32x2){(S).v.x, (S).v.y}; *(u32x2*)(b_ + KBYTES + vdv * VSTR + vcc * 16 + 8) = (u32x2){(S).v.z, (S).v.w}; } while (0)
  PA_GLOAD(sA, 0); PA_LSTORE(sA, 0); if (ntiles > 1) PA_GLOAD(sB, 1); __syncthreads();
  f32x16 o0, o1;
#pragma unroll
  for (int r = 0; r < 16; ++r) { o0[r] = 0.f; o1[r] = 0.f; }
  float m = -1e30f, l = 0.f;
  const int qlo = qpos0 + 32 * wid;
  auto compute_tile = [&](int t) {
    const unsigned char* kb = lds + (t & 1) * STG; const unsigned char* vb = kb + KBYTES;
    const bool active = !CAUSAL || (64 * t <= qlo + 31);
    if (active) {
      f32x16 p0, p1;
#pragma unroll
      for (int r = 0; r < 16; ++r) { p0[r] = 0.f; p1[r] = 0.f; }
#pragma unroll
      for (int s = 0; s < KS; ++s) {
        const bf16x8 a0 = *(const bf16x8*)(kb + r32 * KSTR + (16 * s + 8 * hi) * 2);
        const bf16x8 a1 = *(const bf16x8*)(kb + (32 + r32) * KSTR + (16 * s + 8 * hi) * 2);
        p0 = __builtin_amdgcn_mfma_f32_32x32x16_bf16(a0, qf[s], p0, 0, 0, 0);
        p1 = __builtin_amdgcn_mfma_f32_32x32x16_bf16(a1, qf[s], p1, 0, 0, 0);
      }
      if (CAUSAL && (64 * t + 63 > qlo)) {
        const int q = qlo + r32;
#pragma unroll
        for (int r = 0; r < 16; ++r) { const int key = 64 * t + crow(r, hi); if (key > q) p0[r] = -1e30f; if (key + 32 > q) p1[r] = -1e30f; }
      }
      float mx = fmaxf(p0[0], p1[0]);
#pragma unroll
      for (int r = 1; r < 16; ++r) mx = fmaxf(mx, fmaxf(p0[r], p1[r]));
      mx = swap_max(mx);
      const float mn = fmaxf(m, mx), alpha = __builtin_amdgcn_exp2f(m - mn);
      m = mn;
      float ps = 0.f;
#pragma unroll
      for (int r = 0; r < 16; ++r) { p0[r] = __builtin_amdgcn_exp2f(p0[r] - mn); p1[r] = __builtin_amdgcn_exp2f(p1[r] - mn); ps += p0[r] + p1[r]; }
      l = l * alpha + ps;
#pragma unroll
      for (int r = 0; r < 16; ++r) { o0[r] *= alpha; o1[r] *= alpha; }
      bf16x8 pb[4];
#pragma unroll
      for (int k = 0; k < 4; ++k) {
        u32x4 w;
        if (k < 2) { w.x = cvtpk(p0[8 * k], p0[8 * k + 1]); w.y = cvtpk(p0[8 * k + 2], p0[8 * k + 3]); w.z = cvtpk(p0[8 * k + 4], p0[8 * k + 5]); w.w = cvtpk(p0[8 * k + 6], p0[8 * k + 7]); }
        else { const int kk = k - 2; w.x = cvtpk(p1[8 * kk], p1[8 * kk + 1]); w.y = cvtpk(p1[8 * kk + 2], p1[8 * kk + 3]); w.z = cvtpk(p1[8 * kk + 4], p1[8 * kk + 5]); w.w = cvtpk(p1[8 * kk + 6], p1[8 * kk + 7]); }
        pb[k] = __builtin_bit_cast(bf16x8, w);
      }
#pragma unroll
      for (int k = 0; k < 4; ++k) {
#pragma unroll
        for (int d = 0; d < 2; ++d) {
          const unsigned char* vp = vb + (32 * d + r32) * VSTR + (16 * k + 4 * hi) * 2;
          const u32x2 lo = *(const u32x2*)vp, hi2 = *(const u32x2*)(vp + 16);
          const u32x4 w = {lo.x, lo.y, hi2.x, hi2.y};
          const bf16x8 va = __builtin_bit_cast(bf16x8, w);
          if (d == 0) o0 = __builtin_amdgcn_mfma_f32_32x32x16_bf16(va, pb[k], o0, 0, 0, 0);
          else o1 = __builtin_amdgcn_mfma_f32_32x32x16_bf16(va, pb[k], o1, 0, 0, 0);
        }
      }
    }
  };
  for (int t = 0; t < ntiles; t += 2) {
    if (t + 2 < ntiles) PA_GLOAD(sA, t + 2);
    compute_tile(t);
    if (t + 1 < ntiles) PA_LSTORE(sB, (t + 1) & 1);
    __syncthreads();
    if (t + 1 < ntiles) {
      if (t + 3 < ntiles) PA_GLOAD(sB, t + 3);
      compute_tile(t + 1);
      if (t + 2 < ntiles) PA_LSTORE(sA, t & 1);
      __syncthreads();
    }
  }
#undef PA_GLOAD
#undef PA_LSTORE
  const float inv = 1.f / swap_sum(l);
#pragma unroll
  for (int g = 0; g < 4; ++g) {
    out(32 * wid + r32, 8 * g + 4 * hi, make_float4(o0[4 * g] * inv, o0[4 * g + 1] * inv, o0[4 * g + 2] * inv, o0[4 * g + 3] * inv));
    out(32 * wid + r32, 32 + 8 * g + 4 * hi, make_float4(o1[4 * g] * inv, o1[4 * g + 1] * inv, o1[4 * g + 2] * inv, o1[4 * g + 3] * inv));
  }
}
}

namespace sa {
using pa::bf16x8; using pa::f32x16; using pa::u32x4; using pa::u32x2; using pa::cvtpk; using pa::crow; using pa::swap_max; using pa::swap_sum;
typedef float f32x4 __attribute__((ext_vector_type(4)));
typedef short v4i16_t __attribute__((ext_vector_type(4)));
constexpr int KVSTR = 336, TK = 128, TILE = TK * KVSTR;
__device__ __forceinline__ void sample_attn_item(unsigned char* lds, const Params& p, const bf16* Qs, float* PO, float* PML, int item, int wid_s) {
  const int db = item >> 1, half = item & 1;
  const int tid = mk_tid(wid_s), lane = tid & 63, wid = wid_s, r32 = lane & 31, hi = lane >> 5;
  const int qt = wid >> 2, ks = wid & 3;
  bf16x8 qf[10];
#pragma unroll
  for (int s = 0; s < 10; ++s) qf[s] = *(const bf16x8*)(Qs + (size_t)(db * 64 + 32 * qt + r32) * 160 + 16 * s + 8 * hi);
  const int ntiles = 32 + half;
  f32x4 stA[8], spA[2], stB[8], spB[2];
  const f32x4 zero4 = {0.f, 0.f, 0.f, 0.f};
#define SA_GLOAD(st, sp, t) do { if ((t) < 32) { const int page_ = p.page_table[db * NPG + 32 * half + (t)]; \
      const f32x4* ck_ = (const f32x4*)(p.cache_ckv + (size_t)page_ * PAGE * 128); const f32x4* kp_ = (const f32x4*)(p.cache_kpe + (size_t)page_ * PAGE * 32); \
      _Pragma("unroll") for (int i_ = 0; i_ < 8; ++i_) st[i_] = __builtin_nontemporal_load(ck_ + tid + 512 * i_); \
      sp[0] = __builtin_nontemporal_load(kp_ + tid); sp[1] = __builtin_nontemporal_load(kp_ + tid + 512); \
    } else { const float* ck_ = p.out + O_CKVS + (size_t)db * 8 * 128; const float* kp_ = p.out + O_KPES + (size_t)db * 8 * 32; \
      st[0] = (tid < 256) ? *(const f32x4*)(ck_ + (size_t)tid * 4) : zero4; \
      _Pragma("unroll") for (int i_ = 1; i_ < 8; ++i_) st[i_] = zero4; \
      sp[0] = (tid < 64) ? *(const f32x4*)(kp_ + (size_t)tid * 4) : zero4; sp[1] = zero4; } } while (0)
#define SA_LSTORE(st, sp, buf) do { _Pragma("unroll") for (int i_ = 0; i_ < 8; ++i_) { const int f_ = tid + 512 * i_, key_ = f_ >> 5, c4_ = f_ & 31; \
      *(u32x2*)(lds + (buf) * TILE + key_ * KVSTR + c4_ * 8) = (u32x2){cvtpk(st[i_].x, st[i_].y), cvtpk(st[i_].z, st[i_].w)}; } \
    _Pragma("unroll") for (int i_ = 0; i_ < 2; ++i_) { const int f_ = tid + 512 * i_, key_ = f_ >> 3, c4_ = f_ & 7; \
      *(u32x2*)(lds + (buf) * TILE + key_ * KVSTR + 256 + c4_ * 8) = (u32x2){cvtpk(sp[i_].x, sp[i_].y), cvtpk(sp[i_].z, sp[i_].w)}; } } while (0)
#if PROF_SEL == 120 || PROF_SEL == 121 || PROF_SEL == 122
  if (item == 0 && tid == 0 && PROF_SEL != 121) ((unsigned long long*)(p.ws + W_TS))[0] = __builtin_amdgcn_s_memrealtime();
#endif
  SA_GLOAD(stA, spA, 0); SA_LSTORE(stA, spA, 0); SA_GLOAD(stB, spB, 1); __syncthreads();
  f32x16 o[4];
#pragma unroll
  for (int c = 0; c < 4; ++c)
#pragma unroll
    for (int r = 0; r < 16; ++r) o[c][r] = 0.f;
  float m = -1e30f, l = 0.f;
  const int tq = (32 * qt + r32) >> 3;
  auto compute_tile = [&](int t) {
    const unsigned char* kb = lds + (t & 1) * TILE + (32 * ks) * KVSTR;
    if (t < 32 || ks == 0) {
      f32x16 p0;
#pragma unroll
      for (int r = 0; r < 16; ++r) p0[r] = 0.f;
#pragma unroll
      for (int s = 0; s < 10; ++s) {
        const bf16x8 a0 = *(const bf16x8*)(kb + r32 * KVSTR + (16 * s + 8 * hi) * 2);
        p0 = __builtin_amdgcn_mfma_f32_32x32x16_bf16(a0, qf[s], p0, 0, 0, 0);
      }
      if (t == 32) {
#pragma unroll
        for (int r = 0; r < 16; ++r) { const int u = crow(r, hi); if (!(u < 8 && u <= tq)) p0[r] = -1e30f; }
      }
      float mx = p0[0];
#pragma unroll
      for (int r = 1; r < 16; ++r) mx = fmaxf(mx, p0[r]);
      mx = swap_max(mx);
      const float mn = fmaxf(m, mx), alpha = __builtin_amdgcn_exp2f(m - mn);
      m = mn;
      float ps = 0.f;
#pragma unroll
      for (int r = 0; r < 16; ++r) { p0[r] = __builtin_amdgcn_exp2f(p0[r] - mn); ps += p0[r]; }
      l = l * alpha + ps;
#pragma unroll
      for (int c = 0; c < 4; ++c)
#pragma unroll
        for (int r = 0; r < 16; ++r) o[c][r] *= alpha;
      bf16x8 pb[2];
#pragma unroll
      for (int k = 0; k < 2; ++k) {
        u32x4 w; w.x = cvtpk(p0[8 * k], p0[8 * k + 1]); w.y = cvtpk(p0[8 * k + 2], p0[8 * k + 3]); w.z = cvtpk(p0[8 * k + 4], p0[8 * k + 5]); w.w = cvtpk(p0[8 * k + 6], p0[8 * k + 7]);
        pb[k] = __builtin_bit_cast(bf16x8, w);
      }
      const int g = lane >> 4, i = lane & 15;
      const LAS unsigned char* vbase = (const LAS unsigned char*)kb + (4 * (g >> 1) + (i >> 2)) * KVSTR + (16 * (g & 1) + 4 * (i & 3)) * 2;
#pragma unroll
      for (int k = 0; k < 2; ++k) {
#pragma unroll
        for (int c = 0; c < 4; ++c) {
          const v4i16_t lo = __builtin_amdgcn_ds_read_tr16_b64_v4i16((LAS v4i16_t*)(vbase + (16 * k) * KVSTR + 64 * c));
          const v4i16_t hi4 = __builtin_amdgcn_ds_read_tr16_b64_v4i16((LAS v4i16_t*)(vbase + (16 * k + 8) * KVSTR + 64 * c));
          const bf16x8 va = {lo[0], lo[1], lo[2], lo[3], hi4[0], hi4[1], hi4[2], hi4[3]};
          o[c] = __builtin_amdgcn_mfma_f32_32x32x16_bf16(va, pb[k], o[c], 0, 0, 0);
        }
      }
    }
  };
  for (int t = 0; t < ntiles; t += 2) {
    if (t + 2 < ntiles) SA_GLOAD(stA, spA, t + 2);
    compute_tile(t);
    if (t + 1 < ntiles) SA_LSTORE(stB, spB, (t + 1) & 1);
    __syncthreads();
    if (t + 1 < ntiles) {
      if (t + 3 < ntiles) SA_GLOAD(stB, spB, t + 3);
      compute_tile(t + 1);
      if (t + 2 < ntiles) SA_LSTORE(stA, spA, t & 1);
      __syncthreads();
    }
  }
#undef SA_GLOAD
#undef SA_LSTORE
#if PROF_SEL == 120 || PROF_SEL == 121
  if (item == 0 && tid == 0) ((unsigned long long*)(p.ws + W_TS))[PROF_SEL == 120 ? 1 : 0] = __builtin_amdgcn_s_memrealtime();
#endif
  {
    float* X = (float*)lds;
#pragma unroll
    for (int round = 0; round < 2; ++round) {
      const bool writer = round == 0 ? (ks >= 2) : (ks == 1);
      const bool reader = round == 0 ? (ks < 2) : (ks == 0);
      const int slot = round == 0 ? (qt * 2 + (ks & 1)) : qt;
      float* xs = X + (size_t)slot * (66 * 64);
      if (writer) {
        xs[lane] = m; xs[64 + lane] = l;
#pragma unroll
        for (int c = 0; c < 4; ++c)
#pragma unroll
          for (int r = 0; r < 16; ++r) xs[(2 + c * 16 + r) * 64 + lane] = o[c][r];
      }
      __syncthreads();
      if (reader) {
        const float m2 = xs[lane], l2 = xs[64 + lane];
        const float mn = fmaxf(m, m2), s1 = __builtin_amdgcn_exp2f(m - mn), s2 = __builtin_amdgcn_exp2f(m2 - mn);
        m = mn; l = l * s1 + l2 * s2;
#pragma unroll
        for (int c = 0; c < 4; ++c)
#pragma unroll
          for (int r = 0; r < 16; ++r) o[c][r] = o[c][r] * s1 + xs[(2 + c * 16 + r) * 64 + lane] * s2;
      }
      __syncthreads();
    }
  }
  const int q = 32 * qt + r32;
  if (ks == 0) {
    const float lt = swap_sum(l);
    if (hi == 0) __hip_atomic_store((unsigned long long*)(PML + ((size_t)item * 64 + q) * 2), ((unsigned long long)__float_as_uint(lt) << 32) | __float_as_uint(m), __ATOMIC_RELAXED, __HIP_MEMORY_SCOPE_AGENT);
#pragma unroll
    for (int c = 0; c < 4; ++c)
#pragma unroll
      for (int g4 = 0; g4 < 4; ++g4) {
        const int c0 = 32 * c + 8 * g4 + 4 * hi;
        unsigned long long* dst_ = (unsigned long long*)(PO + ((size_t)item * 64 + q) * 128 + c0);
        __hip_atomic_store(dst_, ((unsigned long long)__float_as_uint(o[c][4 * g4 + 1]) << 32) | __float_as_uint(o[c][4 * g4]), __ATOMIC_RELAXED, __HIP_MEMORY_SCOPE_AGENT);
        __hip_atomic_store(dst_ + 1, ((unsigned long long)__float_as_uint(o[c][4 * g4 + 3]) << 32) | __float_as_uint(o[c][4 * g4 + 2]), __ATOMIC_RELAXED, __HIP_MEMORY_SCOPE_AGENT);
      }
  }
  asm volatile("s_waitcnt vmcnt(0)" ::: "memory");
  __syncthreads();
  volatile unsigned* flag = (volatile unsigned*)(lds + 2 * TILE);
  if (tid == 0) *flag = atomicAdd((unsigned*)(p.ws + W_CTL) + 64 + db, 1u);
  __syncthreads();
  const unsigned arrived = *flag;
  __syncthreads();
  if (arrived == 1u) {
    __builtin_amdgcn_fence(__ATOMIC_ACQUIRE, "agent");
    typedef float f32x4_t __attribute__((ext_vector_type(4)));
    const int h = wid, r16 = lane & 15, kq = lane >> 4;
    const bool rv = r16 < 8;
    const int qq = (rv ? r16 : 0) * 8 + h;
    const float* ml0 = PML + ((size_t)(2 * db) * 64 + qq) * 2; const float* ml1 = ml0 + 128;
    const float m0 = ml0[0], m1 = ml1[0], M_ = fmaxf(m0, m1), w0_ = __builtin_amdgcn_exp2f(m0 - M_), w1_ = __builtin_amdgcn_exp2f(m1 - M_);
    const float invL = 1.f / (ml0[1] * w0_ + ml1[1] * w1_);
    const float s0 = rv ? w0_ * invL : 0.f, s1 = rv ? w1_ * invL : 0.f;
    const float* po0 = PO + ((size_t)(2 * db) * 64 + qq) * 128; const float* po1 = po0 + 64 * 128;
    const bf16* wuv = (const bf16*)(p.ws + W_END) + B_WUV;
    f32x4_t acc[4];
#pragma unroll
    for (int nt = 0; nt < 4; ++nt) acc[nt] = (f32x4_t){0.f, 0.f, 0.f, 0.f};
#pragma unroll
    for (int ks = 0; ks < 4; ++ks) {
      const int c0 = 32 * ks + 8 * kq;
      const f32x4_t a0 = *(const f32x4_t*)(po0 + c0), a1 = *(const f32x4_t*)(po0 + c0 + 4), b0 = *(const f32x4_t*)(po1 + c0), b1 = *(const f32x4_t*)(po1 + c0 + 4);
      const f32x4_t x0 = a0 * s0 + b0 * s1, x1 = a1 * s0 + b1 * s1;
      u32x4 aw; aw.x = cvtpk(x0.x, x0.y); aw.y = cvtpk(x0.z, x0.w); aw.z = cvtpk(x1.x, x1.y); aw.w = cvtpk(x1.z, x1.w);
      const bf16x8 af = __builtin_bit_cast(bf16x8, aw);
#pragma unroll
      for (int nt = 0; nt < 4; ++nt) {
        const bf16x8 bfr = *(const bf16x8*)(wuv + (size_t)(h * 64 + 16 * nt + r16) * 128 + c0);
        acc[nt] = __builtin_amdgcn_mfma_f32_16x16x32_bf16(af, bfr, acc[nt], 0, 0, 0);
      }
    }
    if (kq < 2) {
      bf16* mix = (bf16*)(p.ws + W_END) + B_MIX;
#pragma unroll
      for (int nt = 0; nt < 4; ++nt)
#pragma unroll
        for (int rg = 0; rg < 4; ++rg) {
          const int t = 4 * kq + rg, col = h * 64 + 16 * nt + r16;
          const size_t row = (size_t)NP + db * 8 + t;
          const float g = pj((const bf16*)(p.ws + W_END) + B_PROJ, row, C_GMLA + col);
          mix[row * 1024 + col] = (bf16)f2bf(acc[nt][rg] * (g / (1.f + __expf(-g))));
        }
    }
  }
#if PROF_SEL == 121 || PROF_SEL == 122
  if (item == 0 && tid == 0) ((unsigned long long*)(p.ws + W_TS))[1] = __builtin_amdgcn_s_memrealtime();
#endif
}
}

namespace rw {
typedef float f32x4 __attribute__((ext_vector_type(4)));
constexpr int CH = 32, STEPF = 384, CHF = CH * STEPF;
__device__ __forceinline__ float dpp_sum16(float v) {
  v += __int_as_float(__builtin_amdgcn_update_dpp(0, __float_as_int(v), 0xB1, 0xF, 0xF, true));
  v += __int_as_float(__builtin_amdgcn_update_dpp(0, __float_as_int(v), 0x4E, 0xF, 0xF, true));
  v += __int_as_float(__builtin_amdgcn_update_dpp(0, __float_as_int(v), 0x141, 0xF, 0xF, true));
  v += __int_as_float(__builtin_amdgcn_update_dpp(0, __float_as_int(v), 0x140, 0xF, 0xF, true));
  return v;
}
__device__ __forceinline__ float dpp_sum8(float v) {
  v += __int_as_float(__builtin_amdgcn_update_dpp(0, __float_as_int(v), 0xB1, 0xF, 0xF, true));
  v += __int_as_float(__builtin_amdgcn_update_dpp(0, __float_as_int(v), 0x4E, 0xF, 0xF, true));
  v += __int_as_float(__builtin_amdgcn_update_dpp(0, __float_as_int(v), 0x141, 0xF, 0xF, true));
  return v;
}
__device__ __forceinline__ void rwkv_prompt_item(unsigned char* lds, const Params& p, int item, int wid_s) {
  const int bh = item >> 1, half = item & 1, b = bh >> 2, h = bh & 3;
  const int tid = mk_tid(wid_s);
  float* L = (float*)lds; float* yb = L + 2 * CHF;
  const float* ws = p.ws;
  const size_t rowbase = (size_t)b * SEQ;
  constexpr int NCH = SEQ / CH;
  if (wid_s >= 4) {
    const int ht = tid - 256;
    f32x4 g[12];
#define RW_GLOAD(c) do { _Pragma("unroll") for (int i_ = 0; i_ < 12; ++i_) { const int f_ = ht + 256 * i_, arr_ = f_ >> 9, s_ = (f_ >> 4) & 31, k4_ = f_ & 15; \
      const size_t off_ = (rowbase + (size_t)(c) * CH + s_) * 256 + h * 64 + k4_ * 4; \
      const size_t base_ = arr_ == 0 ? W_KK : arr_ == 1 ? W_W : arr_ == 2 ? W_BB : arr_ == 3 ? W_KF : arr_ == 4 ? W_R : W_VV; \
      g[i_] = *(const f32x4*)(ws + base_ + off_); } } while (0)
#define RW_LSTORE(buf) do { _Pragma("unroll") for (int i_ = 0; i_ < 12; ++i_) { const int f_ = ht + 256 * i_, arr_ = f_ >> 9, s_ = (f_ >> 4) & 31, k4_ = f_ & 15; \
      *(f32x4*)(L + (buf) * CHF + s_ * STEPF + arr_ * 64 + k4_ * 4) = (arr_ == 2) ? -g[i_] : g[i_]; } } while (0)
#define RW_FLUSH(c) do { const float* ybc_ = yb + ((c) & 1) * (32 * 33); _Pragma("unroll") for (int i_ = 0; i_ < 4; ++i_) { const int f_ = ht + 256 * i_, s_ = f_ >> 5, vv_ = f_ & 31; \
      p.ws[W_Y + (rowbase + (size_t)(c) * CH + s_) * 256 + h * 64 + 32 * half + vv_] = ybc_[vv_ * 33 + s_]; } } while (0)
    RW_GLOAD(0); RW_LSTORE(0);
    __syncthreads();
    for (int c = 0; c < NCH; ++c) {
      if (c + 1 < NCH) { RW_GLOAD(c + 1); RW_LSTORE((c + 1) & 1); }
      if (c > 0) RW_FLUSH(c - 1);
      __syncthreads();
    }
    RW_FLUSH(NCH - 1);
#undef RW_GLOAD
#undef RW_LSTORE
#undef RW_FLUSH
  } else {
    const int sub = tid & 7, vl = tid >> 3, v = 32 * half + vl;
    f32x4 Sa = {0.f, 0.f, 0.f, 0.f}, Sb = {0.f, 0.f, 0.f, 0.f};
    struct Ops { f32x4 kk0, kk1, w0, w1, nb0, nb1, kf0, kf1, r0, r1; float vv; };
#define RW_LD(o, s) do { const float* sb_ = cb + (s) * STEPF + 8 * sub; (o).kk0 = *(const f32x4*)(sb_); (o).kk1 = *(const f32x4*)(sb_ + 4); \
      (o).w0 = *(const f32x4*)(sb_ + 64); (o).w1 = *(const f32x4*)(sb_ + 68); (o).nb0 = *(const f32x4*)(sb_ + 128); (o).nb1 = *(const f32x4*)(sb_ + 132); \
      (o).kf0 = *(const f32x4*)(sb_ + 192); (o).kf1 = *(const f32x4*)(sb_ + 196); (o).r0 = *(const f32x4*)(sb_ + 256); (o).r1 = *(const f32x4*)(sb_ + 260); \
      (o).vv = cb[(s) * STEPF + 320 + v]; } while (0)
#define RW_STEP(o, s) do { const f32x4 ta_ = (o).kf0 * (o).vv, tb_ = (o).kf1 * (o).vv; const f32x4 d4_ = Sa * (o).kk0 + Sb * (o).kk1; \
      float dot_ = (d4_.x + d4_.y) + (d4_.z + d4_.w); dot_ = dpp_sum8(dot_); \
      Sa = Sa * (o).w0 + ((o).nb0 * dot_ + ta_); Sb = Sb * (o).w1 + ((o).nb1 * dot_ + tb_); \
      const f32x4 y4_ = Sa * (o).r0 + Sb * (o).r1; float y_ = (y4_.x + y4_.y) + (y4_.z + y4_.w); y_ = dpp_sum8(y_); \
      ykeep = (sub == ((s) & 7)) ? y_ : ykeep; \
      if (((s) & 7) == 7) ybc[vl * 33 + ((s) - 7) + sub] = ykeep; } while (0)
    __syncthreads();
    for (int c = 0; c < NCH; ++c) {
      const float* cb = L + (c & 1) * CHF;
      float* ybc = yb + (c & 1) * (32 * 33);
      float ykeep = 0.f;
      Ops A, B;
      RW_LD(A, 0);
#pragma unroll
      for (int s = 0; s < CH; s += 2) {
        RW_LD(B, s + 1);
        RW_STEP(A, s);
        if (s + 2 < CH) RW_LD(A, s + 2);
        RW_STEP(B, s + 1);
      }
      __syncthreads();
    }
#undef RW_LD
#undef RW_STEP
    float* so = p.out + O_WKVP + ((size_t)(b * 4 + h) * 64 + v) * 64 + 8 * sub;
    *(f32x4*)so = Sa; *(f32x4*)(so + 4) = Sb;
  }
  __syncthreads();
}
}

namespace rw {
__device__ __forceinline__ void rwkv_sample_item(unsigned char* lds, const Params& p, int item, int wid_s) {
  float* YL = (float*)lds;
  const int db = item >> 2, h = item & 3;
  const int tid = mk_tid(wid_s), sub = tid & 7, v = tid >> 3;
  const float* ws = p.ws;
  const float* s0 = p.state_wkv + ((size_t)(db * 4 + h) * 64 + v) * 64 + 8 * sub;
  f32x4 Sa = *(const f32x4*)s0, Sb = *(const f32x4*)(s0 + 4);
  const size_t row0 = (size_t)NP + db * DT;
  struct Ops { f32x4 kk0, kk1, w0, w1, b0, b1, kf0, kf1, r0, r1; float vv; };
#define RS_LD(o, t) do { const size_t off_ = (row0 + (t)) * 256 + h * 64; const float* q_ = ws + off_ + 8 * sub; \
    (o).kk0 = *(const f32x4*)(q_ + W_KK); (o).kk1 = *(const f32x4*)(q_ + W_KK + 4); (o).w0 = *(const f32x4*)(q_ + W_W); (o).w1 = *(const f32x4*)(q_ + W_W + 4); \
    (o).b0 = *(const f32x4*)(q_ + W_BB); (o).b1 = *(const f32x4*)(q_ + W_BB + 4); (o).kf0 = *(const f32x4*)(q_ + W_KF); (o).kf1 = *(const f32x4*)(q_ + W_KF + 4); \
    (o).r0 = *(const f32x4*)(q_ + W_R); (o).r1 = *(const f32x4*)(q_ + W_R + 4); (o).vv = ws[W_VV + off_ + v]; } while (0)
#define RS_STEP(o, t) do { const f32x4 d4_ = Sa * (o).kk0 + Sb * (o).kk1; float dot_ = (d4_.x + d4_.y) + (d4_.z + d4_.w); dot_ = dpp_sum8(dot_); \
    const float sa_ = -dot_; \
    Sa = Sa * (o).w0 + ((o).b0 * sa_ + (o).kf0 * (o).vv); Sb = Sb * (o).w1 + ((o).b1 * sa_ + (o).kf1 * (o).vv); \
    const f32x4 y4_ = Sa * (o).r0 + Sb * (o).r1; float y_ = (y4_.x + y4_.y) + (y4_.z + y4_.w); y_ = dpp_sum8(y_); \
    if (sub == 0) YL[(t) * 64 + v] = y_; } while (0)
  Ops A, B;
  RS_LD(A, 0);
#pragma unroll
  for (int t = 0; t < DT; t += 2) {
    RS_LD(B, t + 1);
    RS_STEP(A, t);
    if (t + 2 < DT) RS_LD(A, t + 2);
    RS_STEP(B, t + 1);
  }
#undef RS_LD
#undef RS_STEP
  float* so = p.out + O_WKVS + ((size_t)(db * 4 + h) * 64 + v) * 64 + 8 * sub;
  *(f32x4*)so = Sa; *(f32x4*)(so + 4) = Sb;
  __syncthreads();
  {
    const int t = wid_s, lane = tid & 63;
    const size_t row = row0 + t, off = row * 256 + h * 64 + lane;
    const float y = YL[t * 64 + lane];
    const float mean = wave_sum_fast(y) * (1.f / 64.f), d = y - mean, var = wave_sum_fast(d * d) * (1.f / 64.f);
    const float yn = d * rsqrtf(var + GN_EPS) * p.lnx_g[h * 64 + lane] + p.lnx_b[h * 64 + lane];
    const float bsum = wave_sum_fast(ws[W_R + off] * ws[W_KF + off] * p.r_k[h * 64 + lane]);
    const float o = yn + bsum * ws[W_VV + off];
    const float g = pj((const bf16*)(p.ws + W_END) + B_PROJ, row, C_GRWKV + h * 64 + lane);
    ((bf16*)(p.ws + W_END))[B_MIX + row * 1024 + 512 + h * 64 + lane] = (bf16)f2bf(o * (g / (1.f + __expf(-g))));
  }
  __syncthreads();
}
}

namespace ma {
typedef float f32x4 __attribute__((ext_vector_type(4)));
__device__ __forceinline__ void mem_sample_item(unsigned char* lds, const Params& p, int db, int wid_s) {
  const int tid = mk_tid(wid_s), lane = tid & 63, t = wid_s;
  constexpr int KST = 65;
  float* Kl = (float*)lds;
  float* Vl = Kl + 256 * KST;
  float* ps = Vl + 256 * 64 + t * 256;
  const float* ws = p.ws;
  const float* kg = p.cache_mem_k + (size_t)db * 65536; const float* vg = p.cache_mem_v + (size_t)db * 65536;
  const size_t row = (size_t)NP + db * 8 + t;
  f32x4 kr[8], vr[8];
#define MS_GLOAD(h) do { _Pragma("unroll") for (int i_ = 0; i_ < 8; ++i_) { const int f_ = tid + 512 * i_, m_ = f_ >> 4, c4_ = f_ & 15; \
    kr[i_] = *(const f32x4*)(kg + (size_t)m_ * 256 + (h) * 64 + c4_ * 4); vr[i_] = *(const f32x4*)(vg + (size_t)m_ * 256 + (h) * 64 + c4_ * 4); } } while (0)
#define MS_LSTORE() do { _Pragma("unroll") for (int i_ = 0; i_ < 8; ++i_) { const int f_ = tid + 512 * i_, m_ = f_ >> 4, c4_ = f_ & 15; \
    float* kd_ = Kl + m_ * KST + c4_ * 4; kd_[0] = kr[i_].x; kd_[1] = kr[i_].y; kd_[2] = kr[i_].z; kd_[3] = kr[i_].w; \
    *(f32x4*)(Vl + m_ * 64 + c4_ * 4) = vr[i_]; } } while (0)
  MS_GLOAD(0);
  bf16* mix = (bf16*)(p.ws + W_END) + B_MIX;
  for (int h = 0; h < 4; ++h) {
    __syncthreads();
    MS_LSTORE();
    if (h + 1 < 4) MS_GLOAD(h + 1);
    float q[64];
    { const bf16* PJ = (const bf16*)(p.ws + W_END) + B_PROJ;
#pragma unroll
      for (int d4 = 0; d4 < 16; ++d4) { const float4 v = pj4(PJ, row, C_QX + h * 64 + d4 * 4); q[4 * d4] = v.x * X_SCALE; q[4 * d4 + 1] = v.y * X_SCALE; q[4 * d4 + 2] = v.z * X_SCALE; q[4 * d4 + 3] = v.w * X_SCALE; } }
    __syncthreads();
    float s[4] = {0.f, 0.f, 0.f, 0.f};
#pragma unroll
    for (int d = 0; d < 64; ++d) {
#pragma unroll
      for (int j = 0; j < 4; ++j) s[j] += Kl[(lane + 64 * j) * KST + d] * q[d];
    }
    float mx = wave_max(fmaxf(fmaxf(s[0], s[1]), fmaxf(s[2], s[3])));
    float sum = 0.f;
#pragma unroll
    for (int j = 0; j < 4; ++j) { s[j] = __expf(s[j] - mx); sum += s[j]; }
    const float inv = 1.f / wave_sum_fast(sum);
#pragma unroll
    for (int j = 0; j < 4; ++j) ps[lane + 64 * j] = s[j] * inv;
    float o0 = 0.f, o1 = 0.f, o2 = 0.f, o3 = 0.f;
#pragma unroll 4
    for (int m = 0; m < 256; m += 4) {
      const f32x4 pm = *(const f32x4*)(ps + m);
      o0 += pm.x * Vl[(m) * 64 + lane]; o1 += pm.y * Vl[(m + 1) * 64 + lane]; o2 += pm.z * Vl[(m + 2) * 64 + lane]; o3 += pm.w * Vl[(m + 3) * 64 + lane];
    }
    const float o = (o0 + o1) + (o2 + o3);
    const float g = pj((const bf16*)(p.ws + W_END) + B_PROJ, row, C_GX + h * 64 + lane);
    mix[row * 1024 + 768 + h * 64 + lane] = (bf16)f2bf(o * (g / (1.f + __expf(-g))));
  }
#undef MS_GLOAD
#undef MS_LSTORE
  __syncthreads();
}
}

typedef unsigned v4u __attribute__((ext_vector_type(4)));
__device__ __forceinline__ unsigned f2bf(float f) { unsigned u = __builtin_bit_cast(unsigned, f); return (u + 0x7fffu + ((u >> 16) & 1u)) >> 16; }
__device__ __forceinline__ unsigned pk2(float lo, float hi) { return f2bf(lo) | (f2bf(hi) << 16); }
__device__ __forceinline__ void p0_transpose_item(const float* W, int K, int N, bf16* WT, int row_off, LAS float* scr, int item, int lane) {
  const int nblk = N / 32, kb = item / nblk, nb = item % nblk, k0 = 64 * kb, n0 = 32 * nb;
#pragma unroll 8
  for (int i = 0; i < 32; ++i) { const int kk = 2 * i + (lane >> 5); scr[kk * 33 + (lane & 31)] = W[(size_t)(k0 + kk) * N + n0 + (lane & 31)]; }
  asm volatile("s_waitcnt lgkmcnt(0)" ::: "memory");
  const int c = lane & 7;
#pragma unroll
  for (int j = 0; j < 4; ++j) { const int n = (lane >> 3) + 8 * j; const LAS float* s = scr + (8 * c) * 33 + n;
    v4u o; o.x = pk2(s[0 * 33], s[1 * 33]); o.y = pk2(s[2 * 33], s[3 * 33]); o.z = pk2(s[4 * 33], s[5 * 33]); o.w = pk2(s[6 * 33], s[7 * 33]);
    *(v4u*)(WT + (size_t)(row_off + n0 + n) * K + k0 + 8 * c) = o; }
  asm volatile("s_waitcnt lgkmcnt(0)" ::: "memory");
}


#if PROF_SEL >= 0
#define PROF_STAMP(i) do { if ((i) == PROF_SEL || (i) == PROF_SEL + 1 || ((i) == 0 && PROF_SEL >= 130 && PROF_SEL <= 136)) { if (blockIdx.x == 0 && mk_tid(wid_s) == 0) ((unsigned long long*)(p.ws + W_TS))[(i) == 0 ? 0 : (i) - PROF_SEL] = __builtin_amdgcn_s_memrealtime(); } } while (0)
#else
#define PROF_STAMP(i) do { } while (0)
#endif
__global__ void __launch_bounds__(512) fwd_megakernel(Params p) {
  cg::grid_group grid = cg::this_grid();
  extern __shared__ __attribute__((aligned(16))) unsigned char lds[];
  float* sm = (float*)lds;
  bf16* wb = (bf16*)(p.ws + W_END);
  float* ws = p.ws;
  const int wid_s = __builtin_amdgcn_readfirstlane((int)(threadIdx.x >> 6));
  PROF_STAMP(0);
#define PH_IDS const int tid = mk_tid(wid_s); const int lane = tid & 63, wv = tid >> 6; const int gw = blockIdx.x * 8 + wv, NGW = gridDim.x * 8; \
  const int gtid = blockIdx.x * 512 + tid, NTH = gridDim.x * 512; (void)lane; (void)wv; (void)gw; (void)NGW; (void)gtid; (void)NTH;
  { PH_IDS

  {
    LAS float* scr = (LAS float*)((LAS unsigned char*)lds + wv * 16384);
    constexpr int I_IN = 16 * (INC / 32), I_MEM = 16 * (512 / 32), I_OUT = 16 * (1024 / 32);
    for (int it = gw; it < I_IN + I_MEM + I_OUT; it += NGW) {
      int r = it;
      if (r < I_IN) { p0_transpose_item(p.w_in, 1024, INC, wb + B_WIN, 0, scr, r, lane); continue; } r -= I_IN;
      if (r < I_MEM) { p0_transpose_item(p.w_mem_kv, 1024, 512, wb + B_WMEM, 0, scr, r, lane); continue; } r -= I_MEM;
      p0_transpose_item(p.w_out, 1024, 1024, wb + B_WOUT, 0, scr, r, lane);
    }
    if (gtid < 256) ((unsigned*)(p.ws + W_CTL))[gtid] = 0u;

#if PROF_SEL == 130
    if (blockIdx.x == 0 && tid == 0) { asm volatile("s_waitcnt vmcnt(0)" ::: "memory"); ((unsigned long long*)(p.ws + W_TS))[1] = __builtin_amdgcn_s_memrealtime(); }
#endif
    for (int it = gw; it < 64; it += NGW) {
      if (it < 32) p0_transpose_item(p.w_uk, 128, 512, wb + B_WUK, 0, scr, it, lane);
      else p0_transpose_item(p.w_uv, 128, 512, wb + B_WUV, 0, scr, it - 32, lane);
    }

#if PROF_SEL == 131
    if (blockIdx.x == 0 && tid == 0) { asm volatile("s_waitcnt vmcnt(0)" ::: "memory"); ((unsigned long long*)(p.ws + W_TS))[1] = __builtin_amdgcn_s_memrealtime(); }
#endif
    for (int i = gtid; i < 768 * 256; i += NTH) {
      const int n = i >> 8, k = i & 255;
      const int orig = n < 512 ? (n >> 6) * 96 + (n & 63) : (n < 640 ? ((n - 512) >> 4) * 96 + 64 + ((n - 512) & 15) : ((n - 640) >> 4) * 96 + 80 + ((n - 640) & 15));
      wb[B_WUQ + i] = (bf16)f2bf(p.w_uq[(size_t)k * 768 + orig]);
    }

#if PROF_SEL == 132
    if (blockIdx.x == 0 && tid == 0) { asm volatile("s_waitcnt vmcnt(0)" ::: "memory"); ((unsigned long long*)(p.ws + W_TS))[1] = __builtin_amdgcn_s_memrealtime(); }
#endif
    for (int it0 = gw; it0 < 1024; it0 += NGW) {
      const int it = __builtin_amdgcn_readfirstlane(it0);
      const int h = it >> 7, k = ((it >> 5) & 3) * 64 + lane, cg = it & 31;
      float ar[64];
#pragma unroll
      for (int d4 = 0; d4 < 16; ++d4) { const float4 v = *(const float4*)(p.w_uq + (size_t)k * 768 + h * 96 + d4 * 4); ar[4 * d4] = v.x; ar[4 * d4 + 1] = v.y; ar[4 * d4 + 2] = v.z; ar[4 * d4 + 3] = v.w; }
#pragma unroll 4
      for (int c = cg * 4; c < cg * 4 + 4; ++c) {
        const float* br = p.w_uk + (size_t)c * 512 + h * 64;
        float acc = 0.f;
#pragma unroll
        for (int d4 = 0; d4 < 16; ++d4) { const float4 v = *(const float4*)(br + d4 * 4); acc += (ar[4 * d4] * v.x + ar[4 * d4 + 1] * v.y) + (ar[4 * d4 + 2] * v.z + ar[4 * d4 + 3] * v.w); }
        wb[B_WQL + (size_t)(h * 128 + c) * 256 + k] = (bf16)f2bf(acc);
      }
    }

#if PROF_SEL == 133
    if (blockIdx.x == 0 && tid == 0) { asm volatile("s_waitcnt vmcnt(0)" ::: "memory"); ((unsigned long long*)(p.ws + W_TS))[1] = __builtin_amdgcn_s_memrealtime(); }
#endif
    for (int i = gtid; i < 512 * 1024; i += NTH) {
      const int n = i >> 10, k = i & 1023, h = n >> 6, hk = k >> 7, c = k & 127;
      wb[B_WUVBD + i] = hk == h ? (bf16)f2bf(p.w_uv[(size_t)c * 512 + n]) : (bf16)0;
    }

#if PROF_SEL == 134
    if (blockIdx.x == 0 && tid == 0) { asm volatile("s_waitcnt vmcnt(0)" ::: "memory"); ((unsigned long long*)(p.ws + W_TS))[1] = __builtin_amdgcn_s_memrealtime(); }
#endif
    for (int i = gtid; i < 4104 * 16; i += NTH) {
      const int pi = i >> 4, j = i & 15; const int pos = pi < 4096 ? pi : PAST + (pi - 4096);
      const float inv = 1.0f / powf(10000.0f, (float)j * (2.0f / 32.0f));
      const float ang = (float)pos * inv;
      p.ws[W_CS + (size_t)i * 2] = cosf(ang); p.ws[W_CS + (size_t)i * 2 + 1] = sinf(ang);
    }
    for (int i = gtid; i < (INCP - INC) * 1024 / 8; i += NTH) ((v4u*)(wb + B_WIN + (size_t)INC * 1024))[i] = (v4u){0u, 0u, 0u, 0u};
  }

#if PROF_SEL == 135
    if (blockIdx.x == 0 && tid == 0) { asm volatile("s_waitcnt vmcnt(0)" ::: "memory"); ((unsigned long long*)(p.ws + W_TS))[1] = __builtin_amdgcn_s_memrealtime(); }
#endif
  for (int r = gw; r < NT + 1024; r += NGW) {
    const float* src; const float* g; bf16* dst;
    if (r < NT) { src = xrow(p, r); g = p.ln_g; dst = wb + B_H + (size_t)r * 1024; }
    else { src = p.mem_prompt + (size_t)(r - NT) * 1024; g = p.mem_norm_g; dst = wb + B_HM + (size_t)(r - NT) * 1024; }
    float4 v[4]; float ss = 0.f;
#pragma unroll
    for (int i = 0; i < 4; ++i) { v[i] = *(const float4*)(src + 4 * lane + 256 * i); ss += v[i].x * v[i].x + v[i].y * v[i].y + v[i].z * v[i].z + v[i].w * v[i].w; }
    const float rs = rsqrtf(wave_sum_fast(ss) * (1.f / 1024.f) + RMS_EPS);
#pragma unroll
    for (int i = 0; i < 4; ++i) {
      const float4 gg = *(const float4*)(g + 4 * lane + 256 * i);
      uint2 o; o.x = pk2(v[i].x * rs * gg.x, v[i].y * rs * gg.y); o.y = pk2(v[i].z * rs * gg.z, v[i].w * rs * gg.w);
      *(uint2*)(dst + 4 * lane + 256 * i) = o;
    }
  }
  }
  grid.sync();
  PROF_STAMP(1);
  { PH_IDS

  {
    pg8::Gemm g{wb + B_H, wb + B_WIN, NT, INCP, 1024}; pg8::StaticOrder S; S.init(NT, INCP, (int)gridDim.x, (int)blockIdx.x);
    bf16* PJ = wb + B_PROJ;
    auto f = [=](int row, int col) -> bf16* { return col < INC ? PJ + (size_t)row * INC + col : nullptr; };
    pg8::EpiBf16F<decltype(f)> E{f, 1.f};
    pg8::gemm_phase<pg8::EpiBf16F<decltype(f)>, pg8::StaticOrder, true, true>((PG8_LAS unsigned char*)lds, g, S, E, wid_s);
  }
  {
    pg8::Gemm g{wb + B_HM, wb + B_WMEM, 1024, 512, 1024}; pg8::StaticOrder S; S.init(1024, 512, (int)gridDim.x, (int)((blockIdx.x + 20) % gridDim.x));
    pg8::EpiF32 E{p.out + O_MKP, 256, 256, 256, O_MVP - O_MKP, nullptr, nullptr, 0};
    pg8::gemm_phase<pg8::EpiF32, pg8::StaticOrder, true, true>((PG8_LAS unsigned char*)lds, g, S, E, wid_s);
  }
  }
  grid.sync();
  PROF_STAMP(2);
  { PH_IDS

  for (size_t i = gtid; i < (size_t)4 * 256 * 256; i += NTH) {
    wb[B_KM + i] = (bf16)f2bf(p.out[O_MKP + i]);
    const size_t b_ = i >> 16, c = (i >> 8) & 255, m_ = i & 255;
    wb[B_VMT + i] = (bf16)f2bf(p.out[O_MVP + (b_ * 256 + m_) * 256 + c]);
  }
  {
    constexpr int WST = 72, TST = 136;
    bf16* wl = (bf16*)lds; bf16* al = wl + 256 * WST;
    bf16* td = al + 256 * WST + wv * (16 * TST);
    for (int i = tid; i < 64 * 256; i += 512) { const int k = i >> 8, n = i & 255; wl[n * WST + k] = (bf16)f2bf(p.w_up[i]); al[n * WST + k] = (bf16)f2bf(p.a_up[i]); }
    __syncthreads();
    float mu[14];
#pragma unroll
    for (int i = 0; i < 14; ++i) mu[i] = p.shift_mu[lane + 64 * i];
    float qg[4], kg[2];
#pragma unroll
    for (int i = 0; i < 4; ++i) qg[i] = p.q_norm_g[lane + 64 * i];
    kg[0] = p.kv_norm_g[lane]; kg[1] = p.kv_norm_g[64 + lane];
    constexpr int GT = 8;
    struct TokIn { unsigned short cq[4], ck0, ck1, kr1, kr2, z[14], zpb[14]; float zpf[14]; float2 csv; uint2 qx4; bool first, isp; };
    auto tok_load = [&](int row, TokIn& T) {
      const bf16* pr = wb + B_PROJ + (size_t)row * INC;
      const bool isp = row < NP; const int srow = row - NP;
      const bool first = isp ? ((row & (SEQ - 1)) == 0) : ((srow & 7) == 0);
      const bf16* pp = first ? pr : pr - INC;
#pragma unroll
      for (int i = 0; i < 4; ++i) T.cq[i] = pr[C_CQ + lane + 64 * i];
      T.ck0 = pr[C_CKV + lane]; T.ck1 = pr[C_CKV + 64 + lane];
      T.kr1 = pr[C_KR + (lane & 15)]; T.kr2 = pr[C_KR + 16 + (lane & 15)];
#pragma unroll
      for (int i = 0; i < 14; ++i) { T.z[i] = pr[C_Z + lane + 64 * i]; T.zpb[i] = pp[C_Z + lane + 64 * i]; T.zpf[i] = 0.f; }
      T.first = first; T.isp = isp;
      if (first && !isp) {
        const float* sst = p.state_shift + (size_t)(srow >> 3) * 896;
#pragma unroll
        for (int i = 0; i < 14; ++i) T.zpf[i] = sst[lane + 64 * i];
      }
      const int pi = isp ? (row & (SEQ - 1)) : 4096 + (srow & 7);
      T.csv = *(const float2*)(ws + W_CS + ((size_t)pi * 16 + (lane & 15)) * 2);
      T.qx4 = *(const uint2*)(wb + B_PROJ + (size_t)row * INC + C_QX + lane * 4);
    };
    for (int grp = gw; grp < NT / GT; grp += NGW) {
      TokIn cur; tok_load(grp * GT, cur);
      for (int ti = 0; ti < GT; ++ti) {
        const int row = grp * GT + ti;
        TokIn nxt; tok_load(ti + 1 < GT ? row + 1 : row, nxt);
        const bool isp = row < NP;
        const int srow = row - NP;
        float z[14], zm[14];
#pragma unroll
        for (int i = 0; i < 14; ++i) { z[i] = bf2f(cur.z[i]); const float zp = cur.first ? cur.zpf[i] : bf2f(cur.zpb[i]); zm[i] = z[i] + (zp - z[i]) * mu[i]; }
        const float cq0 = bf2f(cur.cq[0]), cq1 = bf2f(cur.cq[1]), cq2 = bf2f(cur.cq[2]), cq3 = bf2f(cur.cq[3]);
        const float ck0 = bf2f(cur.ck0), ck1 = bf2f(cur.ck1), kr1 = bf2f(cur.kr1), kr2 = bf2f(cur.kr2);
        { const float e2 = __expf(2.f * zm[12]); td[ti * TST + lane] = (bf16)f2bf(1.f - 2.f / (e2 + 1.f)); } td[ti * TST + 64 + lane] = (bf16)f2bf(zm[13]);
#pragma unroll
        for (int hh = 0; hh < 4; ++hh) { const size_t o = (size_t)row * 256 + hh * 64 + lane; ws[W_R + o] = zm[hh]; ws[W_KF + o] = zm[4 + hh]; ws[W_VV + o] = zm[8 + hh]; }
        {
          const float rs = rsqrtf(wave_sum_fast((cq0 * cq0 + cq1 * cq1) + (cq2 * cq2 + cq3 * cq3)) * (1.f / 256.f) + RMS_EPS);
          wb[B_CQN + (size_t)row * 256 + lane] = (bf16)f2bf(cq0 * rs * qg[0]); wb[B_CQN + (size_t)row * 256 + lane + 64] = (bf16)f2bf(cq1 * rs * qg[1]);
          wb[B_CQN + (size_t)row * 256 + lane + 128] = (bf16)f2bf(cq2 * rs * qg[2]); wb[B_CQN + (size_t)row * 256 + lane + 192] = (bf16)f2bf(cq3 * rs * qg[3]);
          const float rs2 = rsqrtf(wave_sum_fast(ck0 * ck0 + ck1 * ck1) * (1.f / 128.f) + RMS_EPS);
          const float c0 = ck0 * rs2 * kg[0], c1 = ck1 * rs2 * kg[1];
          float* o = ckv_out_row(p, row);
          o[lane] = c0; o[64 + lane] = c1;
          if (isp) { wb[B_CKVN + (size_t)row * 128 + lane] = (bf16)f2bf(c0); wb[B_CKVN + (size_t)row * 128 + 64 + lane] = (bf16)f2bf(c1); }
        }
        {
          const float y1 = kr1 * cur.csv.x - kr2 * cur.csv.y, y2 = kr2 * cur.csv.x + kr1 * cur.csv.y;
          if (lane < 16) { float* o = kpe_out_row(p, row); o[lane] = y1; o[16 + lane] = y2; }
          if (isp) {
            const bf16 b1 = (bf16)f2bf(y1), b2 = (bf16)f2bf(y2);
            const int j = lane & 15, hq = lane >> 4;
            wb[B_KP + (size_t)row * 768 + (2 * hq) * 96 + 64 + j] = b1; wb[B_KP + (size_t)row * 768 + (2 * hq) * 96 + 80 + j] = b2;
            wb[B_KP + (size_t)row * 768 + (2 * hq + 1) * 96 + 64 + j] = b1; wb[B_KP + (size_t)row * 768 + (2 * hq + 1) * 96 + 80 + j] = b2;
            const float XSC = X_SCALE * 1.4426950408889634f;
            const uint2 qw = cur.qx4;
            *(uint2*)(wb + B_QX + (size_t)row * 256 + lane * 4) = make_uint2(pk2(__uint_as_float(qw.x << 16) * XSC, __uint_as_float(qw.x & 0xffff0000u) * XSC), pk2(__uint_as_float(qw.y << 16) * XSC, __uint_as_float(qw.y & 0xffff0000u) * XSC));
          }
        }
        if (isp) { if ((row & (SEQ - 1)) == SEQ - 1) { const int b = row / SEQ;
#pragma unroll
            for (int i = 0; i < 14; ++i) p.out[O_SHP + (size_t)b * 896 + lane + 64 * i] = z[i]; } }
        else { if ((srow & 7) == 7) { const int db = srow >> 3;
#pragma unroll
            for (int i = 0; i < 14; ++i) p.out[O_SHS + (size_t)db * 896 + lane + 64 * i] = z[i]; } }
        cur = nxt;
      }
      {
        typedef short bf16x8_t __attribute__((ext_vector_type(8)));
        typedef float f32x4_t __attribute__((ext_vector_type(4)));
        const int r16 = lane & 15, kq = lane >> 4;
        bf16x8_t at[2], aa_[2];
#pragma unroll
        for (int ks = 0; ks < 2; ++ks) { at[ks] = *(const bf16x8_t*)(td + r16 * TST + 32 * ks + 8 * kq); aa_[ks] = *(const bf16x8_t*)(td + r16 * TST + 64 + 32 * ks + 8 * kq); }
#pragma unroll 1
        for (int hh = 0; hh < 4; ++hh) {
          f32x4_t au[4], aA[4];
#pragma unroll
          for (int nt = 0; nt < 4; ++nt) {
            const int n = hh * 64 + nt * 16 + r16;
            au[nt] = (f32x4_t){0.f, 0.f, 0.f, 0.f}; aA[nt] = (f32x4_t){0.f, 0.f, 0.f, 0.f};
#pragma unroll
            for (int ks = 0; ks < 2; ++ks) {
              const bf16x8_t bw = *(const bf16x8_t*)(wl + n * WST + 32 * ks + 8 * kq), ba = *(const bf16x8_t*)(al + n * WST + 32 * ks + 8 * kq);
              au[nt] = __builtin_amdgcn_mfma_f32_16x16x32_bf16(at[ks], bw, au[nt], 0, 0, 0);
              aA[nt] = __builtin_amdgcn_mfma_f32_16x16x32_bf16(aa_[ks], ba, aA[nt], 0, 0, 0);
            }
          }
          float kkv[4][4], av[4][4], kraw[4][4], ssq[4] = {0.f, 0.f, 0.f, 0.f};
#pragma unroll
          for (int nt = 0; nt < 4; ++nt) {
            const int c = hh * 64 + nt * 16 + r16;
            const float w0c = p.w0[c], a0c = p.a0[c], kkc = p.k_k[c];
#pragma unroll
            for (int r = 0; r < 4; ++r) {
              const size_t o = (size_t)(grp * GT + (kq < 2 ? 4 * kq + r : 0)) * 256 + c;
              const float nu = -(w0c + au[nt][r]);
              const float sp = fmaxf(nu, 0.f) + __logf(1.f + __expf(-fabsf(nu)));
              if (kq < 2) ws[W_W + o] = __expf(-__expf(-sp - 0.5f));
              av[nt][r] = 1.f / (1.f + __expf(-(a0c + aA[nt][r])));
              kraw[nt][r] = ws[W_KF + o];
              kkv[nt][r] = kraw[nt][r] * kkc;
              ssq[r] += kkv[nt][r] * kkv[nt][r];
            }
          }
#pragma unroll
          for (int r = 0; r < 4; ++r) ssq[r] = 1.f / fmaxf(sqrtf(rw::dpp_sum16(ssq[r])), 1e-12f);
#pragma unroll
          for (int nt = 0; nt < 4; ++nt) {
            const int c = hh * 64 + nt * 16 + r16;
            const float kac = p.k_a[c];
#pragma unroll
            for (int r = 0; r < 4; ++r) {
              const size_t o = (size_t)(grp * GT + 4 * kq + r) * 256 + c;
              const float kk = kkv[nt][r] * ssq[r];
              if (kq < 2) { ws[W_KK + o] = kk; ws[W_BB + o] = kk * av[nt][r];
                ws[W_KF + o] = kraw[nt][r] * (1.f + (av[nt][r] - 1.f) * kac); }
            }
          }
        }
      }
    }
  }
  }
  grid.sync();
  PROF_STAMP(3);
  { PH_IDS

  {
    unsigned* dctr = (unsigned*)(p.ws + W_CTL) + 2;
    const unsigned nd = gridDim.x - NSCAN;
    if ((int)blockIdx.x >= NSCAN) {
      const float QSC = MLA_SCALE * 1.4426950408889634f;
      const int G = (int)gridDim.x - NSCAN, bx = (int)blockIdx.x - NSCAN;
      {
        pg8::Gemm g{wb + B_CQN, wb + B_WUQ, NT, 768, 256}; pg8::StaticOrder S; S.init(NT, 768, G, bx);
        pg8::EpiQ E{wb + B_QP, wb + B_QS, ws + W_CS, QSC, NP};
        pg8::gemm_phase<pg8::EpiQ, pg8::StaticOrder, true, true>((PG8_LAS unsigned char*)lds, g, S, E, wid_s);
      }
      {
        bf16* Qs = wb + B_QS;
        auto f = [=](int row, int col) -> bf16* { return Qs + ((size_t)row * 8 + (col >> 7)) * 160 + (col & 127); };
        pg8::Gemm g{wb + B_CQN + (size_t)NP * 256, wb + B_WQL, NS, 1024, 256}; pg8::StaticOrder S; S.init(NS, 1024, G, (bx + G - 204 % G) % G);
        pg8::EpiBf16F<decltype(f)> E{f, QSC};
        pg8::gemm_phase<pg8::EpiBf16F<decltype(f)>, pg8::StaticOrder, true, true>((PG8_LAS unsigned char*)lds, g, S, E, wid_s);
      }
      {
        bf16* Kp = wb + B_KP;
        auto f = [=](int row, int col) -> bf16* { return Kp + (size_t)row * 768 + (col >> 6) * 96 + (col & 63); };
        pg8::Gemm g{wb + B_CKVN, wb + B_WUK, NP, 512, 128}; pg8::StaticOrder S; S.init(NP, 512, G, (bx + G - 220 % G) % G);
        pg8::EpiBf16F<decltype(f)> E{f, 1.f};
        pg8::gemm_phase<pg8::EpiBf16F<decltype(f)>, pg8::StaticOrder, true, true>((PG8_LAS unsigned char*)lds, g, S, E, wid_s);
      }
      {
        bf16* Vt = wb + B_VT;
        auto f = [=](int row, int col) -> bf16* { return Vt + (size_t)row * NP + col; };
        pg8::Gemm g{wb + B_WUV, wb + B_CKVN, 512, NP, 128}; pg8::StaticOrder S; S.init(512, NP, G, (bx + G - 124 % G) % G);
        pg8::EpiBf16F<decltype(f)> E{f, 1.f};
        pg8::gemm_phase<pg8::EpiBf16F<decltype(f)>, pg8::StaticOrder, true, true>((PG8_LAS unsigned char*)lds, g, S, E, wid_s);
      }
      asm volatile("s_waitcnt vmcnt(0)" ::: "memory");
      __syncthreads();
      if (mk_tid(wid_s) == 0) { __builtin_amdgcn_fence(__ATOMIC_RELEASE, "agent"); asm volatile("s_waitcnt vmcnt(0)" ::: "memory"); __hip_atomic_fetch_add(dctr, 1u, __ATOMIC_RELAXED, __HIP_MEMORY_SCOPE_AGENT); }
    }
  }
  }
  { PH_IDS

  {
    unsigned* qctr = (unsigned*)(p.ws + W_CTL);
    volatile unsigned* qslot = (volatile unsigned*)(lds + LDS_BYTES - 16);
    constexpr int Q_RW = 32, Q_SA = 256, Q_PA = 512, Q_MA = 256, Q_RS = 512, Q_MS = 128, Q_TOT = Q_RW + Q_SA + Q_PA + Q_MA + Q_RS + Q_MS;
#if PROF_SEL >= 100 && PROF_SEL < 110
    int prof_prev_ = -1;
#endif
#if PROF_SEL >= 110 && PROF_SEL <= 116
    if (blockIdx.x == 0 && tid == 0) ((unsigned long long*)(p.ws + W_TS))[0] = __builtin_amdgcn_s_memrealtime();
#endif
    bool d_ready = false;
    for (;;) {
      if (tid == 0) *qslot = atomicAdd(qctr, 1u);
      __syncthreads();
      int item = (int)*qslot;
      __syncthreads();
      item = __builtin_amdgcn_readfirstlane(item);
#if PROF_SEL >= 100 && PROF_SEL < 110
      { constexpr int probe_items[8] = {0, 32, 34, 32 + 767, 32 + 765, 800, 1056, 1056 + 512};
        static unsigned long long* const dummy_ = nullptr; (void)dummy_;
        unsigned long long* ts_ = (unsigned long long*)(p.ws + W_TS);
        if (tid == 0 && item == probe_items[PROF_SEL - 100] + 1 + 100000) ts_[1] = 0;
        if (tid == 0) { if (prof_prev_ == probe_items[PROF_SEL - 100]) ts_[1] = __builtin_amdgcn_s_memrealtime(); if (item == probe_items[PROF_SEL - 100]) ts_[0] = __builtin_amdgcn_s_memrealtime(); }
        prof_prev_ = item; }
#endif
#if PROF_SEL >= 112 && PROF_SEL <= 116
      { constexpr int marks[5] = {Q_RW + Q_SA, Q_RW + Q_SA + 256, Q_RW + Q_SA + Q_PA, Q_RW + Q_SA + Q_PA + Q_MA, Q_RW + Q_SA + Q_PA + Q_MA + 64};
        if (tid == 0 && item == marks[PROF_SEL - 112]) ((unsigned long long*)(p.ws + W_TS))[1] = __builtin_amdgcn_s_memrealtime(); }
#endif
#if PROF_SEL == 110
      if (item >= Q_TOT && blockIdx.x == 0 && tid == 0) ((unsigned long long*)(p.ws + W_TS))[1] = __builtin_amdgcn_s_memrealtime();
#endif
#if PROF_SEL == 111
      if (item >= Q_TOT && tid == 0) { ((unsigned long long*)(p.ws + W_TS))[1] = __builtin_amdgcn_s_memrealtime(); }
#endif
      if (item >= Q_TOT) break;
      if (item < Q_RW) { rw::rwkv_prompt_item(lds, p, item, wid_s); continue; }
      if (!d_ready) {
        unsigned* dctr = (unsigned*)(p.ws + W_CTL) + 2; const unsigned nd = gridDim.x - NSCAN;
        if (tid == 0) { while (__hip_atomic_load(dctr, __ATOMIC_RELAXED, __HIP_MEMORY_SCOPE_AGENT) < nd) __builtin_amdgcn_s_sleep(8); }
        __syncthreads();
        __builtin_amdgcn_fence(__ATOMIC_ACQUIRE, "agent");
        d_ready = true;
      }
      item -= Q_RW;
      if (item < Q_SA + Q_PA) {
        const int grp = item / 3, sub3 = item - grp * 3;
        if (sub3 == 2) { sa::sample_attn_item(lds, p, wb + B_QS, ws + W_PO, ws + W_PML, grp, wid_s); continue; }
        item = grp * 2 + sub3;
        const int bh = item & 31, qb = 15 - (item >> 5);
        const int b = bh >> 3, h = bh & 7;
        const size_t row0 = (size_t)b * SEQ + 256 * qb;
        auto out = [&](int ql, int dv0, float4 v) {
          const size_t row = row0 + ql;
          const float4 g = pj4(wb + B_PROJ, row, C_GMLA + h * 64 + dv0);
          *(uint2*)(wb + B_MIX + row * 1024 + h * 64 + dv0) = make_uint2(pk2(v.x * silu(g.x), v.y * silu(g.y)), pk2(v.z * silu(g.z), v.w * silu(g.w)));
        };
        pa::attn_unit<96, true>(lds, wb + B_QP + row0 * 768 + h * 96, 768, wb + B_KP + (size_t)b * SEQ * 768 + h * 96, 768,
                                wb + B_VT + (size_t)(h * 64) * NP + (size_t)b * SEQ, NP, 4 * qb + 4, 256 * qb, out, wid_s);
        continue;
      }
      item -= Q_SA + Q_PA;
      if (item >= Q_MA) {
        item -= Q_MA;
        if (item < Q_RS) rw::rwkv_sample_item(lds, p, item, wid_s);
        else { ma::mem_sample_item(lds, p, item - Q_RS, wid_s); }
        continue;
      }
      {
        const int qb = item & 15, h = (item >> 4) & 3, b = item >> 6;
        const size_t row0 = (size_t)b * SEQ + 256 * qb;
        auto out = [&](int ql, int dv0, float4 v) {
          const size_t row = row0 + ql;
          const float4 g = pj4(wb + B_PROJ, row, C_GX + h * 64 + dv0);
          *(uint2*)(wb + B_MIX + row * 1024 + 768 + h * 64 + dv0) = make_uint2(pk2(v.x * silu(g.x), v.y * silu(g.y)), pk2(v.z * silu(g.z), v.w * silu(g.w)));
        };
        pa::attn_unit<64, false>(lds, wb + B_QX + row0 * 256 + h * 64, 256, wb + B_KM + (size_t)b * 65536 + h * 64, 256,
                                 wb + B_VMT + (size_t)b * 65536 + (size_t)(h * 64) * 256, 256, 4, 0, out, wid_s);
      }
    }
    __syncthreads();
  }
  }
  grid.sync();
  PROF_STAMP(4);
  { PH_IDS

  constexpr int NGB = 16;
  for (int it0 = (int)blockIdx.x >= NGB ? gw - NGB * 8 : NP * 2; it0 < NP * 2; it0 += NGW - NGB * 8) {
    float y[2], rr[2], kf_[2], vv_[2], g_[2]; size_t off[2]; int hh_[2]; size_t rowi[2];
#pragma unroll
    for (int u = 0; u < 2; ++u) {
      const int it = it0 * 2 + u; const int row = it >> 2, h = it & 3;
      rowi[u] = row; hh_[u] = h; off[u] = (size_t)row * 256 + h * 64 + lane;
      y[u] = ws[W_Y + off[u]]; rr[u] = ws[W_R + off[u]]; kf_[u] = ws[W_KF + off[u]]; vv_[u] = ws[W_VV + off[u]];
      g_[u] = pj(wb + B_PROJ, (size_t)row, C_GRWKV + h * 64 + lane);
    }
#pragma unroll
    for (int u = 0; u < 2; ++u) {
      const int h = hh_[u];
      const float mean = wave_sum_fast(y[u]) * (1.f / 64.f), d = y[u] - mean, var = wave_sum_fast(d * d) * (1.f / 64.f);
      const float yn = d * rsqrtf(var + GN_EPS) * p.lnx_g[h * 64 + lane] + p.lnx_b[h * 64 + lane];
      const float bsum = wave_sum_fast(rr[u] * kf_[u] * p.r_k[h * 64 + lane]);
      const float o = yn + bsum * vv_[u];
      wb[B_MIX + rowi[u] * 1024 + 512 + h * 64 + lane] = (bf16)f2bf(o * silu(g_[u]));
    }
  }
  {
    pg8::Gemm g{wb + B_MIX + (size_t)NP * 1024, wb + B_WOUT, NS, 1024, 1024}; pg8::StaticOrder S; S.init(NS, 1024, (int)gridDim.x, (int)blockIdx.x);
    pg8::EpiF32 E{p.out + O_YS, 1024, 1024, 0, 0, p.x_sample, p.x_sample, NS};
    pg8::gemm_phase<pg8::EpiF32, pg8::StaticOrder, true, true>((PG8_LAS unsigned char*)lds, g, S, E, wid_s);
  }
  }
  grid.sync();
  PROF_STAMP(5);
  { PH_IDS
  for (int r = NP + gw; r < NT; r += NGW) {
    float* y = p.out + (size_t)r * 1024;
    float v[16]; float ss = 0.f;
#pragma unroll
    for (int i = 0; i < 16; ++i) { v[i] = y[lane + 64 * i]; ss += v[i] * v[i]; }
    const float rs = rsqrtf(wave_sum_fast(ss) * (1.f / 1024.f) + RMS_EPS);
#pragma unroll
    for (int i = 0; i < 16; ++i) y[lane + 64 * i] = v[i] * rs * p.final_g[lane + 64 * i];
  }
  {
    pg8::Gemm g{wb + B_MIX, wb + B_WOUT, NP, 1024, 1024}; pg8::StaticOrder S; S.init(NP, 1024, (int)gridDim.x, (int)blockIdx.x);
    pg8::EpiRmsOut E{p.x_prompt, p.out, p.final_g, ws + W_XB, (unsigned*)(ws + W_CTL) + 192, RMS_EPS};
    pg8::gemm_phase<pg8::EpiRmsOut, pg8::StaticOrder, false, true>((PG8_LAS unsigned char*)lds, g, S, E, wid_s);
  }
#if PROF_SEL >= 0
  grid.sync();
  PROF_STAMP(6);
#endif
#if PROF_SEL >= 0
    if (blockIdx.x == 0 && tid == 0) {
      unsigned long long* ts_ = (unsigned long long*)(p.ws + W_TS);
      asm volatile("s_waitcnt vmcnt(0) lgkmcnt(0)" ::: "memory");
      __builtin_amdgcn_fence(__ATOMIC_ACQUIRE, "agent");
      const float us_ = (float)(ts_[1] - ts_[0]) * 0.01f;
      p.out[0] += us_ * 0.01f;
    }
#endif
  }
#undef PH_IDS
}

extern "C" void kernel_launch(void* const* d_in, const int* in_sizes, int n_in, void* d_out,
                              int out_size, void* d_ws, size_t ws_size, hipStream_t stream) {
  static int grid_blocks = 0;
  if (!grid_blocks) {
    int dev = 0, cus = 0, per_cu = 0;
    (void)hipGetDevice(&dev);
    (void)hipDeviceGetAttribute(&cus, hipDeviceAttributeMultiprocessorCount, dev);
    (void)hipFuncSetAttribute((const void*)fwd_megakernel, hipFuncAttributeMaxDynamicSharedMemorySize, LDS_BYTES);
    (void)hipOccupancyMaxActiveBlocksPerMultiprocessor(&per_cu, fwd_megakernel, 512, LDS_BYTES);
    if (per_cu < 1) per_cu = 1;
    grid_blocks = cus;
    if (ws_size < WS_BYTES) fprintf(stderr, "workspace too small: %zu < %zu\n", ws_size, (size_t)WS_BYTES);
  }
  Params p{};
  const float** pf = (const float**)&p;
  (void)pf;
  p.x_prompt = (const float*)d_in[0]; p.x_sample = (const float*)d_in[1]; p.mem_prompt = (const float*)d_in[2];
  p.cache_ckv = (const float*)d_in[3]; p.cache_kpe = (const float*)d_in[4]; p.page_table = (const int*)d_in[5];
  p.state_wkv = (const float*)d_in[6]; p.state_shift = (const float*)d_in[7]; p.cache_mem_k = (const float*)d_in[8];
  p.cache_mem_v = (const float*)d_in[9]; p.ln_g = (const float*)d_in[10]; p.w_in = (const float*)d_in[11];
  p.q_norm_g = (const float*)d_in[12]; p.kv_norm_g = (const float*)d_in[13]; p.w_uq = (const float*)d_in[14];
  p.w_uk = (const float*)d_in[15]; p.w_uv = (const float*)d_in[16]; p.shift_mu = (const float*)d_in[17];
  p.w0 = (const float*)d_in[18]; p.w_up = (const float*)d_in[19]; p.a0 = (const float*)d_in[20]; p.a_up = (const float*)d_in[21];
  p.k_k = (const float*)d_in[22]; p.k_a = (const float*)d_in[23]; p.r_k = (const float*)d_in[24]; p.lnx_g = (const float*)d_in[25];
  p.lnx_b = (const float*)d_in[26]; p.mem_norm_g = (const float*)d_in[27]; p.w_mem_kv = (const float*)d_in[28];
  p.w_out = (const float*)d_in[29]; p.final_g = (const float*)d_in[30];
  p.out = (float*)d_out; p.ws = (float*)d_ws;
  void* args[] = {&p};
  hipError_t e = hipLaunchCooperativeKernel((void*)fwd_megakernel, dim3(grid_blocks), dim3(512), args, LDS_BYTES, stream);
  if (e != hipSuccess) fprintf(stderr, "cooperative launch failed: %s (grid %d)\n", hipGetErrorString(e), grid_blocks);
}
```

```cpp
#include <hip/hip_runtime.h>
#ifndef PROF_SEL
#define PROF_SEL -1
#endif
#include <hip/hip_cooperative_groups.h>
#include <cstdio>
#include <cstdint>
namespace cg = cooperative_groups;

__device__ __forceinline__ int mk_tid(int wid_s) { int z; asm volatile("s_mov_b32 %0, 0" : "=s"(z)); return wid_s * 64 + (int)__builtin_amdgcn_mbcnt_hi(~0u, __builtin_amdgcn_mbcnt_lo(~0u, (unsigned)z)); }
namespace pg8 {
#define PG8_LAS __attribute__((address_space(3)))
typedef unsigned short bf16_t;
typedef short bf16x8 __attribute__((ext_vector_type(8)));
typedef float f32x4 __attribute__((ext_vector_type(4)));
typedef unsigned u32x4 __attribute__((ext_vector_type(4)));
constexpr int BM = 256, BK = 64, HALF = 128, HTB = HALF * BK * 2  , STAGE_BYTES = 8 * HTB, NXCD = 8, WGM = 8;

__host__ __device__ __forceinline__ int lds_byte(int r, int c) { const int st = (r >> 4) * 2 + (c >> 5), rr = r & 15, cc = c & 31, ob = rr * 64 + cc * 2; return st * 1024 + (ob ^ (((ob >> 9) & 1) << 5)); }
__host__ __device__ __forceinline__ void stage_rc(int b, int& R, int& C) { const int st = b / 1024, sb = b % 1024, swz = sb ^ (((sb >> 9) & 1) << 5); R = (st >> 1) * 16 + swz / 64; C = (st & 1) * 32 + (swz % 64) / 2; }
__host__ __device__ __forceinline__ int perm32(int rho) { const int n = rho >> 4, i = rho & 15; return 8 * (i >> 2) + 4 * n + (i & 3); }

struct Unit { int pm, pn; };
struct Gemm { const bf16_t* A; const bf16_t* Bt; int M, N, K; };

struct StaticOrder {
    int nM, nN, nwg, G, c;
    __host__ __device__ void init(int M, int N, int G_, int c_) { nM = M / BM; nN = N / BM; nwg = nM * nN; G = G_; c = c_; }
    __host__ __device__ bool next(int i, Unit& u) const {
        const long L = (long)i * G + c; if (L >= nwg) return false;
        int wgid = (int)L; { const int q = nwg / NXCD, r = nwg % NXCD, xcd = wgid % NXCD, off = wgid / NXCD; wgid = (xcd < r ? xcd * (q + 1) : r * (q + 1) + (xcd - r) * q) + off; }
        const int nig = WGM * nN, gid = wgid / nig, fm = gid * WGM, gsz = (nM - fm) < WGM ? (nM - fm) : WGM;
        u.pm = fm + ((wgid % nig) % gsz); u.pn = (wgid % nig) / gsz; return true;
    }
    __device__ __forceinline__ void a_ready(const Unit&) const {}
    __device__ __forceinline__ void done(const Unit&) const {}
};
__device__ __forceinline__ unsigned cvt_pk_bf16(float lo, float hi) { unsigned r; asm volatile("v_cvt_pk_bf16_f32 %0, %1, %2" : "=v"(r) : "v"(lo), "v"(hi)); return r; }
typedef float f32x2 __attribute__((ext_vector_type(2)));
template <class Epi, class Sched, bool ALIGN_EPI = false, bool SP2 = false>
__device__ __forceinline__ void gemm_phase(PG8_LAS unsigned char* lds, const Gemm g, const Sched& S, const Epi& E, int wid_s) {
    const int tid = mk_tid(wid_s), wid = wid_s, lane = tid & 63, wr = wid >> 2, wc = wid & 3, fr = lane & 15, fq = lane >> 4;
    const int K = g.K, nt = K / BK;
    unsigned voffA[2], voffB[2];
#pragma unroll
    for (int i = 0; i < 2; ++i) { int R, C; stage_rc(tid * 16 + i * 8192, R, C); const int Rb = Epi::PERM ? ((R & ~31) + perm32(R & 31)) : R;
        voffA[i] = (unsigned)(R * K + C) * 2u; voffB[i] = (unsigned)(Rb * K + C) * 2u; }
    const size_t kstep = (size_t)(BK * 2);
    const size_t hstep = (size_t)HALF * K * 2;
    const size_t tstep = 2 * hstep;
    const unsigned ldsw = (unsigned)wid * 1024u;
    const int aoff = lds_byte(wr * 64 + fr, fq * 8), boff = lds_byte(wc * 32 + fr, fq * 8);
#define PG8_SA(b, h) (((b) * 2 + (h)) * HTB)
#define PG8_SB(b, h) ((4 + (b) * 2 + (h)) * HTB)
#define PG8_STAGE(bufoff, gbase, voff) do { _Pragma("unroll") for (int _i = 0; _i < 2; ++_i) \
        __builtin_amdgcn_global_load_lds((const unsigned*)((const char*)(gbase) + (voff)[_i]), (PG8_LAS unsigned*)(lds + (bufoff) + ldsw + _i * 8192), 16, 0, 0); } while (0)
#define PG8_LDA(dst, b, h) do { _Pragma("unroll") for (int m = 0; m < 4; ++m) _Pragma("unroll") for (int k = 0; k < 2; ++k) dst[m][k] = *(const PG8_LAS bf16x8*)(lds + PG8_SA(b, h) + aoff + m * 2048 + k * 1024); } while (0)
#define PG8_LDB(dst, b, h) do { _Pragma("unroll") for (int n = 0; n < 2; ++n) _Pragma("unroll") for (int k = 0; k < 2; ++k) dst[n][k] = *(const PG8_LAS bf16x8*)(lds + PG8_SB(b, h) + boff + n * 2048 + k * 1024); } while (0)
#define PG8_MMA(ai, bj, At, Bt) do { __builtin_amdgcn_s_setprio(1); _Pragma("unroll") for (int m = 0; m < 4; ++m) _Pragma("unroll") for (int n = 0; n < 2; ++n) _Pragma("unroll") for (int k = 0; k < 2; ++k) \
        acc[ai][bj][m][n] = __builtin_amdgcn_mfma_f32_16x16x32_bf16(Bt[n][k], At[m][k], acc[ai][bj][m][n], 0, 0, 0); __builtin_amdgcn_s_setprio(0); } while (0)
#define PG8_WAIT_V(n) asm volatile("s_waitcnt vmcnt(" #n ")" ::: "memory")
#define PG8_WAIT_L(n) asm volatile("s_waitcnt lgkmcnt(" #n ")" ::: "memory")
#define PG8_BAR __builtin_amdgcn_s_barrier()
#define PG8_SCHED __builtin_amdgcn_sched_barrier(0)
    Unit cur, nxt; int ui = 0;
    if (!S.next(0, cur)) return;
    f32x4 acc[2][2][4][2];
    if constexpr (Epi::HAS_INIT) { E.init(acc, cur, wr, wc, fr, fq); }
    else {
#pragma unroll
    for (int a = 0; a < 2; ++a)
#pragma unroll
        for (int b = 0; b < 2; ++b)
#pragma unroll
            for (int m = 0; m < 4; ++m)
#pragma unroll
                for (int n = 0; n < 2; ++n) acc[a][b][m][n] = (f32x4){0.f, 0.f, 0.f, 0.f};
    }
    bf16x8 At[4][2], B0[2][2], B1[2][2];
    const char* cA = (const char*)g.A + (size_t)cur.pm * tstep; const char* cB = (const char*)g.Bt + (size_t)cur.pn * tstep;
    S.a_ready(cur);
    if constexpr (SP2) {
        PG8_STAGE(PG8_SB(0, 0), cB, voffB); PG8_STAGE(PG8_SB(0, 1), cB + hstep, voffB); PG8_STAGE(PG8_SA(0, 0), cA, voffA); PG8_STAGE(PG8_SA(0, 1), cA + hstep, voffA);
        if (wr == 1) PG8_BAR;
        PG8_WAIT_V(2); PG8_BAR;
        PG8_STAGE(PG8_SB(1, 0), cB + kstep, voffB); PG8_STAGE(PG8_SA(1, 0), cA + kstep, voffA); PG8_STAGE(PG8_SB(1, 1), cB + hstep + kstep, voffB);
        PG8_WAIT_V(6); PG8_BAR;
    } else {
        PG8_STAGE(PG8_SB(0, 0), cB, voffB); PG8_STAGE(PG8_SA(0, 0), cA, voffA); PG8_STAGE(PG8_SB(0, 1), cB + hstep, voffB); PG8_STAGE(PG8_SA(0, 1), cA + hstep, voffA);
        if (wr == 1) PG8_BAR;
        PG8_WAIT_V(4); PG8_BAR;
        PG8_STAGE(PG8_SB(1, 0), cB + kstep, voffB); PG8_STAGE(PG8_SA(1, 0), cA + kstep, voffA); PG8_STAGE(PG8_SB(1, 1), cB + hstep + kstep, voffB);
        PG8_WAIT_V(6); PG8_BAR;
    }
    for (;;) {
        const bool has_next = S.next(ui + 1, nxt);
        const char* nA = has_next ? (const char*)g.A + (size_t)nxt.pm * tstep : cA; const char* nB = has_next ? (const char*)g.Bt + (size_t)nxt.pn * tstep : cB;
        for (int t = 0; t < nt; t += 2) {
            const bool last = (t == nt - 2);
            const char* a1 = cA + (size_t)(t + 1) * kstep;
            const char* a2 = last ? nA : cA + (size_t)(t + 2) * kstep; const char* b2 = last ? nB : cB + (size_t)(t + 2) * kstep;
            const char* a3 = a2 + kstep; const char* b3 = b2 + kstep;
            if (last && has_next) S.a_ready(nxt);
            if constexpr (SP2) {
            PG8_LDB(B0, 0, 0); PG8_LDB(B1, 0, 1); PG8_SCHED; PG8_LDA(At, 0, 0); PG8_STAGE(PG8_SA(1, 1), a1 + hstep, voffA);
            PG8_WAIT_V(8); PG8_WAIT_L(0); PG8_BAR; PG8_MMA(0, 0, At, B0); PG8_MMA(0, 1, At, B1); PG8_BAR; PG8_SCHED;
            PG8_LDA(At, 0, 1); PG8_STAGE(PG8_SB(0, 0), b2, voffB); PG8_STAGE(PG8_SB(0, 1), b2 + hstep, voffB); PG8_STAGE(PG8_SA(0, 0), a2, voffA);
            PG8_WAIT_V(8); PG8_WAIT_L(0); PG8_BAR; PG8_MMA(1, 0, At, B0); PG8_MMA(1, 1, At, B1); PG8_BAR; PG8_SCHED;
            PG8_LDB(B0, 1, 0); PG8_LDB(B1, 1, 1); PG8_SCHED; PG8_LDA(At, 1, 0); PG8_STAGE(PG8_SA(0, 1), a2 + hstep, voffA);
            PG8_WAIT_V(8); PG8_WAIT_L(0); PG8_BAR; PG8_MMA(0, 0, At, B0); PG8_MMA(0, 1, At, B1); PG8_BAR; PG8_SCHED;
            PG8_LDA(At, 1, 1); PG8_STAGE(PG8_SB(1, 0), b3, voffB); PG8_STAGE(PG8_SB(1, 1), b3 + hstep, voffB); PG8_STAGE(PG8_SA(1, 0), a3, voffA);
            PG8_WAIT_V(8); PG8_WAIT_L(0); PG8_BAR; PG8_MMA(1, 0, At, B0); PG8_MMA(1, 1, At, B1); PG8_BAR; PG8_SCHED;
            } else {
            PG8_LDB(B0, 0, 0); PG8_SCHED; PG8_LDA(At, 0, 0); PG8_STAGE(PG8_SA(1, 1), a1 + hstep, voffA);
            PG8_WAIT_L(8); PG8_BAR; PG8_WAIT_L(0); PG8_MMA(0, 0, At, B0); PG8_BAR; PG8_SCHED;
            PG8_LDB(B1, 0, 1); PG8_STAGE(PG8_SB(0, 0), b2, voffB);
            PG8_BAR; PG8_WAIT_L(0); PG8_MMA(0, 1, At, B1); PG8_BAR;
            PG8_LDA(At, 0, 1); PG8_STAGE(PG8_SA(0, 0), a2, voffA);
            PG8_BAR; PG8_WAIT_L(0); PG8_MMA(1, 0, At, B0); PG8_BAR; PG8_SCHED;
            PG8_STAGE(PG8_SB(0, 1), b2 + hstep, voffB);
            PG8_WAIT_V(6); PG8_BAR; PG8_MMA(1, 1, At, B1); PG8_BAR;
            PG8_LDB(B0, 1, 0); PG8_SCHED; PG8_LDA(At, 1, 0); PG8_STAGE(PG8_SA(0, 1), a2 + hstep, voffA);
            PG8_WAIT_L(8); PG8_BAR; PG8_WAIT_L(0); PG8_MMA(0, 0, At, B0); PG8_BAR; PG8_SCHED;
            PG8_LDB(B1, 1, 1); PG8_STAGE(PG8_SB(1, 0), b3, voffB);
            PG8_BAR; PG8_WAIT_L(0); PG8_MMA(0, 1, At, B1); PG8_BAR;
            PG8_LDA(At, 1, 1); PG8_STAGE(PG8_SA(1, 0), a3, voffA);
            PG8_BAR; PG8_WAIT_L(0); PG8_MMA(1, 0, At, B0); PG8_BAR; PG8_SCHED;
            PG8_STAGE(PG8_SB(1, 1), b3 + hstep, voffB);
            PG8_WAIT_V(6); PG8_BAR; PG8_MMA(1, 1, At, B1); PG8_BAR;
            }
        }
        if constexpr (ALIGN_EPI) { if (wr == 0) PG8_BAR; }
        if constexpr (!Epi::AFTER_DRAIN) { E(acc, cur, wr, wc, fr, fq); S.done(cur); }
        if (!has_next) break;
#pragma unroll
        for (int a = 0; a < 2; ++a)
#pragma unroll
            for (int b = 0; b < 2; ++b)
#pragma unroll
                for (int m = 0; m < 4; ++m)
#pragma unroll
                    for (int n = 0; n < 2; ++n) acc[a][b][m][n] = (f32x4){0.f, 0.f, 0.f, 0.f};
        cur = nxt; cA = nA; cB = nB; ++ui;
        if constexpr (ALIGN_EPI) { if (wr == 1) PG8_BAR; }
    }
    PG8_WAIT_V(0);
    if constexpr (!ALIGN_EPI) { if (wr == 0) PG8_BAR; }
    PG8_BAR;
    if constexpr (Epi::AFTER_DRAIN) { E.fused(acc, cur, wr, wc, fr, fq, lds, wid, lane); S.done(cur); }
#undef PG8_SA
#undef PG8_SB
#undef PG8_STAGE
#undef PG8_LDA
#undef PG8_LDB
#undef PG8_MMA
#undef PG8_WAIT_V
#undef PG8_WAIT_L
#undef PG8_BAR
#undef PG8_SCHED
}
}

namespace pg8 {
struct EpiF32 {
  static constexpr bool PERM = false, AFTER_DRAIN = false, HAS_INIT = false;
  float* C; int ldc; int ncols; int split_cols; size_t split_stride; const float* r0; const float* r1; int nr0;
  __device__ __forceinline__ void operator()(const f32x4 (&acc)[2][2][4][2], const Unit& u, int wr, int wc, int fr0, int fq0) const {
    int fr = fr0, fq = fq0; asm volatile("" : "+v"(fr), "+v"(fq));
    const int row0 = u.pm * BM + wr * 64 + fr; int colt = u.pn * BM; float* base = C;
    if (split_cols) { const int t = colt / split_cols; base += (size_t)t * split_stride; colt -= t * split_cols; }
    const int col0 = colt + wc * 32 + 4 * fq;
#pragma unroll
    for (int ai = 0; ai < 2; ++ai)
#pragma unroll
      for (int m = 0; m < 4; ++m) {
        const int row = row0 + ai * HALF + m * 16;
        const float* rr = r0 ? (row < nr0 ? r0 + (size_t)row * ldc : r1 + (size_t)(row - nr0) * ldc) : nullptr;
#pragma unroll
        for (int bj = 0; bj < 2; ++bj)
#pragma unroll
          for (int n = 0; n < 2; ++n) {
            const int col = col0 + bj * HALF + n * 16;
            if (col < ncols) { f32x4 v = acc[ai][bj][m][n]; if (rr) v += *(const f32x4*)(rr + col); *(f32x4*)(base + (size_t)row * ldc + col) = v; }
          }
        asm volatile("" ::: "memory");
      }
  }
};
}

constexpr int DM = 1024, BATCH = 4, SEQ = 4096, DB = 128, DT = 8, PAST = 8192, PAGE = 128, NPG = 64, NMEM = 256;
constexpr int NP = BATCH * SEQ, NS = DB * DT, NT = NP + NS;
constexpr int INC = 2592;
constexpr int C_CQ = 0, C_CKV = 256, C_KR = 384, C_GMLA = 416, C_Z = 928, C_GRWKV = 1824, C_QX = 2080, C_GX = 2336;
constexpr float MLA_SCALE = 0.10206207261596575f;
constexpr float X_SCALE = 0.125f;
constexpr float RMS_EPS = 1e-6f, GN_EPS = 64e-5f;
constexpr size_t O_YP = 0, O_YS = 16777216, O_CKVP = 17825792, O_KPEP = 19922944, O_WKVP = 20447232, O_SHP = 20512768,
                 O_MKP = 20516352, O_MVP = 20778496, O_CKVS = 21040640, O_KPES = 21171712, O_WKVS = 21204480, O_SHS = 23301632;
constexpr size_t W_H = 0;
constexpr size_t W_HM = W_H + (size_t)NT * 1024;
constexpr size_t W_PROJ = W_HM + (size_t)1024 * 1024;
constexpr size_t W_CQN = W_PROJ + (size_t)NT * INC;
constexpr size_t W_Q = W_CQN + (size_t)NT * 256;
constexpr size_t W_KN = W_Q + (size_t)NT * 768;
constexpr size_t W_V = W_KN + (size_t)NP * 512;
constexpr size_t W_QLAT = W_V + (size_t)NP * 512;
constexpr size_t W_OLAT = W_QLAT + (size_t)NS * 1024;
constexpr size_t W_R = W_OLAT + (size_t)NS * 1024;
constexpr size_t W_W = W_R + (size_t)NT * 256;
constexpr size_t W_KF = W_W + (size_t)NT * 256;
constexpr size_t W_VV = W_KF + (size_t)NT * 256;
constexpr size_t W_KK = W_VV + (size_t)NT * 256;
constexpr size_t W_BB = W_KK + (size_t)NT * 256;
constexpr size_t W_MIX = W_BB + (size_t)NT * 256;
constexpr size_t W_PO = W_MIX + (size_t)NT * 1024;
constexpr size_t W_PML = W_PO + (size_t)256 * 64 * 128;
constexpr size_t W_Y = W_PML + (size_t)256 * 64 * 2;
constexpr size_t W_CTL = W_Y + (size_t)NT * 256;
constexpr size_t W_CS = W_CTL + 256;
constexpr size_t W_XB = W_CS + (size_t)4104 * 32;
constexpr size_t W_YU = W_XB + (size_t)NP * 4;
constexpr size_t W_SMID = W_YU + (size_t)16 * 2048 * 64;
constexpr size_t W_QST = W_SMID + (size_t)16 * 4096;
constexpr size_t W_EST = W_QST + (size_t)16 * 4096;
constexpr size_t W_BAR = W_EST + (size_t)16 * 4096;
constexpr size_t W_TS = W_BAR + 3456;
constexpr size_t W_END = W_TS + 64;
constexpr int INCP = 2816;
constexpr size_t B_H = 0;
constexpr size_t B_HM = B_H + (size_t)NT * 1024;
constexpr size_t B_WIN = B_HM + (size_t)1024 * 1024;
constexpr size_t B_WMEM = B_WIN + (size_t)INCP * 1024;
constexpr size_t B_WOUT = B_WMEM + (size_t)512 * 1024;
constexpr size_t B_MIX = B_WOUT + (size_t)1024 * 1024;
constexpr size_t B_QP = B_MIX + (size_t)NT * 1024;
constexpr size_t B_KP = B_QP + (size_t)NP * 768;
constexpr size_t B_VT = B_KP + (size_t)NP * 768;
constexpr size_t B_QS = B_VT + (size_t)512 * NP;
constexpr size_t B_QX = B_QS + (size_t)NS * 8 * 160;
constexpr size_t B_KM = B_QX + (size_t)NP * 256;
constexpr size_t B_VMT = B_KM + (size_t)4 * 256 * 256;
constexpr size_t B_CQN = B_VMT + (size_t)4 * 256 * 256;
constexpr size_t B_CKVN = B_CQN + (size_t)NT * 256;
constexpr size_t B_WUQ = B_CKVN + (size_t)NP * 128;
constexpr size_t B_WQL = B_WUQ + (size_t)768 * 256;
constexpr size_t B_WUK = B_WQL + (size_t)1024 * 256;
constexpr size_t B_WUV = B_WUK + (size_t)512 * 128;
constexpr size_t B_OLAT = B_WUV + (size_t)512 * 128;
constexpr size_t B_WUVBD = B_OLAT + (size_t)NS * 1024;
constexpr size_t B_PROJ = B_WUVBD + (size_t)512 * 1024;
constexpr size_t B_END = B_PROJ + (size_t)NT * INC;
constexpr size_t WS_BYTES = W_END * 4 + B_END * 2;
constexpr int LDS_BYTES = 147456;
constexpr int SEG1 = 3072, SEG2 = SEQ - SEG1;
constexpr int NSCAN = 32;

struct Params {
  const float* x_prompt; const float* x_sample; const float* mem_prompt; const float* cache_ckv; const float* cache_kpe;
  const int* page_table; const float* state_wkv; const float* state_shift; const float* cache_mem_k; const float* cache_mem_v;
  const float* ln_g; const float* w_in; const float* q_norm_g; const float* kv_norm_g; const float* w_uq; const float* w_uk;
  const float* w_uv; const float* shift_mu; const float* w0; const float* w_up; const float* a0; const float* a_up;
  const float* k_k; const float* k_a; const float* r_k; const float* lnx_g; const float* lnx_b; const float* mem_norm_g;
  const float* w_mem_kv; const float* w_out; const float* final_g;
  float* out; float* ws;
};

__device__ __forceinline__ unsigned f2bf(float f);
__device__ __forceinline__ unsigned pk2(float lo, float hi);
typedef unsigned short bf16;

__device__ __forceinline__ float bf2f(unsigned short b) { return __uint_as_float((unsigned)b << 16); }
__device__ __forceinline__ float pj(const unsigned short* P, size_t row, int col) { return bf2f(P[row * INC + col]); }
__device__ __forceinline__ float4 pj4(const unsigned short* P, size_t row, int col) {
  const uint2 w = *(const uint2*)(P + row * INC + col);
  return make_float4(__uint_as_float(w.x << 16), __uint_as_float(w.x & 0xffff0000u), __uint_as_float(w.y << 16), __uint_as_float(w.y & 0xffff0000u));
}
__device__ __forceinline__ float wave_sum(float v) {
#pragma unroll
  for (int o = 1; o < 64; o <<= 1) v += __shfl_xor(v, o);
  return v;
}

__device__ __forceinline__ float wave_sum_fast(float v) {
  v += __int_as_float(__builtin_amdgcn_update_dpp(0, __float_as_int(v), 0xB1, 0xF, 0xF, true));
  v += __int_as_float(__builtin_amdgcn_update_dpp(0, __float_as_int(v), 0x4E, 0xF, 0xF, true));
  v += __int_as_float(__builtin_amdgcn_update_dpp(0, __float_as_int(v), 0x141, 0xF, 0xF, true));
  v += __int_as_float(__builtin_amdgcn_update_dpp(0, __float_as_int(v), 0x140, 0xF, 0xF, true));
  v += __int_as_float(__builtin_amdgcn_update_dpp(0, __float_as_int(v), 0x142, 0xA, 0xF, false));
  v += __int_as_float(__builtin_amdgcn_update_dpp(0, __float_as_int(v), 0x143, 0xC, 0xF, false));
  return __int_as_float(__builtin_amdgcn_readlane(__float_as_int(v), 63));
}
__device__ __forceinline__ float wave_max(float v) {
#pragma unroll
  for (int o = 1; o < 64; o <<= 1) v = fmaxf(v, __shfl_xor(v, o));
  return v;
}
__device__ __forceinline__ float silu(float x) { return x / (1.f + expf(-x)); }
__device__ __forceinline__ const float* xrow(const Params& p, int row) {
  return row < NP ? p.x_prompt + (size_t)row * DM : p.x_sample + (size_t)(row - NP) * DM;
}
__device__ __forceinline__ float* ckv_out_row(const Params& p, int row) {
  return row < NP ? p.out + O_CKVP + (size_t)row * 128 : p.out + O_CKVS + (size_t)(row - NP) * 128;
}
__device__ __forceinline__ float* kpe_out_row(const Params& p, int row) {
  return row < NP ? p.out + O_KPEP + (size_t)row * 32 : p.out + O_KPES + (size_t)(row - NP) * 32;
}


namespace pg8 {
typedef unsigned u32x2 __attribute__((ext_vector_type(2)));
template <class F> struct EpiBf16F {
  static constexpr bool PERM = true, AFTER_DRAIN = false, HAS_INIT = false;
  F f; float scale;
  __device__ __forceinline__ void operator()(const f32x4 (&acc)[2][2][4][2], const Unit& u, int wr, int wc, int fr, int fq) const {
    int fr_ = fr, fq_ = fq; asm volatile("" : "+v"(fr_), "+v"(fq_));
    const int row0 = u.pm * BM + wr * 64 + fr_, col0 = u.pn * BM + wc * 32 + 8 * fq_;
#pragma unroll
    for (int ai = 0; ai < 2; ++ai)
#pragma unroll
      for (int m = 0; m < 4; ++m)
#pragma unroll
        for (int bj = 0; bj < 2; ++bj) {
          bf16_t* dst = f(row0 + ai * HALF + m * 16, col0 + bj * HALF);
          if (dst) { const f32x4 v0 = acc[ai][bj][m][0] * scale, v1 = acc[ai][bj][m][1] * scale;
            u32x4 w; w.x = cvt_pk_bf16(v0[0], v0[1]); w.y = cvt_pk_bf16(v0[2], v0[3]); w.z = cvt_pk_bf16(v1[0], v1[1]); w.w = cvt_pk_bf16(v1[2], v1[3]);
            *(u32x4*)dst = w; }
        }
  }
};
struct EpiQ {
  static constexpr bool PERM = true, AFTER_DRAIN = false, HAS_INIT = false;
  bf16_t* Qp; bf16_t* Qs; const float* CS; float scale; int np;
  __device__ __forceinline__ void operator()(const f32x4 (&acc)[2][2][4][2], const Unit& u, int wr, int wc, int fr0, int fq0) const {
    int fr = fr0, fq = fq0; asm volatile("" : "+v"(fr), "+v"(fq));
    const int row0 = u.pm * BM + wr * 64 + fr;
    if (u.pn < 2) {
      if (u.pm * BM >= np) return;
#pragma unroll
      for (int ai = 0; ai < 2; ++ai)
#pragma unroll
        for (int m = 0; m < 4; ++m) {
          const int row = row0 + ai * HALF + m * 16;
#pragma unroll
          for (int bj = 0; bj < 2; ++bj) {
            const int col = u.pn * BM + bj * HALF + wc * 32 + 8 * fq, head = col >> 6, d = col & 63;
            const f32x4 v0 = acc[ai][bj][m][0] * scale, v1 = acc[ai][bj][m][1] * scale;
            u32x4 w; w.x = cvt_pk_bf16(v0[0], v0[1]); w.y = cvt_pk_bf16(v0[2], v0[3]); w.z = cvt_pk_bf16(v1[0], v1[1]); w.w = cvt_pk_bf16(v1[2], v1[3]);
            *(u32x4*)(Qp + (size_t)row * 768 + head * 96 + d) = w;
          }
        }
    } else {
      const int head = 2 * wc + (fq >> 1), j0 = 8 * (fq & 1);
#pragma unroll
      for (int ai = 0; ai < 2; ++ai)
#pragma unroll
        for (int m = 0; m < 4; ++m) {
          const int row = row0 + ai * HALF + m * 16;
          const bool pr = row < np;
          const int pi = pr ? (row & 4095) : 4096 + ((row - np) & 7);
          u32x4 w1, w2;
#pragma unroll
          for (int n = 0; n < 2; ++n) {
            const int j = j0 + 4 * n;
            const f32x4 cs0 = *(const f32x4*)(CS + ((size_t)pi * 16 + j) * 2), cs1 = *(const f32x4*)(CS + ((size_t)pi * 16 + j) * 2 + 4);
            const f32x4 x1 = acc[ai][0][m][n], x2 = acc[ai][1][m][n];
            f32x4 y1, y2;
            y1[0] = x1[0] * cs0[0] - x2[0] * cs0[1]; y2[0] = x2[0] * cs0[0] + x1[0] * cs0[1];
            y1[1] = x1[1] * cs0[2] - x2[1] * cs0[3]; y2[1] = x2[1] * cs0[2] + x1[1] * cs0[3];
            y1[2] = x1[2] * cs1[0] - x2[2] * cs1[1]; y2[2] = x2[2] * cs1[0] + x1[2] * cs1[1];
            y1[3] = x1[3] * cs1[2] - x2[3] * cs1[3]; y2[3] = x2[3] * cs1[2] + x1[3] * cs1[3];
            y1 = y1 * scale; y2 = y2 * scale;
            if (n == 0) { w1.x = cvt_pk_bf16(y1[0], y1[1]); w1.y = cvt_pk_bf16(y1[2], y1[3]); w2.x = cvt_pk_bf16(y2[0], y2[1]); w2.y = cvt_pk_bf16(y2[2], y2[3]); }
            else { w1.z = cvt_pk_bf16(y1[0], y1[1]); w1.w = cvt_pk_bf16(y1[2], y1[3]); w2.z = cvt_pk_bf16(y2[0], y2[1]); w2.w = cvt_pk_bf16(y2[2], y2[3]); }
          }
          bf16_t* dst = pr ? Qp + (size_t)row * 768 + head * 96 + 64 + j0 : Qs + ((size_t)(row - np) * 8 + head) * 160 + 128 + j0;
          *(u32x4*)dst = w1;
          *(u32x4*)(dst + 16) = w2;
          asm volatile("" ::: "memory");
        }
    }
  }
};
}

namespace pg8 {
struct EpiGateBf16 {
  static constexpr bool PERM = true, AFTER_DRAIN = false, HAS_INIT = false;
  bf16_t* O; int ldo; const float* G; int ldg;
  __device__ __forceinline__ float sl(float x) const { return x / (1.f + __expf(-x)); }
  __device__ __forceinline__ void operator()(const f32x4 (&acc)[2][2][4][2], const Unit& u, int wr, int wc, int fr0, int fq0) const {
    int fr = fr0, fq = fq0; asm volatile("" : "+v"(fr), "+v"(fq));
    const int row0 = u.pm * BM + wr * 64 + fr, col0 = u.pn * BM + wc * 32 + 8 * fq;
#pragma unroll
    for (int ai = 0; ai < 2; ++ai)
#pragma unroll
      for (int m = 0; m < 4; ++m)
#pragma unroll
        for (int bj = 0; bj < 2; ++bj) {
          const int row = row0 + ai * HALF + m * 16, col = col0 + bj * HALF;
          const f32x4 g0 = *(const f32x4*)(G + (size_t)row * ldg + col), g1 = *(const f32x4*)(G + (size_t)row * ldg + col + 4);
          const f32x4 v0 = acc[ai][bj][m][0], v1 = acc[ai][bj][m][1];
          u32x4 w; w.x = cvt_pk_bf16(v0[0] * sl(g0[0]), v0[1] * sl(g0[1])); w.y = cvt_pk_bf16(v0[2] * sl(g0[2]), v0[3] * sl(g0[3]));
          w.z = cvt_pk_bf16(v1[0] * sl(g1[0]), v1[1] * sl(g1[1])); w.w = cvt_pk_bf16(v1[2] * sl(g1[2]), v1[3] * sl(g1[3]));
          *(u32x4*)(O + (size_t)row * ldo + col) = w;
          asm volatile("" ::: "memory");
        }
  }
};
}

namespace pg8 {
struct EpiRmsOut {
  static constexpr bool PERM = false, AFTER_DRAIN = true, HAS_INIT = true;
  const float* x; float* out; const float* gain; float* xbuf; unsigned* cnt; float eps;
  __device__ __forceinline__ void init(f32x4 (&acc)[2][2][4][2], const Unit& u, int wr, int wc, int fr, int fq) const {
    const int col0 = u.pn * BM + wc * 32 + 4 * fq;
#pragma unroll
    for (int ai = 0; ai < 2; ++ai)
#pragma unroll
      for (int m = 0; m < 4; ++m) {
        const float* xr = x + (size_t)(u.pm * BM + ai * HALF + wr * 64 + m * 16 + fr) * 1024;
#pragma unroll
        for (int bj = 0; bj < 2; ++bj)
#pragma unroll
          for (int n = 0; n < 2; ++n) acc[ai][bj][m][n] = *(const f32x4*)(xr + col0 + bj * HALF + n * 16);
      }
  }
  __device__ __forceinline__ void fused(f32x4 (&acc)[2][2][4][2], const Unit& u, int wr, int wc, int fr0, int fq0, PG8_LAS unsigned char* lds, int wid, int lane) const {
    int fr = fr0, fq = fq0; asm volatile("" : "+v"(fr), "+v"(fq));
    PG8_LAS float* P = (PG8_LAS float*)lds;
    PG8_LAS float* S = (PG8_LAS float*)(lds + 4096);
    const int col0 = u.pn * BM + wc * 32 + 4 * fq;
#pragma unroll
    for (int ai = 0; ai < 2; ++ai)
#pragma unroll
      for (int m = 0; m < 4; ++m) {
        const int rl = ai * HALF + wr * 64 + m * 16 + fr;
        float s = 0.f;
#pragma unroll
        for (int bj = 0; bj < 2; ++bj)
#pragma unroll
          for (int n = 0; n < 2; ++n) {
            const f32x4 v = acc[ai][bj][m][n];
            s += (v[0] * v[0] + v[1] * v[1]) + (v[2] * v[2] + v[3] * v[3]);
          }
        s += __shfl_xor(s, 16); s += __shfl_xor(s, 32);
        if (fq == 0) P[rl * 4 + wc] = s;
        asm volatile("" ::: "memory");
      }
    asm volatile("s_waitcnt lgkmcnt(0)" ::: "memory"); __builtin_amdgcn_s_barrier(); asm volatile("" ::: "memory");
    const int tid = wid * 64 + lane;
    if (tid < 256) {
      const float tot = (P[tid * 4] + P[tid * 4 + 1]) + (P[tid * 4 + 2] + P[tid * 4 + 3]);
      __hip_atomic_store((unsigned*)xbuf + ((size_t)(u.pm * BM + tid)) * 4 + u.pn, __float_as_uint(tot), __ATOMIC_RELAXED, __HIP_MEMORY_SCOPE_AGENT);
    }
    asm volatile("s_waitcnt vmcnt(0)" ::: "memory");
    if (tid < 256 && lane == 0) __hip_atomic_fetch_add(cnt + u.pm, 1u, __ATOMIC_RELAXED, __HIP_MEMORY_SCOPE_AGENT);
    if (wid == 0) {
      for (;;) {
        const unsigned c_ = (unsigned)__builtin_amdgcn_readfirstlane((int)__hip_atomic_load(cnt + u.pm, __ATOMIC_RELAXED, __HIP_MEMORY_SCOPE_AGENT));
        if (c_ >= 16u) break;
        __builtin_amdgcn_s_sleep(2);
      }
      __builtin_amdgcn_fence(__ATOMIC_ACQUIRE, "agent");
    }
    asm volatile("s_waitcnt vmcnt(0) lgkmcnt(0)" ::: "memory"); __builtin_amdgcn_s_barrier(); asm volatile("" ::: "memory");
    if (tid < 256) {
      unsigned* xb = (unsigned*)xbuf + ((size_t)(u.pm * BM + tid)) * 4;
      const float ssq = (__uint_as_float(__hip_atomic_load(xb, __ATOMIC_RELAXED, __HIP_MEMORY_SCOPE_AGENT)) + __uint_as_float(__hip_atomic_load(xb + 1, __ATOMIC_RELAXED, __HIP_MEMORY_SCOPE_AGENT))) +
                        (__uint_as_float(__hip_atomic_load(xb + 2, __ATOMIC_RELAXED, __HIP_MEMORY_SCOPE_AGENT)) + __uint_as_float(__hip_atomic_load(xb + 3, __ATOMIC_RELAXED, __HIP_MEMORY_SCOPE_AGENT)));
      S[tid] = 1.0f / sqrtf(ssq * (1.f / 1024.f) + eps);
    }
    asm volatile("s_waitcnt lgkmcnt(0)" ::: "memory"); __builtin_amdgcn_s_barrier(); asm volatile("" ::: "memory");
#pragma unroll
    for (int ai = 0; ai < 2; ++ai)
#pragma unroll
      for (int m = 0; m < 4; ++m) {
        const int rl = ai * HALF + wr * 64 + m * 16 + fr;
        const float rs = S[rl];
        float* orow = out + (size_t)(u.pm * BM + rl) * 1024;
#pragma unroll
        for (int bj = 0; bj < 2; ++bj)
#pragma unroll
          for (int n = 0; n < 2; ++n) {
            const int col = col0 + bj * HALF + n * 16;
            *(f32x4*)(orow + col) = acc[ai][bj][m][n] * rs * *(const f32x4*)(gain + col);
          }
        asm volatile("" ::: "memory");
      }
  }
};
}
#define LAS __attribute__((address_space(3)))
namespace pa {
typedef short bf16x8 __attribute__((ext_vector_type(8)));
typedef short s16x4 __attribute__((ext_vector_type(4)));
typedef float f32x16 __attribute__((ext_vector_type(16)));
typedef unsigned u32x4 __attribute__((ext_vector_type(4)));
typedef unsigned u32x2 __attribute__((ext_vector_type(2)));
typedef float f32x2_t __attribute__((ext_vector_type(2)));
typedef __bf16 bf16x2_t __attribute__((ext_vector_type(2)));
constexpr int KSTR = 208, VSTR = 136, KBYTES = 64 * KSTR, VBYTES = 64 * VSTR, STG = KBYTES + VBYTES;
__device__ __forceinline__ unsigned cvtpk(float lo, float hi) { f32x2_t v = {lo, hi}; bf16x2_t b = __builtin_convertvector(v, bf16x2_t); return __builtin_bit_cast(unsigned, b); }
__device__ __forceinline__ int crow(int r, int hi) { return (r & 3) + 8 * (r >> 2) + 4 * hi; }
__device__ __forceinline__ float swap_max(float v) { auto rr = __builtin_amdgcn_permlane32_swap(__float_as_uint(v), __float_as_uint(v), false, false); return fmaxf(__uint_as_float(rr[0]), __uint_as_float(rr[1])); }
__device__ __forceinline__ float swap_sum(float v) { auto rr = __builtin_amdgcn_permlane32_swap(__float_as_uint(v), __float_as_uint(v), false, false); return __uint_as_float(rr[0]) + __uint_as_float(rr[1]); }

template <int DQK, bool CAUSAL, class Out>
__device__ __forceinline__ void attn_unit(unsigned char* lds, const bf16* Qb, int qs, const bf16* Kb, int ks, const bf16* Vb, int vs, int ntiles, int qpos0, const Out& out, int wid_s) {
  const int tid = mk_tid(wid_s), lane = tid & 63, wid = wid_s, r32 = lane & 31, hi = lane >> 5;
  constexpr int CPR = DQK / 8, NKC = 64 * CPR, KS = DQK / 16;
  bf16x8 qf[KS];
#pragma unroll
  for (int s = 0; s < KS; ++s) qf[s] = *(const bf16x8*)(Qb + (size_t)(wid * 32 + r32) * qs + 16 * s + 8 * hi);
  struct Stg { u32x4 k0, k1, v; } sA, sB;
  const int kc0 = tid, kc1 = tid + 512;
  const int krow0 = kc0 / CPR, kcc0 = kc0 % CPR, krow1 = kc1 / CPR, kcc1 = kc1 % CPR;
  const int vdv = tid >> 3, vcc = tid & 7;
#define PA_GLOAD(S, t) do { (S).k0 = *(const u32x4*)(Kb + (size_t)(64 * (t) + krow0) * ks + kcc0 * 8); \
    if (kc1 < NKC) (S).k1 = *(const u32x4*)(Kb + (size_t)(64 * (t) + krow1) * ks + kcc1 * 8); \
    (S).v = *(const u32x4*)(Vb + (size_t)vdv * vs + 64 * (t) + vcc * 8); } while (0)
#define PA_LSTORE(S, buf) do { unsigned char* b_ = lds + (buf) * STG; *(u32x4*)(b_ + krow0 * KSTR + kcc0 * 16) = (S).k0; \
    if (kc1 < NKC) *(u32x4*)(b_ + krow1 * KSTR + kcc1 * 16) = (S).k1; \
    *(u32x2*)(b_ + KBYTES + vdv * VSTR + vcc * 16) = (u32x2){(S).v.x, (S).v.y}; *(u32x2*)(b_ + KBYTES + vdv * VSTR + vcc * 16 + 8) = (u32x2){(S).v.z, (S).v.w}; } while (0)
  PA_GLOAD(sA, 0); if (ntiles > 1) PA_GLOAD(sB, 1); PA_LSTORE(sA, 0); if (ntiles > 1) PA_LSTORE(sB, 1); if (ntiles > 2) PA_GLOAD(sA, 2); __syncthreads();
  bf16x8 ka[KS], kc[KS];
#pragma unroll
  for (int s = 0; s < KS; ++s) {
    ka[s] = *(const bf16x8*)(lds + r32 * KSTR + (16 * s + 8 * hi) * 2);
    kc[s] = *(const bf16x8*)(lds + (32 + r32) * KSTR + (16 * s + 8 * hi) * 2);
  }
  f32x16 o0, o1;
#pragma unroll
  for (int r = 0; r < 16; ++r) { o0[r] = 0.f; o1[r] = 0.f; }
  constexpr float PA_THR = 6.f;
  float m = 0.f, l = 0.f;
  f32x16 nm;
#pragma unroll
  for (int r = 0; r < 16; ++r) nm[r] = 0.f;
  const int qlo = qpos0 + 32 * wid;
#define PA_MX3(a, b, c) __builtin_fmaxf(__builtin_fmaxf((a), (b)), (c))
  auto compute_tile = [&](int t) {
    const int slot = t % 3, nslot = slot == 2 ? 0 : slot + 1;
    const unsigned char* vb = lds + slot * STG + KBYTES; const unsigned char* kn = lds + nslot * STG;
    const bool active = !CAUSAL || (64 * t <= qlo + 31);
    if (active) {
      bf16x8 va[8];
      f32x16 p0, p1;
#pragma unroll
      for (int s = 0; s < KS; ++s) {
        if (s == 0) { p0 = __builtin_amdgcn_mfma_f32_32x32x16_bf16(ka[s], qf[s], nm, 0, 0, 0); p1 = __builtin_amdgcn_mfma_f32_32x32x16_bf16(kc[s], qf[s], nm, 0, 0, 0); }
        else { p0 = __builtin_amdgcn_mfma_f32_32x32x16_bf16(ka[s], qf[s], p0, 0, 0, 0); p1 = __builtin_amdgcn_mfma_f32_32x32x16_bf16(kc[s], qf[s], p1, 0, 0, 0); }
        if (s < 4) {
#pragma unroll
          for (int d = 0; d < 2; ++d) {
            const unsigned char* vp = vb + (32 * d + r32) * VSTR + (16 * s + 4 * hi) * 2;
            const u32x2 lo = *(const u32x2*)vp, hi2 = *(const u32x2*)(vp + 16);
            const u32x4 w = {lo.x, lo.y, hi2.x, hi2.y};
            va[2 * s + d] = __builtin_bit_cast(bf16x8, w);
          }
        }
        __builtin_amdgcn_sched_barrier(0);
      }
      if (CAUSAL && (64 * t + 63 > qlo)) {
        const int q = qlo + r32;
#pragma unroll
        for (int r = 0; r < 16; ++r) { const int key = 64 * t + crow(r, hi); if (key > q) p0[r] = -1e30f; if (key + 32 > q) p1[r] = -1e30f; }
      }
      float mxa = PA_MX3(p0[0], p0[1], p1[0]), mxb = PA_MX3(p0[2], p0[3], p1[1]); mxa = PA_MX3(mxa, p1[2], p1[3]);
#pragma unroll
      for (int r = 4; r < 16; r += 4) { mxa = PA_MX3(mxa, p0[r], p0[r + 1]); mxb = PA_MX3(mxb, p0[r + 2], p0[r + 3]); mxa = PA_MX3(mxa, p1[r], p1[r + 1]); mxb = PA_MX3(mxb, p1[r + 2], p1[r + 3]); }
      const float mx = swap_max(fmaxf(mxa, mxb));
      if (t == 0 || __builtin_amdgcn_ballot_w64(mx > PA_THR) != 0ull) {
        const float d = (t == 0) ? mx : fmaxf(mx, 0.f), alpha = __builtin_amdgcn_exp2f(-d);
        m += d; l *= alpha;
#pragma unroll
        for (int r = 0; r < 16; ++r) { nm[r] = -m; p0[r] -= d; p1[r] -= d; o0[r] *= alpha; o1[r] *= alpha; }
      }
      float ps = 0.f;
#pragma unroll
      for (int r = 0; r < 16; ++r) { p0[r] = __builtin_amdgcn_exp2f(p0[r]); p1[r] = __builtin_amdgcn_exp2f(p1[r]); ps += p0[r] + p1[r]; }
      l += ps;
      bf16x8 pb[4];
#pragma unroll
      for (int k = 0; k < 4; ++k) {
        u32x4 w;
        if (k < 2) { w.x = cvtpk(p0[8 * k], p0[8 * k + 1]); w.y = cvtpk(p0[8 * k + 2], p0[8 * k + 3]); w.z = cvtpk(p0[8 * k + 4], p0[8 * k + 5]); w.w = cvtpk(p0[8 * k + 6], p0[8 * k + 7]); }
        else { const int kk = k - 2; w.x = cvtpk(p1[8 * kk], p1[8 * kk + 1]); w.y = cvtpk(p1[8 * kk + 2], p1[8 * kk + 3]); w.z = cvtpk(p1[8 * kk + 4], p1[8 * kk + 5]); w.w = cvtpk(p1[8 * kk + 6], p1[8 * kk + 7]); }
        pb[k] = __builtin_bit_cast(bf16x8, w);
      }
      __builtin_amdgcn_sched_barrier(0);
#pragma unroll
      for (int k = 0; k < 4; ++k) {
        o0 = __builtin_amdgcn_mfma_f32_32x32x16_bf16(va[2 * k], pb[k], o0, 0, 0, 0);
        o1 = __builtin_amdgcn_mfma_f32_32x32x16_bf16(va[2 * k + 1], pb[k], o1, 0, 0, 0);
#pragma unroll
        for (int s = (k * KS) / 4; s < ((k + 1) * KS) / 4; ++s) {
          ka[s] = *(const bf16x8*)(kn + r32 * KSTR + (16 * s + 8 * hi) * 2);
          kc[s] = *(const bf16x8*)(kn + (32 + r32) * KSTR + (16 * s + 8 * hi) * 2);
        }
        __builtin_amdgcn_sched_barrier(0);
      }
    }
  };
  for (int t = 0; t < ntiles; t += 2) {
    if (t + 3 < ntiles) PA_GLOAD(sB, t + 3);
    compute_tile(t);
    if (t + 2 < ntiles) PA_LSTORE(sA, (t + 2) % 3);
    __syncthreads();
    if (t + 1 < ntiles) {
      if (t + 4 < ntiles) PA_GLOAD(sA, t + 4);
      compute_tile(t + 1);
      if (t + 3 < ntiles) PA_LSTORE(sB, (t + 3) % 3);
      __syncthreads();
    }
  }
#undef PA_GLOAD
#undef PA_LSTORE
  const float inv = 1.f / swap_sum(l);
#pragma unroll
  for (int g = 0; g < 4; ++g) {
    out(32 * wid + r32, 8 * g + 4 * hi, make_float4(o0[4 * g] * inv, o0[4 * g + 1] * inv, o0[4 * g + 2] * inv, o0[4 * g + 3] * inv));
    out(32 * wid + r32, 32 + 8 * g + 4 * hi, make_float4(o1[4 * g] * inv, o1[4 * g + 1] * inv, o1[4 * g + 2] * inv, o1[4 * g + 3] * inv));
  }
}
}

namespace sa {
using pa::bf16x8; using pa::f32x16; using pa::u32x4; using pa::u32x2; using pa::cvtpk; using pa::crow; using pa::swap_max; using pa::swap_sum;
typedef float f32x4 __attribute__((ext_vector_type(4)));
typedef short v4i16_t __attribute__((ext_vector_type(4)));
constexpr int KVSTR = 336, TK = 128, TILE = TK * KVSTR;
__device__ __forceinline__ void sample_attn_item(unsigned char* lds, const Params& p, const bf16* Qs, float* PO, float* PML, int item, int wid_s) {
  const int db = item >> 1, half = item & 1;
  const int tid = mk_tid(wid_s), lane = tid & 63, wid = wid_s, r32 = lane & 31, hi = lane >> 5;
  const int qt = wid >> 2, ks = wid & 3;
  bf16x8 qf[10];
#pragma unroll
  for (int s = 0; s < 10; ++s) qf[s] = *(const bf16x8*)(Qs + (size_t)(db * 64 + 32 * qt + r32) * 160 + 16 * s + 8 * hi);
  const int ntiles = 32 + half;
  f32x4 stA[8], spA[2], stB[8], spB[2];
  const f32x4 zero4 = {0.f, 0.f, 0.f, 0.f};
  const int pg_all = p.page_table[db * NPG + 32 * half + (lane & 31)];
#define SA_GLOAD(st, sp, t) do { if ((t) < 32) { const int page_ = __builtin_amdgcn_readlane(pg_all, (t)); \
      const f32x4* ck_ = (const f32x4*)(p.cache_ckv + (size_t)page_ * PAGE * 128); const f32x4* kp_ = (const f32x4*)(p.cache_kpe + (size_t)page_ * PAGE * 32); \
      _Pragma("unroll") for (int i_ = 0; i_ < 8; ++i_) st[i_] = __builtin_nontemporal_load(ck_ + tid + 512 * i_); \
      sp[0] = __builtin_nontemporal_load(kp_ + tid); sp[1] = __builtin_nontemporal_load(kp_ + tid + 512); \
    } else { const float* ck_ = p.out + O_CKVS + (size_t)db * 8 * 128; const float* kp_ = p.out + O_KPES + (size_t)db * 8 * 32; \
      st[0] = (tid < 256) ? *(const f32x4*)(ck_ + (size_t)tid * 4) : zero4; \
      _Pragma("unroll") for (int i_ = 1; i_ < 8; ++i_) st[i_] = zero4; \
      sp[0] = (tid < 64) ? *(const f32x4*)(kp_ + (size_t)tid * 4) : zero4; sp[1] = zero4; } } while (0)
#define SA_LSTORE(st, sp, buf) do { _Pragma("unroll") for (int i_ = 0; i_ < 8; ++i_) { const int f_ = tid + 512 * i_, key_ = f_ >> 5, c4_ = f_ & 31; \
      *(u32x2*)(lds + (buf) * TILE + key_ * KVSTR + c4_ * 8) = (u32x2){cvtpk(st[i_].x, st[i_].y), cvtpk(st[i_].z, st[i_].w)}; } \
    _Pragma("unroll") for (int i_ = 0; i_ < 2; ++i_) { const int f_ = tid + 512 * i_, key_ = f_ >> 3, c4_ = f_ & 7; \
      *(u32x2*)(lds + (buf) * TILE + key_ * KVSTR + 256 + c4_ * 8) = (u32x2){cvtpk(sp[i_].x, sp[i_].y), cvtpk(sp[i_].z, sp[i_].w)}; } } while (0)
#if PROF_SEL == 120 || PROF_SEL == 121 || PROF_SEL == 122
  if (item == 0 && tid == 0 && PROF_SEL != 121) ((unsigned long long*)(p.ws + W_TS))[0] = __builtin_amdgcn_s_memrealtime();
#endif
  SA_GLOAD(stA, spA, 0); SA_LSTORE(stA, spA, 0); SA_GLOAD(stB, spB, 1); __syncthreads();
  f32x16 o[4];
#pragma unroll
  for (int c = 0; c < 4; ++c)
#pragma unroll
    for (int r = 0; r < 16; ++r) o[c][r] = 0.f;
  float m = -1e30f, l = 0.f;
  const int tq = (32 * qt + r32) >> 3;
  auto compute_tile = [&](int t) {
    const unsigned char* kb = lds + (t & 1) * TILE + (32 * ks) * KVSTR;
    if (t < 32 || ks == 0) {
      bf16x8 ka[10], va[4], vc[4];
#pragma unroll
      for (int s = 0; s < 2; ++s) ka[s] = *(const bf16x8*)(kb + r32 * KVSTR + (16 * s + 8 * hi) * 2);
      __builtin_amdgcn_sched_barrier(0);
      const int g = lane >> 4, i = lane & 15;
      const LAS unsigned char* vbase = (const LAS unsigned char*)kb + (4 * (g >> 1) + (i >> 2)) * KVSTR + (16 * (g & 1) + 4 * (i & 3)) * 2;
      f32x16 p0;
#pragma unroll
      for (int r = 0; r < 16; ++r) p0[r] = 0.f;
#pragma unroll
      for (int s = 0; s < 10; ++s) {
        p0 = __builtin_amdgcn_mfma_f32_32x32x16_bf16(ka[s], qf[s], p0, 0, 0, 0);
        if (s + 2 < 10) ka[s + 2] = *(const bf16x8*)(kb + r32 * KVSTR + (16 * (s + 2) + 8 * hi) * 2);
        else {
          const int j = s - 8;
          const v4i16_t lo = __builtin_amdgcn_ds_read_tr16_b64_v4i16((LAS v4i16_t*)(vbase + 64 * j));
          const v4i16_t hi4 = __builtin_amdgcn_ds_read_tr16_b64_v4i16((LAS v4i16_t*)(vbase + 8 * KVSTR + 64 * j));
          va[j] = (bf16x8){lo[0], lo[1], lo[2], lo[3], hi4[0], hi4[1], hi4[2], hi4[3]};
        }
        __builtin_amdgcn_sched_barrier(0);
      }
      if (t == 32) {
#pragma unroll
        for (int r = 0; r < 16; ++r) { const int u = crow(r, hi); if (!(u < 8 && u <= tq)) p0[r] = -1e30f; }
      }
      float mx = p0[0];
#pragma unroll
      for (int r = 1; r < 16; ++r) mx = fmaxf(mx, p0[r]);
      mx = swap_max(mx);
      const float mn = fmaxf(m, mx), alpha = __builtin_amdgcn_exp2f(m - mn);
      m = mn;
      float ps = 0.f;
#pragma unroll
      for (int r = 0; r < 16; ++r) { p0[r] = __builtin_amdgcn_exp2f(p0[r] - mn); ps += p0[r]; }
      l = l * alpha + ps;
      if (__builtin_amdgcn_ballot_w64(alpha != 1.f) != 0ull) {
#pragma unroll
        for (int c = 0; c < 4; ++c)
#pragma unroll
          for (int r = 0; r < 16; ++r) o[c][r] *= alpha;
      }
      bf16x8 pb[2];
#pragma unroll
      for (int k = 0; k < 2; ++k) {
        u32x4 w; w.x = cvtpk(p0[8 * k], p0[8 * k + 1]); w.y = cvtpk(p0[8 * k + 2], p0[8 * k + 3]); w.z = cvtpk(p0[8 * k + 4], p0[8 * k + 5]); w.w = cvtpk(p0[8 * k + 6], p0[8 * k + 7]);
        pb[k] = __builtin_bit_cast(bf16x8, w);
      }
      __builtin_amdgcn_sched_barrier(0);
#define SA_VC(c) do { const v4i16_t lo_ = __builtin_amdgcn_ds_read_tr16_b64_v4i16((LAS v4i16_t*)(vbase + 16 * KVSTR + 64 * (c))); \
        const v4i16_t hi_ = __builtin_amdgcn_ds_read_tr16_b64_v4i16((LAS v4i16_t*)(vbase + 24 * KVSTR + 64 * (c))); \
        vc[c] = (bf16x8){lo_[0], lo_[1], lo_[2], lo_[3], hi_[0], hi_[1], hi_[2], hi_[3]}; } while (0)
#define SA_VA(c) do { const v4i16_t lo_ = __builtin_amdgcn_ds_read_tr16_b64_v4i16((LAS v4i16_t*)(vbase + 64 * (c))); \
        const v4i16_t hi_ = __builtin_amdgcn_ds_read_tr16_b64_v4i16((LAS v4i16_t*)(vbase + 8 * KVSTR + 64 * (c))); \
        va[c] = (bf16x8){lo_[0], lo_[1], lo_[2], lo_[3], hi_[0], hi_[1], hi_[2], hi_[3]}; } while (0)
      SA_VA(2); SA_VA(3);
      __builtin_amdgcn_sched_barrier(0);
      o[0] = __builtin_amdgcn_mfma_f32_32x32x16_bf16(va[0], pb[0], o[0], 0, 0, 0);
      o[1] = __builtin_amdgcn_mfma_f32_32x32x16_bf16(va[1], pb[0], o[1], 0, 0, 0);
      SA_VC(0); SA_VC(1);
      __builtin_amdgcn_sched_barrier(0);
      o[2] = __builtin_amdgcn_mfma_f32_32x32x16_bf16(va[2], pb[0], o[2], 0, 0, 0);
      o[3] = __builtin_amdgcn_mfma_f32_32x32x16_bf16(va[3], pb[0], o[3], 0, 0, 0);
      SA_VC(2); SA_VC(3);
      __builtin_amdgcn_sched_barrier(0);
#undef SA_VA
#undef SA_VC
#pragma unroll
      for (int c = 0; c < 4; ++c) o[c] = __builtin_amdgcn_mfma_f32_32x32x16_bf16(vc[c], pb[1], o[c], 0, 0, 0);
    }
  };
  for (int t = 0; t < ntiles; t += 2) {
    if (t + 2 < ntiles) SA_GLOAD(stA, spA, t + 2);
    compute_tile(t);
    if (t + 1 < ntiles) SA_LSTORE(stB, spB, (t + 1) & 1);
    __syncthreads();
    if (t + 1 < ntiles) {
      if (t + 3 < ntiles) SA_GLOAD(stB, spB, t + 3);
      compute_tile(t + 1);
      if (t + 2 < ntiles) SA_LSTORE(stA, spA, t & 1);
      __syncthreads();
    }
  }
#undef SA_GLOAD
#undef SA_LSTORE
#if PROF_SEL == 120 || PROF_SEL == 121
  if (item == 0 && tid == 0) ((unsigned long long*)(p.ws + W_TS))[PROF_SEL == 120 ? 1 : 0] = __builtin_amdgcn_s_memrealtime();
#endif
  {
    float* X = (float*)lds;
#pragma unroll
    for (int round = 0; round < 2; ++round) {
      const bool writer = round == 0 ? (ks >= 2) : (ks == 1);
      const bool reader = round == 0 ? (ks < 2) : (ks == 0);
      const int slot = round == 0 ? (qt * 2 + (ks & 1)) : qt;
      float* xs = X + (size_t)slot * (66 * 64);
      if (writer) {
        xs[lane] = m; xs[64 + lane] = l;
#pragma unroll
        for (int c = 0; c < 4; ++c)
#pragma unroll
          for (int r = 0; r < 16; ++r) xs[(2 + c * 16 + r) * 64 + lane] = o[c][r];
      }
      __syncthreads();
      if (reader) {
        const float m2 = xs[lane], l2 = xs[64 + lane];
        const float mn = fmaxf(m, m2), s1 = __builtin_amdgcn_exp2f(m - mn), s2 = __builtin_amdgcn_exp2f(m2 - mn);
        m = mn; l = l * s1 + l2 * s2;
#pragma unroll
        for (int c = 0; c < 4; ++c)
#pragma unroll
          for (int r = 0; r < 16; ++r) o[c][r] = o[c][r] * s1 + xs[(2 + c * 16 + r) * 64 + lane] * s2;
      }
      __syncthreads();
    }
  }
  const int q = 32 * qt + r32;
  if (ks == 0) {
    const float lt = swap_sum(l);
    if (hi == 0) __hip_atomic_store((unsigned long long*)(PML + ((size_t)item * 64 + q) * 2), ((unsigned long long)__float_as_uint(lt) << 32) | __float_as_uint(m), __ATOMIC_RELAXED, __HIP_MEMORY_SCOPE_AGENT);
#pragma unroll
    for (int c = 0; c < 4; ++c)
#pragma unroll
      for (int g4 = 0; g4 < 4; ++g4) {
        const int c0 = 32 * c + 8 * g4 + 4 * hi;
        unsigned long long* dst_ = (unsigned long long*)(PO + ((size_t)item * 64 + q) * 128 + c0);
        __hip_atomic_store(dst_, ((unsigned long long)__float_as_uint(o[c][4 * g4 + 1]) << 32) | __float_as_uint(o[c][4 * g4]), __ATOMIC_RELAXED, __HIP_MEMORY_SCOPE_AGENT);
        __hip_atomic_store(dst_ + 1, ((unsigned long long)__float_as_uint(o[c][4 * g4 + 3]) << 32) | __float_as_uint(o[c][4 * g4 + 2]), __ATOMIC_RELAXED, __HIP_MEMORY_SCOPE_AGENT);
      }
  }
  asm volatile("s_waitcnt vmcnt(0)" ::: "memory");
  __syncthreads();
  volatile unsigned* flag = (volatile unsigned*)(lds + 2 * TILE);
  if (tid == 0) *flag = atomicAdd((unsigned*)(p.ws + W_CTL) + 64 + db, 1u);
  __syncthreads();
  const unsigned arrived = *flag;
  __syncthreads();
  if (arrived == 1u) {
    __builtin_amdgcn_fence(__ATOMIC_ACQUIRE, "agent");
    typedef float f32x4_t __attribute__((ext_vector_type(4)));
    const int h = wid, r16 = lane & 15, kq = lane >> 4;
    const bool rv = r16 < 8;
    const int qq = (rv ? r16 : 0) * 8 + h;
    const float* ml0 = PML + ((size_t)(2 * db) * 64 + qq) * 2; const float* ml1 = ml0 + 128;
    const float m0 = ml0[0], m1 = ml1[0], M_ = fmaxf(m0, m1), w0_ = __builtin_amdgcn_exp2f(m0 - M_), w1_ = __builtin_amdgcn_exp2f(m1 - M_);
    const float invL = 1.f / (ml0[1] * w0_ + ml1[1] * w1_);
    const float s0 = rv ? w0_ * invL : 0.f, s1 = rv ? w1_ * invL : 0.f;
    const float* po0 = PO + ((size_t)(2 * db) * 64 + qq) * 128; const float* po1 = po0 + 64 * 128;
    const bf16* wuv = (const bf16*)(p.ws + W_END) + B_WUV;
    f32x4_t acc[4];
#pragma unroll
    for (int nt = 0; nt < 4; ++nt) acc[nt] = (f32x4_t){0.f, 0.f, 0.f, 0.f};
#pragma unroll
    for (int ks = 0; ks < 4; ++ks) {
      const int c0 = 32 * ks + 8 * kq;
      const f32x4_t a0 = *(const f32x4_t*)(po0 + c0), a1 = *(const f32x4_t*)(po0 + c0 + 4), b0 = *(const f32x4_t*)(po1 + c0), b1 = *(const f32x4_t*)(po1 + c0 + 4);
      const f32x4_t x0 = a0 * s0 + b0 * s1, x1 = a1 * s0 + b1 * s1;
      u32x4 aw; aw.x = cvtpk(x0.x, x0.y); aw.y = cvtpk(x0.z, x0.w); aw.z = cvtpk(x1.x, x1.y); aw.w = cvtpk(x1.z, x1.w);
      const bf16x8 af = __builtin_bit_cast(bf16x8, aw);
#pragma unroll
      for (int nt = 0; nt < 4; ++nt) {
        const bf16x8 bfr = *(const bf16x8*)(wuv + (size_t)(h * 64 + 16 * nt + r16) * 128 + c0);
        acc[nt] = __builtin_amdgcn_mfma_f32_16x16x32_bf16(af, bfr, acc[nt], 0, 0, 0);
      }
    }
    if (kq < 2) {
      bf16* mix = (bf16*)(p.ws + W_END) + B_MIX;
#pragma unroll
      for (int nt = 0; nt < 4; ++nt)
#pragma unroll
        for (int rg = 0; rg < 4; ++rg) {
          const int t = 4 * kq + rg, col = h * 64 + 16 * nt + r16;
          const size_t row = (size_t)NP + db * 8 + t;
          const float g = pj((const bf16*)(p.ws + W_END) + B_PROJ, row, C_GMLA + col);
          mix[row * 1024 + col] = (bf16)f2bf(acc[nt][rg] * (g / (1.f + __expf(-g))));
        }
    }
  }
#if PROF_SEL == 121 || PROF_SEL == 122
  if (item == 0 && tid == 0) ((unsigned long long*)(p.ws + W_TS))[1] = __builtin_amdgcn_s_memrealtime();
#endif
}
}

namespace rw {
typedef float f32x4 __attribute__((ext_vector_type(4)));
constexpr int CH = 32, STEPF = 384, CHF = CH * STEPF;
__device__ __forceinline__ float dpp_sum16(float v) {
  v += __int_as_float(__builtin_amdgcn_update_dpp(0, __float_as_int(v), 0xB1, 0xF, 0xF, true));
  v += __int_as_float(__builtin_amdgcn_update_dpp(0, __float_as_int(v), 0x4E, 0xF, 0xF, true));
  v += __int_as_float(__builtin_amdgcn_update_dpp(0, __float_as_int(v), 0x141, 0xF, 0xF, true));
  v += __int_as_float(__builtin_amdgcn_update_dpp(0, __float_as_int(v), 0x140, 0xF, 0xF, true));
  return v;
}
__device__ __forceinline__ float dpp_sum8(float v) {
  v += __int_as_float(__builtin_amdgcn_update_dpp(0, __float_as_int(v), 0xB1, 0xF, 0xF, true));
  v += __int_as_float(__builtin_amdgcn_update_dpp(0, __float_as_int(v), 0x4E, 0xF, 0xF, true));
  v += __int_as_float(__builtin_amdgcn_update_dpp(0, __float_as_int(v), 0x141, 0xF, 0xF, true));
  return v;
}
__device__ __forceinline__ void rwkv_prompt_item(unsigned char* lds, const Params& p, int item, int wid_s) {
  const int kind = item >> 5, rem = item & 31;
  const int bh = rem >> 1, half = rem & 1, b = bh >> 2, h = bh & 3;
  const int tid = mk_tid(wid_s);
  float* L = (float*)lds; float* yb = L + 2 * CHF;
  const float* ws = p.ws;
  const int NCH = (kind ? SEG2 : SEG1) / CH;
  const size_t rowbase = (size_t)b * SEQ + (kind ? SEG1 : 0);
  if (wid_s >= 4) {
    const int ht = tid - 256;
    f32x4 g[12];
#define RW_GLOAD(c) do { _Pragma("unroll") for (int i_ = 0; i_ < 12; ++i_) { const int f_ = ht + 256 * i_, arr_ = f_ >> 9, s_ = (f_ >> 4) & 31, k4_ = f_ & 15; \
      const size_t off_ = (rowbase + (size_t)(c) * CH + s_) * 256 + h * 64 + k4_ * 4; \
      const size_t base_ = arr_ == 0 ? W_KK : arr_ == 1 ? W_W : arr_ == 2 ? W_BB : arr_ == 3 ? W_KF : arr_ == 4 ? W_R : W_VV; \
      g[i_] = *(const f32x4*)(ws + base_ + off_); } } while (0)
#define RW_LSTORE(buf) do { _Pragma("unroll") for (int i_ = 0; i_ < 12; ++i_) { const int f_ = ht + 256 * i_, arr_ = f_ >> 9, s_ = (f_ >> 4) & 31, k4_ = f_ & 15; \
      *(f32x4*)(L + (buf) * CHF + s_ * STEPF + arr_ * 64 + k4_ * 4) = (arr_ == 2) ? -g[i_] : ((arr_ == 5 && kind == 2) ? (f32x4){0.f, 0.f, 0.f, 0.f} : g[i_]); } } while (0)
#define RW_FLUSH(c) do { const float* ybc_ = yb + ((c) & 1) * (32 * 33); _Pragma("unroll") for (int i_ = 0; i_ < 4; ++i_) { const int f_ = ht + 256 * i_, s_ = f_ >> 5, vv_ = f_ & 31; \
      const float yv_ = ybc_[vv_ * 33 + s_]; \
      if (kind == 2) p.ws[W_YU + ((size_t)bh * SEG2 + (size_t)(c) * CH + s_) * 64 + 32 * half + vv_] = yv_; \
      else p.ws[W_Y + (rowbase + (size_t)(c) * CH + s_) * 256 + h * 64 + 32 * half + vv_] = yv_; } } while (0)
    RW_GLOAD(0); RW_LSTORE(0);
    __syncthreads();
    for (int c = 0; c < NCH; ++c) {
      if (c + 1 < NCH) { RW_GLOAD(c + 1); RW_LSTORE((c + 1) & 1); }
      if (c > 0) RW_FLUSH(c - 1);
      __syncthreads();
    }
    RW_FLUSH(NCH - 1);
#undef RW_GLOAD
#undef RW_LSTORE
#undef RW_FLUSH
  } else {
    const int sub = tid & 7, vl = tid >> 3, v = 32 * half + vl;
    f32x4 Sa = {0.f, 0.f, 0.f, 0.f}, Sb = {0.f, 0.f, 0.f, 0.f};
    if (kind == 2) {
#pragma unroll
      for (int e = 0; e < 4; ++e) { Sa[e] = (8 * sub + e == v) ? 1.f : 0.f; Sb[e] = (8 * sub + 4 + e == v) ? 1.f : 0.f; }
    }
    struct Ops { f32x4 kk0, kk1, w0, w1, nb0, nb1, kf0, kf1, r0, r1; float vv; };
#define RW_LD(o, s) do { const float* sb_ = cb + (s) * STEPF + 8 * sub; (o).kk0 = *(const f32x4*)(sb_); (o).kk1 = *(const f32x4*)(sb_ + 4); \
      (o).w0 = *(const f32x4*)(sb_ + 64); (o).w1 = *(const f32x4*)(sb_ + 68); (o).nb0 = *(const f32x4*)(sb_ + 128); (o).nb1 = *(const f32x4*)(sb_ + 132); \
      (o).kf0 = *(const f32x4*)(sb_ + 192); (o).kf1 = *(const f32x4*)(sb_ + 196); (o).r0 = *(const f32x4*)(sb_ + 256); (o).r1 = *(const f32x4*)(sb_ + 260); \
      (o).vv = cb[(s) * STEPF + 320 + v]; } while (0)
#define RW_STEP(o, s) do { const f32x4 ta_ = (o).kf0 * (o).vv, tb_ = (o).kf1 * (o).vv; const f32x4 d4_ = Sa * (o).kk0 + Sb * (o).kk1; \
      float dot_ = (d4_.x + d4_.y) + (d4_.z + d4_.w); dot_ = dpp_sum8(dot_); \
      Sa = Sa * (o).w0 + ((o).nb0 * dot_ + ta_); Sb = Sb * (o).w1 + ((o).nb1 * dot_ + tb_); \
      const f32x4 y4_ = Sa * (o).r0 + Sb * (o).r1; float y_ = (y4_.x + y4_.y) + (y4_.z + y4_.w); y_ = dpp_sum8(y_); \
      ykeep = (sub == ((s) & 7)) ? y_ : ykeep; \
      if (((s) & 7) == 7) ybc[vl * 33 + ((s) - 7) + sub] = ykeep; } while (0)
    __syncthreads();
    __builtin_amdgcn_s_setprio(3);
    for (int c = 0; c < NCH; ++c) {
      const float* cb = L + (c & 1) * CHF;
      float* ybc = yb + (c & 1) * (32 * 33);
      float ykeep = 0.f;
      Ops A, B;
      RW_LD(A, 0);
#pragma unroll
      for (int s = 0; s < CH; s += 2) {
        RW_LD(B, s + 1);
        RW_STEP(A, s);
        if (s + 2 < CH) RW_LD(A, s + 2);
        RW_STEP(B, s + 1);
      }
      __syncthreads();
    }
#undef RW_LD
#undef RW_STEP
    __builtin_amdgcn_s_setprio(0);
    float* so = p.ws + (kind == 0 ? W_SMID : kind == 1 ? W_QST : W_EST) + ((size_t)bh * 64 + v) * 64 + 8 * sub;
    *(f32x4*)so = Sa; *(f32x4*)(so + 4) = Sb;
  }
  __syncthreads();
}
}

namespace rw {
__device__ __forceinline__ void rwkv_sample_item(unsigned char* lds, const Params& p, int item, int wid_s) {
  float* YL = (float*)lds;
  const int db = item >> 2, h = item & 3;
  const int tid = mk_tid(wid_s), sub = tid & 7, v = tid >> 3;
  const float* ws = p.ws;
  const float* s0 = p.state_wkv + ((size_t)(db * 4 + h) * 64 + v) * 64 + 8 * sub;
  f32x4 Sa = *(const f32x4*)s0, Sb = *(const f32x4*)(s0 + 4);
  const size_t row0 = (size_t)NP + db * DT;
  struct Ops { f32x4 kk0, kk1, w0, w1, b0, b1, kf0, kf1, r0, r1; float vv; };
#define RS_LD(o, t) do { const size_t off_ = (row0 + (t)) * 256 + h * 64; const float* q_ = ws + off_ + 8 * sub; \
    (o).kk0 = *(const f32x4*)(q_ + W_KK); (o).kk1 = *(const f32x4*)(q_ + W_KK + 4); (o).w0 = *(const f32x4*)(q_ + W_W); (o).w1 = *(const f32x4*)(q_ + W_W + 4); \
    (o).b0 = *(const f32x4*)(q_ + W_BB); (o).b1 = *(const f32x4*)(q_ + W_BB + 4); (o).kf0 = *(const f32x4*)(q_ + W_KF); (o).kf1 = *(const f32x4*)(q_ + W_KF + 4); \
    (o).r0 = *(const f32x4*)(q_ + W_R); (o).r1 = *(const f32x4*)(q_ + W_R + 4); (o).vv = ws[W_VV + off_ + v]; } while (0)
#define RS_STEP(o, t) do { const f32x4 d4_ = Sa * (o).kk0 + Sb * (o).kk1; float dot_ = (d4_.x + d4_.y) + (d4_.z + d4_.w); dot_ = dpp_sum8(dot_); \
    const float sa_ = -dot_; \
    Sa = Sa * (o).w0 + ((o).b0 * sa_ + (o).kf0 * (o).vv); Sb = Sb * (o).w1 + ((o).b1 * sa_ + (o).kf1 * (o).vv); \
    const f32x4 y4_ = Sa * (o).r0 + Sb * (o).r1; float y_ = (y4_.x + y4_.y) + (y4_.z + y4_.w); y_ = dpp_sum8(y_); \
    if (sub == 0) YL[(t) * 64 + v] = y_; } while (0)
  Ops A, B;
  RS_LD(A, 0);
#pragma unroll
  for (int t = 0; t < DT; t += 2) {
    RS_LD(B, t + 1);
    RS_STEP(A, t);
    if (t + 2 < DT) RS_LD(A, t + 2);
    RS_STEP(B, t + 1);
  }
#undef RS_LD
#undef RS_STEP
  float* so = p.out + O_WKVS + ((size_t)(db * 4 + h) * 64 + v) * 64 + 8 * sub;
  *(f32x4*)so = Sa; *(f32x4*)(so + 4) = Sb;
  __syncthreads();
  {
    const int t = wid_s, lane = tid & 63;
    const size_t row = row0 + t, off = row * 256 + h * 64 + lane;
    const float y = YL[t * 64 + lane];
    const float mean = wave_sum_fast(y) * (1.f / 64.f), d = y - mean, var = wave_sum_fast(d * d) * (1.f / 64.f);
    const float yn = d * rsqrtf(var + GN_EPS) * p.lnx_g[h * 64 + lane] + p.lnx_b[h * 64 + lane];
    const float bsum = wave_sum_fast(ws[W_R + off] * ws[W_KF + off] * p.r_k[h * 64 + lane]);
    const float o = yn + bsum * ws[W_VV + off];
    const float g = pj((const bf16*)(p.ws + W_END) + B_PROJ, row, C_GRWKV + h * 64 + lane);
    ((bf16*)(p.ws + W_END))[B_MIX + row * 1024 + 512 + h * 64 + lane] = (bf16)f2bf(o * (g / (1.f + __expf(-g))));
  }
  __syncthreads();
}
}

namespace ma {
typedef float f32x4 __attribute__((ext_vector_type(4)));
__device__ __forceinline__ void mem_sample_item(unsigned char* lds, const Params& p, int db, int wid_s) {
  const int tid = mk_tid(wid_s), lane = tid & 63, t = wid_s;
  constexpr int KST = 65;
  float* Kl = (float*)lds;
  float* Vl = Kl + 256 * KST;
  float* ps = Vl + 256 * 64 + t * 256;
  const float* ws = p.ws;
  const float* kg = p.cache_mem_k + (size_t)db * 65536; const float* vg = p.cache_mem_v + (size_t)db * 65536;
  const size_t row = (size_t)NP + db * 8 + t;
  f32x4 kr[8], vr[8];
#define MS_GLOAD(h) do { _Pragma("unroll") for (int i_ = 0; i_ < 8; ++i_) { const int f_ = tid + 512 * i_, m_ = f_ >> 4, c4_ = f_ & 15; \
    kr[i_] = *(const f32x4*)(kg + (size_t)m_ * 256 + (h) * 64 + c4_ * 4); vr[i_] = *(const f32x4*)(vg + (size_t)m_ * 256 + (h) * 64 + c4_ * 4); } } while (0)
#define MS_LSTORE() do { _Pragma("unroll") for (int i_ = 0; i_ < 8; ++i_) { const int f_ = tid + 512 * i_, m_ = f_ >> 4, c4_ = f_ & 15; \
    float* kd_ = Kl + m_ * KST + c4_ * 4; kd_[0] = kr[i_].x; kd_[1] = kr[i_].y; kd_[2] = kr[i_].z; kd_[3] = kr[i_].w; \
    *(f32x4*)(Vl + m_ * 64 + c4_ * 4) = vr[i_]; } } while (0)
  float qv0, qv1, qv2, qv3;
  { const float4 v = pj4((const bf16*)(p.ws + W_END) + B_PROJ, row, C_QX + lane * 4); qv0 = v.x * X_SCALE; qv1 = v.y * X_SCALE; qv2 = v.z * X_SCALE; qv3 = v.w * X_SCALE; }
  MS_GLOAD(0);
  bf16* mix = (bf16*)(p.ws + W_END) + B_MIX;
  for (int h = 0; h < 4; ++h) {
    __syncthreads();
    MS_LSTORE();
    if (h + 1 < 4) MS_GLOAD(h + 1);
    float q[64];
#pragma unroll
    for (int d4 = 0; d4 < 16; ++d4) { const int sl = h * 16 + d4;
      q[4 * d4] = __int_as_float(__builtin_amdgcn_readlane(__float_as_int(qv0), sl)); q[4 * d4 + 1] = __int_as_float(__builtin_amdgcn_readlane(__float_as_int(qv1), sl));
      q[4 * d4 + 2] = __int_as_float(__builtin_amdgcn_readlane(__float_as_int(qv2), sl)); q[4 * d4 + 3] = __int_as_float(__builtin_amdgcn_readlane(__float_as_int(qv3), sl)); }
    __syncthreads();
    float s[4] = {0.f, 0.f, 0.f, 0.f};
#pragma unroll
    for (int d = 0; d < 64; ++d) {
#pragma unroll
      for (int j = 0; j < 4; ++j) s[j] += Kl[(lane + 64 * j) * KST + d] * q[d];
    }
    float mx = wave_max(fmaxf(fmaxf(s[0], s[1]), fmaxf(s[2], s[3])));
    float sum = 0.f;
#pragma unroll
    for (int j = 0; j < 4; ++j) { s[j] = __expf(s[j] - mx); sum += s[j]; }
    const float inv = 1.f / wave_sum_fast(sum);
#pragma unroll
    for (int j = 0; j < 4; ++j) ps[lane + 64 * j] = s[j] * inv;
    float o0 = 0.f, o1 = 0.f, o2 = 0.f, o3 = 0.f;
#pragma unroll 4
    for (int m = 0; m < 256; m += 4) {
      const f32x4 pm = *(const f32x4*)(ps + m);
      o0 += pm.x * Vl[(m) * 64 + lane]; o1 += pm.y * Vl[(m + 1) * 64 + lane]; o2 += pm.z * Vl[(m + 2) * 64 + lane]; o3 += pm.w * Vl[(m + 3) * 64 + lane];
    }
    const float o = (o0 + o1) + (o2 + o3);
    const float g = pj((const bf16*)(p.ws + W_END) + B_PROJ, row, C_GX + h * 64 + lane);
    mix[row * 1024 + 768 + h * 64 + lane] = (bf16)f2bf(o * (g / (1.f + __expf(-g))));
  }
#undef MS_GLOAD
#undef MS_LSTORE
  __syncthreads();
}
}

typedef unsigned v4u __attribute__((ext_vector_type(4)));
__device__ __forceinline__ unsigned f2bf(float f) { unsigned u = __builtin_bit_cast(unsigned, f); return (u + 0x7fffu + ((u >> 16) & 1u)) >> 16; }
__device__ __forceinline__ unsigned pk2(float lo, float hi) { return f2bf(lo) | (f2bf(hi) << 16); }
__device__ __forceinline__ void p0_transpose_item(const float* W, int K, int N, bf16* WT, int row_off, LAS float* scr, int item, int lane) {
  const int nblk = N / 32, kb = item / nblk, nb = item % nblk, k0 = 64 * kb, n0 = 32 * nb;
#pragma unroll 8
  for (int i = 0; i < 32; ++i) { const int kk = 2 * i + (lane >> 5); scr[kk * 33 + (lane & 31)] = W[(size_t)(k0 + kk) * N + n0 + (lane & 31)]; }
  asm volatile("s_waitcnt lgkmcnt(0)" ::: "memory");
  const int c = lane & 7;
#pragma unroll
  for (int j = 0; j < 4; ++j) { const int n = (lane >> 3) + 8 * j; const LAS float* s = scr + (8 * c) * 33 + n;
    v4u o; o.x = pk2(s[0 * 33], s[1 * 33]); o.y = pk2(s[2 * 33], s[3 * 33]); o.z = pk2(s[4 * 33], s[5 * 33]); o.w = pk2(s[6 * 33], s[7 * 33]);
    *(v4u*)(WT + (size_t)(row_off + n0 + n) * K + k0 + 8 * c) = o; }
  asm volatile("s_waitcnt lgkmcnt(0)" ::: "memory");
}


#define XB_TMO      128
#define XB_XCNT(j)  (256  + 64 * (j))
#define XB_XSUB(j)  (1280 + 64 * (j))
#define XB_XGEN(j)  (2304 + 64 * (j))
#define XB_TOP      3328
#define XB_TOPGEN   3392
#define XCD_BAR_WORDS 3456
#define XB_SPIN_CAP (1u << 18)

__device__ __forceinline__ unsigned xb_ld(unsigned* p)              { return __hip_atomic_load(p, __ATOMIC_RELAXED, __HIP_MEMORY_SCOPE_AGENT); }
__device__ __forceinline__ unsigned xb_add(unsigned* p, unsigned v) { return __hip_atomic_fetch_add(p, v, __ATOMIC_RELAXED, __HIP_MEMORY_SCOPE_AGENT); }
__device__ __forceinline__ unsigned xb_xcc_id() { return (unsigned)__builtin_amdgcn_s_getreg((3 << 11) | 20) & 0xFu; }
#define XB_SPIN(cond, bar) do { unsigned _sp = 0; while (cond) { __builtin_amdgcn_s_sleep(1); \
    if ((++_sp & 255u) == 0u) { if (xb_ld(&(bar)[XB_TMO])) break; if (_sp > XB_SPIN_CAP) { atomicAdd(&(bar)[XB_TMO], 1u); break; } } } } while (0)

struct XcdBarrier {
    unsigned* bar; unsigned x;
    volatile LAS unsigned* st;
};

__device__ __forceinline__ XcdBarrier xcd_barrier_post(unsigned* bar, volatile LAS unsigned* st) {
    XcdBarrier b; b.bar = bar; b.x = xb_xcc_id(); b.st = st;
    if (threadIdx.x == 0) (void)xb_add(&bar[XB_XCNT(b.x)], 1u);
    return b;
}
__device__ __forceinline__ void xcd_barrier_complete(unsigned* bar, unsigned x, unsigned& nloc, unsigned& nx) {
    const unsigned G = gridDim.x * gridDim.y * gridDim.z;
    unsigned sum, cnt, mine, sp = 0u;
    for (;;) {
        sum = 0u; cnt = 0u; mine = 0u;
#pragma unroll
        for (unsigned j = 0; j < 16; ++j) { const unsigned c = xb_ld(&bar[XB_XCNT(j)]); sum += c; cnt += (c > 0u) ? 1u : 0u; mine = (j == x) ? c : mine; }
        if (sum == G) break;
        __builtin_amdgcn_s_sleep(1);
        if ((++sp & 255u) == 0u) { if (xb_ld(&bar[XB_TMO])) break; if (sp > XB_SPIN_CAP) { atomicAdd(&bar[XB_TMO], 1u); break; } }
    }
    nloc = mine > 0u ? mine : 1u; nx = cnt > 0u ? cnt : 1u;
}

__device__ __forceinline__ void xcd_barrier(const XcdBarrier& b) {
    asm volatile("s_waitcnt vmcnt(0)" ::: "memory");
    __syncthreads();
    if (threadIdx.x == 0) {
        unsigned* bar = b.bar;
        __builtin_amdgcn_s_waitcnt(0);
        unsigned nloc = b.st[0], nx = b.st[1];
        if (nloc == 0u) { xcd_barrier_complete(bar, b.x, nloc, nx); b.st[0] = nloc; b.st[1] = nx; }
        const unsigned old = xb_add(&bar[XB_XSUB(b.x)], 1u);
        const unsigned gen = old / nloc;
        if (old + 1u == (gen + 1u) * nloc) {
            __builtin_amdgcn_fence(__ATOMIC_RELEASE, "agent");
            asm volatile("s_waitcnt vmcnt(0)" ::: "memory");
            const unsigned og = xb_add(&bar[XB_TOP], 1u);
            const unsigned tg = og / nx;
            if (og + 1u == (tg + 1u) * nx) xb_add(&bar[XB_TOPGEN], 1u);
            else XB_SPIN(xb_ld(&bar[XB_TOPGEN]) == tg, bar);
            __builtin_amdgcn_fence(__ATOMIC_ACQUIRE, "agent");
            xb_add(&bar[XB_XGEN(b.x)], 1u);
            asm volatile("s_waitcnt vmcnt(0)" ::: "memory");
        } else {
            XB_SPIN(xb_ld(&bar[XB_XGEN(b.x)]) == gen, bar);
            __builtin_amdgcn_fence(__ATOMIC_ACQUIRE, "agent");
            asm volatile("s_waitcnt vmcnt(0)" ::: "memory");
        }
    }
    __syncthreads();
}


#if PROF_SEL >= 0
#define PROF_STAMP(i) do { if ((i) == PROF_SEL || (i) == PROF_SEL + 1 || ((i) == 0 && PROF_SEL >= 130 && PROF_SEL <= 136) || (((i) == 2 || (i) == 3) && PROF_SEL >= 140 && PROF_SEL <= 149)) { if (blockIdx.x == 0 && mk_tid(wid_s) == 0) ((unsigned long long*)(p.ws + W_TS))[(PROF_SEL >= 140 && PROF_SEL <= 149) ? (i) - 2 : ((i) == 0 ? 0 : (i) - PROF_SEL)] = __builtin_amdgcn_s_memrealtime(); } } while (0)
#else
#define PROF_STAMP(i) do { } while (0)
#endif
__global__ void __launch_bounds__(512) fwd_megakernel(Params p) {
  cg::grid_group grid = cg::this_grid();
  extern __shared__ __attribute__((aligned(16))) unsigned char lds[];
  float* sm = (float*)lds;
  bf16* wb = (bf16*)(p.ws + W_END);
  float* ws = p.ws;
  const int wid_s = __builtin_amdgcn_readfirstlane((int)(threadIdx.x >> 6));
  volatile LAS unsigned* xb_st = (volatile LAS unsigned*)((LAS unsigned char*)lds + LDS_BYTES - 64);
  if (threadIdx.x < 2) xb_st[threadIdx.x] = 0u;
  __syncthreads();
  const XcdBarrier xbar = xcd_barrier_post((unsigned*)(p.ws + W_BAR), xb_st);
  if (p.out == nullptr) grid.sync();
  PROF_STAMP(0);
#define PH_IDS const int tid = mk_tid(wid_s); const int lane = tid & 63, wv = tid >> 6; const int gw = blockIdx.x * 8 + wv, NGW = gridDim.x * 8; \
  const int gtid = blockIdx.x * 512 + tid, NTH = gridDim.x * 512; (void)lane; (void)wv; (void)gw; (void)NGW; (void)gtid; (void)NTH;
  { PH_IDS

  {
    LAS float* scr = (LAS float*)((LAS unsigned char*)lds + wv * 16384);
    constexpr int I_IN = 16 * (INC / 32), I_MEM = 16 * (512 / 32), I_OUT = 16 * (1024 / 32);
    for (int it = gw; it < I_IN + I_MEM + I_OUT; it += NGW) {
      int r = it;
      if (r < I_IN) { p0_transpose_item(p.w_in, 1024, INC, wb + B_WIN, 0, scr, r, lane); continue; } r -= I_IN;
      if (r < I_MEM) { p0_transpose_item(p.w_mem_kv, 1024, 512, wb + B_WMEM, 0, scr, r, lane); continue; } r -= I_MEM;
      p0_transpose_item(p.w_out, 1024, 1024, wb + B_WOUT, 0, scr, r, lane);
    }
    if (gtid < 256) ((unsigned*)(p.ws + W_CTL))[gtid] = 0u;

#if PROF_SEL == 130
    if (blockIdx.x == 0 && tid == 0) { asm volatile("s_waitcnt vmcnt(0)" ::: "memory"); ((unsigned long long*)(p.ws + W_TS))[1] = __builtin_amdgcn_s_memrealtime(); }
#endif
    for (int it = gw; it < 64; it += NGW) {
      if (it < 32) p0_transpose_item(p.w_uk, 128, 512, wb + B_WUK, 0, scr, it, lane);
      else p0_transpose_item(p.w_uv, 128, 512, wb + B_WUV, 0, scr, it - 32, lane);
    }

#if PROF_SEL == 131
    if (blockIdx.x == 0 && tid == 0) { asm volatile("s_waitcnt vmcnt(0)" ::: "memory"); ((unsigned long long*)(p.ws + W_TS))[1] = __builtin_amdgcn_s_memrealtime(); }
#endif
    for (int i = gtid; i < 768 * 256; i += NTH) {
      const int n = i >> 8, k = i & 255;
      const int orig = n < 512 ? (n >> 6) * 96 + (n & 63) : (n < 640 ? ((n - 512) >> 4) * 96 + 64 + ((n - 512) & 15) : ((n - 640) >> 4) * 96 + 80 + ((n - 640) & 15));
      wb[B_WUQ + i] = (bf16)f2bf(p.w_uq[(size_t)k * 768 + orig]);
    }

#if PROF_SEL == 132
    if (blockIdx.x == 0 && tid == 0) { asm volatile("s_waitcnt vmcnt(0)" ::: "memory"); ((unsigned long long*)(p.ws + W_TS))[1] = __builtin_amdgcn_s_memrealtime(); }
#endif
    for (int it0 = gw; it0 < 1024; it0 += NGW) {
      const int it = __builtin_amdgcn_readfirstlane(it0);
      const int h = it >> 7, k = ((it >> 5) & 3) * 64 + lane, cg = it & 31;
      float ar[64];
#pragma unroll
      for (int d4 = 0; d4 < 16; ++d4) { const float4 v = *(const float4*)(p.w_uq + (size_t)k * 768 + h * 96 + d4 * 4); ar[4 * d4] = v.x; ar[4 * d4 + 1] = v.y; ar[4 * d4 + 2] = v.z; ar[4 * d4 + 3] = v.w; }
#pragma unroll 4
      for (int c = cg * 4; c < cg * 4 + 4; ++c) {
        const float* br = p.w_uk + (size_t)c * 512 + h * 64;
        float acc = 0.f;
#pragma unroll
        for (int d4 = 0; d4 < 16; ++d4) { const float4 v = *(const float4*)(br + d4 * 4); acc += (ar[4 * d4] * v.x + ar[4 * d4 + 1] * v.y) + (ar[4 * d4 + 2] * v.z + ar[4 * d4 + 3] * v.w); }
        wb[B_WQL + (size_t)(h * 128 + c) * 256 + k] = (bf16)f2bf(acc);
      }
    }

#if PROF_SEL == 133
    if (blockIdx.x == 0 && tid == 0) { asm volatile("s_waitcnt vmcnt(0)" ::: "memory"); ((unsigned long long*)(p.ws + W_TS))[1] = __builtin_amdgcn_s_memrealtime(); }
#endif

#if PROF_SEL == 134
    if (blockIdx.x == 0 && tid == 0) { asm volatile("s_waitcnt vmcnt(0)" ::: "memory"); ((unsigned long long*)(p.ws + W_TS))[1] = __builtin_amdgcn_s_memrealtime(); }
#endif
    for (int i = gtid; i < 4104 * 16; i += NTH) {
      const int pi = i >> 4, j = i & 15; const int pos = pi < 4096 ? pi : PAST + (pi - 4096);
      const float inv = 1.0f / powf(10000.0f, (float)j * (2.0f / 32.0f));
      const float ang = (float)pos * inv;
      p.ws[W_CS + (size_t)i * 2] = cosf(ang); p.ws[W_CS + (size_t)i * 2 + 1] = sinf(ang);
    }
    for (int i = gtid; i < (INCP - INC) * 1024 / 8; i += NTH) ((v4u*)(wb + B_WIN + (size_t)INC * 1024))[i] = (v4u){0u, 0u, 0u, 0u};
  }

#if PROF_SEL == 135
    if (blockIdx.x == 0 && tid == 0) { asm volatile("s_waitcnt vmcnt(0)" ::: "memory"); ((unsigned long long*)(p.ws + W_TS))[1] = __builtin_amdgcn_s_memrealtime(); }
#endif
  {
    typedef float f32x4_t __attribute__((ext_vector_type(4)));
    auto row_src = [&](int r) -> const float* { return r < NT ? xrow(p, r) : p.mem_prompt + (size_t)(r - NT) * 1024; };
    int r = gw;
    f32x4_t cur[4];
    if (r < NT + 1024) { const float* s_ = row_src(r);
#pragma unroll
      for (int i = 0; i < 4; ++i) cur[i] = *(const f32x4_t*)(s_ + 4 * lane + 256 * i); }
    for (; r < NT + 1024; r += NGW) {
      f32x4_t nxt[4];
      { const float* s_ = row_src(r + NGW < NT + 1024 ? r + NGW : r);
#pragma unroll
        for (int i = 0; i < 4; ++i) nxt[i] = *(const f32x4_t*)(s_ + 4 * lane + 256 * i); }
      const float* g = r < NT ? p.ln_g : p.mem_norm_g;
      bf16* dst = r < NT ? wb + B_H + (size_t)r * 1024 : wb + B_HM + (size_t)(r - NT) * 1024;
      float ss = 0.f;
#pragma unroll
      for (int i = 0; i < 4; ++i) ss += (cur[i].x * cur[i].x + cur[i].y * cur[i].y) + (cur[i].z * cur[i].z + cur[i].w * cur[i].w);
      const float rs = rsqrtf(wave_sum_fast(ss) * (1.f / 1024.f) + RMS_EPS);
#pragma unroll
      for (int i = 0; i < 4; ++i) {
        const float4 gg = *(const float4*)(g + 4 * lane + 256 * i);
        uint2 o; o.x = pk2(cur[i].x * rs * gg.x, cur[i].y * rs * gg.y); o.y = pk2(cur[i].z * rs * gg.z, cur[i].w * rs * gg.w);
        *(uint2*)(dst + 4 * lane + 256 * i) = o;
      }
#pragma unroll
      for (int i = 0; i < 4; ++i) cur[i] = nxt[i];
    }
  }
  }
  xcd_barrier(xbar);
  PROF_STAMP(1);
  { PH_IDS

  {
    pg8::Gemm g{wb + B_H, wb + B_WIN, NT, INCP, 1024}; pg8::StaticOrder S; S.init(NT, INCP, (int)gridDim.x, (int)blockIdx.x);
    bf16* PJ = wb + B_PROJ;
    auto f = [=](int row, int col) -> bf16* { return col < INC ? PJ + (size_t)row * INC + col : nullptr; };
    pg8::EpiBf16F<decltype(f)> E{f, 1.f};
    pg8::gemm_phase<pg8::EpiBf16F<decltype(f)>, pg8::StaticOrder, true, true>((PG8_LAS unsigned char*)lds, g, S, E, wid_s);
  }
  {
    pg8::Gemm g{wb + B_HM, wb + B_WMEM, 1024, 512, 1024}; pg8::StaticOrder S; S.init(1024, 512, (int)gridDim.x, (int)((blockIdx.x + 20) % gridDim.x));
    pg8::EpiF32 E{p.out + O_MKP, 256, 256, 256, O_MVP - O_MKP, nullptr, nullptr, 0};
    pg8::gemm_phase<pg8::EpiF32, pg8::StaticOrder, true, true>((PG8_LAS unsigned char*)lds, g, S, E, wid_s);
  }
  }
  xcd_barrier(xbar);
  PROF_STAMP(2);
  { PH_IDS

  for (size_t i = gtid; i < (size_t)4 * 256 * 256; i += 2 * (size_t)NTH) {
    const size_t i2 = i + NTH < (size_t)4 * 256 * 256 ? i + NTH : i;
    const size_t b_ = i >> 16, c = (i >> 8) & 255, m_ = i & 255;
    const size_t b2 = i2 >> 16, c2 = (i2 >> 8) & 255, m2 = i2 & 255;
    const float k1 = p.out[O_MKP + i], v1 = p.out[O_MVP + (b_ * 256 + m_) * 256 + c], k2 = p.out[O_MKP + i2], v2 = p.out[O_MVP + (b2 * 256 + m2) * 256 + c2];
    wb[B_KM + i] = (bf16)f2bf(k1); wb[B_VMT + i] = (bf16)f2bf(v1);
    wb[B_KM + i2] = (bf16)f2bf(k2); wb[B_VMT + i2] = (bf16)f2bf(v2);
  }
  {
    constexpr int WST = 72, TST = 136;
    bf16* wl = (bf16*)lds; bf16* al = wl + 256 * WST;
    bf16* td = al + 256 * WST + wv * (16 * TST);
    float* cst = (float*)(al + 256 * WST + 8 * (16 * TST));
    {
      float wv_[32], av_[32];
#pragma unroll
      for (int j = 0; j < 32; ++j) { wv_[j] = p.w_up[tid + 512 * j]; av_[j] = p.a_up[tid + 512 * j]; }
#pragma unroll
      for (int j = 0; j < 32; ++j) { const int i = tid + 512 * j, k = i >> 8, n = i & 255; wl[n * WST + k] = (bf16)f2bf(wv_[j]); al[n * WST + k] = (bf16)f2bf(av_[j]); }
    }
    if (tid < 256) { cst[tid] = p.w0[tid]; cst[256 + tid] = p.a0[tid]; cst[512 + tid] = p.k_k[tid]; cst[768 + tid] = p.k_a[tid]; }
    __syncthreads();
    float mu[14];
#pragma unroll
    for (int i = 0; i < 14; ++i) mu[i] = p.shift_mu[lane + 64 * i];
    float qg[4], kg[2];
#pragma unroll
    for (int i = 0; i < 4; ++i) qg[i] = p.q_norm_g[lane + 64 * i];
    kg[0] = p.kv_norm_g[lane]; kg[1] = p.kv_norm_g[64 + lane];
    struct TokIn { unsigned short cq[4], ck0, ck1, kr1, kr2, z[14], zpb[14]; float zpf[14]; float2 csv; uint2 qx4; bool first, isp; };
    auto tok_load = [&](int row, TokIn& T) {
      const bf16* pr = wb + B_PROJ + (size_t)row * INC;
      const bool isp = row < NP; const int srow = row - NP;
      const bool first = isp ? ((row & (SEQ - 1)) == 0) : ((srow & 7) == 0);
      const bf16* pp = first ? pr : pr - INC;
#pragma unroll
      for (int i = 0; i < 4; ++i) T.cq[i] = pr[C_CQ + lane + 64 * i];
      T.ck0 = pr[C_CKV + lane]; T.ck1 = pr[C_CKV + 64 + lane];
      T.kr1 = pr[C_KR + (lane & 15)]; T.kr2 = pr[C_KR + 16 + (lane & 15)];
#pragma unroll
      for (int i = 0; i < 14; ++i) { T.z[i] = pr[C_Z + lane + 64 * i]; T.zpb[i] = pp[C_Z + lane + 64 * i]; T.zpf[i] = 0.f; }
      T.first = first; T.isp = isp;
      if (first && !isp) {
        const float* sst = p.state_shift + (size_t)(srow >> 3) * 896;
#pragma unroll
        for (int i = 0; i < 14; ++i) T.zpf[i] = sst[lane + 64 * i];
      }
      const int pi = isp ? (row & (SEQ - 1)) : 4096 + (srow & 7);
      T.csv = *(const float2*)(ws + W_CS + ((size_t)pi * 16 + (lane & 15)) * 2);
      T.qx4 = *(const uint2*)(wb + B_PROJ + (size_t)row * INC + C_QX + lane * 4);
    };
#if PROF_SEL == 150 || PROF_SEL == 151
    unsigned long long acc_t_ = 0;
#endif
    for (int grp = gw; grp < 2048; grp += NGW) {
      const int GT = grp < 1024 ? 9 : 8;
      const int row_base = grp < 1024 ? 9 * grp : 9216 + 8 * (grp - 1024);
#if PROF_SEL == 150
      const unsigned long long t0_ = __builtin_amdgcn_s_memrealtime();
#endif
      TokIn cur; tok_load(row_base, cur);
      for (int ti = 0; ti < GT; ++ti) {
        const int row = row_base + ti;
        TokIn nxt; tok_load(ti + 1 < GT ? row + 1 : row, nxt);
        const bool isp = row < NP;
        const int srow = row - NP;
        float z[14], zm[14];
#pragma unroll
        for (int i = 0; i < 14; ++i) { z[i] = bf2f(cur.z[i]); const float zp = cur.first ? cur.zpf[i] : bf2f(cur.zpb[i]); zm[i] = z[i] + (zp - z[i]) * mu[i]; }
        const float cq0 = bf2f(cur.cq[0]), cq1 = bf2f(cur.cq[1]), cq2 = bf2f(cur.cq[2]), cq3 = bf2f(cur.cq[3]);
        const float ck0 = bf2f(cur.ck0), ck1 = bf2f(cur.ck1), kr1 = bf2f(cur.kr1), kr2 = bf2f(cur.kr2);
        { const float e2 = __expf(2.f * zm[12]); td[ti * TST + lane] = (bf16)f2bf(1.f - 2.f / (e2 + 1.f)); } td[ti * TST + 64 + lane] = (bf16)f2bf(zm[13]);
#pragma unroll
        for (int hh = 0; hh < 4; ++hh) { const size_t o = (size_t)row * 256 + hh * 64 + lane; ws[W_R + o] = zm[hh]; ws[W_KF + o] = zm[4 + hh]; ws[W_VV + o] = zm[8 + hh]; }
        {
          const float rs = rsqrtf(wave_sum_fast((cq0 * cq0 + cq1 * cq1) + (cq2 * cq2 + cq3 * cq3)) * (1.f / 256.f) + RMS_EPS);
          wb[B_CQN + (size_t)row * 256 + lane] = (bf16)f2bf(cq0 * rs * qg[0]); wb[B_CQN + (size_t)row * 256 + lane + 64] = (bf16)f2bf(cq1 * rs * qg[1]);
          wb[B_CQN + (size_t)row * 256 + lane + 128] = (bf16)f2bf(cq2 * rs * qg[2]); wb[B_CQN + (size_t)row * 256 + lane + 192] = (bf16)f2bf(cq3 * rs * qg[3]);
          const float rs2 = rsqrtf(wave_sum_fast(ck0 * ck0 + ck1 * ck1) * (1.f / 128.f) + RMS_EPS);
          const float c0 = ck0 * rs2 * kg[0], c1 = ck1 * rs2 * kg[1];
          float* o = ckv_out_row(p, row);
          o[lane] = c0; o[64 + lane] = c1;
          if (isp) { wb[B_CKVN + (size_t)row * 128 + lane] = (bf16)f2bf(c0); wb[B_CKVN + (size_t)row * 128 + 64 + lane] = (bf16)f2bf(c1); }
        }
        {
          const float y1 = kr1 * cur.csv.x - kr2 * cur.csv.y, y2 = kr2 * cur.csv.x + kr1 * cur.csv.y;
          if (lane < 16) { float* o = kpe_out_row(p, row); o[lane] = y1; o[16 + lane] = y2; }
          if (isp) {
            const bf16 b1 = (bf16)f2bf(y1), b2 = (bf16)f2bf(y2);
            const int j = lane & 15, hq = lane >> 4;
            wb[B_KP + (size_t)row * 768 + (2 * hq) * 96 + 64 + j] = b1; wb[B_KP + (size_t)row * 768 + (2 * hq) * 96 + 80 + j] = b2;
            wb[B_KP + (size_t)row * 768 + (2 * hq + 1) * 96 + 64 + j] = b1; wb[B_KP + (size_t)row * 768 + (2 * hq + 1) * 96 + 80 + j] = b2;
            const float XSC = X_SCALE * 1.4426950408889634f;
            const uint2 qw = cur.qx4;
            *(uint2*)(wb + B_QX + (size_t)row * 256 + lane * 4) = make_uint2(pk2(__uint_as_float(qw.x << 16) * XSC, __uint_as_float(qw.x & 0xffff0000u) * XSC), pk2(__uint_as_float(qw.y << 16) * XSC, __uint_as_float(qw.y & 0xffff0000u) * XSC));
          }
        }
        if (isp) { if ((row & (SEQ - 1)) == SEQ - 1) { const int b = row / SEQ;
#pragma unroll
            for (int i = 0; i < 14; ++i) p.out[O_SHP + (size_t)b * 896 + lane + 64 * i] = z[i]; } }
        else { if ((srow & 7) == 7) { const int db = srow >> 3;
#pragma unroll
            for (int i = 0; i < 14; ++i) p.out[O_SHS + (size_t)db * 896 + lane + 64 * i] = z[i]; } }
        cur = nxt;
      }
#if PROF_SEL == 150
      asm volatile("s_waitcnt vmcnt(0)" ::: "memory"); acc_t_ += __builtin_amdgcn_s_memrealtime() - t0_;
#endif
#if PROF_SEL == 151
      const unsigned long long t1_ = __builtin_amdgcn_s_memrealtime();
#endif
      {
        typedef short bf16x8_t __attribute__((ext_vector_type(8)));
        typedef float f32x4_t __attribute__((ext_vector_type(4)));
        const int r16 = lane & 15, kq = lane >> 4;
        bf16x8_t at[2], aa_[2];
#pragma unroll
        for (int ks = 0; ks < 2; ++ks) { at[ks] = *(const bf16x8_t*)(td + r16 * TST + 32 * ks + 8 * kq); aa_[ks] = *(const bf16x8_t*)(td + r16 * TST + 64 + 32 * ks + 8 * kq); }
        float kraw[4][4][4];
#pragma unroll
        for (int hh = 0; hh < 4; ++hh)
#pragma unroll
          for (int nt = 0; nt < 4; ++nt)
#pragma unroll
            for (int r = 0; r < 4; ++r) kraw[hh][nt][r] = ws[W_KF + (size_t)(row_base + (4 * kq + r < GT ? 4 * kq + r : 0)) * 256 + hh * 64 + nt * 16 + r16];
#pragma unroll
        for (int hh = 0; hh < 4; ++hh) {
          f32x4_t au[4], aA[4];
#pragma unroll
          for (int nt = 0; nt < 4; ++nt) {
            const int n = hh * 64 + nt * 16 + r16;
            au[nt] = (f32x4_t){0.f, 0.f, 0.f, 0.f}; aA[nt] = (f32x4_t){0.f, 0.f, 0.f, 0.f};
#pragma unroll
            for (int ks = 0; ks < 2; ++ks) {
              const bf16x8_t bw = *(const bf16x8_t*)(wl + n * WST + 32 * ks + 8 * kq), ba = *(const bf16x8_t*)(al + n * WST + 32 * ks + 8 * kq);
              au[nt] = __builtin_amdgcn_mfma_f32_16x16x32_bf16(at[ks], bw, au[nt], 0, 0, 0);
              aA[nt] = __builtin_amdgcn_mfma_f32_16x16x32_bf16(aa_[ks], ba, aA[nt], 0, 0, 0);
            }
          }
          float kkv[4][4], av[4][4], dec[4][4], ssq[4] = {0.f, 0.f, 0.f, 0.f};
#pragma unroll
          for (int nt = 0; nt < 4; ++nt) {
#pragma unroll
            for (int r = 0; r < 4; ++r) {
              const float nu = -(cst[hh * 64 + nt * 16 + r16] + au[nt][r]);
              const float sp = fmaxf(nu, 0.f) + __logf(1.f + __expf(-fabsf(nu)));
              dec[nt][r] = __expf(-__expf(-sp - 0.5f));
              av[nt][r] = 1.f / (1.f + __expf(-(cst[256 + hh * 64 + nt * 16 + r16] + aA[nt][r])));
              kkv[nt][r] = kraw[hh][nt][r] * cst[512 + hh * 64 + nt * 16 + r16];
              ssq[r] += kkv[nt][r] * kkv[nt][r];
            }
          }
#pragma unroll
          for (int r = 0; r < 4; ++r) ssq[r] = 1.f / fmaxf(sqrtf(rw::dpp_sum16(ssq[r])), 1e-12f);
          if (kq < 3) {
#pragma unroll
            for (int nt = 0; nt < 4; ++nt) {
              const int c = hh * 64 + nt * 16 + r16;
#pragma unroll
              for (int r = 0; r < 4; ++r) {
                if (4 * kq + r < GT) {
                  const size_t o = (size_t)(row_base + 4 * kq + r) * 256 + c;
                  const float kk = kkv[nt][r] * ssq[r];
                  ws[W_W + o] = dec[nt][r]; ws[W_KK + o] = kk; ws[W_BB + o] = kk * av[nt][r];
                  ws[W_KF + o] = kraw[hh][nt][r] * (1.f + (av[nt][r] - 1.f) * cst[768 + c]);
                }
              }
            }
          }
        }
      }
#if PROF_SEL == 151
      asm volatile("s_waitcnt vmcnt(0)" ::: "memory"); acc_t_ += __builtin_amdgcn_s_memrealtime() - t1_;
#endif
#if PROF_SEL == 150 || PROF_SEL == 151
      if (blockIdx.x == 0 && tid == 0) { ((unsigned long long*)(p.ws + W_TS))[0] = 0; ((unsigned long long*)(p.ws + W_TS))[1] = acc_t_; }
#endif
    }
  }
  }
  xcd_barrier(xbar);
  PROF_STAMP(3);
  { PH_IDS

  {
    unsigned* dctr = (unsigned*)(p.ws + W_CTL) + 2;
    const unsigned nd = gridDim.x - NSCAN;
#if PROF_SEL >= 160 && PROF_SEL <= 163
    if ((int)blockIdx.x == NSCAN + (PROF_SEL >= 162 ? 100 : 0) && mk_tid(wid_s) == 0) ((unsigned long long*)(p.ws + W_TS))[0] = __builtin_amdgcn_s_memrealtime();
#endif
    if ((int)blockIdx.x >= NSCAN) {
      const float QSC = MLA_SCALE * 1.4426950408889634f;
      const int G = (int)gridDim.x - NSCAN, bx = (int)blockIdx.x - NSCAN;
      {
        pg8::Gemm g{wb + B_CQN, wb + B_WUQ, NT, 768, 256}; pg8::StaticOrder S; S.init(NT, 768, G, bx);
        pg8::EpiQ E{wb + B_QP, wb + B_QS, ws + W_CS, QSC, NP};
        pg8::gemm_phase<pg8::EpiQ, pg8::StaticOrder, true, true>((PG8_LAS unsigned char*)lds, g, S, E, wid_s);
      }
      {
        bf16* Qs = wb + B_QS;
        auto f = [=](int row, int col) -> bf16* { return Qs + ((size_t)row * 8 + (col >> 7)) * 160 + (col & 127); };
        pg8::Gemm g{wb + B_CQN + (size_t)NP * 256, wb + B_WQL, NS, 1024, 256}; pg8::StaticOrder S; S.init(NS, 1024, G, (bx + G - 204 % G) % G);
        pg8::EpiBf16F<decltype(f)> E{f, QSC};
        pg8::gemm_phase<pg8::EpiBf16F<decltype(f)>, pg8::StaticOrder, true, true>((PG8_LAS unsigned char*)lds, g, S, E, wid_s);
      }
      {
        bf16* Kp = wb + B_KP;
        auto f = [=](int row, int col) -> bf16* { return Kp + (size_t)row * 768 + (col >> 6) * 96 + (col & 63); };
        pg8::Gemm g{wb + B_CKVN, wb + B_WUK, NP, 512, 128}; pg8::StaticOrder S; S.init(NP, 512, G, (bx + G - 220 % G) % G);
        pg8::EpiBf16F<decltype(f)> E{f, 1.f};
        pg8::gemm_phase<pg8::EpiBf16F<decltype(f)>, pg8::StaticOrder, true, true>((PG8_LAS unsigned char*)lds, g, S, E, wid_s);
      }
      {
        bf16* Vt = wb + B_VT;
        auto f = [=](int row, int col) -> bf16* { return Vt + (size_t)row * NP + col; };
        pg8::Gemm g{wb + B_WUV, wb + B_CKVN, 512, NP, 128}; pg8::StaticOrder S; S.init(512, NP, G, (bx + G - 124 % G) % G);
        pg8::EpiBf16F<decltype(f)> E{f, 1.f};
        pg8::gemm_phase<pg8::EpiBf16F<decltype(f)>, pg8::StaticOrder, true, true>((PG8_LAS unsigned char*)lds, g, S, E, wid_s);
      }
      asm volatile("s_waitcnt vmcnt(0)" ::: "memory");
      __syncthreads();
#if PROF_SEL == 160 || PROF_SEL == 162
      if ((int)blockIdx.x == NSCAN + (PROF_SEL >= 162 ? 100 : 0) && mk_tid(wid_s) == 0) ((unsigned long long*)(p.ws + W_TS))[1] = __builtin_amdgcn_s_memrealtime();
#endif
      if (mk_tid(wid_s) == 0) { __builtin_amdgcn_fence(__ATOMIC_RELEASE, "agent"); asm volatile("s_waitcnt vmcnt(0)" ::: "memory"); __hip_atomic_fetch_add(dctr, 1u, __ATOMIC_RELAXED, __HIP_MEMORY_SCOPE_AGENT); }
    }
  }
  }
  { PH_IDS

  {
    unsigned* qctr = (unsigned*)(p.ws + W_CTL);
    volatile unsigned* qslot = (volatile unsigned*)(lds + LDS_BYTES - 16);
    constexpr int Q_RW = 96, Q_SA = 256, Q_PA = 512, Q_MA = 256, Q_RS = 512, Q_MS = 128, Q_TOT = Q_RW + Q_SA + Q_PA + Q_MA + Q_RS + Q_MS;
#if PROF_SEL >= 100 && PROF_SEL < 110
    int prof_prev_ = -1;
#endif
#if PROF_SEL >= 110 && PROF_SEL <= 116
    if (blockIdx.x == 0 && tid == 0) ((unsigned long long*)(p.ws + W_TS))[0] = __builtin_amdgcn_s_memrealtime();
#endif
    bool d_ready = false;
    for (;;) {
      if (tid == 0) *qslot = atomicAdd(qctr, 1u);
      __syncthreads();
      int item = (int)*qslot;
      __syncthreads();
      item = __builtin_amdgcn_readfirstlane(item);
#if PROF_SEL >= 100 && PROF_SEL < 110
      { constexpr int probe_items[8] = {0, 32, 34, 32 + 767, 32 + 765, 800, 1056, 1056 + 512};
        static unsigned long long* const dummy_ = nullptr; (void)dummy_;
        unsigned long long* ts_ = (unsigned long long*)(p.ws + W_TS);
        if (tid == 0 && item == probe_items[PROF_SEL - 100] + 1 + 100000) ts_[1] = 0;
        if (tid == 0) { if (prof_prev_ == probe_items[PROF_SEL - 100]) ts_[1] = __builtin_amdgcn_s_memrealtime(); if (item == probe_items[PROF_SEL - 100]) ts_[0] = __builtin_amdgcn_s_memrealtime(); }
        prof_prev_ = item; }
#endif
#if PROF_SEL >= 112 && PROF_SEL <= 116
      { constexpr int marks[5] = {Q_RW + Q_SA, Q_RW + Q_SA + 256, Q_RW + Q_SA + Q_PA, Q_RW + Q_SA + Q_PA + Q_MA, Q_RW + Q_SA + Q_PA + Q_MA + 64};
        if (tid == 0 && item == marks[PROF_SEL - 112]) ((unsigned long long*)(p.ws + W_TS))[1] = __builtin_amdgcn_s_memrealtime(); }
#endif
#if PROF_SEL == 110
      if (item >= Q_TOT && blockIdx.x == 0 && tid == 0) ((unsigned long long*)(p.ws + W_TS))[1] = __builtin_amdgcn_s_memrealtime();
#endif
#if PROF_SEL == 111
      if (item >= Q_TOT && tid == 0) { ((unsigned long long*)(p.ws + W_TS))[1] = __builtin_amdgcn_s_memrealtime(); }
#endif
      if (item >= Q_TOT) break;
      if (item < Q_RW) { rw::rwkv_prompt_item(lds, p, item, wid_s); continue; }
      if (!d_ready) {
        unsigned* dctr = (unsigned*)(p.ws + W_CTL) + 2; const unsigned nd = gridDim.x - NSCAN;
        if (tid == 0) { while (__hip_atomic_load(dctr, __ATOMIC_RELAXED, __HIP_MEMORY_SCOPE_AGENT) < nd) __builtin_amdgcn_s_sleep(8); }
        __syncthreads();
        __builtin_amdgcn_fence(__ATOMIC_ACQUIRE, "agent");
        d_ready = true;
#if PROF_SEL == 161 || PROF_SEL == 163
        if ((int)blockIdx.x == NSCAN + (PROF_SEL >= 162 ? 100 : 0) && tid == 0) ((unsigned long long*)(p.ws + W_TS))[1] = __builtin_amdgcn_s_memrealtime();
#endif
      }
      item -= Q_RW;
      if (item < Q_SA + Q_PA) {
        const int grp = item / 3, sub3 = item - grp * 3;
        if (sub3 == 2) { sa::sample_attn_item(lds, p, wb + B_QS, ws + W_PO, ws + W_PML, grp, wid_s); continue; }
        item = grp * 2 + sub3;
        const int bh = item & 31, qb = 15 - (item >> 5);
        const int b = bh >> 3, h = bh & 7;
        const size_t row0 = (size_t)b * SEQ + 256 * qb;
        auto out = [&](int ql, int dv0, float4 v) {
          const size_t row = row0 + ql;
          const float4 g = pj4(wb + B_PROJ, row, C_GMLA + h * 64 + dv0);
          *(uint2*)(wb + B_MIX + row * 1024 + h * 64 + dv0) = make_uint2(pk2(v.x * silu(g.x), v.y * silu(g.y)), pk2(v.z * silu(g.z), v.w * silu(g.w)));
        };
        pa::attn_unit<96, true>(lds, wb + B_QP + row0 * 768 + h * 96, 768, wb + B_KP + (size_t)b * SEQ * 768 + h * 96, 768,
                                wb + B_VT + (size_t)(h * 64) * NP + (size_t)b * SEQ, NP, 4 * qb + 4, 256 * qb, out, wid_s);
        continue;
      }
      item -= Q_SA + Q_PA;
      if (item >= Q_MA) {
        item -= Q_MA;
        if (item < Q_RS) rw::rwkv_sample_item(lds, p, item, wid_s);
        else { ma::mem_sample_item(lds, p, item - Q_RS, wid_s); }
        continue;
      }
      {
        const int qb = item & 15, h = (item >> 4) & 3, b = item >> 6;
        const size_t row0 = (size_t)b * SEQ + 256 * qb;
        auto out = [&](int ql, int dv0, float4 v) {
          const size_t row = row0 + ql;
          const float4 g = pj4(wb + B_PROJ, row, C_GX + h * 64 + dv0);
          *(uint2*)(wb + B_MIX + row * 1024 + 768 + h * 64 + dv0) = make_uint2(pk2(v.x * silu(g.x), v.y * silu(g.y)), pk2(v.z * silu(g.z), v.w * silu(g.w)));
        };
        pa::attn_unit<64, false>(lds, wb + B_QX + row0 * 256 + h * 64, 256, wb + B_KM + (size_t)b * 65536 + h * 64, 256,
                                 wb + B_VMT + (size_t)b * 65536 + (size_t)(h * 64) * 256, 256, 4, 0, out, wid_s);
      }
    }
    __syncthreads();
  }
  }
  xcd_barrier(xbar);
  PROF_STAMP(4);
  { PH_IDS

  constexpr int NGB = 16;
  {
    for (int task = gw; task < 16 * 64; task += NGW) {
      const int bh = task >> 6, v = task & 63;
      const float spv = ws[W_SMID + ((size_t)bh * 64 + v) * 64 + lane];
      const float* ep_ = ws + W_EST + (size_t)bh * 4096 + lane;
      float acc = ws[W_QST + ((size_t)bh * 64 + v) * 64 + lane];
      float e_[64];
#pragma unroll
      for (int j = 0; j < 64; ++j) e_[j] = ep_[j * 64];
#pragma unroll
      for (int j = 0; j < 64; ++j) acc += __int_as_float(__builtin_amdgcn_readlane(__float_as_int(spv), j)) * e_[j];
      p.out[O_WKVP + ((size_t)bh * 64 + v) * 64 + lane] = acc;
    }
    struct GIn { float y, rr, kf, vv; unsigned short g; };
    float lg4[4], lb4[4], rk4[4];
#pragma unroll
    for (int hh = 0; hh < 4; ++hh) { lg4[hh] = p.lnx_g[hh * 64 + lane]; lb4[hh] = p.lnx_b[hh * 64 + lane]; rk4[hh] = p.r_k[hh * 64 + lane]; }
    auto finish = [&](const GIn& T, float y, int row, int h) {
      const float lg = h == 0 ? lg4[0] : h == 1 ? lg4[1] : h == 2 ? lg4[2] : lg4[3];
      const float lb = h == 0 ? lb4[0] : h == 1 ? lb4[1] : h == 2 ? lb4[2] : lb4[3];
      const float rk = h == 0 ? rk4[0] : h == 1 ? rk4[1] : h == 2 ? rk4[2] : rk4[3];
      const float mean = wave_sum_fast(y) * (1.f / 64.f), d = y - mean, var = wave_sum_fast(d * d) * (1.f / 64.f);
      const float yn = d * rsqrtf(var + GN_EPS) * lg + lb;
      const float bsum = wave_sum_fast(T.rr * T.kf * rk);
      const float o = yn + bsum * T.vv;
      wb[B_MIX + (size_t)row * 1024 + 512 + h * 64 + lane] = (bf16)f2bf(o * silu(bf2f(T.g)));
    };
    auto g_load = [&](int row, int h, GIn& T) {
      const size_t off = (size_t)row * 256 + h * 64 + lane;
      T.y = ws[W_Y + off]; T.rr = ws[W_R + off]; T.kf = ws[W_KF + off]; T.vv = ws[W_VV + off];
      T.g = wb[B_PROJ + (size_t)row * INC + C_GRWKV + h * 64 + lane];
    };
    if ((int)blockIdx.x >= NGB) {
      const int gwg = gw - NGB * 8, nwg = NGW - NGB * 8;
      {
        const int n1 = BATCH * SEG1 * 4;
        auto rh = [&](int it, int& row, int& h) { const int b = it / (SEG1 * 4), r = it - b * (SEG1 * 4); row = b * SEQ + (r >> 2); h = r & 3; };
        int it = gwg; GIn cur; int row, h;
        if (it < n1) { rh(it, row, h); g_load(row, h, cur); }
        for (; it < n1; it += nwg) {
          GIn nxt; int nrow = row, nh = h;
          if (it + nwg < n1) rh(it + nwg, nrow, nh);
          g_load(nrow, nh, nxt);
          finish(cur, cur.y, row, h);
          cur = nxt; row = nrow; h = nh;
        }
      }
      {
        const int n2 = 16 * SEG2, per = (n2 + nwg - 1) / nwg;
        const int i0 = gwg * per, i1 = (i0 + per < n2) ? i0 + per : n2;
        float sm_[64]; int cur_bh = -1;
        typedef float f32x4_t __attribute__((ext_vector_type(4)));
        struct G2 { GIn t; f32x4_t u[16]; };
        auto g2_load = [&](int i, G2& T) {
          const int bh = i / SEG2, t2 = i - bh * SEG2;
          g_load((bh >> 2) * SEQ + SEG1 + t2, bh & 3, T.t);
          const f32x4_t* yu = (const f32x4_t*)(ws + W_YU + ((size_t)bh * SEG2 + t2) * 64);
#pragma unroll
          for (int j4 = 0; j4 < 16; ++j4) T.u[j4] = yu[j4];
        };
        G2 cur;
        if (i0 < i1) g2_load(i0, cur);
        for (int i = i0; i < i1; ++i) {
          G2 nxt; g2_load(i + 1 < i1 ? i + 1 : i, nxt);
          const int bh = i / SEG2, t2 = i - bh * SEG2, b = bh >> 2, h = bh & 3;
          if (bh != cur_bh) {
            const float* sp_ = ws + W_SMID + ((size_t)bh * 64 + lane) * 64;
#pragma unroll
            for (int j4 = 0; j4 < 16; ++j4) { const float4 v4 = *(const float4*)(sp_ + 4 * j4); sm_[4 * j4] = v4.x; sm_[4 * j4 + 1] = v4.y; sm_[4 * j4 + 2] = v4.z; sm_[4 * j4 + 3] = v4.w; }
            cur_bh = bh;
          }
          float acc = 0.f;
#pragma unroll
          for (int j4 = 0; j4 < 16; ++j4) acc += (sm_[4 * j4] * cur.u[j4].x + sm_[4 * j4 + 1] * cur.u[j4].y) + (sm_[4 * j4 + 2] * cur.u[j4].z + sm_[4 * j4 + 3] * cur.u[j4].w);
          finish(cur.t, cur.t.y + acc, b * SEQ + SEG1 + t2, h);
          cur = nxt;
        }
      }
    }
  }
  {
    pg8::Gemm g{wb + B_MIX + (size_t)NP * 1024, wb + B_WOUT, NS, 1024, 1024}; pg8::StaticOrder S; S.init(NS, 1024, (int)gridDim.x, (int)blockIdx.x);
    pg8::EpiRmsOut E{p.x_sample, p.out + O_YS, p.final_g, ws + W_PML, (unsigned*)(ws + W_CTL) + 8, RMS_EPS};
    pg8::gemm_phase<pg8::EpiRmsOut, pg8::StaticOrder, false, true>((PG8_LAS unsigned char*)lds, g, S, E, wid_s);
  }
  }
  xcd_barrier(xbar);
  PROF_STAMP(5);
  { PH_IDS
  {
    pg8::Gemm g{wb + B_MIX, wb + B_WOUT, NP, 1024, 1024}; pg8::StaticOrder S; S.init(NP, 1024, (int)gridDim.x, (int)blockIdx.x);
    pg8::EpiRmsOut E{p.x_prompt, p.out, p.final_g, ws + W_XB, (unsigned*)(ws + W_CTL) + 192, RMS_EPS};
    pg8::gemm_phase<pg8::EpiRmsOut, pg8::StaticOrder, false, true>((PG8_LAS unsigned char*)lds, g, S, E, wid_s);
  }
#if PROF_SEL >= 0
  xcd_barrier(xbar);
  PROF_STAMP(6);
#endif
#if PROF_SEL >= 0
    if (blockIdx.x == 0 && tid == 0) {
      unsigned long long* ts_ = (unsigned long long*)(p.ws + W_TS);
      asm volatile("s_waitcnt vmcnt(0) lgkmcnt(0)" ::: "memory");
      __builtin_amdgcn_fence(__ATOMIC_ACQUIRE, "agent");
      const float us_ = (float)(ts_[1] - ts_[0]) * 0.01f;
      p.out[0] += us_ * 0.01f;
    }
#endif
  }
#undef PH_IDS
}

extern "C" void kernel_launch(void* const* d_in, const int* in_sizes, int n_in, void* d_out,
                              int out_size, void* d_ws, size_t ws_size, hipStream_t stream) {
  static int grid_blocks = 0;
  if (!grid_blocks) {
    int dev = 0, cus = 0, per_cu = 0;
    (void)hipGetDevice(&dev);
    (void)hipDeviceGetAttribute(&cus, hipDeviceAttributeMultiprocessorCount, dev);
    (void)hipFuncSetAttribute((const void*)fwd_megakernel, hipFuncAttributeMaxDynamicSharedMemorySize, LDS_BYTES);
    (void)hipOccupancyMaxActiveBlocksPerMultiprocessor(&per_cu, fwd_megakernel, 512, LDS_BYTES);
    if (per_cu < 1) per_cu = 1;
    grid_blocks = 256;
    if (cus < 256) fprintf(stderr, "this kernel needs 256 CUs (device has %d)\n", cus);
    if (ws_size < WS_BYTES) fprintf(stderr, "workspace too small: %zu < %zu\n", ws_size, (size_t)WS_BYTES);
  }
  Params p{};
  const float** pf = (const float**)&p;
  (void)pf;
  p.x_prompt = (const float*)d_in[0]; p.x_sample = (const float*)d_in[1]; p.mem_prompt = (const float*)d_in[2];
  p.cache_ckv = (const float*)d_in[3]; p.cache_kpe = (const float*)d_in[4]; p.page_table = (const int*)d_in[5];
  p.state_wkv = (const float*)d_in[6]; p.state_shift = (const float*)d_in[7]; p.cache_mem_k = (const float*)d_in[8];
  p.cache_mem_v = (const float*)d_in[9]; p.ln_g = (const float*)d_in[10]; p.w_in = (const float*)d_in[11];
  p.q_norm_g = (const float*)d_in[12]; p.kv_norm_g = (const float*)d_in[13]; p.w_uq = (const float*)d_in[14];
  p.w_uk = (const float*)d_in[15]; p.w_uv = (const float*)d_in[16]; p.shift_mu = (const float*)d_in[17];
  p.w0 = (const float*)d_in[18]; p.w_up = (const float*)d_in[19]; p.a0 = (const float*)d_in[20]; p.a_up = (const float*)d_in[21];
  p.k_k = (const float*)d_in[22]; p.k_a = (const float*)d_in[23]; p.r_k = (const float*)d_in[24]; p.lnx_g = (const float*)d_in[25];
  p.lnx_b = (const float*)d_in[26]; p.mem_norm_g = (const float*)d_in[27]; p.w_mem_kv = (const float*)d_in[28];
  p.w_out = (const float*)d_in[29]; p.final_g = (const float*)d_in[30];
  p.out = (float*)d_out; p.ws = (float*)d_ws;
  (void)hipMemsetAsync((char*)d_ws + W_BAR * sizeof(float), 0, 3456 * sizeof(unsigned), stream);
  void* args[] = {&p};
  hipError_t e = hipLaunchCooperativeKernel((void*)fwd_megakernel, dim3(grid_blocks), dim3(512), args, LDS_BYTES, stream);
  if (e != hipSuccess) fprintf(stderr, "cooperative launch failed: %s (grid %d)\n", hipGetErrorString(e), grid_blocks);
}
```
